# Optimizing an MI355X kernel written in HIP

```python
import jax, jax.numpy as jnp
from jax import lax
import numpy as np

D_MODEL = 2048
BATCH = 2
SEQ = 4096
DEPTH = 1

MEM_LEN = 256
EPS = 1e-6

HG_HEADS = 6
HG_DK = 128
HG_DV = 128
HG_WIDTH = HG_HEADS * HG_DK
HG_CHUNK = 64

DIL_GROUPS = ((128, 1), (512, 4), (2048, 16))
DIL_HEADS_PER_GROUP = 4
DIL_HEADS = DIL_HEADS_PER_GROUP * len(DIL_GROUPS)
DIL_HEAD_DIM = 64
DIL_WIDTH = DIL_HEADS * DIL_HEAD_DIM
DIL_QBLOCK = 128
ALIBI_MAX = 8.0

MEM_HEADS = 4
MEM_HEAD_DIM = 128
MEM_WIDTH = MEM_HEADS * MEM_HEAD_DIM

N_BRANCH = 3
MIX_WIDTH = HG_WIDTH + DIL_WIDTH + MEM_WIDTH
N_IN = 5 * HG_WIDTH + 3 * DIL_WIDTH + MEM_WIDTH + N_BRANCH * D_MODEL

PEER_HEADS = 8
PEER_NKEYS = 128
PEER_N_EXPERTS = PEER_NKEYS * PEER_NKEYS
PEER_HALF = 128
PEER_QDIM = 2 * PEER_HALF
PEER_TOPK = 16
PEER_TBLOCK = 64

kernel_name = "hybrid_hgrn2_dilated_mem_peer_encoder"


def rmsnorm(x, g):
    xf = x.astype(jnp.float32)
    y = xf * lax.rsqrt(jnp.mean(xf * xf, axis=-1, keepdims=True) + EPS)
    return (y * g.astype(jnp.float32)).astype(x.dtype)


def hgrn2_scan(q, k, v, logf):
    B, H, S, dk = q.shape
    dv = v.shape[-1]
    n = S // HG_CHUNK

    def chunks(t):
        return jnp.moveaxis(t.reshape(B, H, n, HG_CHUNK, t.shape[-1]), 2, 0)

    mask = jnp.tril(jnp.ones((HG_CHUNK, HG_CHUNK), dtype=bool))[:, :, None]

    def step(state, inp):
        qc, kc, vc, lf = inp
        b = jnp.cumsum(lf, axis=2)
        o_inter = jnp.einsum('bhtc,bhcv->bhtv', qc * jnp.exp(b), state)
        diff = b[:, :, :, None, :] - b[:, :, None, :, :]
        decay = jnp.exp(jnp.where(mask, diff, -jnp.inf))
        a = jnp.einsum('bhtsc,bhsc->bhts', qc[:, :, :, None, :] * decay, kc)
        o_intra = jnp.einsum('bhts,bhsv->bhtv', a, vc)
        b_last = b[:, :, -1:, :]
        new_state = jnp.exp(b_last[:, :, 0, :])[..., None] * state + jnp.einsum(
            'bhsc,bhsv->bhcv', kc * jnp.exp(b_last - b), vc)
        return new_state, o_inter + o_intra

    init = jnp.zeros((B, H, dk, dv), jnp.float32)
    _, ys = lax.scan(step, init, (chunks(q), chunks(k), chunks(v), chunks(logf)))
    return jnp.moveaxis(ys, 0, 2).reshape(B, H, S, dv)


def dilated_group_attn(q, k, v, slopes, dilation, n_side):
    B, Hg, S, hd = q.shape
    offs = jnp.arange(-n_side, n_side + 1) * dilation
    bias = -slopes[:, None] * jnp.abs(offs).astype(jnp.float32)[None, :]
    scale = hd ** -0.5

    def block(i):
        start = i * DIL_QBLOCK
        qb = lax.dynamic_slice_in_dim(q, start, DIL_QBLOCK, axis=2)
        pos = start + jnp.arange(DIL_QBLOCK)
        idx = pos[:, None] + offs[None, :]
        valid = (idx >= 0) & (idx < S)
        idxc = jnp.clip(idx, 0, S - 1)
        kb = k[:, :, idxc]
        vb = v[:, :, idxc]
        s = jnp.einsum('bhqd,bhqkd->bhqk', qb, kb).astype(jnp.float32) * scale + bias[None, :, None, :]
        s = jnp.where(valid[None, None], s, -1e30)
        lse = jax.nn.logsumexp(s, axis=-1)
        p = jnp.exp(s - lse[..., None]).astype(v.dtype)
        o = jnp.einsum('bhqk,bhqkd->bhqd', p, vb)
        return o, lse

    o, lse = lax.map(block, jnp.arange(S // DIL_QBLOCK))
    o = jnp.moveaxis(o, 0, 2).reshape(B, Hg, S, hd)
    lse = jnp.moveaxis(lse, 0, 2).reshape(B, Hg, S)
    return o, lse


def token_mixer(h, mem_n, w_in, b_gate, lb_f, lb_b, g_hg, w_mem_kv, w_up, w_out):
    B, S, D = h.shape
    f32 = jnp.float32
    sizes = [HG_WIDTH] * 5 + [DIL_WIDTH] * 3 + [MEM_WIDTH] + [D_MODEL] * N_BRANCH
    cuts = np.cumsum(sizes)[:-1].tolist()
    proj = h @ w_in
    (hq, hi, hff, hfb, hgate, dq, dk, dv, mq, gate_cols) = (
        *jnp.split(proj, cuts[:9], axis=-1)[:9], proj[..., cuts[8]:])

    def heads(t, nh, d):
        return t.reshape(B, S, nh, d).transpose(0, 2, 1, 3)

    def forget(z, lb):
        f = lb + (1.0 - lb) * jax.nn.sigmoid(z.astype(f32))
        return heads(1.0 - f, HG_HEADS, HG_DK), heads(jnp.log(f), HG_HEADS, HG_DK)

    q_hg = heads(hq.astype(f32), HG_HEADS, HG_DK)
    v_hg = heads(hi.astype(f32), HG_HEADS, HG_DV)
    k_f, logf_f = forget(hff, lb_f)
    k_b, logf_b = forget(hfb, lb_b)
    o_fwd = hgrn2_scan(q_hg, k_f, v_hg, logf_f)
    flip = lambda t: jnp.flip(t, axis=2)
    o_bwd = flip(hgrn2_scan(flip(q_hg), flip(k_b), flip(v_hg), flip(logf_b)))
    o_hg = o_fwd + o_bwd
    o_hg = o_hg * lax.rsqrt(jnp.mean(o_hg * o_hg, axis=-1, keepdims=True) + EPS) * g_hg.astype(f32)
    o_hg = o_hg.transpose(0, 2, 1, 3).reshape(B, S, HG_WIDTH)
    o_hg = (o_hg * jax.nn.silu(hgate.astype(f32))).astype(h.dtype)

    dq = heads(dq, DIL_HEADS, DIL_HEAD_DIM)
    dk = heads(dk, DIL_HEADS, DIL_HEAD_DIM)
    dv = heads(dv, DIL_HEADS, DIL_HEAD_DIM)
    slopes = jnp.exp2(-ALIBI_MAX * jnp.arange(1, DIL_HEADS + 1, dtype=f32) / DIL_HEADS)
    outs, lses = [], []
    for gi, (window, dil) in enumerate(DIL_GROUPS):
        sl = slice(gi * DIL_HEADS_PER_GROUP, (gi + 1) * DIL_HEADS_PER_GROUP)
        n_side = (window // 2) // dil
        o_g, lse_g = dilated_group_attn(dq[:, sl], dk[:, sl], dv[:, sl], slopes[sl], dil, n_side)
        outs.append(o_g)
        lses.append(lse_g)
    alpha = jax.nn.softmax(jnp.stack(lses, axis=0), axis=0)
    o_dil = jnp.concatenate(
        [alpha[gi][..., None].astype(h.dtype) * outs[gi] for gi in range(len(DIL_GROUPS))], axis=1)
    o_dil = o_dil.transpose(0, 2, 1, 3).reshape(B, S, DIL_WIDTH)

    q_m = heads(mq, MEM_HEADS, MEM_HEAD_DIM)
    kv = mem_n @ w_mem_kv
    M = kv.shape[1]
    k_m = kv[..., :MEM_WIDTH].reshape(B, M, MEM_HEADS, MEM_HEAD_DIM).transpose(0, 2, 1, 3)
    v_m = kv[..., MEM_WIDTH:].reshape(B, M, MEM_HEADS, MEM_HEAD_DIM).transpose(0, 2, 1, 3)
    s_m = jnp.einsum('bhqd,bhkd->bhqk', q_m, k_m).astype(f32) * (MEM_HEAD_DIM ** -0.5)
    p_m = jax.nn.softmax(s_m, axis=-1).astype(v_m.dtype)
    o_mem = jnp.einsum('bhqk,bhkd->bhqd', p_m, v_m).transpose(0, 2, 1, 3).reshape(B, S, MEM_WIDTH)

    gates = jax.nn.sigmoid((gate_cols + b_gate).astype(f32)).reshape(B, S, N_BRANCH, D).astype(h.dtype)
    w_up_hg, w_up_dil, w_up_mem = jnp.split(w_up, [HG_WIDTH, HG_WIDTH + DIL_WIDTH], axis=0)
    merged = (gates[:, :, 0] * (o_hg @ w_up_hg)
              + gates[:, :, 1] * (o_dil @ w_up_dil)
              + gates[:, :, 2] * (o_mem @ w_up_mem))
    return merged @ w_out


def peer_ffn(h, w_q, sub_keys, expert_u, expert_v):
    B, S, D = h.shape
    T = B * S
    xt = h.reshape(T, D)
    q = (xt @ w_q).reshape(T, PEER_HEADS, 2, PEER_HALF)
    s = jnp.einsum('thpc,pnc->thpn', q, sub_keys).astype(jnp.float32)
    top_s, top_i = lax.top_k(s, PEER_TOPK)
    cand_s = top_s[:, :, 0, :, None] + top_s[:, :, 1, None, :]
    cand_i = top_i[:, :, 0, :, None] * PEER_NKEYS + top_i[:, :, 1, None, :]
    kk = PEER_TOPK * PEER_TOPK
    best_s, best_pos = lax.top_k(cand_s.reshape(T, PEER_HEADS, kk), PEER_TOPK)
    expert_idx = jnp.take_along_axis(cand_i.reshape(T, PEER_HEADS, kk), best_pos, axis=-1)
    gate = jax.nn.softmax(best_s, axis=-1).astype(h.dtype)
    nb = T // PEER_TBLOCK
    n_sel = PEER_HEADS * PEER_TOPK
    xb = xt.reshape(nb, PEER_TBLOCK, D)
    ib = expert_idx.reshape(nb, PEER_TBLOCK, n_sel)
    gb = gate.reshape(nb, PEER_TBLOCK, n_sel)

    def block(args):
        xs, idx, g = args
        u_sel = expert_u[idx]
        a = jnp.einsum('tkd,td->tk', u_sel, xs)
        hid = jax.nn.gelu(a, approximate=False) * g
        return jnp.einsum('tk,tkd->td', hid, expert_v[idx])

    out = lax.map(block, (xb, ib, gb))
    return out.reshape(B, S, D)


def setup_inputs(seed: int = 0) -> dict:
    key = jax.random.key(seed)
    ks = jax.random.split(key, 20)
    f32 = jnp.float32

    def nrm(k, shape, scale):
        return jax.random.normal(k, shape, f32) * scale

    D = D_MODEL
    return {
        "x": nrm(ks[0], (BATCH, SEQ, D), 1.0),
        "mem": nrm(ks[1], (BATCH, MEM_LEN, D), 1.0),
        "g_mix": 1.0 + nrm(ks[2], (DEPTH, D), 0.02),
        "w_in": nrm(ks[3], (DEPTH, D, N_IN), D ** -0.5),
        "b_gate": nrm(ks[4], (DEPTH, N_BRANCH * D), 0.02),
        "lb_fwd_logits": nrm(ks[5], (DEPTH + 1, HG_WIDTH), 0.1),
        "lb_bwd_logits": nrm(ks[6], (DEPTH + 1, HG_WIDTH), 0.1),
        "g_hgrn": 1.0 + nrm(ks[7], (DEPTH, HG_DV), 0.02),
        "w_mem_kv": nrm(ks[8], (DEPTH, D, 2 * MEM_WIDTH), D ** -0.5),
        "g_mem": 1.0 + nrm(ks[9], (DEPTH, D), 0.02),
        "w_up": nrm(ks[10], (DEPTH, MIX_WIDTH, D), MIX_WIDTH ** -0.5),
        "w_out": nrm(ks[11], (DEPTH, D, D), D ** -0.5),
        "g_ffn": 1.0 + nrm(ks[12], (DEPTH, D), 0.02),
        "w_peer_q": nrm(ks[13], (DEPTH, D, PEER_HEADS * PEER_QDIM), D ** -0.5),
        "peer_sub_keys": nrm(ks[14], (DEPTH, 2, PEER_NKEYS, PEER_HALF), PEER_HALF ** -0.5),
        "peer_u": nrm(ks[15], (DEPTH, PEER_N_EXPERTS, D), D ** -0.5),
        "peer_v": nrm(ks[16], (DEPTH, PEER_N_EXPERTS, D), 0.5),
        "g_final": 1.0 + nrm(ks[17], (D,), 0.02),
    }


def reference(x, mem, g_mix, w_in, b_gate, lb_fwd_logits, lb_bwd_logits, g_hgrn, w_mem_kv, g_mem,
              w_up, w_out, g_ffn, w_peer_q, peer_sub_keys, peer_u, peer_v, g_final):
    lb_f_all = jnp.cumsum(jax.nn.softmax(lb_fwd_logits.astype(jnp.float32), axis=0), axis=0)
    lb_b_all = jnp.cumsum(jax.nn.softmax(lb_bwd_logits.astype(jnp.float32), axis=0), axis=0)
    for l in range(DEPTH):
        h = rmsnorm(x, g_mix[l])
        mem_n = rmsnorm(mem, g_mem[l])
        x = x + token_mixer(h, mem_n, w_in[l], b_gate[l], lb_f_all[l], lb_b_all[l], g_hgrn[l],
                            w_mem_kv[l], w_up[l], w_out[l])
        x = x + peer_ffn(rmsnorm(x, g_ffn[l]), w_peer_q[l], peer_sub_keys[l], peer_u[l], peer_v[l])
    return rmsnorm(x, g_final)
```

```cpp
#include <hip/hip_runtime.h>
#include <hip/hip_cooperative_groups.h>
#include <cstdio>
#include <cstdint>
namespace cg = cooperative_groups;
namespace pg8 {
#define PG8_LAS __attribute__((address_space(3)))
typedef unsigned short bf16_t;
typedef short bf16x8 __attribute__((ext_vector_type(8)));
typedef float f32x4 __attribute__((ext_vector_type(4)));
typedef unsigned u32x4 __attribute__((ext_vector_type(4)));
constexpr int BM = 256, BK = 64, HALF = 128, HTB = HALF * BK * 2  , STAGE_BYTES = 8 * HTB, NXCD = 8, WGM = 8;

__host__ __device__ __forceinline__ int lds_byte(int r, int c) { const int st = (r >> 4) * 2 + (c >> 5), rr = r & 15, cc = c & 31, ob = rr * 64 + cc * 2; return st * 1024 + (ob ^ (((ob >> 9) & 1) << 5)); }
__host__ __device__ __forceinline__ void stage_rc(int b, int& R, int& C) { const int st = b / 1024, sb = b % 1024, swz = sb ^ (((sb >> 9) & 1) << 5); R = (st >> 1) * 16 + swz / 64; C = (st & 1) * 32 + (swz % 64) / 2; }
__host__ __device__ __forceinline__ int perm32(int rho) { const int n = rho >> 4, i = rho & 15; return 8 * (i >> 2) + 4 * n + (i & 3); }

struct Unit { int pm, pn; };
struct Gemm { const bf16_t* A; const bf16_t* Bt; int M, N, K, lda, ldb; };

struct StaticOrder {
    int nM, nN, nwg, G, c;
    __host__ __device__ void init(int M, int N, int G_, int c_) { nM = M / BM; nN = N / BM; nwg = nM * nN; G = G_; c = c_; }
    __host__ __device__ bool next(int i, Unit& u) const {
        const long L = (long)i * G + c; if (L >= nwg) return false;
        int wgid = (int)L; { const int q = nwg / NXCD, r = nwg % NXCD, xcd = wgid % NXCD, off = wgid / NXCD; wgid = (xcd < r ? xcd * (q + 1) : r * (q + 1) + (xcd - r) * q) + off; }
        const int nig = WGM * nN, gid = wgid / nig, fm = gid * WGM, gsz = (nM - fm) < WGM ? (nM - fm) : WGM;
        u.pm = fm + ((wgid % nig) % gsz); u.pn = (wgid % nig) / gsz; return true;
    }
    __device__ __forceinline__ void a_ready(const Unit&) const {}
    __device__ __forceinline__ void done(const Unit&) const {}
};

__device__ __forceinline__ unsigned cvt_pk_bf16(float lo, float hi) { unsigned r; asm volatile("v_cvt_pk_bf16_f32 %0, %1, %2" : "=v"(r) : "v"(lo), "v"(hi)); return r; }
typedef float f32x2 __attribute__((ext_vector_type(2)));
__device__ __forceinline__ f32x2 gelu_pk(f32x2 v) {
    const f32x2 av = __builtin_elementwise_abs(v), d = av * 0.2316418882f + 1.0f;
    f32x2 t; t.x = __builtin_amdgcn_rcpf(d.x); t.y = __builtin_amdgcn_rcpf(d.y);
    f32x2 q = t * 0.5307027145f + (-0.7265760135f); q = q * t + 0.7107068705f; q = q * t + (-0.142248368f); q = q * t + 0.127414796f; q = q * t;
    const f32x2 s = (v * v) * (-0.72134752044f);
    f32x2 e; e.x = __builtin_amdgcn_exp2f(s.x); e.y = __builtin_amdgcn_exp2f(s.y);
    const f32x2 m = v * (q * e), r = v - m;
    f32x2 o; o.x = v.x < 0.f ? m.x : r.x; o.y = v.y < 0.f ? m.y : r.y; return o;
}

template <int ACT  > struct EpiBf16 {
    static constexpr bool PERM = true, AFTER_DRAIN = false; static_assert(ACT == 0 || ACT == 1, "EpiBf16: ACT is 0 (none) or 1 (gelu_pk)");
    bf16_t* O; int ldc; const float* bias; int split_cols; size_t split_stride; float scale0;
    __device__ __forceinline__ void operator()(const f32x4 (&acc)[2][2][4][2], const Unit& u, int wr, int wc, int fr, int fq) const {
        const int row0 = u.pm * BM + wr * 64 + fr; int colt = u.pn * BM; bf16_t* base = O;
        float sc = 1.f; if (split_cols) { const int t = colt / split_cols; base += (size_t)t * split_stride; colt -= t * split_cols; if (t == 0) sc = scale0; }
        const int col0 = colt + wc * 32 + 8 * fq, bcol0 = u.pn * BM + wc * 32 + 8 * fq;
        f32x4 bv[2][2];
#pragma unroll
        for (int bj = 0; bj < 2; ++bj)
#pragma unroll
            for (int n = 0; n < 2; ++n) bv[bj][n] = bias ? *(const f32x4*)(bias + bcol0 + bj * HALF + 4 * n) : (f32x4){0.f, 0.f, 0.f, 0.f};
#pragma unroll
        for (int ai = 0; ai < 2; ++ai)
#pragma unroll
            for (int m = 0; m < 4; ++m) { bf16_t* rowp = base + (size_t)(row0 + ai * HALF + m * 16) * ldc + col0;
#pragma unroll
                for (int bj = 0; bj < 2; ++bj) { f32x4 v0 = acc[ai][bj][m][0] + bv[bj][0], v1 = acc[ai][bj][m][1] + bv[bj][1];
                    if (ACT == 1) { f32x2 a = gelu_pk((f32x2){v0[0], v0[1]}), b = gelu_pk((f32x2){v0[2], v0[3]}), c = gelu_pk((f32x2){v1[0], v1[1]}), d = gelu_pk((f32x2){v1[2], v1[3]});
                        v0 = (f32x4){a.x, a.y, b.x, b.y}; v1 = (f32x4){c.x, c.y, d.x, d.y}; }
                    v0 = v0 * sc; v1 = v1 * sc; u32x4 w; w.x = cvt_pk_bf16(v0[0], v0[1]); w.y = cvt_pk_bf16(v0[2], v0[3]); w.z = cvt_pk_bf16(v1[0], v1[1]); w.w = cvt_pk_bf16(v1[2], v1[3]);
                    *(u32x4*)(rowp + bj * HALF) = w; } }
    }
};
template <class Epi, class Sched, bool ALIGN_EPI = false, bool SP2 = false>
__device__ __forceinline__ void gemm_phase(PG8_LAS unsigned char* lds, const Gemm g, const Sched& S, const Epi& E) {
    const int tid = threadIdx.x, wid = __builtin_amdgcn_readfirstlane(tid >> 6), lane = tid & 63, wr = wid >> 2, wc = wid & 3, fr = lane & 15, fq = lane >> 4;
    const int K = g.K, nt = K / BK;
    unsigned voffA[2], voffB[2];
#pragma unroll
    for (int i = 0; i < 2; ++i) { int R, C; stage_rc(tid * 16 + i * 8192, R, C); const int Rb = Epi::PERM ? ((R & ~31) + perm32(R & 31)) : R;
        voffA[i] = (unsigned)(R * g.lda + C) * 2u; voffB[i] = (unsigned)(Rb * g.ldb + C) * 2u; }
    const size_t kstep = (size_t)(BK * 2);
    const size_t hstepA = (size_t)HALF * g.lda * 2, hstepB = (size_t)HALF * g.ldb * 2;
    const size_t tstepA = 2 * hstepA, tstepB = 2 * hstepB;
    const unsigned ldsw = (unsigned)wid * 1024u;
    const int aoff = lds_byte(wr * 64 + fr, fq * 8), boff = lds_byte(wc * 32 + fr, fq * 8);
#define PG8_SA(b, h) (((b) * 2 + (h)) * HTB)
#define PG8_SB(b, h) ((4 + (b) * 2 + (h)) * HTB)
#define PG8_STAGE(bufoff, gbase, voff) do { _Pragma("unroll") for (int _i = 0; _i < 2; ++_i) \
        __builtin_amdgcn_global_load_lds((const unsigned*)((const char*)(gbase) + (voff)[_i]), (PG8_LAS unsigned*)(lds + (bufoff) + ldsw + _i * 8192), 16, 0, 0); } while (0)
#define PG8_LDA(dst, b, h) do { _Pragma("unroll") for (int m = 0; m < 4; ++m) _Pragma("unroll") for (int k = 0; k < 2; ++k) dst[m][k] = *(const PG8_LAS bf16x8*)(lds + PG8_SA(b, h) + aoff + m * 2048 + k * 1024); } while (0)
#define PG8_LDB(dst, b, h) do { _Pragma("unroll") for (int n = 0; n < 2; ++n) _Pragma("unroll") for (int k = 0; k < 2; ++k) dst[n][k] = *(const PG8_LAS bf16x8*)(lds + PG8_SB(b, h) + boff + n * 2048 + k * 1024); } while (0)
#define PG8_MMA(ai, bj, At, Bt) do { __builtin_amdgcn_s_setprio(1); _Pragma("unroll") for (int m = 0; m < 4; ++m) _Pragma("unroll") for (int n = 0; n < 2; ++n) _Pragma("unroll") for (int k = 0; k < 2; ++k) \
        acc[ai][bj][m][n] = __builtin_amdgcn_mfma_f32_16x16x32_bf16(Bt[n][k], At[m][k], acc[ai][bj][m][n], 0, 0, 0); __builtin_amdgcn_s_setprio(0); } while (0)
#define PG8_WAIT_V(n) asm volatile("s_waitcnt vmcnt(" #n ")" ::: "memory")
#define PG8_WAIT_L(n) asm volatile("s_waitcnt lgkmcnt(" #n ")" ::: "memory")
#define PG8_BAR __builtin_amdgcn_s_barrier()
#define PG8_SCHED __builtin_amdgcn_sched_barrier(0)
    Unit cur, nxt; int ui = 0;
    if (!S.next(0, cur)) return;
    f32x4 acc[2][2][4][2];
#pragma unroll
    for (int a = 0; a < 2; ++a)
#pragma unroll
        for (int b = 0; b < 2; ++b)
#pragma unroll
            for (int m = 0; m < 4; ++m)
#pragma unroll
                for (int n = 0; n < 2; ++n) acc[a][b][m][n] = (f32x4){0.f, 0.f, 0.f, 0.f};
    bf16x8 At[4][2], B0[2][2], B1[2][2];
    const char* cA = (const char*)g.A + (size_t)cur.pm * tstepA; const char* cB = (const char*)g.Bt + (size_t)cur.pn * tstepB;
    S.a_ready(cur);
    if constexpr (SP2) {
        PG8_STAGE(PG8_SB(0, 0), cB, voffB); PG8_STAGE(PG8_SB(0, 1), cB + hstepB, voffB); PG8_STAGE(PG8_SA(0, 0), cA, voffA); PG8_STAGE(PG8_SA(0, 1), cA + hstepA, voffA);
        if (wr == 1) PG8_BAR;
        PG8_WAIT_V(2); PG8_BAR;
        PG8_STAGE(PG8_SB(1, 0), cB + kstep, voffB); PG8_STAGE(PG8_SA(1, 0), cA + kstep, voffA); PG8_STAGE(PG8_SB(1, 1), cB + hstepB + kstep, voffB);
        PG8_WAIT_V(6); PG8_BAR;
    } else {
        PG8_STAGE(PG8_SB(0, 0), cB, voffB); PG8_STAGE(PG8_SA(0, 0), cA, voffA); PG8_STAGE(PG8_SB(0, 1), cB + hstepB, voffB); PG8_STAGE(PG8_SA(0, 1), cA + hstepA, voffA);
        if (wr == 1) PG8_BAR;
        PG8_WAIT_V(4); PG8_BAR;
        PG8_STAGE(PG8_SB(1, 0), cB + kstep, voffB); PG8_STAGE(PG8_SA(1, 0), cA + kstep, voffA); PG8_STAGE(PG8_SB(1, 1), cB + hstepB + kstep, voffB);
        PG8_WAIT_V(6); PG8_BAR;
    }
    for (;;) {
        const bool has_next = S.next(ui + 1, nxt);
        const char* nA = has_next ? (const char*)g.A + (size_t)nxt.pm * tstepA : cA; const char* nB = has_next ? (const char*)g.Bt + (size_t)nxt.pn * tstepB : cB;
        for (int t = 0; t < nt; t += 2) {
            const bool last = (t == nt - 2);
            const char* a1 = cA + (size_t)(t + 1) * kstep;
            const char* a2 = last ? nA : cA + (size_t)(t + 2) * kstep; const char* b2 = last ? nB : cB + (size_t)(t + 2) * kstep;
            const char* a3 = a2 + kstep; const char* b3 = b2 + kstep;
            if (last && has_next) S.a_ready(nxt);
            if constexpr (SP2) {
            PG8_LDB(B0, 0, 0); PG8_LDB(B1, 0, 1); PG8_SCHED; PG8_LDA(At, 0, 0); PG8_STAGE(PG8_SA(1, 1), a1 + hstepA, voffA);
            PG8_WAIT_V(8); PG8_WAIT_L(0); PG8_BAR; PG8_MMA(0, 0, At, B0); PG8_MMA(0, 1, At, B1); PG8_BAR; PG8_SCHED;
            PG8_LDA(At, 0, 1); PG8_STAGE(PG8_SB(0, 0), b2, voffB); PG8_STAGE(PG8_SB(0, 1), b2 + hstepB, voffB); PG8_STAGE(PG8_SA(0, 0), a2, voffA);
            PG8_WAIT_V(8); PG8_WAIT_L(0); PG8_BAR; PG8_MMA(1, 0, At, B0); PG8_MMA(1, 1, At, B1); PG8_BAR; PG8_SCHED;
            PG8_LDB(B0, 1, 0); PG8_LDB(B1, 1, 1); PG8_SCHED; PG8_LDA(At, 1, 0); PG8_STAGE(PG8_SA(0, 1), a2 + hstepA, voffA);
            PG8_WAIT_V(8); PG8_WAIT_L(0); PG8_BAR; PG8_MMA(0, 0, At, B0); PG8_MMA(0, 1, At, B1); PG8_BAR; PG8_SCHED;
            PG8_LDA(At, 1, 1); PG8_STAGE(PG8_SB(1, 0), b3, voffB); PG8_STAGE(PG8_SB(1, 1), b3 + hstepB, voffB); PG8_STAGE(PG8_SA(1, 0), a3, voffA);
            PG8_WAIT_V(8); PG8_WAIT_L(0); PG8_BAR; PG8_MMA(1, 0, At, B0); PG8_MMA(1, 1, At, B1); PG8_BAR; PG8_SCHED;
            } else {
            PG8_LDB(B0, 0, 0); PG8_SCHED; PG8_LDA(At, 0, 0); PG8_STAGE(PG8_SA(1, 1), a1 + hstepA, voffA);
            PG8_WAIT_L(8); PG8_BAR; PG8_WAIT_L(0); PG8_MMA(0, 0, At, B0); PG8_BAR; PG8_SCHED;
            PG8_LDB(B1, 0, 1); PG8_STAGE(PG8_SB(0, 0), b2, voffB);
            PG8_BAR; PG8_WAIT_L(0); PG8_MMA(0, 1, At, B1); PG8_BAR;
            PG8_LDA(At, 0, 1); PG8_STAGE(PG8_SA(0, 0), a2, voffA);
            PG8_BAR; PG8_WAIT_L(0); PG8_MMA(1, 0, At, B0); PG8_BAR; PG8_SCHED;
            PG8_STAGE(PG8_SB(0, 1), b2 + hstepB, voffB);
            PG8_WAIT_V(6); PG8_BAR; PG8_MMA(1, 1, At, B1); PG8_BAR;
            PG8_LDB(B0, 1, 0); PG8_SCHED; PG8_LDA(At, 1, 0); PG8_STAGE(PG8_SA(0, 1), a2 + hstepA, voffA);
            PG8_WAIT_L(8); PG8_BAR; PG8_WAIT_L(0); PG8_MMA(0, 0, At, B0); PG8_BAR; PG8_SCHED;
            PG8_LDB(B1, 1, 1); PG8_STAGE(PG8_SB(1, 0), b3, voffB);
            PG8_BAR; PG8_WAIT_L(0); PG8_MMA(0, 1, At, B1); PG8_BAR;
            PG8_LDA(At, 1, 1); PG8_STAGE(PG8_SA(1, 0), a3, voffA);
            PG8_BAR; PG8_WAIT_L(0); PG8_MMA(1, 0, At, B0); PG8_BAR; PG8_SCHED;
            PG8_STAGE(PG8_SB(1, 1), b3 + hstepB, voffB);
            PG8_WAIT_V(6); PG8_BAR; PG8_MMA(1, 1, At, B1); PG8_BAR;
            }
        }
        if constexpr (ALIGN_EPI) { if (wr == 0) PG8_BAR; }
        if constexpr (!Epi::AFTER_DRAIN) { E(acc, cur, wr, wc, fr, fq); S.done(cur); }
        if (!has_next) break;
#pragma unroll
        for (int a = 0; a < 2; ++a)
#pragma unroll
            for (int b = 0; b < 2; ++b)
#pragma unroll
                for (int m = 0; m < 4; ++m)
#pragma unroll
                    for (int n = 0; n < 2; ++n) acc[a][b][m][n] = (f32x4){0.f, 0.f, 0.f, 0.f};
        cur = nxt; cA = nA; cB = nB; ++ui;
        if constexpr (ALIGN_EPI) { if (wr == 1) PG8_BAR; }
    }
    PG8_WAIT_V(0);
    if constexpr (!ALIGN_EPI) { if (wr == 0) PG8_BAR; }
    PG8_BAR;
    if constexpr (Epi::AFTER_DRAIN) { E.fused(acc, cur, wr, wc, fr, fq, lds, wid, lane); S.done(cur); }
#undef PG8_SA
#undef PG8_SB
#undef PG8_STAGE
#undef PG8_LDA
#undef PG8_LDB
#undef PG8_MMA
#undef PG8_WAIT_V
#undef PG8_WAIT_L
#undef PG8_BAR
#undef PG8_SCHED
}
struct EpiF32 {
    static constexpr bool PERM = false, AFTER_DRAIN = false;
    float* C; int ldc;
    __device__ __forceinline__ void operator()(const f32x4 (&acc)[2][2][4][2], const Unit& u, int wr, int wc, int fr, int fq) const {
        const int row0 = u.pm * BM + wr * 64 + fr, col0 = u.pn * BM + wc * 32 + 4 * fq;
#pragma unroll
        for (int ai = 0; ai < 2; ++ai)
#pragma unroll
            for (int m = 0; m < 4; ++m) { float* rowp = C + (size_t)(row0 + ai * HALF + m * 16) * ldc + col0;
#pragma unroll
                for (int bj = 0; bj < 2; ++bj)
#pragma unroll
                    for (int n = 0; n < 2; ++n) *(f32x4*)(rowp + bj * HALF + n * 16) = acc[ai][bj][m][n]; }
    }
};
__device__ __forceinline__ float bfu(unsigned short h) { return __uint_as_float(((unsigned)h) << 16); }
__device__ __forceinline__ float sigm(float x) { return 1.0f / (1.0f + __expf(-x)); }
struct EpiUp {
    static constexpr bool PERM = true, AFTER_DRAIN = false;
    const bf16_t* graw; int ldg;
    const float* bg;
    float* part; bf16_t* merged; int mode;
    __device__ __forceinline__ void operator()(const f32x4 (&acc)[2][2][4][2], const Unit& u, int wr, int wc, int fr, int fq) const {
        const int row0 = u.pm * BM + wr * 64 + fr, col0 = u.pn * BM + wc * 32 + 8 * fq;
#pragma unroll
        for (int ai = 0; ai < 2; ++ai)
#pragma unroll
            for (int m = 0; m < 4; ++m) { const size_t row = (size_t)(row0 + ai * HALF + m * 16);
#pragma unroll
                for (int bj = 0; bj < 2; ++bj) { const int col = col0 + bj * HALF;
                    const u32x4 gr = *(const u32x4*)(graw + row * ldg + col);
                    const f32x4 b0 = *(const f32x4*)(bg + col), b1 = *(const f32x4*)(bg + col + 4);
                    f32x4 g0, g1;
                    g0[0] = sigm(__uint_as_float(gr.x << 16) + b0[0]); g0[1] = sigm(__uint_as_float(gr.x & 0xffff0000u) + b0[1]);
                    g0[2] = sigm(__uint_as_float(gr.y << 16) + b0[2]); g0[3] = sigm(__uint_as_float(gr.y & 0xffff0000u) + b0[3]);
                    g1[0] = sigm(__uint_as_float(gr.z << 16) + b1[0]); g1[1] = sigm(__uint_as_float(gr.z & 0xffff0000u) + b1[1]);
                    g1[2] = sigm(__uint_as_float(gr.w << 16) + b1[2]); g1[3] = sigm(__uint_as_float(gr.w & 0xffff0000u) + b1[3]);
                    f32x4 v0 = acc[ai][bj][m][0] * g0, v1 = acc[ai][bj][m][1] * g1;
                    float* pp = part + row * 2048 + col;
                    if (mode != 0) { v0 += *(const f32x4*)pp; v1 += *(const f32x4*)(pp + 4); }
                    if (mode != 2) { *(f32x4*)pp = v0; *(f32x4*)(pp + 4) = v1; }
                    else { u32x4 w; w.x = cvt_pk_bf16(v0[0], v0[1]); w.y = cvt_pk_bf16(v0[2], v0[3]); w.z = cvt_pk_bf16(v1[0], v1[1]); w.w = cvt_pk_bf16(v1[2], v1[3]);
                        *(u32x4*)(merged + row * 2048 + col) = w; } } }
    }
};
struct EpiOut {
    static constexpr bool PERM = true, AFTER_DRAIN = false;
    const float* x; float* x1; bf16_t* xg; const float* gffn; float* rowss;
    __device__ __forceinline__ void operator()(const f32x4 (&acc)[2][2][4][2], const Unit& u, int wr, int wc, int fr, int fq) const {
        const int row0 = u.pm * BM + wr * 64 + fr, col0 = u.pn * BM + wc * 32 + 8 * fq;
#pragma unroll
        for (int ai = 0; ai < 2; ++ai)
#pragma unroll
            for (int m = 0; m < 4; ++m) { const size_t row = (size_t)(row0 + ai * HALF + m * 16); float ss = 0.f;
#pragma unroll
                for (int bj = 0; bj < 2; ++bj) { const int col = col0 + bj * HALF; const size_t off = row * 2048 + col;
                    const f32x4 v0 = acc[ai][bj][m][0] + *(const f32x4*)(x + off), v1 = acc[ai][bj][m][1] + *(const f32x4*)(x + off + 4);
                    *(f32x4*)(x1 + off) = v0; *(f32x4*)(x1 + off + 4) = v1;
                    ss += (v0[0] * v0[0] + v0[1] * v0[1]) + (v0[2] * v0[2] + v0[3] * v0[3]) + (v1[0] * v1[0] + v1[1] * v1[1]) + (v1[2] * v1[2] + v1[3] * v1[3]);
                    const f32x4 g0 = *(const f32x4*)(gffn + col), g1 = *(const f32x4*)(gffn + col + 4);
                    const f32x4 y0 = v0 * g0, y1 = v1 * g1;
                    u32x4 w; w.x = cvt_pk_bf16(y0[0], y0[1]); w.y = cvt_pk_bf16(y0[2], y0[3]); w.z = cvt_pk_bf16(y1[0], y1[1]); w.w = cvt_pk_bf16(y1[2], y1[3]);
                    *(u32x4*)(xg + off) = w; }
                ss += __shfl_xor(ss, 16); ss += __shfl_xor(ss, 32);
                if (fq == 0) rowss[row * 32 + u.pn * 4 + wc] = ss; }
    }
};
}
constexpr int NWAVES = 8, NTHR = 512;
constexpr int BATCH = 2, SEQ = 4096, DM = 2048, T = BATCH * SEQ;
constexpr int NIN = 12800, MEML = 256, MROWS = BATCH * MEML;
constexpr int HG_H = 6, DIL_H = 12, MEM_H = 4;
constexpr int C_Q = 0, C_V = 768, C_ZF = 1536, C_ZB = 2304, C_HG = 3072, C_DQ = 3840, C_DK = 4608, C_DV = 5376, C_MQ = 6144, C_GATE = 6656;
constexpr int NEXP = 16384;
constexpr float EPS = 1e-6f;
constexpr size_t MiB = 1u << 20;
constexpr size_t WS_CTL = 0;
constexpr size_t WS_LBF = 64 * 1024, WS_LBB = WS_LBF + 4096, WS_ROWSS = 128 * 1024  , WS_SKB = 256 * 1024  , WS_DEC = 512 * 1024  ;
constexpr size_t WS_WIN = 1 * MiB;
constexpr size_t WS_MERGED = WS_WIN;
constexpr size_t WS_WUP = 51 * MiB, WS_WOUT = 59 * MiB, WS_WQ = 67 * MiB, WS_WKV = 75 * MiB;
constexpr size_t WS_KVM = 79 * MiB, WS_KVMT = 80 * MiB;
constexpr size_t WS_MEMN = 81 * MiB;
constexpr size_t WS_LSE = 83 * MiB;
constexpr size_t WS_D = 84 * MiB;
constexpr size_t WS_IDX = 85 * MiB, WS_GATE = 89 * MiB;
constexpr size_t WS_UBF = 93 * MiB, WS_VBF = 157 * MiB;
constexpr size_t WS_H = 221 * MiB;
constexpr size_t WS_OCAT = WS_H;
constexpr size_t WS_ST = 253 * MiB;
constexpr size_t WS_PROJ = 301 * MiB;
constexpr size_t WS_XG = WS_PROJ, WS_QP = WS_PROJ + 32 * MiB, WS_SC = WS_PROJ + 64 * MiB;
constexpr size_t WS_RSP = 501 * MiB;
constexpr size_t WS_END = 502 * MiB;
constexpr int LDS_BYTES = 147456;
#define GAS __attribute__((address_space(1)))
#define LAS __attribute__((address_space(3)))
typedef unsigned short bf16;
typedef unsigned v4u __attribute__((ext_vector_type(4)));
typedef unsigned v2u __attribute__((ext_vector_type(2)));
typedef float f32x4 __attribute__((ext_vector_type(4)));
typedef float f32x16 __attribute__((ext_vector_type(16)));
typedef short bf16x8 __attribute__((ext_vector_type(8)));
__device__ __forceinline__ float bf2f(unsigned short h) { return __uint_as_float(((unsigned)h) << 16); }
__device__ __forceinline__ unsigned f2bf(float f) { unsigned u = __float_as_uint(f); return (u + 0x7fffu + ((u >> 16) & 1u)) >> 16; }
__device__ __forceinline__ unsigned pk2(float lo, float hi) { return f2bf(lo) | (f2bf(hi) << 16); }
__device__ __forceinline__ float wave_sum(float v) {
#pragma unroll
    for (int o = 1; o < 64; o <<= 1) v += __shfl_xor(v, o);
    return v;
}
__device__ __forceinline__ float wave_max(float v) {
#pragma unroll
    for (int o = 1; o < 64; o <<= 1) v = fmaxf(v, __shfl_xor(v, o));
    return v;
}
__device__ __forceinline__ float row_rstd(const float* rsp, int t) {
    const f32x4* q = (const f32x4*)(rsp + (size_t)t * 32); float s = 0.f;
#pragma unroll
    for (int i = 0; i < 8; ++i) { const f32x4 v = q[i]; s += (v.x + v.y) + (v.z + v.w); }
    return rsqrtf(s * (1.f / 2048.f) + 1e-6f);
}
__device__ __forceinline__ float sigmoidf_(float x) { return 1.0f / (1.0f + __expf(-x)); }

struct P {
    const float *x, *mem, *g_mix, *w_in, *b_gate, *lbf_l, *lbb_l, *g_hg, *w_kv, *g_mem, *w_up, *w_out, *g_ffn, *w_q, *subk, *pu, *pv, *g_final;
    float* out; unsigned char* ws; int ph_lo, ph_hi;
};
#define WSP(T_, off) ((T_*)(p.ws + (off)))

__device__ __forceinline__ void p0_transpose_item(const float* W, int K, int N, bf16* WT, float* scr, int item, int lane) {
    const int nblk = N / 32, kb = item / nblk, nb = item % nblk, k0 = 64 * kb, n0 = 32 * nb;
#pragma unroll 8
    for (int i = 0; i < 32; ++i) { const int kk = 2 * i + (lane >> 5); scr[kk * 33 + (lane & 31)] = W[(size_t)(k0 + kk) * N + n0 + (lane & 31)]; }
    asm volatile("s_waitcnt lgkmcnt(0)" ::: "memory");
    const int c = lane & 7;
#pragma unroll
    for (int j = 0; j < 4; ++j) { const int n = (lane >> 3) + 8 * j; const float* s = scr + (8 * c) * 33 + n;
        v4u o; o.x = pk2(s[0 * 33], s[1 * 33]); o.y = pk2(s[2 * 33], s[3 * 33]); o.z = pk2(s[4 * 33], s[5 * 33]); o.w = pk2(s[6 * 33], s[7 * 33]);
        *(v4u*)(WT + (size_t)(n0 + n) * K + k0 + 8 * c) = o; }
    asm volatile("s_waitcnt lgkmcnt(0)" ::: "memory");
}
__device__ __forceinline__ void rms_row_to_bf16(const float* xrow, const float* g, bf16* orow, int lane) {
    const f32x4* xr = (const f32x4*)xrow + lane; const f32x4* gr = (const f32x4*)g + lane;
    f32x4 v[8]; float s = 0.f;
#pragma unroll
    for (int j = 0; j < 8; ++j) { v[j] = xr[64 * j]; s += (v[j].x * v[j].x + v[j].y * v[j].y) + (v[j].z * v[j].z + v[j].w * v[j].w); }
    const float rstd = rsqrtf(wave_sum(s) * (1.f / DM) + EPS);
    v2u* o8 = (v2u*)orow + lane;
#pragma unroll
    for (int j = 0; j < 8; ++j) { const f32x4 gg = gr[64 * j]; v2u w; w.x = pk2(v[j].x * rstd * gg.x, v[j].y * rstd * gg.y); w.y = pk2(v[j].z * rstd * gg.z, v[j].w * rstd * gg.w); o8[64 * j] = w; }
}
__device__ __forceinline__ void phase0(const P& p, unsigned char* lds, int vcu, int G) {
    const int tid = threadIdx.x, lane = tid & 63, wave = tid >> 6;
    float* scr = (float*)(lds + wave * 16384);
    const int gw = vcu * NWAVES + wave, NGW = G * NWAVES;
    constexpr int I_IN = (DM / 64) * (NIN / 32), I_KV = (DM / 64) * (1024 / 32), I_SQ = (DM / 64) * (DM / 32);
    constexpr int NITEMS = I_IN + I_KV + 3 * I_SQ;
    for (int it = gw; it < NITEMS; it += NGW) {
        int r = it;
        if (r < I_IN) { p0_transpose_item(p.w_in, DM, NIN, WSP(bf16, WS_WIN), scr, r, lane); continue; } r -= I_IN;
        if (r < I_KV) { p0_transpose_item(p.w_kv, DM, 1024, WSP(bf16, WS_WKV), scr, r, lane); continue; } r -= I_KV;
        if (r < I_SQ) { p0_transpose_item(p.w_up, DM, DM, WSP(bf16, WS_WUP), scr, r, lane); continue; } r -= I_SQ;
        if (r < I_SQ) { p0_transpose_item(p.w_out, DM, DM, WSP(bf16, WS_WOUT), scr, r, lane); continue; } r -= I_SQ;
        p0_transpose_item(p.w_q, DM, DM, WSP(bf16, WS_WQ), scr, r, lane);
    }
    for (int m = gw; m < T; m += NGW) rms_row_to_bf16(p.x + (size_t)m * DM, p.g_mix, WSP(bf16, WS_H) + (size_t)m * DM, lane);
    for (int m = gw; m < MROWS; m += NGW) rms_row_to_bf16(p.mem + (size_t)m * DM, p.g_mem, WSP(bf16, WS_MEMN) + (size_t)m * DM, lane);
    const size_t gt = (size_t)vcu * NTHR + tid, NGT = (size_t)G * NTHR;
    for (size_t i = gt; i < (size_t)NEXP * DM / 8; i += NGT) {
        const f32x4 a = ((const f32x4*)p.pu)[2 * i], b = ((const f32x4*)p.pu)[2 * i + 1];
        v4u o; o.x = pk2(a.x, a.y); o.y = pk2(a.z, a.w); o.z = pk2(b.x, b.y); o.w = pk2(b.z, b.w); WSP(v4u, WS_UBF)[i] = o;
        const f32x4 c = ((const f32x4*)p.pv)[2 * i], d = ((const f32x4*)p.pv)[2 * i + 1];
        v4u q; q.x = pk2(c.x, c.y); q.y = pk2(c.z, c.w); q.z = pk2(d.x, d.y); q.w = pk2(d.z, d.w); WSP(v4u, WS_VBF)[i] = q;
    }
    for (size_t i = gt; i < 65536; i += NGT) { const int n = (int)(i >> 8), c = (int)(i & 255); float v = 0.f;
        if (n < 128 && c < 128) v = p.subk[n * 128 + c]; else if (n >= 128 && c >= 128) v = p.subk[16384 + (n - 128) * 128 + (c - 128)];
        WSP(bf16, WS_SKB)[i] = (bf16)f2bf(v); }
    for (size_t i = gt; i < 768; i += NGT) { WSP(float, WS_LBF)[i] = 1.0f / (1.0f + __expf(p.lbf_l[768 + i] - p.lbf_l[i])); WSP(float, WS_LBB)[i] = 1.0f / (1.0f + __expf(p.lbb_l[768 + i] - p.lbb_l[i])); }
}
__device__ __forceinline__ f32x16 mfma32(bf16x8 a, bf16x8 b, f32x16 c) { return __builtin_amdgcn_mfma_f32_32x32x16_bf16(a, b, c, 0, 0, 0); }
__device__ __forceinline__ f32x4 mfma16(bf16x8 a, bf16x8 b, f32x4 c) { return __builtin_amdgcn_mfma_f32_16x16x32_bf16(a, b, c, 0, 0, 0); }
__device__ __forceinline__ f32x16 zero16() { f32x16 z; for (int i = 0; i < 16; ++i) z[i] = 0.f; return z; }

__device__ __forceinline__ void h1_item(const P& p, unsigned char* lds, int item) {
    const int tid = threadIdx.x, lane = tid & 63, wave = tid >> 6, c = tid & 127, tq = tid >> 7;
    const int n = item & 63, dir = (item >> 6) & 1, bh = item >> 7, b = bh / 6, h = bh % 6, chain = bh * 2 + dir;
    const bf16* proj = WSP(const bf16, WS_PROJ) + (size_t)(b * SEQ + n * 64) * NIN;
    const int zc = (dir ? C_ZB : C_ZF) + h * 128 + c, vc = C_V + h * 128 + c;
    const float lb = WSP(const float, dir ? WS_LBB : WS_LBF)[h * 128 + c];
    float* segs = (float*)lds;
    bf16* KhT = (bf16*)(lds + 2048);
    bf16* VT = (bf16*)(lds + 2048 + 18432);
    float lf[16], kk[16]; float seg = 0.f;
#pragma unroll
    for (int i = 0; i < 16; ++i) { const int s = tq * 16 + i; const float z = bf2f(proj[(size_t)s * NIN + zc]); const float f = lb + (1.f - lb) * sigmoidf_(z);
        lf[i] = __logf(f); kk[i] = 1.f - f; seg += lf[i]; VT[c * 72 + s] = proj[(size_t)s * NIN + vc]; }
    segs[tq * 128 + c] = seg;
    __syncthreads();
    const float s0 = segs[c], s1 = segs[128 + c], s2 = segs[256 + c], s3 = segs[384 + c];
    if (dir == 0) { float run = (tq < 1 ? s1 : 0.f) + (tq < 2 ? s2 : 0.f) + (tq < 3 ? s3 : 0.f);
#pragma unroll
        for (int i = 15; i >= 0; --i) { KhT[c * 72 + tq * 16 + i] = (bf16)f2bf(kk[i] * __expf(run)); run += lf[i]; } }
    else { float run = (tq > 0 ? s0 : 0.f) + (tq > 1 ? s1 : 0.f) + (tq > 2 ? s2 : 0.f);
#pragma unroll
        for (int i = 0; i < 16; ++i) { KhT[c * 72 + tq * 16 + i] = (bf16)f2bf(kk[i] * __expf(run)); run += lf[i]; } }
    if (tq == 0) WSP(float, WS_D)[(size_t)(chain * 64 + n) * 128 + c] = __expf((s0 + s1) + (s2 + s3));
    __syncthreads();
    const int r32 = lane & 31, hi = lane >> 5, dvt = wave >> 1, c0 = (wave & 1) * 64;
    f32x16 acc0 = zero16(), acc1 = zero16();
#pragma unroll
    for (int ks = 0; ks < 4; ++ks) {
        const bf16x8 a = *(const bf16x8*)(VT + (dvt * 32 + r32) * 72 + ks * 16 + hi * 8);
        const bf16x8 b0 = *(const bf16x8*)(KhT + (c0 + r32) * 72 + ks * 16 + hi * 8), b1 = *(const bf16x8*)(KhT + (c0 + 32 + r32) * 72 + ks * 16 + hi * 8);
        acc0 = mfma32(a, b0, acc0); acc1 = mfma32(a, b1, acc1); }
    bf16* st = WSP(bf16, WS_ST) + (size_t)(chain * 64 + n) * 16384;
#pragma unroll
    for (int r = 0; r < 16; ++r) { const int dv = dvt * 32 + (r & 3) + 8 * (r >> 2) + 4 * hi;
        st[dv * 128 + c0 + r32] = (bf16)f2bf(acc0[r]); st[dv * 128 + c0 + 32 + r32] = (bf16)f2bf(acc1[r]); }
    __syncthreads();
}

__device__ __forceinline__ void h2_scan(const P& p, int vcu, int G) {
    const int gt = vcu * NTHR + threadIdx.x, NGT = G * NTHR;
    for (int w = gt; w < 24 * 2048; w += NGT) {
        const int chain = w >> 11, e8 = w & 2047, c8 = (e8 & 15) * 8, dir = chain & 1;
        float run[8];
#pragma unroll
        for (int j = 0; j < 8; ++j) run[j] = 0.f;
        for (int k = 0; k < 64; ++k) { const int n = dir ? 63 - k : k;
            v4u* ptr = WSP(v4u, WS_ST) + ((size_t)(chain * 64 + n) * 16384 + e8 * 8) / 8;
            const v4u L = *ptr; const f32x4 d0 = *(const f32x4*)(WSP(const float, WS_D) + (size_t)(chain * 64 + n) * 128 + c8), d1 = *(const f32x4*)(WSP(const float, WS_D) + (size_t)(chain * 64 + n) * 128 + c8 + 4);
            v4u o; o.x = pk2(run[0], run[1]); o.y = pk2(run[2], run[3]); o.z = pk2(run[4], run[5]); o.w = pk2(run[6], run[7]); *ptr = o;
            run[0] = d0.x * run[0] + __uint_as_float(L.x << 16); run[1] = d0.y * run[1] + __uint_as_float(L.x & 0xffff0000u);
            run[2] = d0.z * run[2] + __uint_as_float(L.y << 16); run[3] = d0.w * run[3] + __uint_as_float(L.y & 0xffff0000u);
            run[4] = d1.x * run[4] + __uint_as_float(L.z << 16); run[5] = d1.y * run[5] + __uint_as_float(L.z & 0xffff0000u);
            run[6] = d1.z * run[6] + __uint_as_float(L.w << 16); run[7] = d1.w * run[7] + __uint_as_float(L.w & 0xffff0000u);
        }
    }
}

__device__ __forceinline__ void h3_item(const P& p, unsigned char* lds, int item) {
    const int tid = threadIdx.x, lane = tid & 63, wave = tid >> 6, c = tid & 127, tq = tid >> 7;
    const int n = item & 63, bh = item >> 6, b = bh / 6, h = bh % 6;
    const size_t row0 = (size_t)(b * SEQ + n * 64);
    const bf16* proj = WSP(const bf16, WS_PROJ) + row0 * NIN;
    float* SEG = (float*)lds;
    bf16* QF = (bf16*)(lds + 4096);
    bf16* QB = (bf16*)(lds + 4096 + 17408);
    bf16* KF = (bf16*)(lds + 4096 + 2 * 17408);
    bf16* KB = (bf16*)(lds + 4096 + 3 * 17408);
    bf16* VT = (bf16*)(lds + 4096 + 4 * 17408);
    bf16* A2 = (bf16*)(lds + 4096 + 4 * 17408 + 18432);
    float* OB = (float*)(lds + 4096);
    float lff[16], kf[16], lfb[16], kb[16];
    { const float lbF = WSP(const float, WS_LBF)[h * 128 + c], lbB = WSP(const float, WS_LBB)[h * 128 + c]; float sf = 0.f, sb = 0.f;
#pragma unroll
      for (int i = 0; i < 16; ++i) { const int s = tq * 16 + i;
        const float zf = bf2f(proj[(size_t)s * NIN + C_ZF + h * 128 + c]), zb = bf2f(proj[(size_t)s * NIN + C_ZB + h * 128 + c]);
        const float ff = lbF + (1.f - lbF) * sigmoidf_(zf), fb = lbB + (1.f - lbB) * sigmoidf_(zb);
        lff[i] = __logf(ff); kf[i] = 1.f - ff; sf += lff[i]; lfb[i] = __logf(fb); kb[i] = 1.f - fb; sb += lfb[i];
        VT[c * 72 + s] = proj[(size_t)s * NIN + C_V + h * 128 + c]; }
      SEG[tq * 128 + c] = sf; SEG[512 + tq * 128 + c] = sb; }
    __syncthreads();
    {
      float runf = (tq > 0 ? SEG[c] : 0.f) + (tq > 1 ? SEG[128 + c] : 0.f) + (tq > 2 ? SEG[256 + c] : 0.f);
      float runb = (tq < 1 ? SEG[512 + 128 + c] : 0.f) + (tq < 2 ? SEG[512 + 256 + c] : 0.f) + (tq < 3 ? SEG[512 + 384 + c] : 0.f);
      float bb[16];
#pragma unroll
      for (int i = 15; i >= 0; --i) { runb += lfb[i]; bb[i] = runb; }
#pragma unroll
      for (int i = 0; i < 16; ++i) { const int s = tq * 16 + i; runf += lff[i];
        const float q = bf2f(proj[(size_t)s * NIN + C_Q + h * 128 + c]);
        QF[s * 136 + c] = (bf16)f2bf(q * __expf(runf)); KF[s * 136 + c] = (bf16)f2bf(kf[i] * __expf(-runf));
        QB[s * 136 + c] = (bf16)f2bf(q * __expf(bb[i])); KB[s * 136 + c] = (bf16)f2bf(kb[i] * __expf(-bb[i])); } }
    __syncthreads();
    const int r32 = lane & 31, hi = lane >> 5;
    {
      const int dir = wave >> 2, ti = (wave >> 1) & 1, si = wave & 1;
      const bf16* Qd = dir ? QB : QF; const bf16* Kd = dir ? KB : KF;
      f32x16 a = zero16();
#pragma unroll
      for (int ks = 0; ks < 8; ++ks) a = mfma32(*(const bf16x8*)(Qd + (ti * 32 + r32) * 136 + ks * 16 + hi * 8), *(const bf16x8*)(Kd + (si * 32 + r32) * 136 + ks * 16 + hi * 8), a);
#pragma unroll
      for (int r = 0; r < 16; ++r) { const int t = ti * 32 + (r & 3) + 8 * (r >> 2) + 4 * hi, s = si * 32 + r32;
        const bool keep = dir ? (s >= t) : (s <= t);
        A2[t * 136 + dir * 64 + s] = (bf16)f2bf(keep ? a[r] : 0.f); } }
    __syncthreads();
    f32x16 o = zero16();
    const int tt = wave >> 2, dt = wave & 3;
    { const bf16* stf = WSP(const bf16, WS_ST) + (size_t)((bh * 2 + 0) * 64 + n) * 16384 + (size_t)(dt * 32 + r32) * 128 + hi * 8;
      const bf16* stb = WSP(const bf16, WS_ST) + (size_t)((bh * 2 + 1) * 64 + n) * 16384 + (size_t)(dt * 32 + r32) * 128 + hi * 8;
#pragma unroll
      for (int ks = 0; ks < 8; ++ks) {
        o = mfma32(*(const bf16x8*)(QF + (tt * 32 + r32) * 136 + ks * 16 + hi * 8), *(const bf16x8*)(stf + ks * 16), o);
        o = mfma32(*(const bf16x8*)(QB + (tt * 32 + r32) * 136 + ks * 16 + hi * 8), *(const bf16x8*)(stb + ks * 16), o);
        o = mfma32(*(const bf16x8*)(A2 + (tt * 32 + r32) * 136 + ks * 16 + hi * 8), *(const bf16x8*)(VT + (dt * 32 + r32) * 72 + (ks & 3) * 16 + hi * 8), o); } }
    __syncthreads();
#pragma unroll
    for (int r = 0; r < 16; ++r) OB[(tt * 32 + (r & 3) + 8 * (r >> 2) + 4 * hi) * 132 + dt * 32 + r32] = o[r];
    __syncthreads();
    for (int rr = 0; rr < 8; ++rr) { const int t = wave * 8 + rr;
        const float v0 = OB[t * 132 + lane], v1 = OB[t * 132 + 64 + lane];
        const float rstd = rsqrtf(wave_sum(v0 * v0 + v1 * v1) * (1.f / 128.f) + EPS);
        const float g0 = bf2f(proj[(size_t)t * NIN + C_HG + h * 128 + lane]), g1 = bf2f(proj[(size_t)t * NIN + C_HG + h * 128 + 64 + lane]);
        bf16* orow = WSP(bf16, WS_OCAT) + (row0 + t) * DM + h * 128;
        orow[lane] = (bf16)f2bf(v0 * rstd * p.g_hg[lane] * (g0 * sigmoidf_(g0)));
        orow[64 + lane] = (bf16)f2bf(v1 * rstd * p.g_hg[64 + lane] * (g1 * sigmoidf_(g1))); }
    __syncthreads();
}
__device__ __forceinline__ void dil_item(const P& p, unsigned char* lds, int item) {
    const int tid = threadIdx.x, lane = tid & 63, wave = tid >> 6;
    const int blk = item & 63, bh = item >> 6, b = bh / 12, head = bh % 12, g = head >> 2;
    const int r = (g == 0) ? 1 : (g == 1 ? 4 : 16), Ls = SEQ / r, nblk = Ls / 64;
    const int cres = blk / nblk, i0 = (blk % nblk) * 64;
    const bf16* proj = WSP(const bf16, WS_PROJ) + (size_t)(b * SEQ) * NIN;
    bf16* Qs = (bf16*)lds;
    bf16* Ks = (bf16*)(lds + 9216);
    bf16* VT = (bf16*)(lds + 36864);
    float* Ss = (float*)(lds + 62464);
    { const int row = tid >> 3, ch = tid & 7; const int tok = cres + r * (i0 + row);
      *(v4u*)(Qs + row * 72 + ch * 8) = *(const v4u*)(proj + (size_t)tok * NIN + C_DQ + head * 64 + ch * 8); }
#pragma unroll
    for (int k = 0; k < 3; ++k) { const int idx = tid + 512 * k, row = idx >> 3, ch = idx & 7; const int j = i0 - 64 + row;
        v4u kv = {0u, 0u, 0u, 0u}, vv = {0u, 0u, 0u, 0u};
        if (j >= 0 && j < Ls) { const size_t tok = (size_t)(cres + r * j); kv = *(const v4u*)(proj + tok * NIN + C_DK + head * 64 + ch * 8); vv = *(const v4u*)(proj + tok * NIN + C_DV + head * 64 + ch * 8); }
        *(v4u*)(Ks + row * 72 + ch * 8) = kv;
        bf16* vt = VT + (ch * 8) * 200 + row;
        vt[0] = (bf16)(vv.x & 0xffff); vt[200] = (bf16)(vv.x >> 16); vt[400] = (bf16)(vv.y & 0xffff); vt[600] = (bf16)(vv.y >> 16);
        vt[800] = (bf16)(vv.z & 0xffff); vt[1000] = (bf16)(vv.z >> 16); vt[1200] = (bf16)(vv.w & 0xffff); vt[1400] = (bf16)(vv.w >> 16); }
    __syncthreads();
    const int fr = lane & 15, fq = lane >> 4, qt = wave & 3;
    { const bf16x8 a0 = *(const bf16x8*)(Qs + (qt * 16 + fr) * 72 + fq * 8), a1 = *(const bf16x8*)(Qs + (qt * 16 + fr) * 72 + 32 + fq * 8);
#pragma unroll
      for (int k = 0; k < 6; ++k) { const int kt = (wave >> 2) * 6 + k;
        f32x4 s = {0.f, 0.f, 0.f, 0.f};
        s = mfma16(a0, *(const bf16x8*)(Ks + (kt * 16 + fr) * 72 + fq * 8), s);
        s = mfma16(a1, *(const bf16x8*)(Ks + (kt * 16 + fr) * 72 + 32 + fq * 8), s);
#pragma unroll
        for (int e = 0; e < 4; ++e) Ss[(qt * 16 + fq * 4 + e) * 196 + kt * 16 + fr] = s[e]; } }
    __syncthreads();
    const float slope = exp2f(-8.0f * (float)(head + 1) / 12.0f) * (float)r;
    for (int rr = 0; rr < 8; ++rr) { const int q = wave * 8 + rr, i = i0 + q;
        float sv[3]; bool ok[3]; float m = -3.0e38f;
#pragma unroll
        for (int k = 0; k < 3; ++k) { const int jj = lane + 64 * k, j = i0 - 64 + jj, dj = j - i, adj = dj < 0 ? -dj : dj;
            ok[k] = (j >= 0) && (j < Ls) && (adj <= 64);
            sv[k] = ok[k] ? Ss[q * 196 + jj] * 0.125f - slope * (float)adj : -1.0e30f; m = fmaxf(m, sv[k]); }
        m = wave_max(m);
        float l = 0.f;
#pragma unroll
        for (int k = 0; k < 3; ++k) { sv[k] = ok[k] ? __expf(sv[k] - m) : 0.f; l += sv[k]; }
        l = wave_sum(l);
        const float inv = 1.0f / l;
        bf16* Pr = (bf16*)(Ss + q * 196);
#pragma unroll
        for (int k = 0; k < 3; ++k) Pr[lane + 64 * k] = (bf16)f2bf(sv[k] * inv);
        if (lane == 0) WSP(float, WS_LSE)[(size_t)(b * 12 + head) * SEQ + cres + r * i] = m + __logf(l); }
    __syncthreads();
    { f32x4 o0 = {0.f, 0.f, 0.f, 0.f}, o1 = {0.f, 0.f, 0.f, 0.f}; const int d0 = (wave >> 2) * 32;
#pragma unroll
      for (int kk = 0; kk < 6; ++kk) { const bf16x8 a = *(const bf16x8*)((const bf16*)(Ss + (qt * 16 + fr) * 196) + kk * 32 + fq * 8);
        o0 = mfma16(a, *(const bf16x8*)(VT + (d0 + fr) * 200 + kk * 32 + fq * 8), o0);
        o1 = mfma16(a, *(const bf16x8*)(VT + (d0 + 16 + fr) * 200 + kk * 32 + fq * 8), o1); }
#pragma unroll
      for (int e = 0; e < 4; ++e) { const int q = qt * 16 + fq * 4 + e; const size_t tok = (size_t)(b * SEQ + cres + r * (i0 + q));
        bf16* orow = WSP(bf16, WS_OCAT) + tok * DM + 768 + head * 64;
        orow[d0 + fr] = (bf16)f2bf(o0[e]); orow[d0 + 16 + fr] = (bf16)f2bf(o1[e]); } }
    __syncthreads();
}

__device__ __forceinline__ void mem_item(const P& p, unsigned char* lds, int item) {
    const int tid = threadIdx.x, lane = tid & 63, wave = tid >> 6;
    const int blk = item & 63, bh = item >> 6, b = bh >> 2, head = bh & 3;
    const size_t row0 = (size_t)(b * SEQ + blk * 64);
    const bf16* proj = WSP(const bf16, WS_PROJ) + row0 * NIN;
    bf16* Qs = (bf16*)lds;
    float* Ss = (float*)(lds + 17408);
#pragma unroll
    for (int k = 0; k < 2; ++k) { const int idx = tid + 512 * k, row = idx >> 4, ch = idx & 15;
        *(v4u*)(Qs + row * 136 + ch * 8) = *(const v4u*)(proj + (size_t)row * NIN + C_MQ + head * 128 + ch * 8); }
    __syncthreads();
    const int fr = lane & 15, fq = lane >> 4, qt = wave & 3;
    { bf16x8 a[4];
#pragma unroll
      for (int kk = 0; kk < 4; ++kk) a[kk] = *(const bf16x8*)(Qs + (qt * 16 + fr) * 136 + kk * 32 + fq * 8);
      const bf16* kvm = WSP(const bf16, WS_KVM) + (size_t)(b * MEML) * 1024 + head * 128 + fq * 8;
#pragma unroll
      for (int k = 0; k < 8; ++k) { const int kt = (wave >> 2) * 8 + k; f32x4 s = {0.f, 0.f, 0.f, 0.f};
#pragma unroll
        for (int kk = 0; kk < 4; ++kk) s = mfma16(a[kk], *(const bf16x8*)(kvm + (size_t)(kt * 16 + fr) * 1024 + kk * 32), s);
#pragma unroll
        for (int e = 0; e < 4; ++e) Ss[(qt * 16 + fq * 4 + e) * 260 + kt * 16 + fr] = s[e]; } }
    __syncthreads();
    for (int rr = 0; rr < 8; ++rr) { const int q = wave * 8 + rr;
        float sv[4]; float m = -3.0e38f;
#pragma unroll
        for (int k = 0; k < 4; ++k) { sv[k] = Ss[q * 260 + lane + 64 * k] * 0.08838834764831845f; m = fmaxf(m, sv[k]); }
        m = wave_max(m); float l = 0.f;
#pragma unroll
        for (int k = 0; k < 4; ++k) { sv[k] = __expf(sv[k] - m); l += sv[k]; }
        l = wave_sum(l); const float inv = 1.0f / l;
        bf16* Pr = (bf16*)(Ss + q * 260);
#pragma unroll
        for (int k = 0; k < 4; ++k) Pr[lane + 64 * k] = (bf16)f2bf(sv[k] * inv); }
    __syncthreads();
    { f32x4 o[4]; const int d0 = (wave >> 2) * 64;
#pragma unroll
      for (int j = 0; j < 4; ++j) o[j] = (f32x4){0.f, 0.f, 0.f, 0.f};
      const bf16* vt = WSP(const bf16, WS_KVMT) + (size_t)(512 + head * 128 + d0 + fr) * 512 + b * MEML + fq * 8;
#pragma unroll
      for (int kk = 0; kk < 8; ++kk) { const bf16x8 a = *(const bf16x8*)((const bf16*)(Ss + (qt * 16 + fr) * 260) + kk * 32 + fq * 8);
#pragma unroll
        for (int j = 0; j < 4; ++j) o[j] = mfma16(a, *(const bf16x8*)(vt + (size_t)(j * 16) * 512 + kk * 32), o[j]); }
#pragma unroll
      for (int e = 0; e < 4; ++e) { const int q = qt * 16 + fq * 4 + e; bf16* orow = WSP(bf16, WS_OCAT) + (row0 + q) * DM + 1536 + head * 128 + d0 + fr;
#pragma unroll
        for (int j = 0; j < 4; ++j) orow[j * 16] = (bf16)f2bf(o[j][e]); } }
    __syncthreads();
}

__device__ __forceinline__ void dil_alpha_rows(const P& p, int vcu, int G) {
    const int lane = threadIdx.x & 63, gw = vcu * NWAVES + (threadIdx.x >> 6), NGW = G * NWAVES;
    for (int t = gw; t < T; t += NGW) { const int b = t / SEQ, s = t % SEQ;
        for (int ch = lane; ch < 96; ch += 64) { const int head = ch >> 3, j = head & 3, g = head >> 2;
            const float* L = WSP(const float, WS_LSE) + (size_t)(b * 12 + j) * SEQ + s;
            const float l0 = L[0], l1 = L[4 * SEQ], l2 = L[8 * SEQ], m = fmaxf(l0, fmaxf(l1, l2));
            const float e0 = __expf(l0 - m), e1 = __expf(l1 - m), e2 = __expf(l2 - m);
            const float al = (g == 0 ? e0 : (g == 1 ? e1 : e2)) / (e0 + e1 + e2);
            v4u* ptr = (v4u*)(WSP(bf16, WS_OCAT) + (size_t)t * DM + 768 + ch * 8); v4u v = *ptr;
            v.x = pk2(__uint_as_float(v.x << 16) * al, __uint_as_float(v.x & 0xffff0000u) * al); v.y = pk2(__uint_as_float(v.y << 16) * al, __uint_as_float(v.y & 0xffff0000u) * al);
            v.z = pk2(__uint_as_float(v.z << 16) * al, __uint_as_float(v.z & 0xffff0000u) * al); v.w = pk2(__uint_as_float(v.w << 16) * al, __uint_as_float(v.w & 0xffff0000u) * al);
            *ptr = v; } }
}
__device__ __forceinline__ unsigned okey(float f) { const unsigned u = __float_as_uint(f); return u ^ ((unsigned)((int)u >> 31) | 0x80000000u); }
__device__ __forceinline__ float unkey(unsigned k) { const unsigned u = (k & 0x80000000u) ? (k ^ 0x80000000u) : ~k; return __uint_as_float(u); }
__device__ __forceinline__ unsigned umax_(unsigned a, unsigned b) { return a > b ? a : b; }
__device__ __forceinline__ unsigned umin_(unsigned a, unsigned b) { return a < b ? a : b; }
__device__ __forceinline__ void topk_rows(const P& p, int vcu, int G) {
    const int gt = vcu * NTHR + threadIdx.x, NGT = G * NTHR;
    for (int row = gt; row < T * 8; row += NGT) {
        const int t = row >> 3, h = row & 7;
        const float* sc = WSP(const float, WS_SC) + (size_t)row * 256;
        float s0[16], s1[16]; int n0[16], n1[16];
#pragma unroll
        for (int half = 0; half < 2; ++half) {
            unsigned v[16];
#pragma unroll
            for (int i = 0; i < 16; ++i) v[i] = 0u;
            for (int n4 = 0; n4 < 32; ++n4) { const f32x4 q = *(const f32x4*)(sc + half * 128 + n4 * 4);
#pragma unroll
                for (int e = 0; e < 4; ++e) { unsigned x = (okey(q[e]) & 0xffffff80u) | (unsigned)(127 - (n4 * 4 + e));
#pragma unroll
                    for (int i = 0; i < 16; ++i) { const unsigned hi = umax_(v[i], x); x = umin_(v[i], x); v[i] = hi; } } }
#pragma unroll
            for (int i = 0; i < 16; ++i) { const float sv = unkey(v[i] & 0xffffff80u); const int nn = 127 - (int)(v[i] & 127u);
                if (half == 0) { s0[i] = sv; n0[i] = nn; } else { s1[i] = sv; n1[i] = nn; } }
        }
        unsigned bk[16];
#pragma unroll
        for (int k = 0; k < 16; ++k) bk[k] = 0u;
#pragma unroll
        for (int i = 0; i < 16; ++i)
#pragma unroll
            for (int j = 0; j < 16; ++j) if ((i + 1) * (j + 1) <= 16) {
                unsigned x = (okey(s0[i] + s1[j]) & 0xffffff00u) | (unsigned)(255 - (i * 16 + j));
#pragma unroll
                for (int k = 0; k < 16; ++k) { const unsigned hi = umax_(bk[k], x); x = umin_(bk[k], x); bk[k] = hi; } }
        float bv[16]; int be[16];
#pragma unroll
        for (int k = 0; k < 16; ++k) { bv[k] = unkey(bk[k] & 0xffffff00u); const int code = 255 - (int)(bk[k] & 255u), ci = code >> 4, cj = code & 15;
            int a = n0[0], b = n1[0];
#pragma unroll
            for (int q = 1; q < 16; ++q) { a = (ci == q) ? n0[q] : a; b = (cj == q) ? n1[q] : b; }
            be[k] = a * 128 + b; }
        const float rstd = row_rstd(WSP(const float, WS_RSP), t);
        float m = bv[0] * rstd, l = 0.f;
        float ev[16];
#pragma unroll
        for (int k = 0; k < 16; ++k) { ev[k] = __expf(bv[k] * rstd - m); l += ev[k]; }
        const float inv = 1.0f / l;
        int* io = WSP(int, WS_IDX) + (size_t)t * 128 + h * 16; float* go = WSP(float, WS_GATE) + (size_t)t * 128 + h * 16;
#pragma unroll
        for (int k = 0; k < 16; k += 4) { *(int4*)(io + k) = make_int4(be[k], be[k + 1], be[k + 2], be[k + 3]); *(f32x4*)(go + k) = (f32x4){ev[k] * inv, ev[k + 1] * inv, ev[k + 2] * inv, ev[k + 3] * inv}; }
    }
}

__device__ __forceinline__ void unpack8(const v4u w, float* f) {
    f[0] = __uint_as_float(w.x << 16); f[1] = __uint_as_float(w.x & 0xffff0000u); f[2] = __uint_as_float(w.y << 16); f[3] = __uint_as_float(w.y & 0xffff0000u);
    f[4] = __uint_as_float(w.z << 16); f[5] = __uint_as_float(w.z & 0xffff0000u); f[6] = __uint_as_float(w.w << 16); f[7] = __uint_as_float(w.w & 0xffff0000u);
}
__device__ __forceinline__ void peer_rows(const P& p, int vcu, int G) {
    const int lane = threadIdx.x & 63, gw = vcu * NWAVES + (threadIdx.x >> 6), NGW = G * NWAVES;
    const v4u* U = WSP(const v4u, WS_UBF); const v4u* V = WSP(const v4u, WS_VBF);
    for (int t = gw; t < T; t += NGW) {
        float xh[32];
        { const v4u* xr = WSP(const v4u, WS_XG) + (size_t)t * 256 + lane;
#pragma unroll
          for (int i = 0; i < 4; ++i) unpack8(xr[64 * i], xh + 8 * i); }
        const int ia = WSP(const int, WS_IDX)[(size_t)t * 128 + lane], ib = WSP(const int, WS_IDX)[(size_t)t * 128 + 64 + lane];
        const float ga = WSP(const float, WS_GATE)[(size_t)t * 128 + lane], gb = WSP(const float, WS_GATE)[(size_t)t * 128 + 64 + lane];
        const float rstd = row_rstd(WSP(const float, WS_RSP), t);
        float aa = 0.f, ab = 0.f;
        for (int e0 = 0; e0 < 128; e0 += 4) {
            v4u w[4][4];
#pragma unroll
            for (int j = 0; j < 4; ++j) { const int e = e0 + j; const int row = __builtin_amdgcn_readlane(e < 64 ? ia : ib, e & 63);
                const v4u* ur = U + (size_t)row * 256 + lane;
#pragma unroll
                for (int i = 0; i < 4; ++i) w[j][i] = ur[64 * i]; }
#pragma unroll
            for (int j = 0; j < 4; ++j) { float d = 0.f;
#pragma unroll
                for (int i = 0; i < 4; ++i) { float f[8]; unpack8(w[j][i], f);
#pragma unroll
                    for (int q = 0; q < 8; ++q) d = fmaf(f[q], xh[8 * i + q], d); }
                d = wave_sum(d) * rstd; const int e = e0 + j;
                if (lane == (e & 63)) { if (e < 64) aa = d; else ab = d; } }
        }
        const float ha = 0.5f * aa * (1.0f + erff(aa * 0.70710678118f)) * ga, hb = 0.5f * ab * (1.0f + erff(ab * 0.70710678118f)) * gb;
        float acc[32];
#pragma unroll
        for (int i = 0; i < 32; ++i) acc[i] = 0.f;
        for (int e0 = 0; e0 < 128; e0 += 4) {
            v4u w[4][4]; float hv[4];
#pragma unroll
            for (int j = 0; j < 4; ++j) { const int e = e0 + j; const int row = __builtin_amdgcn_readlane(e < 64 ? ia : ib, e & 63);
                hv[j] = __builtin_bit_cast(float, __builtin_amdgcn_readlane(__builtin_bit_cast(int, e < 64 ? ha : hb), e & 63));
                const v4u* vr = V + (size_t)row * 256 + lane;
#pragma unroll
                for (int i = 0; i < 4; ++i) w[j][i] = vr[64 * i]; }
#pragma unroll
            for (int j = 0; j < 4; ++j)
#pragma unroll
                for (int i = 0; i < 4; ++i) { float f[8]; unpack8(w[j][i], f);
#pragma unroll
                    for (int q = 0; q < 8; ++q) acc[8 * i + q] = fmaf(hv[j], f[q], acc[8 * i + q]); }
        }
        float* orow = p.out + (size_t)t * DM; float ss = 0.f;
#pragma unroll
        for (int i = 0; i < 4; ++i) { const f32x4 a = *(const f32x4*)(orow + i * 512 + lane * 8), b = *(const f32x4*)(orow + i * 512 + lane * 8 + 4);
            acc[8 * i + 0] += a.x; acc[8 * i + 1] += a.y; acc[8 * i + 2] += a.z; acc[8 * i + 3] += a.w; acc[8 * i + 4] += b.x; acc[8 * i + 5] += b.y; acc[8 * i + 6] += b.z; acc[8 * i + 7] += b.w;
#pragma unroll
            for (int q = 0; q < 8; ++q) ss += acc[8 * i + q] * acc[8 * i + q]; }
        const float r2 = rsqrtf(wave_sum(ss) * (1.f / DM) + EPS);
#pragma unroll
        for (int i = 0; i < 4; ++i) { const f32x4 g0 = *(const f32x4*)(p.g_final + i * 512 + lane * 8), g1 = *(const f32x4*)(p.g_final + i * 512 + lane * 8 + 4);
            *(f32x4*)(orow + i * 512 + lane * 8) = (f32x4){acc[8 * i] * r2 * g0.x, acc[8 * i + 1] * r2 * g0.y, acc[8 * i + 2] * r2 * g0.z, acc[8 * i + 3] * r2 * g0.w};
            *(f32x4*)(orow + i * 512 + lane * 8 + 4) = (f32x4){acc[8 * i + 4] * r2 * g1.x, acc[8 * i + 5] * r2 * g1.y, acc[8 * i + 6] * r2 * g1.z, acc[8 * i + 7] * r2 * g1.w}; }
    }
}
#ifndef MK_SPLIT
#define MK_SPLIT 1
#endif
constexpr int NPHASE = 11;
template <int LO, int HI> __global__ void __launch_bounds__(NTHR, 2) mk_fwd(P p) {
    extern __shared__ __attribute__((aligned(16))) unsigned char lds[];
    const int G = gridDim.x, bx = blockIdx.x;
    const int vcu = (G % 8 == 0) ? (bx % 8) * (G / 8) + bx / 8 : bx;
    cg::grid_group grid = cg::this_grid();
#define IN(k) (LO <= (k) && (k) < HI)
#define SEAM(k) do { if constexpr (IN(k) && IN((k) + 1)) grid.sync(); } while (0)
    PG8_LAS unsigned char* glds = (PG8_LAS unsigned char*)lds;
    typedef pg8::EpiBf16<0> EB;
    if constexpr (IN(0)) { phase0(p, lds, vcu, G); } SEAM(0);
    if constexpr (IN(1)) {
        { pg8::Gemm g{WSP(const bf16, WS_H), WSP(const bf16, WS_WIN), T, NIN, DM, DM, DM}; pg8::StaticOrder S; S.init(T, NIN, G, bx);
          EB E{WSP(bf16, WS_PROJ), NIN, nullptr, 0, 0, 1.f}; pg8::gemm_phase<EB, pg8::StaticOrder, true, true>(glds, g, S, E); }
        { pg8::Gemm g{WSP(const bf16, WS_MEMN), WSP(const bf16, WS_WKV), MROWS, 1024, DM, DM, DM}; pg8::StaticOrder S; S.init(MROWS, 1024, G, bx);
          EB E{WSP(bf16, WS_KVM), 1024, nullptr, 0, 0, 1.f}; pg8::gemm_phase<EB, pg8::StaticOrder, true, true>(glds, g, S, E); }
        { pg8::Gemm g{WSP(const bf16, WS_WKV), WSP(const bf16, WS_MEMN), 1024, MROWS, DM, DM, DM}; pg8::StaticOrder S; S.init(1024, MROWS, G, (bx + 8) % G);
          EB E{WSP(bf16, WS_KVMT), MROWS, nullptr, 0, 0, 1.f}; pg8::gemm_phase<EB, pg8::StaticOrder, true, true>(glds, g, S, E); }
    } SEAM(1);
    if constexpr (IN(2)) {
        constexpr int N_DIL = BATCH * DIL_H * 64, N_H1 = BATCH * HG_H * 2 * 64, N_MEM = BATCH * MEM_H * 64;
        for (int it = bx; it < N_DIL + N_H1 + N_MEM; it += G) {
            if (it < N_DIL) dil_item(p, lds, it); else if (it < N_DIL + N_H1) h1_item(p, lds, it - N_DIL); else mem_item(p, lds, it - N_DIL - N_H1); }
    } SEAM(2);
    if constexpr (IN(3)) { h2_scan(p, vcu, G); } SEAM(3);
    if constexpr (IN(4)) { for (int it = bx; it < BATCH * HG_H * 64; it += G) h3_item(p, lds, it); dil_alpha_rows(p, vcu, G); } SEAM(4);
    if constexpr (IN(5)) {
#pragma unroll 1
        for (int br = 0; br < 3; ++br) { const int k0 = br * 768, kb = br < 2 ? 768 : 512;
            pg8::Gemm g{WSP(const bf16, WS_OCAT) + k0, WSP(const bf16, WS_WUP) + k0, T, DM, kb, DM, DM}; pg8::StaticOrder S; S.init(T, DM, G, bx);
            pg8::EpiUp E{WSP(const bf16, WS_PROJ) + C_GATE + br * DM, NIN, p.b_gate + br * DM, p.out, WSP(bf16, WS_MERGED), br};
            pg8::gemm_phase<pg8::EpiUp, pg8::StaticOrder, false, true>(glds, g, S, E); }
    } SEAM(5);
    if constexpr (IN(6)) { pg8::Gemm g{WSP(const bf16, WS_MERGED), WSP(const bf16, WS_WOUT), T, DM, DM, DM, DM}; pg8::StaticOrder S; S.init(T, DM, G, bx);
        pg8::EpiOut E{p.x, p.out, WSP(bf16, WS_XG), p.g_ffn, WSP(float, WS_RSP)};
        pg8::gemm_phase<pg8::EpiOut, pg8::StaticOrder, false, true>(glds, g, S, E); } SEAM(6);
    if constexpr (IN(7)) { pg8::Gemm g{WSP(const bf16, WS_XG), WSP(const bf16, WS_WQ), T, DM, DM, DM, DM}; pg8::StaticOrder S; S.init(T, DM, G, bx);
        EB E{WSP(bf16, WS_QP), DM, nullptr, 0, 0, 1.f}; pg8::gemm_phase<EB, pg8::StaticOrder, false, true>(glds, g, S, E); } SEAM(7);
    if constexpr (IN(8)) { pg8::Gemm g{WSP(const bf16, WS_QP), WSP(const bf16, WS_SKB), T * 8, 256, 256, 256, 256}; pg8::StaticOrder S; S.init(T * 8, 256, G, bx);
        pg8::EpiF32 E{WSP(float, WS_SC), 256}; pg8::gemm_phase<pg8::EpiF32, pg8::StaticOrder, false, true>(glds, g, S, E); } SEAM(8);
    if constexpr (IN(9)) { topk_rows(p, vcu, G); } SEAM(9);
    if constexpr (IN(10)) { peer_rows(p, vcu, G); }
#undef IN
#undef SEAM
}

#if MK_SPLIT
#define MK_FOR_PH(X) X(0) X(1) X(2) X(3) X(4) X(5) X(6) X(7) X(8) X(9) X(10)
static bool set_lds() { bool ok = true;
#define X(k) ok = ok && (hipFuncSetAttribute((const void*)mk_fwd<k, k + 1>, hipFuncAttributeMaxDynamicSharedMemorySize, LDS_BYTES) == hipSuccess);
    MK_FOR_PH(X)
#undef X
    return ok; }
static void launch_split(const P& p, int grid, hipStream_t stream) {
#define X(k) hipLaunchKernelGGL((mk_fwd<k, k + 1>), dim3(grid), dim3(NTHR), LDS_BYTES, stream, p);
    MK_FOR_PH(X)
#undef X
}
#else
static bool set_lds() { return hipFuncSetAttribute((const void*)mk_fwd<0, NPHASE>, hipFuncAttributeMaxDynamicSharedMemorySize, LDS_BYTES) == hipSuccess; }
#endif

extern "C" void kernel_launch(void* const* d_in, const int* in_sizes, int n_in, void* d_out, int out_size, void* d_ws, size_t ws_size, hipStream_t stream) {
    static int grid = 0;
    if (grid == 0) {
        if (n_in != 18 || out_size != T * DM || ws_size < WS_END) { fprintf(stderr, "kernel_launch: unexpected shapes (n_in %d, out %d, ws %zu)\n", n_in, out_size, ws_size); grid = -1; return; }
        int dev = 0, cus = 0, per_cu = 0;
        (void)hipGetDevice(&dev); (void)hipDeviceGetAttribute(&cus, hipDeviceAttributeMultiprocessorCount, dev);
        if (!set_lds()) { fprintf(stderr, "kernel_launch: hipFuncSetAttribute failed\n"); grid = -1; return; }
        (void)per_cu; (void)hipGetLastError();
        grid = cus;
    }
    if (grid < 0) return;
    P p{};
    p.x = (const float*)d_in[0]; p.mem = (const float*)d_in[1]; p.g_mix = (const float*)d_in[2]; p.w_in = (const float*)d_in[3]; p.b_gate = (const float*)d_in[4];
    p.lbf_l = (const float*)d_in[5]; p.lbb_l = (const float*)d_in[6]; p.g_hg = (const float*)d_in[7]; p.w_kv = (const float*)d_in[8]; p.g_mem = (const float*)d_in[9];
    p.w_up = (const float*)d_in[10]; p.w_out = (const float*)d_in[11]; p.g_ffn = (const float*)d_in[12]; p.w_q = (const float*)d_in[13]; p.subk = (const float*)d_in[14];
    p.pu = (const float*)d_in[15]; p.pv = (const float*)d_in[16]; p.g_final = (const float*)d_in[17];
    p.out = (float*)d_out; p.ws = (unsigned char*)d_ws;
#if MK_SPLIT
    launch_split(p, grid, stream);
#else
    p.ph_lo = 0; p.ph_hi = NPHASE;
    void* args[] = {&p};
    hipError_t e = hipLaunchCooperativeKernel((const void*)mk_fwd<0, NPHASE>, dim3(grid), dim3(NTHR), args, LDS_BYTES, stream);
    if (e != hipSuccess) fprintf(stderr, "kernel_launch: cooperative launch failed: %s (grid %d)\n", hipGetErrorString(e), grid);
#endif
}
```

```cpp
#include <hip/hip_runtime.h>
#include <hip/hip_cooperative_groups.h>
#include <cstdio>
#include <cstdint>
namespace cg = cooperative_groups;
namespace pg8 {
#define PG8_LAS __attribute__((address_space(3)))
typedef unsigned short bf16_t;
typedef short bf16x8 __attribute__((ext_vector_type(8)));
typedef float f32x4 __attribute__((ext_vector_type(4)));
typedef unsigned u32x4 __attribute__((ext_vector_type(4)));
constexpr int BM = 256, BK = 64, HALF = 128, HTB = HALF * BK * 2  , STAGE_BYTES = 8 * HTB, NXCD = 8, WGM = 8;

__host__ __device__ __forceinline__ int lds_byte(int r, int c) { const int st = (r >> 4) * 2 + (c >> 5), rr = r & 15, cc = c & 31, ob = rr * 64 + cc * 2; return st * 1024 + (ob ^ (((ob >> 9) & 1) << 5)); }
__host__ __device__ __forceinline__ void stage_rc(int b, int& R, int& C) { const int st = b / 1024, sb = b % 1024, swz = sb ^ (((sb >> 9) & 1) << 5); R = (st >> 1) * 16 + swz / 64; C = (st & 1) * 32 + (swz % 64) / 2; }
__host__ __device__ __forceinline__ int perm32(int rho) { const int n = rho >> 4, i = rho & 15; return 8 * (i >> 2) + 4 * n + (i & 3); }

struct Unit { int pm, pn; };
struct Gemm { const bf16_t* A; const bf16_t* Bt; int M, N, K, lda, ldb; };

struct StaticOrder {
    int nM, nN, nwg, G, c;
    __host__ __device__ void init(int M, int N, int G_, int c_) { nM = M / BM; nN = N / BM; nwg = nM * nN; G = G_; c = c_; }
    __host__ __device__ bool next(int i, Unit& u) const {
        const long L = (long)i * G + c; if (L >= nwg) return false;
        int wgid = (int)L; { const int q = nwg / NXCD, r = nwg % NXCD, xcd = wgid % NXCD, off = wgid / NXCD; wgid = (xcd < r ? xcd * (q + 1) : r * (q + 1) + (xcd - r) * q) + off; }
        const int nig = WGM * nN, gid = wgid / nig, fm = gid * WGM, gsz = (nM - fm) < WGM ? (nM - fm) : WGM;
        u.pm = fm + ((wgid % nig) % gsz); u.pn = (wgid % nig) / gsz; return true;
    }
    __device__ __forceinline__ void a_ready(const Unit&) const {}
    __device__ __forceinline__ void done(const Unit&) const {}
};

__device__ __forceinline__ unsigned cvt_pk_bf16(float lo, float hi) { unsigned r; asm volatile("v_cvt_pk_bf16_f32 %0, %1, %2" : "=v"(r) : "v"(lo), "v"(hi)); return r; }
typedef float f32x2 __attribute__((ext_vector_type(2)));
__device__ __forceinline__ f32x2 gelu_pk(f32x2 v) {
    const f32x2 av = __builtin_elementwise_abs(v), d = av * 0.2316418882f + 1.0f;
    f32x2 t; t.x = __builtin_amdgcn_rcpf(d.x); t.y = __builtin_amdgcn_rcpf(d.y);
    f32x2 q = t * 0.5307027145f + (-0.7265760135f); q = q * t + 0.7107068705f; q = q * t + (-0.142248368f); q = q * t + 0.127414796f; q = q * t;
    const f32x2 s = (v * v) * (-0.72134752044f);
    f32x2 e; e.x = __builtin_amdgcn_exp2f(s.x); e.y = __builtin_amdgcn_exp2f(s.y);
    const f32x2 m = v * (q * e), r = v - m;
    f32x2 o; o.x = v.x < 0.f ? m.x : r.x; o.y = v.y < 0.f ? m.y : r.y; return o;
}

template <int ACT  > struct EpiBf16 {
    static constexpr bool PERM = true, AFTER_DRAIN = false; static_assert(ACT == 0 || ACT == 1, "EpiBf16: ACT is 0 (none) or 1 (gelu_pk)");
    bf16_t* O; int ldc; const float* bias; int split_cols; size_t split_stride; float scale0;
    __device__ __forceinline__ void operator()(const f32x4 (&acc)[2][2][4][2], const Unit& u, int wr, int wc, int fr, int fq) const {
        const int row0 = u.pm * BM + wr * 64 + fr; int colt = u.pn * BM; bf16_t* base = O;
        float sc = 1.f; if (split_cols) { const int t = colt / split_cols; base += (size_t)t * split_stride; colt -= t * split_cols; if (t == 0) sc = scale0; }
        const int col0 = colt + wc * 32 + 8 * fq, bcol0 = u.pn * BM + wc * 32 + 8 * fq;
        f32x4 bv[2][2];
#pragma unroll
        for (int bj = 0; bj < 2; ++bj)
#pragma unroll
            for (int n = 0; n < 2; ++n) bv[bj][n] = bias ? *(const f32x4*)(bias + bcol0 + bj * HALF + 4 * n) : (f32x4){0.f, 0.f, 0.f, 0.f};
#pragma unroll
        for (int ai = 0; ai < 2; ++ai)
#pragma unroll
            for (int m = 0; m < 4; ++m) { bf16_t* rowp = base + (size_t)(row0 + ai * HALF + m * 16) * ldc + col0;
#pragma unroll
                for (int bj = 0; bj < 2; ++bj) { f32x4 v0 = acc[ai][bj][m][0] + bv[bj][0], v1 = acc[ai][bj][m][1] + bv[bj][1];
                    if (ACT == 1) { f32x2 a = gelu_pk((f32x2){v0[0], v0[1]}), b = gelu_pk((f32x2){v0[2], v0[3]}), c = gelu_pk((f32x2){v1[0], v1[1]}), d = gelu_pk((f32x2){v1[2], v1[3]});
                        v0 = (f32x4){a.x, a.y, b.x, b.y}; v1 = (f32x4){c.x, c.y, d.x, d.y}; }
                    v0 = v0 * sc; v1 = v1 * sc; u32x4 w; w.x = cvt_pk_bf16(v0[0], v0[1]); w.y = cvt_pk_bf16(v0[2], v0[3]); w.z = cvt_pk_bf16(v1[0], v1[1]); w.w = cvt_pk_bf16(v1[2], v1[3]);
                    *(u32x4*)(rowp + bj * HALF) = w; } }
    }
};
template <class Epi, class Sched, bool ALIGN_EPI = false, bool SP2 = false>
__device__ __forceinline__ void gemm_phase(PG8_LAS unsigned char* lds, const Gemm g, const Sched& S, const Epi& E) {
    const int tid = threadIdx.x, wid = __builtin_amdgcn_readfirstlane(tid >> 6), lane = tid & 63, wr = wid >> 2, wc = wid & 3, fr = lane & 15, fq = lane >> 4;
    const int K = g.K, nt = K / BK;
    unsigned voffA[2], voffB[2];
#pragma unroll
    for (int i = 0; i < 2; ++i) { int R, C; stage_rc(tid * 16 + i * 8192, R, C); const int Rb = Epi::PERM ? ((R & ~31) + perm32(R & 31)) : R;
        voffA[i] = (unsigned)(R * g.lda + C) * 2u; voffB[i] = (unsigned)(Rb * g.ldb + C) * 2u; }
    const size_t kstep = (size_t)(BK * 2);
    const size_t hstepA = (size_t)HALF * g.lda * 2, hstepB = (size_t)HALF * g.ldb * 2;
    const size_t tstepA = 2 * hstepA, tstepB = 2 * hstepB;
    const unsigned ldsw = (unsigned)wid * 1024u;
    const int aoff = lds_byte(wr * 64 + fr, fq * 8), boff = lds_byte(wc * 32 + fr, fq * 8);
#define PG8_SA(b, h) (((b) * 2 + (h)) * HTB)
#define PG8_SB(b, h) ((4 + (b) * 2 + (h)) * HTB)
#define PG8_STAGE(bufoff, gbase, voff) do { _Pragma("unroll") for (int _i = 0; _i < 2; ++_i) \
        __builtin_amdgcn_global_load_lds((const unsigned*)((const char*)(gbase) + (voff)[_i]), (PG8_LAS unsigned*)(lds + (bufoff) + ldsw + _i * 8192), 16, 0, 0); } while (0)
#define PG8_LDA(dst, b, h) do { _Pragma("unroll") for (int m = 0; m < 4; ++m) _Pragma("unroll") for (int k = 0; k < 2; ++k) dst[m][k] = *(const PG8_LAS bf16x8*)(lds + PG8_SA(b, h) + aoff + m * 2048 + k * 1024); } while (0)
#define PG8_LDB(dst, b, h) do { _Pragma("unroll") for (int n = 0; n < 2; ++n) _Pragma("unroll") for (int k = 0; k < 2; ++k) dst[n][k] = *(const PG8_LAS bf16x8*)(lds + PG8_SB(b, h) + boff + n * 2048 + k * 1024); } while (0)
#define PG8_MMA(ai, bj, At, Bt) do { __builtin_amdgcn_s_setprio(1); _Pragma("unroll") for (int m = 0; m < 4; ++m) _Pragma("unroll") for (int n = 0; n < 2; ++n) _Pragma("unroll") for (int k = 0; k < 2; ++k) \
        acc[ai][bj][m][n] = __builtin_amdgcn_mfma_f32_16x16x32_bf16(Bt[n][k], At[m][k], acc[ai][bj][m][n], 0, 0, 0); __builtin_amdgcn_s_setprio(0); } while (0)
#define PG8_WAIT_V(n) asm volatile("s_waitcnt vmcnt(" #n ")" ::: "memory")
#define PG8_WAIT_L(n) asm volatile("s_waitcnt lgkmcnt(" #n ")" ::: "memory")
#define PG8_BAR __builtin_amdgcn_s_barrier()
#define PG8_SCHED __builtin_amdgcn_sched_barrier(0)
    Unit cur, nxt; int ui = 0;
    if (!S.next(0, cur)) return;
    f32x4 acc[2][2][4][2];
#pragma unroll
    for (int a = 0; a < 2; ++a)
#pragma unroll
        for (int b = 0; b < 2; ++b)
#pragma unroll
            for (int m = 0; m < 4; ++m)
#pragma unroll
                for (int n = 0; n < 2; ++n) acc[a][b][m][n] = (f32x4){0.f, 0.f, 0.f, 0.f};
    bf16x8 At[4][2], B0[2][2], B1[2][2];
    const char* cA = (const char*)g.A + (size_t)cur.pm * tstepA; const char* cB = (const char*)g.Bt + (size_t)cur.pn * tstepB;
    S.a_ready(cur);
    if constexpr (SP2) {
        PG8_STAGE(PG8_SB(0, 0), cB, voffB); PG8_STAGE(PG8_SB(0, 1), cB + hstepB, voffB); PG8_STAGE(PG8_SA(0, 0), cA, voffA); PG8_STAGE(PG8_SA(0, 1), cA + hstepA, voffA);
        if (wr == 1) PG8_BAR;
        PG8_WAIT_V(2); PG8_BAR;
        PG8_STAGE(PG8_SB(1, 0), cB + kstep, voffB); PG8_STAGE(PG8_SA(1, 0), cA + kstep, voffA); PG8_STAGE(PG8_SB(1, 1), cB + hstepB + kstep, voffB);
        PG8_WAIT_V(6); PG8_BAR;
    } else {
        PG8_STAGE(PG8_SB(0, 0), cB, voffB); PG8_STAGE(PG8_SA(0, 0), cA, voffA); PG8_STAGE(PG8_SB(0, 1), cB + hstepB, voffB); PG8_STAGE(PG8_SA(0, 1), cA + hstepA, voffA);
        if (wr == 1) PG8_BAR;
        PG8_WAIT_V(4); PG8_BAR;
        PG8_STAGE(PG8_SB(1, 0), cB + kstep, voffB); PG8_STAGE(PG8_SA(1, 0), cA + kstep, voffA); PG8_STAGE(PG8_SB(1, 1), cB + hstepB + kstep, voffB);
        PG8_WAIT_V(6); PG8_BAR;
    }
    for (;;) {
        const bool has_next = S.next(ui + 1, nxt);
        const char* nA = has_next ? (const char*)g.A + (size_t)nxt.pm * tstepA : cA; const char* nB = has_next ? (const char*)g.Bt + (size_t)nxt.pn * tstepB : cB;
        for (int t = 0; t < nt; t += 2) {
            const bool last = (t == nt - 2);
            const char* a1 = cA + (size_t)(t + 1) * kstep;
            const char* a2 = last ? nA : cA + (size_t)(t + 2) * kstep; const char* b2 = last ? nB : cB + (size_t)(t + 2) * kstep;
            const char* a3 = a2 + kstep; const char* b3 = b2 + kstep;
            if (last && has_next) S.a_ready(nxt);
            if constexpr (SP2) {
            PG8_LDB(B0, 0, 0); PG8_LDB(B1, 0, 1); PG8_SCHED; PG8_LDA(At, 0, 0); PG8_STAGE(PG8_SA(1, 1), a1 + hstepA, voffA);
            PG8_WAIT_V(8); PG8_WAIT_L(0); PG8_BAR; PG8_MMA(0, 0, At, B0); PG8_MMA(0, 1, At, B1); PG8_BAR; PG8_SCHED;
            PG8_LDA(At, 0, 1); PG8_STAGE(PG8_SB(0, 0), b2, voffB); PG8_STAGE(PG8_SB(0, 1), b2 + hstepB, voffB); PG8_STAGE(PG8_SA(0, 0), a2, voffA);
            PG8_WAIT_V(8); PG8_WAIT_L(0); PG8_BAR; PG8_MMA(1, 0, At, B0); PG8_MMA(1, 1, At, B1); PG8_BAR; PG8_SCHED;
            PG8_LDB(B0, 1, 0); PG8_LDB(B1, 1, 1); PG8_SCHED; PG8_LDA(At, 1, 0); PG8_STAGE(PG8_SA(0, 1), a2 + hstepA, voffA);
            PG8_WAIT_V(8); PG8_WAIT_L(0); PG8_BAR; PG8_MMA(0, 0, At, B0); PG8_MMA(0, 1, At, B1); PG8_BAR; PG8_SCHED;
            PG8_LDA(At, 1, 1); PG8_STAGE(PG8_SB(1, 0), b3, voffB); PG8_STAGE(PG8_SB(1, 1), b3 + hstepB, voffB); PG8_STAGE(PG8_SA(1, 0), a3, voffA);
            PG8_WAIT_V(8); PG8_WAIT_L(0); PG8_BAR; PG8_MMA(1, 0, At, B0); PG8_MMA(1, 1, At, B1); PG8_BAR; PG8_SCHED;
            } else {
            PG8_LDB(B0, 0, 0); PG8_SCHED; PG8_LDA(At, 0, 0); PG8_STAGE(PG8_SA(1, 1), a1 + hstepA, voffA);
            PG8_WAIT_L(8); PG8_BAR; PG8_WAIT_L(0); PG8_MMA(0, 0, At, B0); PG8_BAR; PG8_SCHED;
            PG8_LDB(B1, 0, 1); PG8_STAGE(PG8_SB(0, 0), b2, voffB);
            PG8_BAR; PG8_WAIT_L(0); PG8_MMA(0, 1, At, B1); PG8_BAR;
            PG8_LDA(At, 0, 1); PG8_STAGE(PG8_SA(0, 0), a2, voffA);
            PG8_BAR; PG8_WAIT_L(0); PG8_MMA(1, 0, At, B0); PG8_BAR; PG8_SCHED;
            PG8_STAGE(PG8_SB(0, 1), b2 + hstepB, voffB);
            PG8_WAIT_V(6); PG8_BAR; PG8_MMA(1, 1, At, B1); PG8_BAR;
            PG8_LDB(B0, 1, 0); PG8_SCHED; PG8_LDA(At, 1, 0); PG8_STAGE(PG8_SA(0, 1), a2 + hstepA, voffA);
            PG8_WAIT_L(8); PG8_BAR; PG8_WAIT_L(0); PG8_MMA(0, 0, At, B0); PG8_BAR; PG8_SCHED;
            PG8_LDB(B1, 1, 1); PG8_STAGE(PG8_SB(1, 0), b3, voffB);
            PG8_BAR; PG8_WAIT_L(0); PG8_MMA(0, 1, At, B1); PG8_BAR;
            PG8_LDA(At, 1, 1); PG8_STAGE(PG8_SA(1, 0), a3, voffA);
            PG8_BAR; PG8_WAIT_L(0); PG8_MMA(1, 0, At, B0); PG8_BAR; PG8_SCHED;
            PG8_STAGE(PG8_SB(1, 1), b3 + hstepB, voffB);
            PG8_WAIT_V(6); PG8_BAR; PG8_MMA(1, 1, At, B1); PG8_BAR;
            }
        }
        if constexpr (ALIGN_EPI) { if (wr == 0) PG8_BAR; }
        if constexpr (!Epi::AFTER_DRAIN) { E(acc, cur, wr, wc, fr, fq); S.done(cur); }
        if (!has_next) break;
#pragma unroll
        for (int a = 0; a < 2; ++a)
#pragma unroll
            for (int b = 0; b < 2; ++b)
#pragma unroll
                for (int m = 0; m < 4; ++m)
#pragma unroll
                    for (int n = 0; n < 2; ++n) acc[a][b][m][n] = (f32x4){0.f, 0.f, 0.f, 0.f};
        cur = nxt; cA = nA; cB = nB; ++ui;
        if constexpr (ALIGN_EPI) { if (wr == 1) PG8_BAR; }
    }
    PG8_WAIT_V(0);
    if constexpr (!ALIGN_EPI) { if (wr == 0) PG8_BAR; }
    PG8_BAR;
    if constexpr (Epi::AFTER_DRAIN) { E.fused(acc, cur, wr, wc, fr, fq, lds, wid, lane); S.done(cur); }
#undef PG8_SA
#undef PG8_SB
#undef PG8_STAGE
#undef PG8_LDA
#undef PG8_LDB
#undef PG8_MMA
#undef PG8_WAIT_V
#undef PG8_WAIT_L
#undef PG8_BAR
#undef PG8_SCHED
}
struct EpiF32 {
    static constexpr bool PERM = false, AFTER_DRAIN = false;
    float* C; int ldc;
    __device__ __forceinline__ void operator()(const f32x4 (&acc)[2][2][4][2], const Unit& u, int wr, int wc, int fr, int fq) const {
        const int row0 = u.pm * BM + wr * 64 + fr, col0 = u.pn * BM + wc * 32 + 4 * fq;
#pragma unroll
        for (int ai = 0; ai < 2; ++ai)
#pragma unroll
            for (int m = 0; m < 4; ++m) { float* rowp = C + (size_t)(row0 + ai * HALF + m * 16) * ldc + col0;
#pragma unroll
                for (int bj = 0; bj < 2; ++bj)
#pragma unroll
                    for (int n = 0; n < 2; ++n) *(f32x4*)(rowp + bj * HALF + n * 16) = acc[ai][bj][m][n]; }
    }
};
__device__ __forceinline__ float bfu(unsigned short h) { return __uint_as_float(((unsigned)h) << 16); }
__device__ __forceinline__ float sigm(float x) { return 1.0f / (1.0f + __expf(-x)); }
struct EpiUp {
    static constexpr bool PERM = true, AFTER_DRAIN = false;
    const bf16_t* graw; int ldg;
    const float* bg;
    float* part; bf16_t* merged; int mode;
    __device__ __forceinline__ void operator()(const f32x4 (&acc)[2][2][4][2], const Unit& u, int wr, int wc, int fr, int fq) const {
        const int row0 = u.pm * BM + wr * 64 + fr, col0 = u.pn * BM + wc * 32 + 8 * fq;
#pragma unroll
        for (int ai = 0; ai < 2; ++ai)
#pragma unroll
            for (int m = 0; m < 4; ++m) { const size_t row = (size_t)(row0 + ai * HALF + m * 16);
#pragma unroll
                for (int bj = 0; bj < 2; ++bj) { const int col = col0 + bj * HALF;
                    const u32x4 gr = *(const u32x4*)(graw + row * ldg + col);
                    const f32x4 b0 = *(const f32x4*)(bg + col), b1 = *(const f32x4*)(bg + col + 4);
                    f32x4 g0, g1;
                    g0[0] = sigm(__uint_as_float(gr.x << 16) + b0[0]); g0[1] = sigm(__uint_as_float(gr.x & 0xffff0000u) + b0[1]);
                    g0[2] = sigm(__uint_as_float(gr.y << 16) + b0[2]); g0[3] = sigm(__uint_as_float(gr.y & 0xffff0000u) + b0[3]);
                    g1[0] = sigm(__uint_as_float(gr.z << 16) + b1[0]); g1[1] = sigm(__uint_as_float(gr.z & 0xffff0000u) + b1[1]);
                    g1[2] = sigm(__uint_as_float(gr.w << 16) + b1[2]); g1[3] = sigm(__uint_as_float(gr.w & 0xffff0000u) + b1[3]);
                    f32x4 v0 = acc[ai][bj][m][0] * g0, v1 = acc[ai][bj][m][1] * g1;
                    float* pp = part + row * 2048 + col;
                    if (mode != 0) { v0 += *(const f32x4*)pp; v1 += *(const f32x4*)(pp + 4); }
                    if (mode != 2) { *(f32x4*)pp = v0; *(f32x4*)(pp + 4) = v1; }
                    else { u32x4 w; w.x = cvt_pk_bf16(v0[0], v0[1]); w.y = cvt_pk_bf16(v0[2], v0[3]); w.z = cvt_pk_bf16(v1[0], v1[1]); w.w = cvt_pk_bf16(v1[2], v1[3]);
                        *(u32x4*)(merged + row * 2048 + col) = w; } } }
    }
};
struct EpiOut {
    static constexpr bool PERM = true, AFTER_DRAIN = false;
    const float* x; float* x1; bf16_t* xg; const float* gffn; float* rowss;
    __device__ __forceinline__ void operator()(const f32x4 (&acc)[2][2][4][2], const Unit& u, int wr, int wc, int fr, int fq) const {
        const int row0 = u.pm * BM + wr * 64 + fr, col0 = u.pn * BM + wc * 32 + 8 * fq;
#pragma unroll
        for (int ai = 0; ai < 2; ++ai)
#pragma unroll
            for (int m = 0; m < 4; ++m) { const size_t row = (size_t)(row0 + ai * HALF + m * 16); float ss = 0.f;
#pragma unroll
                for (int bj = 0; bj < 2; ++bj) { const int col = col0 + bj * HALF; const size_t off = row * 2048 + col;
                    const f32x4 v0 = acc[ai][bj][m][0] + *(const f32x4*)(x + off), v1 = acc[ai][bj][m][1] + *(const f32x4*)(x + off + 4);
                    *(f32x4*)(x1 + off) = v0; *(f32x4*)(x1 + off + 4) = v1;
                    ss += (v0[0] * v0[0] + v0[1] * v0[1]) + (v0[2] * v0[2] + v0[3] * v0[3]) + (v1[0] * v1[0] + v1[1] * v1[1]) + (v1[2] * v1[2] + v1[3] * v1[3]);
                    const f32x4 g0 = *(const f32x4*)(gffn + col), g1 = *(const f32x4*)(gffn + col + 4);
                    const f32x4 y0 = v0 * g0, y1 = v1 * g1;
                    u32x4 w; w.x = cvt_pk_bf16(y0[0], y0[1]); w.y = cvt_pk_bf16(y0[2], y0[3]); w.z = cvt_pk_bf16(y1[0], y1[1]); w.w = cvt_pk_bf16(y1[2], y1[3]);
                    *(u32x4*)(xg + off) = w; }
                ss += __shfl_xor(ss, 16); ss += __shfl_xor(ss, 32);
                if (fq == 0) rowss[row * 32 + u.pn * 4 + wc] = ss; }
    }
};
}
constexpr int NWAVES = 8, NTHR = 512;
constexpr int BATCH = 2, SEQ = 4096, DM = 2048, T = BATCH * SEQ;
constexpr int NIN = 12800, MEML = 256, MROWS = BATCH * MEML;
constexpr int HG_H = 6, DIL_H = 12, MEM_H = 4;
constexpr int C_Q = 0, C_V = 768, C_ZF = 1536, C_ZB = 2304, C_HG = 3072, C_DQ = 3840, C_DK = 4608, C_DV = 5376, C_MQ = 6144, C_GATE = 6656;
constexpr int NEXP = 16384;
constexpr float EPS = 1e-6f;
constexpr size_t MiB = 1u << 20;
constexpr size_t WS_CTL = 0;
constexpr size_t WS_LBF = 64 * 1024, WS_LBB = WS_LBF + 4096, WS_ROWSS = 128 * 1024  , WS_SKB = 256 * 1024  , WS_DEC = 512 * 1024  ;
constexpr size_t WS_WIN = 1 * MiB;
constexpr size_t WS_MERGED = WS_WIN;
constexpr size_t WS_WUP = 51 * MiB, WS_WOUT = 59 * MiB, WS_WQ = 67 * MiB, WS_WKV = 75 * MiB;
constexpr size_t WS_KVM = 79 * MiB, WS_KVMT = 80 * MiB;
constexpr size_t WS_MEMN = 81 * MiB;
constexpr size_t WS_LSE = 83 * MiB;
constexpr size_t WS_D = 84 * MiB;
constexpr size_t WS_IDX = 85 * MiB, WS_GATE = 89 * MiB;
constexpr size_t WS_UBF = 93 * MiB, WS_VBF = 157 * MiB;
constexpr size_t WS_H = 221 * MiB;
constexpr size_t WS_OCAT = WS_H;
constexpr size_t WS_ST = 253 * MiB;
constexpr size_t WS_PROJ = 301 * MiB;
constexpr size_t WS_XG = WS_PROJ, WS_QP = WS_PROJ + 32 * MiB, WS_SC = WS_PROJ + 64 * MiB;
constexpr size_t WS_RSP = 501 * MiB;
constexpr size_t WS_END = 502 * MiB;
constexpr int LDS_BYTES = 147456;
#define GAS __attribute__((address_space(1)))
#define LAS __attribute__((address_space(3)))
typedef unsigned short bf16;
typedef unsigned v4u __attribute__((ext_vector_type(4)));
typedef unsigned v2u __attribute__((ext_vector_type(2)));
typedef float f32x4 __attribute__((ext_vector_type(4)));
typedef float f32x16 __attribute__((ext_vector_type(16)));
typedef short bf16x8 __attribute__((ext_vector_type(8)));
__device__ __forceinline__ float bf2f(unsigned short h) { return __uint_as_float(((unsigned)h) << 16); }
__device__ __forceinline__ unsigned f2bf(float f) { unsigned u = __float_as_uint(f); return (u + 0x7fffu + ((u >> 16) & 1u)) >> 16; }
__device__ __forceinline__ unsigned pk2(float lo, float hi) { return f2bf(lo) | (f2bf(hi) << 16); }
__device__ __forceinline__ float wave_sum(float v) {
#pragma unroll
    for (int o = 1; o < 64; o <<= 1) v += __shfl_xor(v, o);
    return v;
}
__device__ __forceinline__ float wave_max(float v) {
#pragma unroll
    for (int o = 1; o < 64; o <<= 1) v = fmaxf(v, __shfl_xor(v, o));
    return v;
}
__device__ __forceinline__ float row_rstd(const float* rsp, int t) {
    const f32x4* q = (const f32x4*)(rsp + (size_t)t * 32); float s = 0.f;
#pragma unroll
    for (int i = 0; i < 8; ++i) { const f32x4 v = q[i]; s += (v.x + v.y) + (v.z + v.w); }
    return rsqrtf(s * (1.f / 2048.f) + 1e-6f);
}
__device__ __forceinline__ float sigmoidf_(float x) { return 1.0f / (1.0f + __expf(-x)); }

struct P {
    const float *x, *mem, *g_mix, *w_in, *b_gate, *lbf_l, *lbb_l, *g_hg, *w_kv, *g_mem, *w_up, *w_out, *g_ffn, *w_q, *subk, *pu, *pv, *g_final;
    float* out; unsigned char* ws; int ph_lo, ph_hi;
};
#define WSP(T_, off) ((T_*)(p.ws + (off)))

__device__ __forceinline__ void p0_transpose_item(const float* W, int K, int N, bf16* WT, float* scr, int item, int lane) {
    const int nblk = N / 32, kb = item / nblk, nb = item % nblk, k0 = 64 * kb, n0 = 32 * nb;
#pragma unroll 8
    for (int i = 0; i < 32; ++i) { const int kk = 2 * i + (lane >> 5); scr[kk * 33 + (lane & 31)] = W[(size_t)(k0 + kk) * N + n0 + (lane & 31)]; }
    asm volatile("s_waitcnt lgkmcnt(0)" ::: "memory");
    const int c = lane & 7;
#pragma unroll
    for (int j = 0; j < 4; ++j) { const int n = (lane >> 3) + 8 * j; const float* s = scr + (8 * c) * 33 + n;
        v4u o; o.x = pk2(s[0 * 33], s[1 * 33]); o.y = pk2(s[2 * 33], s[3 * 33]); o.z = pk2(s[4 * 33], s[5 * 33]); o.w = pk2(s[6 * 33], s[7 * 33]);
        *(v4u*)(WT + (size_t)(n0 + n) * K + k0 + 8 * c) = o; }
    asm volatile("s_waitcnt lgkmcnt(0)" ::: "memory");
}
__device__ __forceinline__ void rms_row_to_bf16(const float* xrow, const float* g, bf16* orow, int lane) {
    const f32x4* xr = (const f32x4*)xrow + lane; const f32x4* gr = (const f32x4*)g + lane;
    f32x4 v[8]; float s = 0.f;
#pragma unroll
    for (int j = 0; j < 8; ++j) { v[j] = xr[64 * j]; s += (v[j].x * v[j].x + v[j].y * v[j].y) + (v[j].z * v[j].z + v[j].w * v[j].w); }
    const float rstd = rsqrtf(wave_sum(s) * (1.f / DM) + EPS);
    v2u* o8 = (v2u*)orow + lane;
#pragma unroll
    for (int j = 0; j < 8; ++j) { const f32x4 gg = gr[64 * j]; v2u w; w.x = pk2(v[j].x * rstd * gg.x, v[j].y * rstd * gg.y); w.y = pk2(v[j].z * rstd * gg.z, v[j].w * rstd * gg.w); o8[64 * j] = w; }
}
__device__ __forceinline__ void phase0(const P& p, unsigned char* lds, int vcu, int G) {
    const int tid = threadIdx.x, lane = tid & 63, wave = tid >> 6;
    float* scr = (float*)(lds + wave * 16384);
    const int gw = vcu * NWAVES + wave, NGW = G * NWAVES;
    constexpr int I_IN = (DM / 64) * (NIN / 32), I_KV = (DM / 64) * (1024 / 32), I_SQ = (DM / 64) * (DM / 32);
    constexpr int NITEMS = I_IN + I_KV + 3 * I_SQ;
    for (int it = gw; it < NITEMS; it += NGW) {
        int r = it;
        if (r < I_IN) { p0_transpose_item(p.w_in, DM, NIN, WSP(bf16, WS_WIN), scr, r, lane); continue; } r -= I_IN;
        if (r < I_KV) { p0_transpose_item(p.w_kv, DM, 1024, WSP(bf16, WS_WKV), scr, r, lane); continue; } r -= I_KV;
        if (r < I_SQ) { p0_transpose_item(p.w_up, DM, DM, WSP(bf16, WS_WUP), scr, r, lane); continue; } r -= I_SQ;
        if (r < I_SQ) { p0_transpose_item(p.w_out, DM, DM, WSP(bf16, WS_WOUT), scr, r, lane); continue; } r -= I_SQ;
        p0_transpose_item(p.w_q, DM, DM, WSP(bf16, WS_WQ), scr, r, lane);
    }
    for (int m = gw; m < T; m += NGW) rms_row_to_bf16(p.x + (size_t)m * DM, p.g_mix, WSP(bf16, WS_H) + (size_t)m * DM, lane);
    for (int m = gw; m < MROWS; m += NGW) rms_row_to_bf16(p.mem + (size_t)m * DM, p.g_mem, WSP(bf16, WS_MEMN) + (size_t)m * DM, lane);
    const size_t gt = (size_t)vcu * NTHR + tid, NGT = (size_t)G * NTHR;
    for (size_t i = gt; i < (size_t)NEXP * DM / 8; i += NGT) {
        const f32x4 a = ((const f32x4*)p.pu)[2 * i], b = ((const f32x4*)p.pu)[2 * i + 1];
        v4u o; o.x = pk2(a.x, a.y); o.y = pk2(a.z, a.w); o.z = pk2(b.x, b.y); o.w = pk2(b.z, b.w); WSP(v4u, WS_UBF)[i] = o;
        const f32x4 c = ((const f32x4*)p.pv)[2 * i], d = ((const f32x4*)p.pv)[2 * i + 1];
        v4u q; q.x = pk2(c.x, c.y); q.y = pk2(c.z, c.w); q.z = pk2(d.x, d.y); q.w = pk2(d.z, d.w); WSP(v4u, WS_VBF)[i] = q;
    }
    for (size_t i = gt; i < 65536; i += NGT) { const int n = (int)(i >> 8), c = (int)(i & 255); float v = 0.f;
        if (n < 128 && c < 128) v = p.subk[n * 128 + c]; else if (n >= 128 && c >= 128) v = p.subk[16384 + (n - 128) * 128 + (c - 128)];
        WSP(bf16, WS_SKB)[i] = (bf16)f2bf(v); }
    for (size_t i = gt; i < 768; i += NGT) { WSP(float, WS_LBF)[i] = 1.0f / (1.0f + __expf(p.lbf_l[768 + i] - p.lbf_l[i])); WSP(float, WS_LBB)[i] = 1.0f / (1.0f + __expf(p.lbb_l[768 + i] - p.lbb_l[i])); }
}
__device__ __forceinline__ f32x16 mfma32(bf16x8 a, bf16x8 b, f32x16 c) { return __builtin_amdgcn_mfma_f32_32x32x16_bf16(a, b, c, 0, 0, 0); }
__device__ __forceinline__ f32x4 mfma16(bf16x8 a, bf16x8 b, f32x4 c) { return __builtin_amdgcn_mfma_f32_16x16x32_bf16(a, b, c, 0, 0, 0); }
__device__ __forceinline__ f32x16 zero16() { f32x16 z; for (int i = 0; i < 16; ++i) z[i] = 0.f; return z; }

__device__ __forceinline__ void h1_item(const P& p, unsigned char* lds, int item) {
    const int tid = threadIdx.x, lane = tid & 63, wave = tid >> 6, c = tid & 127, tq = tid >> 7;
    const int n = item & 63, dir = (item >> 6) & 1, bh = item >> 7, b = bh / 6, h = bh % 6, chain = bh * 2 + dir;
    const bf16* proj = WSP(const bf16, WS_PROJ) + (size_t)(b * SEQ + n * 64) * NIN;
    const int zc = (dir ? C_ZB : C_ZF) + h * 128 + c, vc = C_V + h * 128 + c;
    const float lb = WSP(const float, dir ? WS_LBB : WS_LBF)[h * 128 + c];
    float* segs = (float*)lds;
    bf16* KhT = (bf16*)(lds + 2048);
    bf16* VT = (bf16*)(lds + 2048 + 18432);
    float lf[16], kk[16]; float seg = 0.f;
#pragma unroll
    for (int i = 0; i < 16; ++i) { const int s = tq * 16 + i; const float z = bf2f(proj[(size_t)s * NIN + zc]); const float f = lb + (1.f - lb) * sigmoidf_(z);
        lf[i] = __logf(f); kk[i] = 1.f - f; seg += lf[i]; VT[c * 72 + s] = proj[(size_t)s * NIN + vc]; }
    segs[tq * 128 + c] = seg;
    __syncthreads();
    const float s0 = segs[c], s1 = segs[128 + c], s2 = segs[256 + c], s3 = segs[384 + c];
    if (dir == 0) { float run = (tq < 1 ? s1 : 0.f) + (tq < 2 ? s2 : 0.f) + (tq < 3 ? s3 : 0.f);
#pragma unroll
        for (int i = 15; i >= 0; --i) { KhT[c * 72 + tq * 16 + i] = (bf16)f2bf(kk[i] * __expf(run)); run += lf[i]; } }
    else { float run = (tq > 0 ? s0 : 0.f) + (tq > 1 ? s1 : 0.f) + (tq > 2 ? s2 : 0.f);
#pragma unroll
        for (int i = 0; i < 16; ++i) { KhT[c * 72 + tq * 16 + i] = (bf16)f2bf(kk[i] * __expf(run)); run += lf[i]; } }
    if (tq == 0) WSP(float, WS_D)[(size_t)(chain * 64 + n) * 128 + c] = __expf((s0 + s1) + (s2 + s3));
    __syncthreads();
    const int r32 = lane & 31, hi = lane >> 5, dvt = wave >> 1, c0 = (wave & 1) * 64;
    f32x16 acc0 = zero16(), acc1 = zero16();
#pragma unroll
    for (int ks = 0; ks < 4; ++ks) {
        const bf16x8 a = *(const bf16x8*)(VT + (dvt * 32 + r32) * 72 + ks * 16 + hi * 8);
        const bf16x8 b0 = *(const bf16x8*)(KhT + (c0 + r32) * 72 + ks * 16 + hi * 8), b1 = *(const bf16x8*)(KhT + (c0 + 32 + r32) * 72 + ks * 16 + hi * 8);
        acc0 = mfma32(a, b0, acc0); acc1 = mfma32(a, b1, acc1); }
    bf16* st = WSP(bf16, WS_ST) + (size_t)(chain * 64 + n) * 16384;
#pragma unroll
    for (int r = 0; r < 16; ++r) { const int dv = dvt * 32 + (r & 3) + 8 * (r >> 2) + 4 * hi;
        st[dv * 128 + c0 + r32] = (bf16)f2bf(acc0[r]); st[dv * 128 + c0 + 32 + r32] = (bf16)f2bf(acc1[r]); }
    __syncthreads();
}

__device__ __forceinline__ void h2_scan(const P& p, int vcu, int G) {
    const int gt = vcu * NTHR + threadIdx.x, NGT = G * NTHR;
    for (int w = gt; w < 24 * 2048; w += NGT) {
        const int chain = w >> 11, e8 = w & 2047, c8 = (e8 & 15) * 8, dir = chain & 1;
        float run[8];
#pragma unroll
        for (int j = 0; j < 8; ++j) run[j] = 0.f;
        for (int k = 0; k < 64; ++k) { const int n = dir ? 63 - k : k;
            v4u* ptr = WSP(v4u, WS_ST) + ((size_t)(chain * 64 + n) * 16384 + e8 * 8) / 8;
            const v4u L = *ptr; const f32x4 d0 = *(const f32x4*)(WSP(const float, WS_D) + (size_t)(chain * 64 + n) * 128 + c8), d1 = *(const f32x4*)(WSP(const float, WS_D) + (size_t)(chain * 64 + n) * 128 + c8 + 4);
            v4u o; o.x = pk2(run[0], run[1]); o.y = pk2(run[2], run[3]); o.z = pk2(run[4], run[5]); o.w = pk2(run[6], run[7]); *ptr = o;
            run[0] = d0.x * run[0] + __uint_as_float(L.x << 16); run[1] = d0.y * run[1] + __uint_as_float(L.x & 0xffff0000u);
            run[2] = d0.z * run[2] + __uint_as_float(L.y << 16); run[3] = d0.w * run[3] + __uint_as_float(L.y & 0xffff0000u);
            run[4] = d1.x * run[4] + __uint_as_float(L.z << 16); run[5] = d1.y * run[5] + __uint_as_float(L.z & 0xffff0000u);
            run[6] = d1.z * run[6] + __uint_as_float(L.w << 16); run[7] = d1.w * run[7] + __uint_as_float(L.w & 0xffff0000u);
        }
    }
}

__device__ __forceinline__ void h3_item(const P& p, unsigned char* lds, int item) {
    const int tid = threadIdx.x, lane = tid & 63, wave = tid >> 6, c = tid & 127, tq = tid >> 7;
    const int n = item & 63, bh = item >> 6, b = bh / 6, h = bh % 6;
    const size_t row0 = (size_t)(b * SEQ + n * 64);
    const bf16* proj = WSP(const bf16, WS_PROJ) + row0 * NIN;
    float* SEG = (float*)lds;
    bf16* QF = (bf16*)(lds + 4096);
    bf16* QB = (bf16*)(lds + 4096 + 17408);
    bf16* KF = (bf16*)(lds + 4096 + 2 * 17408);
    bf16* KB = (bf16*)(lds + 4096 + 3 * 17408);
    bf16* VT = (bf16*)(lds + 4096 + 4 * 17408);
    bf16* A2 = (bf16*)(lds + 4096 + 4 * 17408 + 18432);
    float* OB = (float*)(lds + 4096);
    float lff[16], kf[16], lfb[16], kb[16];
    { const float lbF = WSP(const float, WS_LBF)[h * 128 + c], lbB = WSP(const float, WS_LBB)[h * 128 + c]; float sf = 0.f, sb = 0.f;
#pragma unroll
      for (int i = 0; i < 16; ++i) { const int s = tq * 16 + i;
        const float zf = bf2f(proj[(size_t)s * NIN + C_ZF + h * 128 + c]), zb = bf2f(proj[(size_t)s * NIN + C_ZB + h * 128 + c]);
        const float ff = lbF + (1.f - lbF) * sigmoidf_(zf), fb = lbB + (1.f - lbB) * sigmoidf_(zb);
        lff[i] = __logf(ff); kf[i] = 1.f - ff; sf += lff[i]; lfb[i] = __logf(fb); kb[i] = 1.f - fb; sb += lfb[i];
        VT[c * 72 + s] = proj[(size_t)s * NIN + C_V + h * 128 + c]; }
      SEG[tq * 128 + c] = sf; SEG[512 + tq * 128 + c] = sb; }
    __syncthreads();
    {
      float runf = (tq > 0 ? SEG[c] : 0.f) + (tq > 1 ? SEG[128 + c] : 0.f) + (tq > 2 ? SEG[256 + c] : 0.f);
      float runb = (tq < 1 ? SEG[512 + 128 + c] : 0.f) + (tq < 2 ? SEG[512 + 256 + c] : 0.f) + (tq < 3 ? SEG[512 + 384 + c] : 0.f);
      float bb[16];
#pragma unroll
      for (int i = 15; i >= 0; --i) { runb += lfb[i]; bb[i] = runb; }
#pragma unroll
      for (int i = 0; i < 16; ++i) { const int s = tq * 16 + i; runf += lff[i];
        const float q = bf2f(proj[(size_t)s * NIN + C_Q + h * 128 + c]);
        QF[s * 136 + c] = (bf16)f2bf(q * __expf(runf)); KF[s * 136 + c] = (bf16)f2bf(kf[i] * __expf(-runf));
        QB[s * 136 + c] = (bf16)f2bf(q * __expf(bb[i])); KB[s * 136 + c] = (bf16)f2bf(kb[i] * __expf(-bb[i])); } }
    __syncthreads();
    const int r32 = lane & 31, hi = lane >> 5;
    {
      const int dir = wave >> 2, ti = (wave >> 1) & 1, si = wave & 1;
      const bf16* Qd = dir ? QB : QF; const bf16* Kd = dir ? KB : KF;
      f32x16 a = zero16();
#pragma unroll
      for (int ks = 0; ks < 8; ++ks) a = mfma32(*(const bf16x8*)(Qd + (ti * 32 + r32) * 136 + ks * 16 + hi * 8), *(const bf16x8*)(Kd + (si * 32 + r32) * 136 + ks * 16 + hi * 8), a);
#pragma unroll
      for (int r = 0; r < 16; ++r) { const int t = ti * 32 + (r & 3) + 8 * (r >> 2) + 4 * hi, s = si * 32 + r32;
        const bool keep = dir ? (s >= t) : (s <= t);
        A2[t * 136 + dir * 64 + s] = (bf16)f2bf(keep ? a[r] : 0.f); } }
    __syncthreads();
    f32x16 o = zero16();
    const int tt = wave >> 2, dt = wave & 3;
    { const bf16* stf = WSP(const bf16, WS_ST) + (size_t)((bh * 2 + 0) * 64 + n) * 16384 + (size_t)(dt * 32 + r32) * 128 + hi * 8;
      const bf16* stb = WSP(const bf16, WS_ST) + (size_t)((bh * 2 + 1) * 64 + n) * 16384 + (size_t)(dt * 32 + r32) * 128 + hi * 8;
#pragma unroll
      for (int ks = 0; ks < 8; ++ks) {
        o = mfma32(*(const bf16x8*)(QF + (tt * 32 + r32) * 136 + ks * 16 + hi * 8), *(const bf16x8*)(stf + ks * 16), o);
        o = mfma32(*(const bf16x8*)(QB + (tt * 32 + r32) * 136 + ks * 16 + hi * 8), *(const bf16x8*)(stb + ks * 16), o);
        o = mfma32(*(const bf16x8*)(A2 + (tt * 32 + r32) * 136 + ks * 16 + hi * 8), *(const bf16x8*)(VT + (dt * 32 + r32) * 72 + (ks & 3) * 16 + hi * 8), o); } }
    __syncthreads();
#pragma unroll
    for (int r = 0; r < 16; ++r) OB[(tt * 32 + (r & 3) + 8 * (r >> 2) + 4 * hi) * 132 + dt * 32 + r32] = o[r];
    __syncthreads();
    for (int rr = 0; rr < 8; ++rr) { const int t = wave * 8 + rr;
        const float v0 = OB[t * 132 + lane], v1 = OB[t * 132 + 64 + lane];
        const float rstd = rsqrtf(wave_sum(v0 * v0 + v1 * v1) * (1.f / 128.f) + EPS);
        const float g0 = bf2f(proj[(size_t)t * NIN + C_HG + h * 128 + lane]), g1 = bf2f(proj[(size_t)t * NIN + C_HG + h * 128 + 64 + lane]);
        bf16* orow = WSP(bf16, WS_OCAT) + (row0 + t) * DM + h * 128;
        orow[lane] = (bf16)f2bf(v0 * rstd * p.g_hg[lane] * (g0 * sigmoidf_(g0)));
        orow[64 + lane] = (bf16)f2bf(v1 * rstd * p.g_hg[64 + lane] * (g1 * sigmoidf_(g1))); }
    __syncthreads();
}
__device__ __forceinline__ void dil_item(const P& p, unsigned char* lds, int item) {
    const int tid = threadIdx.x, lane = tid & 63, wave = tid >> 6;
    const int blk = item & 63, bh = item >> 6, b = bh / 12, head = bh % 12, g = head >> 2;
    const int r = (g == 0) ? 1 : (g == 1 ? 4 : 16), Ls = SEQ / r, nblk = Ls / 64;
    const int cres = blk / nblk, i0 = (blk % nblk) * 64;
    const bf16* proj = WSP(const bf16, WS_PROJ) + (size_t)(b * SEQ) * NIN;
    bf16* Qs = (bf16*)lds;
    bf16* Ks = (bf16*)(lds + 9216);
    bf16* VT = (bf16*)(lds + 36864);
    float* Ss = (float*)(lds + 62464);
    { const int row = tid >> 3, ch = tid & 7; const int tok = cres + r * (i0 + row);
      *(v4u*)(Qs + row * 72 + ch * 8) = *(const v4u*)(proj + (size_t)tok * NIN + C_DQ + head * 64 + ch * 8); }
#pragma unroll
    for (int k = 0; k < 3; ++k) { const int idx = tid + 512 * k, row = idx >> 3, ch = idx & 7; const int j = i0 - 64 + row;
        v4u kv = {0u, 0u, 0u, 0u}, vv = {0u, 0u, 0u, 0u};
        if (j >= 0 && j < Ls) { const size_t tok = (size_t)(cres + r * j); kv = *(const v4u*)(proj + tok * NIN + C_DK + head * 64 + ch * 8); vv = *(const v4u*)(proj + tok * NIN + C_DV + head * 64 + ch * 8); }
        *(v4u*)(Ks + row * 72 + ch * 8) = kv;
        bf16* vt = VT + (ch * 8) * 200 + row;
        vt[0] = (bf16)(vv.x & 0xffff); vt[200] = (bf16)(vv.x >> 16); vt[400] = (bf16)(vv.y & 0xffff); vt[600] = (bf16)(vv.y >> 16);
        vt[800] = (bf16)(vv.z & 0xffff); vt[1000] = (bf16)(vv.z >> 16); vt[1200] = (bf16)(vv.w & 0xffff); vt[1400] = (bf16)(vv.w >> 16); }
    __syncthreads();
    const int fr = lane & 15, fq = lane >> 4, qt = wave & 3;
    { const bf16x8 a0 = *(const bf16x8*)(Qs + (qt * 16 + fr) * 72 + fq * 8), a1 = *(const bf16x8*)(Qs + (qt * 16 + fr) * 72 + 32 + fq * 8);
#pragma unroll
      for (int k = 0; k < 6; ++k) { const int kt = (wave >> 2) * 6 + k;
        f32x4 s = {0.f, 0.f, 0.f, 0.f};
        s = mfma16(a0, *(const bf16x8*)(Ks + (kt * 16 + fr) * 72 + fq * 8), s);
        s = mfma16(a1, *(const bf16x8*)(Ks + (kt * 16 + fr) * 72 + 32 + fq * 8), s);
#pragma unroll
        for (int e = 0; e < 4; ++e) Ss[(qt * 16 + fq * 4 + e) * 196 + kt * 16 + fr] = s[e]; } }
    __syncthreads();
    const float slope = exp2f(-8.0f * (float)(head + 1) / 12.0f) * (float)r;
    for (int rr = 0; rr < 8; ++rr) { const int q = wave * 8 + rr, i = i0 + q;
        float sv[3]; bool ok[3]; float m = -3.0e38f;
#pragma unroll
        for (int k = 0; k < 3; ++k) { const int jj = lane + 64 * k, j = i0 - 64 + jj, dj = j - i, adj = dj < 0 ? -dj : dj;
            ok[k] = (j >= 0) && (j < Ls) && (adj <= 64);
            sv[k] = ok[k] ? Ss[q * 196 + jj] * 0.125f - slope * (float)adj : -1.0e30f; m = fmaxf(m, sv[k]); }
        m = wave_max(m);
        float l = 0.f;
#pragma unroll
        for (int k = 0; k < 3; ++k) { sv[k] = ok[k] ? __expf(sv[k] - m) : 0.f; l += sv[k]; }
        l = wave_sum(l);
        const float inv = 1.0f / l;
        bf16* Pr = (bf16*)(Ss + q * 196);
#pragma unroll
        for (int k = 0; k < 3; ++k) Pr[lane + 64 * k] = (bf16)f2bf(sv[k] * inv);
        if (lane == 0) WSP(float, WS_LSE)[(size_t)(b * 12 + head) * SEQ + cres + r * i] = m + __logf(l); }
    __syncthreads();
    { f32x4 o0 = {0.f, 0.f, 0.f, 0.f}, o1 = {0.f, 0.f, 0.f, 0.f}; const int d0 = (wave >> 2) * 32;
#pragma unroll
      for (int kk = 0; kk < 6; ++kk) { const bf16x8 a = *(const bf16x8*)((const bf16*)(Ss + (qt * 16 + fr) * 196) + kk * 32 + fq * 8);
        o0 = mfma16(a, *(const bf16x8*)(VT + (d0 + fr) * 200 + kk * 32 + fq * 8), o0);
        o1 = mfma16(a, *(const bf16x8*)(VT + (d0 + 16 + fr) * 200 + kk * 32 + fq * 8), o1); }
#pragma unroll
      for (int e = 0; e < 4; ++e) { const int q = qt * 16 + fq * 4 + e; const size_t tok = (size_t)(b * SEQ + cres + r * (i0 + q));
        bf16* orow = WSP(bf16, WS_OCAT) + tok * DM + 768 + head * 64;
        orow[d0 + fr] = (bf16)f2bf(o0[e]); orow[d0 + 16 + fr] = (bf16)f2bf(o1[e]); } }
    __syncthreads();
}

__device__ __forceinline__ void mem_item(const P& p, unsigned char* lds, int item) {
    const int tid = threadIdx.x, lane = tid & 63, wave = tid >> 6;
    const int blk = item & 63, bh = item >> 6, b = bh >> 2, head = bh & 3;
    const size_t row0 = (size_t)(b * SEQ + blk * 64);
    const bf16* proj = WSP(const bf16, WS_PROJ) + row0 * NIN;
    bf16* Qs = (bf16*)lds;
    float* Ss = (float*)(lds + 17408);
#pragma unroll
    for (int k = 0; k < 2; ++k) { const int idx = tid + 512 * k, row = idx >> 4, ch = idx & 15;
        *(v4u*)(Qs + row * 136 + ch * 8) = *(const v4u*)(proj + (size_t)row * NIN + C_MQ + head * 128 + ch * 8); }
    __syncthreads();
    const int fr = lane & 15, fq = lane >> 4, qt = wave & 3;
    { bf16x8 a[4];
#pragma unroll
      for (int kk = 0; kk < 4; ++kk) a[kk] = *(const bf16x8*)(Qs + (qt * 16 + fr) * 136 + kk * 32 + fq * 8);
      const bf16* kvm = WSP(const bf16, WS_KVM) + (size_t)(b * MEML) * 1024 + head * 128 + fq * 8;
#pragma unroll
      for (int k = 0; k < 8; ++k) { const int kt = (wave >> 2) * 8 + k; f32x4 s = {0.f, 0.f, 0.f, 0.f};
#pragma unroll
        for (int kk = 0; kk < 4; ++kk) s = mfma16(a[kk], *(const bf16x8*)(kvm + (size_t)(kt * 16 + fr) * 1024 + kk * 32), s);
#pragma unroll
        for (int e = 0; e < 4; ++e) Ss[(qt * 16 + fq * 4 + e) * 260 + kt * 16 + fr] = s[e]; } }
    __syncthreads();
    for (int rr = 0; rr < 8; ++rr) { const int q = wave * 8 + rr;
        float sv[4]; float m = -3.0e38f;
#pragma unroll
        for (int k = 0; k < 4; ++k) { sv[k] = Ss[q * 260 + lane + 64 * k] * 0.08838834764831845f; m = fmaxf(m, sv[k]); }
        m = wave_max(m); float l = 0.f;
#pragma unroll
        for (int k = 0; k < 4; ++k) { sv[k] = __expf(sv[k] - m); l += sv[k]; }
        l = wave_sum(l); const float inv = 1.0f / l;
        bf16* Pr = (bf16*)(Ss + q * 260);
#pragma unroll
        for (int k = 0; k < 4; ++k) Pr[lane + 64 * k] = (bf16)f2bf(sv[k] * inv); }
    __syncthreads();
    { f32x4 o[4]; const int d0 = (wave >> 2) * 64;
#pragma unroll
      for (int j = 0; j < 4; ++j) o[j] = (f32x4){0.f, 0.f, 0.f, 0.f};
      const bf16* vt = WSP(const bf16, WS_KVMT) + (size_t)(512 + head * 128 + d0 + fr) * 512 + b * MEML + fq * 8;
#pragma unroll
      for (int kk = 0; kk < 8; ++kk) { const bf16x8 a = *(const bf16x8*)((const bf16*)(Ss + (qt * 16 + fr) * 260) + kk * 32 + fq * 8);
#pragma unroll
        for (int j = 0; j < 4; ++j) o[j] = mfma16(a, *(const bf16x8*)(vt + (size_t)(j * 16) * 512 + kk * 32), o[j]); }
#pragma unroll
      for (int e = 0; e < 4; ++e) { const int q = qt * 16 + fq * 4 + e; bf16* orow = WSP(bf16, WS_OCAT) + (row0 + q) * DM + 1536 + head * 128 + d0 + fr;
#pragma unroll
        for (int j = 0; j < 4; ++j) orow[j * 16] = (bf16)f2bf(o[j][e]); } }
    __syncthreads();
}

__device__ __forceinline__ void dil_alpha_rows(const P& p, int vcu, int G) {
    const int lane = threadIdx.x & 63, gw = vcu * NWAVES + (threadIdx.x >> 6), NGW = G * NWAVES;
    for (int t = gw; t < T; t += NGW) { const int b = t / SEQ, s = t % SEQ;
        for (int ch = lane; ch < 96; ch += 64) { const int head = ch >> 3, j = head & 3, g = head >> 2;
            const float* L = WSP(const float, WS_LSE) + (size_t)(b * 12 + j) * SEQ + s;
            const float l0 = L[0], l1 = L[4 * SEQ], l2 = L[8 * SEQ], m = fmaxf(l0, fmaxf(l1, l2));
            const float e0 = __expf(l0 - m), e1 = __expf(l1 - m), e2 = __expf(l2 - m);
            const float al = (g == 0 ? e0 : (g == 1 ? e1 : e2)) / (e0 + e1 + e2);
            v4u* ptr = (v4u*)(WSP(bf16, WS_OCAT) + (size_t)t * DM + 768 + ch * 8); v4u v = *ptr;
            v.x = pk2(__uint_as_float(v.x << 16) * al, __uint_as_float(v.x & 0xffff0000u) * al); v.y = pk2(__uint_as_float(v.y << 16) * al, __uint_as_float(v.y & 0xffff0000u) * al);
            v.z = pk2(__uint_as_float(v.z << 16) * al, __uint_as_float(v.z & 0xffff0000u) * al); v.w = pk2(__uint_as_float(v.w << 16) * al, __uint_as_float(v.w & 0xffff0000u) * al);
            *ptr = v; } }
}
__device__ __forceinline__ unsigned okey(float f) { const unsigned u = __float_as_uint(f); return u ^ ((unsigned)((int)u >> 31) | 0x80000000u); }
__device__ __forceinline__ float unkey(unsigned k) { const unsigned u = (k & 0x80000000u) ? (k ^ 0x80000000u) : ~k; return __uint_as_float(u); }
__device__ __forceinline__ unsigned umax_(unsigned a, unsigned b) { return a > b ? a : b; }
__device__ __forceinline__ unsigned umin_(unsigned a, unsigned b) { return a < b ? a : b; }
__device__ __forceinline__ void topk_rows(const P& p, int vcu, int G) {
    const int gt = vcu * NTHR + threadIdx.x, NGT = G * NTHR;
    for (int row = gt; row < T * 8; row += NGT) {
        const int t = row >> 3, h = row & 7;
        const float* sc = WSP(const float, WS_SC) + (size_t)row * 256;
        float s0[16], s1[16]; int n0[16], n1[16];
#pragma unroll
        for (int half = 0; half < 2; ++half) {
            unsigned v[16];
#pragma unroll
            for (int i = 0; i < 16; ++i) v[i] = 0u;
            for (int n4 = 0; n4 < 32; ++n4) { const f32x4 q = *(const f32x4*)(sc + half * 128 + n4 * 4);
#pragma unroll
                for (int e = 0; e < 4; ++e) { unsigned x = (okey(q[e]) & 0xffffff80u) | (unsigned)(127 - (n4 * 4 + e));
#pragma unroll
                    for (int i = 0; i < 16; ++i) { const unsigned hi = umax_(v[i], x); x = umin_(v[i], x); v[i] = hi; } } }
#pragma unroll
            for (int i = 0; i < 16; ++i) { const float sv = unkey(v[i] & 0xffffff80u); const int nn = 127 - (int)(v[i] & 127u);
                if (half == 0) { s0[i] = sv; n0[i] = nn; } else { s1[i] = sv; n1[i] = nn; } }
        }
        unsigned bk[16];
#pragma unroll
        for (int k = 0; k < 16; ++k) bk[k] = 0u;
#pragma unroll
        for (int i = 0; i < 16; ++i)
#pragma unroll
            for (int j = 0; j < 16; ++j) if ((i + 1) * (j + 1) <= 16) {
                unsigned x = (okey(s0[i] + s1[j]) & 0xffffff00u) | (unsigned)(255 - (i * 16 + j));
#pragma unroll
                for (int k = 0; k < 16; ++k) { const unsigned hi = umax_(bk[k], x); x = umin_(bk[k], x); bk[k] = hi; } }
        float bv[16]; int be[16];
#pragma unroll
        for (int k = 0; k < 16; ++k) { bv[k] = unkey(bk[k] & 0xffffff00u); const int code = 255 - (int)(bk[k] & 255u), ci = code >> 4, cj = code & 15;
            int a = n0[0], b = n1[0];
#pragma unroll
            for (int q = 1; q < 16; ++q) { a = (ci == q) ? n0[q] : a; b = (cj == q) ? n1[q] : b; }
            be[k] = a * 128 + b; }
        const float rstd = row_rstd(WSP(const float, WS_RSP), t);
        float m = bv[0] * rstd, l = 0.f;
        float ev[16];
#pragma unroll
        for (int k = 0; k < 16; ++k) { ev[k] = __expf(bv[k] * rstd - m); l += ev[k]; }
        const float inv = 1.0f / l;
        int* io = WSP(int, WS_IDX) + (size_t)t * 128 + h * 16; float* go = WSP(float, WS_GATE) + (size_t)t * 128 + h * 16;
#pragma unroll
        for (int k = 0; k < 16; k += 4) { *(int4*)(io + k) = make_int4(be[k], be[k + 1], be[k + 2], be[k + 3]); *(f32x4*)(go + k) = (f32x4){ev[k] * inv, ev[k + 1] * inv, ev[k + 2] * inv, ev[k + 3] * inv}; }
    }
}

__device__ __forceinline__ void unpack8(const v4u w, float* f) {
    f[0] = __uint_as_float(w.x << 16); f[1] = __uint_as_float(w.x & 0xffff0000u); f[2] = __uint_as_float(w.y << 16); f[3] = __uint_as_float(w.y & 0xffff0000u);
    f[4] = __uint_as_float(w.z << 16); f[5] = __uint_as_float(w.z & 0xffff0000u); f[6] = __uint_as_float(w.w << 16); f[7] = __uint_as_float(w.w & 0xffff0000u);
}
__device__ __forceinline__ void peer_rows(const P& p, int vcu, int G) {
    const int lane = threadIdx.x & 63, gw = vcu * NWAVES + (threadIdx.x >> 6), NGW = G * NWAVES;
    const v4u* U = WSP(const v4u, WS_UBF); const v4u* V = WSP(const v4u, WS_VBF);
    for (int t = gw; t < T; t += NGW) {
        float xh[32];
        { const v4u* xr = WSP(const v4u, WS_XG) + (size_t)t * 256 + lane;
#pragma unroll
          for (int i = 0; i < 4; ++i) unpack8(xr[64 * i], xh + 8 * i); }
        const int ia = WSP(const int, WS_IDX)[(size_t)t * 128 + lane], ib = WSP(const int, WS_IDX)[(size_t)t * 128 + 64 + lane];
        const float ga = WSP(const float, WS_GATE)[(size_t)t * 128 + lane], gb = WSP(const float, WS_GATE)[(size_t)t * 128 + 64 + lane];
        const float rstd = row_rstd(WSP(const float, WS_RSP), t);
        float aa = 0.f, ab = 0.f;
        for (int e0 = 0; e0 < 128; e0 += 4) {
            v4u w[4][4];
#pragma unroll
            for (int j = 0; j < 4; ++j) { const int e = e0 + j; const int row = __builtin_amdgcn_readlane(e < 64 ? ia : ib, e & 63);
                const v4u* ur = U + (size_t)row * 256 + lane;
#pragma unroll
                for (int i = 0; i < 4; ++i) w[j][i] = ur[64 * i]; }
#pragma unroll
            for (int j = 0; j < 4; ++j) { float d = 0.f;
#pragma unroll
                for (int i = 0; i < 4; ++i) { float f[8]; unpack8(w[j][i], f);
#pragma unroll
                    for (int q = 0; q < 8; ++q) d = fmaf(f[q], xh[8 * i + q], d); }
                d = wave_sum(d) * rstd; const int e = e0 + j;
                if (lane == (e & 63)) { if (e < 64) aa = d; else ab = d; } }
        }
        const float ha = 0.5f * aa * (1.0f + erff(aa * 0.70710678118f)) * ga, hb = 0.5f * ab * (1.0f + erff(ab * 0.70710678118f)) * gb;
        float acc[32];
#pragma unroll
        for (int i = 0; i < 32; ++i) acc[i] = 0.f;
        for (int e0 = 0; e0 < 128; e0 += 4) {
            v4u w[4][4]; float hv[4];
#pragma unroll
            for (int j = 0; j < 4; ++j) { const int e = e0 + j; const int row = __builtin_amdgcn_readlane(e < 64 ? ia : ib, e & 63);
                hv[j] = __builtin_bit_cast(float, __builtin_amdgcn_readlane(__builtin_bit_cast(int, e < 64 ? ha : hb), e & 63));
                const v4u* vr = V + (size_t)row * 256 + lane;
#pragma unroll
                for (int i = 0; i < 4; ++i) w[j][i] = vr[64 * i]; }
#pragma unroll
            for (int j = 0; j < 4; ++j)
#pragma unroll
                for (int i = 0; i < 4; ++i) { float f[8]; unpack8(w[j][i], f);
#pragma unroll
                    for (int q = 0; q < 8; ++q) acc[8 * i + q] = fmaf(hv[j], f[q], acc[8 * i + q]); }
        }
        float* orow = p.out + (size_t)t * DM; float ss = 0.f;
#pragma unroll
        for (int i = 0; i < 4; ++i) { const f32x4 a = *(const f32x4*)(orow + i * 512 + lane * 8), b = *(const f32x4*)(orow + i * 512 + lane * 8 + 4);
            acc[8 * i + 0] += a.x; acc[8 * i + 1] += a.y; acc[8 * i + 2] += a.z; acc[8 * i + 3] += a.w; acc[8 * i + 4] += b.x; acc[8 * i + 5] += b.y; acc[8 * i + 6] += b.z; acc[8 * i + 7] += b.w;
#pragma unroll
            for (int q = 0; q < 8; ++q) ss += acc[8 * i + q] * acc[8 * i + q]; }
        const float r2 = rsqrtf(wave_sum(ss) * (1.f / DM) + EPS);
#pragma unroll
        for (int i = 0; i < 4; ++i) { const f32x4 g0 = *(const f32x4*)(p.g_final + i * 512 + lane * 8), g1 = *(const f32x4*)(p.g_final + i * 512 + lane * 8 + 4);
            *(f32x4*)(orow + i * 512 + lane * 8) = (f32x4){acc[8 * i] * r2 * g0.x, acc[8 * i + 1] * r2 * g0.y, acc[8 * i + 2] * r2 * g0.z, acc[8 * i + 3] * r2 * g0.w};
            *(f32x4*)(orow + i * 512 + lane * 8 + 4) = (f32x4){acc[8 * i + 4] * r2 * g1.x, acc[8 * i + 5] * r2 * g1.y, acc[8 * i + 6] * r2 * g1.z, acc[8 * i + 7] * r2 * g1.w}; }
    }
}
#ifndef MK_SPLIT
#define MK_SPLIT 0
#endif
constexpr int NPHASE = 11;
template <int LO, int HI> __global__ void __launch_bounds__(NTHR, 2) mk_fwd(P p) {
    extern __shared__ __attribute__((aligned(16))) unsigned char lds[];
    const int G = gridDim.x, bx = blockIdx.x;
    const int vcu = (G % 8 == 0) ? (bx % 8) * (G / 8) + bx / 8 : bx;
    cg::grid_group grid = cg::this_grid();
#define IN(k) (LO <= (k) && (k) < HI)
#define SEAM(k) do { if constexpr (IN(k) && IN((k) + 1)) grid.sync(); } while (0)
    PG8_LAS unsigned char* glds = (PG8_LAS unsigned char*)lds;
    typedef pg8::EpiBf16<0> EB;
    if constexpr (IN(0)) { phase0(p, lds, vcu, G); } SEAM(0);
    if constexpr (IN(1)) {
        { pg8::Gemm g{WSP(const bf16, WS_H), WSP(const bf16, WS_WIN), T, NIN, DM, DM, DM}; pg8::StaticOrder S; S.init(T, NIN, G, bx);
          EB E{WSP(bf16, WS_PROJ), NIN, nullptr, 0, 0, 1.f}; pg8::gemm_phase<EB, pg8::StaticOrder, true, true>(glds, g, S, E); }
        { pg8::Gemm g{WSP(const bf16, WS_MEMN), WSP(const bf16, WS_WKV), MROWS, 1024, DM, DM, DM}; pg8::StaticOrder S; S.init(MROWS, 1024, G, bx);
          EB E{WSP(bf16, WS_KVM), 1024, nullptr, 0, 0, 1.f}; pg8::gemm_phase<EB, pg8::StaticOrder, true, true>(glds, g, S, E); }
        { pg8::Gemm g{WSP(const bf16, WS_WKV), WSP(const bf16, WS_MEMN), 1024, MROWS, DM, DM, DM}; pg8::StaticOrder S; S.init(1024, MROWS, G, (bx + 8) % G);
          EB E{WSP(bf16, WS_KVMT), MROWS, nullptr, 0, 0, 1.f}; pg8::gemm_phase<EB, pg8::StaticOrder, true, true>(glds, g, S, E); }
    } SEAM(1);
    if constexpr (IN(2)) {
        constexpr int N_DIL = BATCH * DIL_H * 64, N_H1 = BATCH * HG_H * 2 * 64, N_MEM = BATCH * MEM_H * 64;
        for (int it = bx; it < N_DIL + N_H1 + N_MEM; it += G) {
            if (it < N_DIL) dil_item(p, lds, it); else if (it < N_DIL + N_H1) h1_item(p, lds, it - N_DIL); else mem_item(p, lds, it - N_DIL - N_H1); }
    } SEAM(2);
    if constexpr (IN(3)) { h2_scan(p, vcu, G); } SEAM(3);
    if constexpr (IN(4)) { for (int it = bx; it < BATCH * HG_H * 64; it += G) h3_item(p, lds, it); dil_alpha_rows(p, vcu, G); } SEAM(4);
    if constexpr (IN(5)) {
#pragma unroll 1
        for (int br = 0; br < 3; ++br) { const int k0 = br * 768, kb = br < 2 ? 768 : 512;
            pg8::Gemm g{WSP(const bf16, WS_OCAT) + k0, WSP(const bf16, WS_WUP) + k0, T, DM, kb, DM, DM}; pg8::StaticOrder S; S.init(T, DM, G, bx);
            pg8::EpiUp E{WSP(const bf16, WS_PROJ) + C_GATE + br * DM, NIN, p.b_gate + br * DM, p.out, WSP(bf16, WS_MERGED), br};
            pg8::gemm_phase<pg8::EpiUp, pg8::StaticOrder, false, true>(glds, g, S, E); }
    } SEAM(5);
    if constexpr (IN(6)) { pg8::Gemm g{WSP(const bf16, WS_MERGED), WSP(const bf16, WS_WOUT), T, DM, DM, DM, DM}; pg8::StaticOrder S; S.init(T, DM, G, bx);
        pg8::EpiOut E{p.x, p.out, WSP(bf16, WS_XG), p.g_ffn, WSP(float, WS_RSP)};
        pg8::gemm_phase<pg8::EpiOut, pg8::StaticOrder, false, true>(glds, g, S, E); } SEAM(6);
    if constexpr (IN(7)) { pg8::Gemm g{WSP(const bf16, WS_XG), WSP(const bf16, WS_WQ), T, DM, DM, DM, DM}; pg8::StaticOrder S; S.init(T, DM, G, bx);
        EB E{WSP(bf16, WS_QP), DM, nullptr, 0, 0, 1.f}; pg8::gemm_phase<EB, pg8::StaticOrder, false, true>(glds, g, S, E); } SEAM(7);
    if constexpr (IN(8)) { pg8::Gemm g{WSP(const bf16, WS_QP), WSP(const bf16, WS_SKB), T * 8, 256, 256, 256, 256}; pg8::StaticOrder S; S.init(T * 8, 256, G, bx);
        pg8::EpiF32 E{WSP(float, WS_SC), 256}; pg8::gemm_phase<pg8::EpiF32, pg8::StaticOrder, false, true>(glds, g, S, E); } SEAM(8);
    if constexpr (IN(9)) { topk_rows(p, vcu, G); } SEAM(9);
    if constexpr (IN(10)) { peer_rows(p, vcu, G); }
#undef IN
#undef SEAM
}

#if MK_SPLIT
#define MK_FOR_PH(X) X(0) X(1) X(2) X(3) X(4) X(5) X(6) X(7) X(8) X(9) X(10)
static bool set_lds() { bool ok = true;
#define X(k) ok = ok && (hipFuncSetAttribute((const void*)mk_fwd<k, k + 1>, hipFuncAttributeMaxDynamicSharedMemorySize, LDS_BYTES) == hipSuccess);
    MK_FOR_PH(X)
#undef X
    return ok; }
static void launch_split(const P& p, int grid, hipStream_t stream) {
#define X(k) hipLaunchKernelGGL((mk_fwd<k, k + 1>), dim3(grid), dim3(NTHR), LDS_BYTES, stream, p);
    MK_FOR_PH(X)
#undef X
}
#else
static bool set_lds() { return hipFuncSetAttribute((const void*)mk_fwd<0, NPHASE>, hipFuncAttributeMaxDynamicSharedMemorySize, LDS_BYTES) == hipSuccess; }
#endif

extern "C" void kernel_launch(void* const* d_in, const int* in_sizes, int n_in, void* d_out, int out_size, void* d_ws, size_t ws_size, hipStream_t stream) {
    static int grid = 0;
    if (grid == 0) {
        if (n_in != 18 || out_size != T * DM || ws_size < WS_END) { fprintf(stderr, "kernel_launch: unexpected shapes (n_in %d, out %d, ws %zu)\n", n_in, out_size, ws_size); grid = -1; return; }
        int dev = 0, cus = 0, per_cu = 0;
        (void)hipGetDevice(&dev); (void)hipDeviceGetAttribute(&cus, hipDeviceAttributeMultiprocessorCount, dev);
        if (!set_lds()) { fprintf(stderr, "kernel_launch: hipFuncSetAttribute failed\n"); grid = -1; return; }
        (void)per_cu; (void)hipGetLastError();
        grid = cus;
    }
    if (grid < 0) return;
    P p{};
    p.x = (const float*)d_in[0]; p.mem = (const float*)d_in[1]; p.g_mix = (const float*)d_in[2]; p.w_in = (const float*)d_in[3]; p.b_gate = (const float*)d_in[4];
    p.lbf_l = (const float*)d_in[5]; p.lbb_l = (const float*)d_in[6]; p.g_hg = (const float*)d_in[7]; p.w_kv = (const float*)d_in[8]; p.g_mem = (const float*)d_in[9];
    p.w_up = (const float*)d_in[10]; p.w_out = (const float*)d_in[11]; p.g_ffn = (const float*)d_in[12]; p.w_q = (const float*)d_in[13]; p.subk = (const float*)d_in[14];
    p.pu = (const float*)d_in[15]; p.pv = (const float*)d_in[16]; p.g_final = (const float*)d_in[17];
    p.out = (float*)d_out; p.ws = (unsigned char*)d_ws;
#if MK_SPLIT
    launch_split(p, grid, stream);
#else
    p.ph_lo = 0; p.ph_hi = NPHASE;
    void* args[] = {&p};
    hipError_t e = hipLaunchCooperativeKernel((const void*)mk_fwd<0, NPHASE>, dim3(grid), dim3(NTHR), args, LDS_BYTES, stream);
    if (e != hipSuccess) fprintf(stderr, "kernel_launch: cooperative launch failed: %s (grid %d)\n", hipGetErrorString(e), grid);
#endif
}
```

```cpp
#include <hip/hip_runtime.h>
#include <cstdio>
#include <cstdint>
__device__ __forceinline__ int tidx() { int t = threadIdx.x; asm volatile("" : "+v"(t)); return t; }
namespace pg8 {
#define PG8_LAS __attribute__((address_space(3)))
typedef unsigned short bf16_t;
typedef short bf16x8 __attribute__((ext_vector_type(8)));
typedef float f32x4 __attribute__((ext_vector_type(4)));
typedef unsigned u32x4 __attribute__((ext_vector_type(4)));
typedef unsigned u32x2 __attribute__((ext_vector_type(2)));
constexpr int BM = 256, BK = 64, HALF = 128, HTB = HALF * BK * 2  , STAGE_BYTES = 8 * HTB, NXCD = 8, WGM = 8;

__host__ __device__ __forceinline__ int lds_byte(int r, int c) { const int st = (r >> 4) * 2 + (c >> 5), rr = r & 15, cc = c & 31, ob = rr * 64 + cc * 2; return st * 1024 + (ob ^ (((ob >> 9) & 1) << 5)); }
__host__ __device__ __forceinline__ void stage_rc(int b, int& R, int& C) { const int st = b / 1024, sb = b % 1024, swz = sb ^ (((sb >> 9) & 1) << 5); R = (st >> 1) * 16 + swz / 64; C = (st & 1) * 32 + (swz % 64) / 2; }
__host__ __device__ __forceinline__ int perm32(int rho) { const int n = rho >> 4, i = rho & 15; return 8 * (i >> 2) + 4 * n + (i & 3); }

struct Unit { int pm, pn; };
struct Gemm { const bf16_t* A; const bf16_t* Bt; int M, N, K, lda, ldb; };

struct StaticOrder {
    int nM, nN, nwg, G, c;
    __host__ __device__ void init(int M, int N, int G_, int c_) { nM = M / BM; nN = N / BM; nwg = nM * nN; G = G_; c = c_; }
    __host__ __device__ bool next(int i, Unit& u) const { return map((long)i * G + c, u); }
    __host__ __device__ bool map(long L, Unit& u) const {
        if (L >= nwg) return false;
        int wgid = (int)L; { const int q = nwg / NXCD, r = nwg % NXCD, xcd = wgid % NXCD, off = wgid / NXCD; wgid = (xcd < r ? xcd * (q + 1) : r * (q + 1) + (xcd - r) * q) + off; }
        const int nig = WGM * nN, gid = wgid / nig, fm = gid * WGM, gsz = (nM - fm) < WGM ? (nM - fm) : WGM;
        u.pm = fm + ((wgid % nig) % gsz); u.pn = (wgid % nig) / gsz; return true;
    }
    __device__ __forceinline__ void a_ready(const Unit&) const {}
    __device__ __forceinline__ void done(const Unit&) const {}
};
struct SplitOrder : StaticOrder {
    int NT, RA, RB;
    __host__ __device__ bool next(int i, Unit& u) const {
        if (c >= NT) { if (i >= RA) return false; return map((long)i * (G - NT) + (c - NT), u); }
        if (i >= RB) return false; return map((long)(G - NT) * RA + (long)i * NT + c, u);
    }
};


__device__ __forceinline__ unsigned cvt_pk_bf16(float lo, float hi) { unsigned r; asm volatile("v_cvt_pk_bf16_f32 %0, %1, %2" : "=v"(r) : "v"(lo), "v"(hi)); return r; }
typedef float f32x2 __attribute__((ext_vector_type(2)));
__device__ __forceinline__ f32x2 gelu_pk(f32x2 v) {
    const f32x2 av = __builtin_elementwise_abs(v), d = av * 0.2316418882f + 1.0f;
    f32x2 t; t.x = __builtin_amdgcn_rcpf(d.x); t.y = __builtin_amdgcn_rcpf(d.y);
    f32x2 q = t * 0.5307027145f + (-0.7265760135f); q = q * t + 0.7107068705f; q = q * t + (-0.142248368f); q = q * t + 0.127414796f; q = q * t;
    const f32x2 s = (v * v) * (-0.72134752044f);
    f32x2 e; e.x = __builtin_amdgcn_exp2f(s.x); e.y = __builtin_amdgcn_exp2f(s.y);
    const f32x2 m = v * (q * e), r = v - m;
    f32x2 o; o.x = v.x < 0.f ? m.x : r.x; o.y = v.y < 0.f ? m.y : r.y; return o;
}

template <int ACT  > struct EpiBf16 {
    static constexpr bool PERM = true, AFTER_DRAIN = false, MIDK = false; static_assert(ACT == 0 || ACT == 1, "EpiBf16: ACT is 0 (none) or 1 (gelu_pk)");
    bf16_t* O; int ldc; const float* bias; int split_cols; size_t split_stride; float scale0;
    __device__ __forceinline__ void operator()(const f32x4 (&acc)[2][2][4][2], const Unit& u, int wr, int wc, int fr, int fq) const {
        const int row0 = u.pm * BM + wr * 64 + fr; int colt = u.pn * BM; bf16_t* base = O;
        float sc = 1.f; if (split_cols) { const int t = colt / split_cols; base += (size_t)t * split_stride; colt -= t * split_cols; if (t == 0) sc = scale0; }
        const int col0 = colt + wc * 32 + 8 * fq, bcol0 = u.pn * BM + wc * 32 + 8 * fq;
        f32x4 bv[2][2];
#pragma unroll
        for (int bj = 0; bj < 2; ++bj)
#pragma unroll
            for (int n = 0; n < 2; ++n) bv[bj][n] = bias ? *(const f32x4*)(bias + bcol0 + bj * HALF + 4 * n) : (f32x4){0.f, 0.f, 0.f, 0.f};
#pragma unroll
        for (int ai = 0; ai < 2; ++ai)
#pragma unroll
            for (int m = 0; m < 4; ++m) { bf16_t* rowp = base + (size_t)(row0 + ai * HALF + m * 16) * ldc + col0;
#pragma unroll
                for (int bj = 0; bj < 2; ++bj) { f32x4 v0 = acc[ai][bj][m][0] + bv[bj][0], v1 = acc[ai][bj][m][1] + bv[bj][1];
                    if (ACT == 1) { f32x2 a = gelu_pk((f32x2){v0[0], v0[1]}), b = gelu_pk((f32x2){v0[2], v0[3]}), c = gelu_pk((f32x2){v1[0], v1[1]}), d = gelu_pk((f32x2){v1[2], v1[3]});
                        v0 = (f32x4){a.x, a.y, b.x, b.y}; v1 = (f32x4){c.x, c.y, d.x, d.y}; }
                    v0 = v0 * sc; v1 = v1 * sc; u32x4 w; w.x = cvt_pk_bf16(v0[0], v0[1]); w.y = cvt_pk_bf16(v0[2], v0[3]); w.z = cvt_pk_bf16(v1[0], v1[1]); w.w = cvt_pk_bf16(v1[2], v1[3]);
                    *(u32x4*)(rowp + bj * HALF) = w; } }
    }
};
typedef int i32x4 __attribute__((ext_vector_type(4)));
template <bool I8> __device__ __forceinline__ f32x4 mma_sel(bf16x8 a, bf16x8 b, f32x4 c) {
    if constexpr (I8) return __builtin_bit_cast(f32x4, __builtin_amdgcn_mfma_i32_16x16x64_i8(__builtin_bit_cast(i32x4, a), __builtin_bit_cast(i32x4, b), __builtin_bit_cast(i32x4, c), 0, 0, 0));
    else return __builtin_amdgcn_mfma_f32_16x16x32_bf16(a, b, c, 0, 0, 0);
}
template <class Epi, class Sched, bool ALIGN_EPI = false, bool SP2 = false, bool I8 = false>
__device__ __forceinline__ void gemm_phase(PG8_LAS unsigned char* lds, const Gemm g, const Sched& S, const Epi& E) {
    const int tid = tidx(), wid = __builtin_amdgcn_readfirstlane(tid >> 6), lane = tid & 63, wr = wid >> 2, wc = wid & 3, fr = lane & 15, fq = lane >> 4;
    const int K = g.K, nt = K / BK;
    unsigned voffA[2], voffB[2];
#pragma unroll
    for (int i = 0; i < 2; ++i) { int R, C; stage_rc(tid * 16 + i * 8192, R, C); const int Rb = Epi::PERM ? ((R & ~31) + perm32(R & 31)) : R;
        voffA[i] = (unsigned)(R * g.lda + C) * 2u; voffB[i] = (unsigned)(Rb * g.ldb + C) * 2u; }
    const size_t kstep = (size_t)(BK * 2);
    const size_t hstepA = (size_t)HALF * g.lda * 2, hstepB = (size_t)HALF * g.ldb * 2;
    const size_t tstepA = 2 * hstepA, tstepB = 2 * hstepB;
    const unsigned ldsw = (unsigned)wid * 1024u;
    const int aoff = lds_byte(wr * 64 + fr, fq * 8), boff = lds_byte(wc * 32 + fr, fq * 8);
#define PG8_SA(b, h) (((b) * 2 + (h)) * HTB)
#define PG8_SB(b, h) ((4 + (b) * 2 + (h)) * HTB)
#define PG8_STAGE(bufoff, gbase, voff) do { _Pragma("unroll") for (int _i = 0; _i < 2; ++_i) \
        __builtin_amdgcn_global_load_lds((const unsigned*)((const char*)(gbase) + (voff)[_i]), (PG8_LAS unsigned*)(lds + (bufoff) + ldsw + _i * 8192), 16, 0, 0); } while (0)
#define PG8_LDA(dst, b, h) do { _Pragma("unroll") for (int m = 0; m < 4; ++m) _Pragma("unroll") for (int k = 0; k < 2; ++k) dst[m][k] = *(const PG8_LAS bf16x8*)(lds + PG8_SA(b, h) + aoff + m * 2048 + k * 1024); } while (0)
#define PG8_LDB(dst, b, h) do { _Pragma("unroll") for (int n = 0; n < 2; ++n) _Pragma("unroll") for (int k = 0; k < 2; ++k) dst[n][k] = *(const PG8_LAS bf16x8*)(lds + PG8_SB(b, h) + boff + n * 2048 + k * 1024); } while (0)
#define PG8_MMA(ai, bj, At, Bt) do { __builtin_amdgcn_s_setprio(1); _Pragma("unroll") for (int m = 0; m < 4; ++m) _Pragma("unroll") for (int n = 0; n < 2; ++n) _Pragma("unroll") for (int k = 0; k < 2; ++k) \
        acc[ai][bj][m][n] = mma_sel<I8>(Bt[n][k], At[m][k], acc[ai][bj][m][n]); __builtin_amdgcn_s_setprio(0); } while (0)
#define PG8_WAIT_V(n) asm volatile("s_waitcnt vmcnt(" #n ")" ::: "memory")
#define PG8_WAIT_L(n) asm volatile("s_waitcnt lgkmcnt(" #n ")" ::: "memory")
#define PG8_BAR __builtin_amdgcn_s_barrier()
#define PG8_SCHED __builtin_amdgcn_sched_barrier(0)
    Unit cur, nxt; int ui = 0;
    if (!S.next(0, cur)) return;
    f32x4 acc[2][2][4][2];
#pragma unroll
    for (int a = 0; a < 2; ++a)
#pragma unroll
        for (int b = 0; b < 2; ++b)
#pragma unroll
            for (int m = 0; m < 4; ++m)
#pragma unroll
                for (int n = 0; n < 2; ++n) acc[a][b][m][n] = (f32x4){0.f, 0.f, 0.f, 0.f};
    bf16x8 At[4][2], B0[2][2], B1[2][2];
    const char* cA = (const char*)g.A + (size_t)cur.pm * tstepA; const char* cB = (const char*)g.Bt + (size_t)cur.pn * tstepB;
    S.a_ready(cur);
    if constexpr (SP2) {
        PG8_STAGE(PG8_SB(0, 0), cB, voffB); PG8_STAGE(PG8_SB(0, 1), cB + hstepB, voffB); PG8_STAGE(PG8_SA(0, 0), cA, voffA); PG8_STAGE(PG8_SA(0, 1), cA + hstepA, voffA);
        if (wr == 1) PG8_BAR;
        PG8_WAIT_V(2); PG8_BAR;
        PG8_STAGE(PG8_SB(1, 0), cB + kstep, voffB); PG8_STAGE(PG8_SA(1, 0), cA + kstep, voffA); PG8_STAGE(PG8_SB(1, 1), cB + hstepB + kstep, voffB);
        PG8_WAIT_V(6); PG8_BAR;
    } else {
        PG8_STAGE(PG8_SB(0, 0), cB, voffB); PG8_STAGE(PG8_SA(0, 0), cA, voffA); PG8_STAGE(PG8_SB(0, 1), cB + hstepB, voffB); PG8_STAGE(PG8_SA(0, 1), cA + hstepA, voffA);
        if (wr == 1) PG8_BAR;
        PG8_WAIT_V(4); PG8_BAR;
        PG8_STAGE(PG8_SB(1, 0), cB + kstep, voffB); PG8_STAGE(PG8_SA(1, 0), cA + kstep, voffA); PG8_STAGE(PG8_SB(1, 1), cB + hstepB + kstep, voffB);
        PG8_WAIT_V(6); PG8_BAR;
    }
    for (;;) {
        const bool has_next = S.next(ui + 1, nxt);
        const char* nA = has_next ? (const char*)g.A + (size_t)nxt.pm * tstepA : cA; const char* nB = has_next ? (const char*)g.Bt + (size_t)nxt.pn * tstepB : cB;
        for (int t = 0; t < nt; t += 2) {
            if constexpr (Epi::MIDK) { if (t == E.t1 || t == E.t2) E.mid(acc, cur, t == E.t1 ? 0 : 1, wr, wc, fr, fq); }
            const bool last = (t == nt - 2);
            const char* a1 = cA + (size_t)(t + 1) * kstep;
            const char* a2 = last ? nA : cA + (size_t)(t + 2) * kstep; const char* b2 = last ? nB : cB + (size_t)(t + 2) * kstep;
            const char* a3 = a2 + kstep; const char* b3 = b2 + kstep;
            if (last && has_next) S.a_ready(nxt);
            if constexpr (SP2) {
            PG8_LDB(B0, 0, 0); PG8_LDB(B1, 0, 1); PG8_SCHED; PG8_LDA(At, 0, 0); PG8_STAGE(PG8_SA(1, 1), a1 + hstepA, voffA);
            PG8_WAIT_V(8); PG8_WAIT_L(0); PG8_BAR; PG8_MMA(0, 0, At, B0); PG8_MMA(0, 1, At, B1); PG8_BAR; PG8_SCHED;
            PG8_LDA(At, 0, 1); PG8_STAGE(PG8_SB(0, 0), b2, voffB); PG8_STAGE(PG8_SB(0, 1), b2 + hstepB, voffB); PG8_STAGE(PG8_SA(0, 0), a2, voffA);
            PG8_WAIT_V(8); PG8_WAIT_L(0); PG8_BAR; PG8_MMA(1, 0, At, B0); PG8_MMA(1, 1, At, B1); PG8_BAR; PG8_SCHED;
            PG8_LDB(B0, 1, 0); PG8_LDB(B1, 1, 1); PG8_SCHED; PG8_LDA(At, 1, 0); PG8_STAGE(PG8_SA(0, 1), a2 + hstepA, voffA);
            PG8_WAIT_V(8); PG8_WAIT_L(0); PG8_BAR; PG8_MMA(0, 0, At, B0); PG8_MMA(0, 1, At, B1); PG8_BAR; PG8_SCHED;
            PG8_LDA(At, 1, 1); PG8_STAGE(PG8_SB(1, 0), b3, voffB); PG8_STAGE(PG8_SB(1, 1), b3 + hstepB, voffB); PG8_STAGE(PG8_SA(1, 0), a3, voffA);
            PG8_WAIT_V(8); PG8_WAIT_L(0); PG8_BAR; PG8_MMA(1, 0, At, B0); PG8_MMA(1, 1, At, B1); PG8_BAR; PG8_SCHED;
            } else {
            PG8_LDB(B0, 0, 0); PG8_SCHED; PG8_LDA(At, 0, 0); PG8_STAGE(PG8_SA(1, 1), a1 + hstepA, voffA);
            PG8_WAIT_L(8); PG8_BAR; PG8_WAIT_L(0); PG8_MMA(0, 0, At, B0); PG8_BAR; PG8_SCHED;
            PG8_LDB(B1, 0, 1); PG8_STAGE(PG8_SB(0, 0), b2, voffB);
            PG8_BAR; PG8_WAIT_L(0); PG8_MMA(0, 1, At, B1); PG8_BAR;
            PG8_LDA(At, 0, 1); PG8_STAGE(PG8_SA(0, 0), a2, voffA);
            PG8_BAR; PG8_WAIT_L(0); PG8_MMA(1, 0, At, B0); PG8_BAR; PG8_SCHED;
            PG8_STAGE(PG8_SB(0, 1), b2 + hstepB, voffB);
            PG8_WAIT_V(6); PG8_BAR; PG8_MMA(1, 1, At, B1); PG8_BAR;
            PG8_LDB(B0, 1, 0); PG8_SCHED; PG8_LDA(At, 1, 0); PG8_STAGE(PG8_SA(0, 1), a2 + hstepA, voffA);
            PG8_WAIT_L(8); PG8_BAR; PG8_WAIT_L(0); PG8_MMA(0, 0, At, B0); PG8_BAR; PG8_SCHED;
            PG8_LDB(B1, 1, 1); PG8_STAGE(PG8_SB(1, 0), b3, voffB);
            PG8_BAR; PG8_WAIT_L(0); PG8_MMA(0, 1, At, B1); PG8_BAR;
            PG8_LDA(At, 1, 1); PG8_STAGE(PG8_SA(1, 0), a3, voffA);
            PG8_BAR; PG8_WAIT_L(0); PG8_MMA(1, 0, At, B0); PG8_BAR; PG8_SCHED;
            PG8_STAGE(PG8_SB(1, 1), b3 + hstepB, voffB);
            PG8_WAIT_V(6); PG8_BAR; PG8_MMA(1, 1, At, B1); PG8_BAR;
            }
        }
        if constexpr (ALIGN_EPI) { if (wr == 0) PG8_BAR; }
        if constexpr (!Epi::AFTER_DRAIN) { E(acc, cur, wr, wc, fr, fq); S.done(cur); }
        if (!has_next) break;
#pragma unroll
        for (int a = 0; a < 2; ++a)
#pragma unroll
            for (int b = 0; b < 2; ++b)
#pragma unroll
                for (int m = 0; m < 4; ++m)
#pragma unroll
                    for (int n = 0; n < 2; ++n) acc[a][b][m][n] = (f32x4){0.f, 0.f, 0.f, 0.f};
        cur = nxt; cA = nA; cB = nB; ++ui;
        if constexpr (ALIGN_EPI) { if (wr == 1) PG8_BAR; }
    }
    PG8_WAIT_V(0);
    if constexpr (!ALIGN_EPI) { if (wr == 0) PG8_BAR; }
    PG8_BAR;
    if constexpr (Epi::AFTER_DRAIN) { E.fused(acc, cur, wr, wc, fr, fq, lds, wid, lane); S.done(cur); }
#undef PG8_SA
#undef PG8_SB
#undef PG8_STAGE
#undef PG8_LDA
#undef PG8_LDB
#undef PG8_MMA
#undef PG8_WAIT_V
#undef PG8_WAIT_L
#undef PG8_BAR
#undef PG8_SCHED
}
struct EpiF32 {
    static constexpr bool PERM = false, AFTER_DRAIN = false, MIDK = false;
    float* C; int ldc;
    __device__ __forceinline__ void operator()(const f32x4 (&acc)[2][2][4][2], const Unit& u, int wr, int wc, int fr, int fq) const {
        const int row0 = u.pm * BM + wr * 64 + fr, col0 = u.pn * BM + wc * 32 + 4 * fq;
#pragma unroll
        for (int ai = 0; ai < 2; ++ai)
#pragma unroll
            for (int m = 0; m < 4; ++m) { float* rowp = C + (size_t)(row0 + ai * HALF + m * 16) * ldc + col0;
#pragma unroll
                for (int bj = 0; bj < 2; ++bj)
#pragma unroll
                    for (int n = 0; n < 2; ++n) *(f32x4*)(rowp + bj * HALF + n * 16) = acc[ai][bj][m][n]; }
    }
};
__device__ __forceinline__ float bfu(unsigned short h) { return __uint_as_float(((unsigned)h) << 16); }
__device__ __forceinline__ float sigm(float x) { return 1.0f / (1.0f + __expf(-x)); }
struct EpiUp {
    static constexpr bool PERM = true, AFTER_DRAIN = false, MIDK = true;
    const unsigned char* g8; int ldg;
    bf16_t* merged; int t1, t2;
    __device__ __forceinline__ void mid(f32x4 (&acc)[2][2][4][2], const Unit& u, int which, int wr, int wc, int fr, int fq) const {
        int row0 = u.pm * BM + wr * 64 + fr, col0 = u.pn * BM + wc * 32 + 8 * fq;
        asm volatile("" : "+v"(row0), "+v"(col0));
#pragma unroll
        for (int ai = 0; ai < 2; ++ai) {
            u32x2 gd[4][2], gn[4][2];
#pragma unroll
            for (int m = 0; m < 4; ++m)
#pragma unroll
                for (int bj = 0; bj < 2; ++bj) { const unsigned char* gp = g8 + (size_t)(row0 + ai * HALF + m * 16) * ldg + col0 + bj * HALF;
                    gd[m][bj] = *(const u32x2*)(gp + which * 2048); gn[m][bj] = *(const u32x2*)(gp + (which + 1) * 2048); }
            asm volatile("" ::: "memory");
#pragma unroll
            for (int m = 0; m < 4; ++m)
#pragma unroll
                for (int bj = 0; bj < 2; ++bj) {
#pragma unroll
                    for (int i = 0; i < 4; ++i) {
                        acc[ai][bj][m][0][i] *= (float)((gd[m][bj].x >> (8 * i)) & 0xffu) * __builtin_amdgcn_rcpf((float)((gn[m][bj].x >> (8 * i)) & 0xffu));
                        acc[ai][bj][m][1][i] *= (float)((gd[m][bj].y >> (8 * i)) & 0xffu) * __builtin_amdgcn_rcpf((float)((gn[m][bj].y >> (8 * i)) & 0xffu)); } }
            asm volatile("" ::: "memory");
        }
    }
    __device__ __forceinline__ void operator()(const f32x4 (&acc)[2][2][4][2], const Unit& u, int wr, int wc, int fr, int fq) const {
        const int row0 = u.pm * BM + wr * 64 + fr, col0 = u.pn * BM + wc * 32 + 8 * fq;
        u32x2 g2[2][4][2];
#pragma unroll
        for (int ai = 0; ai < 2; ++ai)
#pragma unroll
            for (int m = 0; m < 4; ++m)
#pragma unroll
                for (int bj = 0; bj < 2; ++bj) g2[ai][m][bj] = *(const u32x2*)(g8 + (size_t)(row0 + ai * HALF + m * 16) * ldg + 2 * 2048 + col0 + bj * HALF);
#pragma unroll
        for (int ai = 0; ai < 2; ++ai)
#pragma unroll
            for (int m = 0; m < 4; ++m) { const size_t row = (size_t)(row0 + ai * HALF + m * 16);
#pragma unroll
                for (int bj = 0; bj < 2; ++bj) { const int col = col0 + bj * HALF;
                    f32x4 v0 = acc[ai][bj][m][0], v1 = acc[ai][bj][m][1];
#pragma unroll
                    for (int i = 0; i < 4; ++i) { v0[i] *= (float)((g2[ai][m][bj].x >> (8 * i)) & 0xffu) * (1.f / 255.f); v1[i] *= (float)((g2[ai][m][bj].y >> (8 * i)) & 0xffu) * (1.f / 255.f); }
                    u32x4 w; w.x = cvt_pk_bf16(v0[0], v0[1]); w.y = cvt_pk_bf16(v0[2], v0[3]); w.z = cvt_pk_bf16(v1[0], v1[1]); w.w = cvt_pk_bf16(v1[2], v1[3]);
                    *(u32x4*)(merged + row * 2048 + col) = w; } }
    }
};
struct EpiOut {
    static constexpr bool PERM = true, AFTER_DRAIN = false, MIDK = false;
    const float* x; bf16_t* xg; float* rowss;
    __device__ __forceinline__ void operator()(const f32x4 (&acc)[2][2][4][2], const Unit& u, int wr, int wc, int fr, int fq) const {
        const int row0 = u.pm * BM + wr * 64 + fr, col0 = u.pn * BM + wc * 32 + 8 * fq;
#pragma unroll
        for (int ai = 0; ai < 2; ++ai) {
            f32x4 xv[4][2][2];
#pragma unroll
            for (int m = 0; m < 4; ++m)
#pragma unroll
                for (int bj = 0; bj < 2; ++bj) { const float* xp = x + (size_t)(row0 + ai * HALF + m * 16) * 2048 + col0 + bj * HALF; xv[m][bj][0] = *(const f32x4*)xp; xv[m][bj][1] = *(const f32x4*)(xp + 4); }
            asm volatile("" ::: "memory");
#pragma unroll
            for (int m = 0; m < 4; ++m) { const size_t row = (size_t)(row0 + ai * HALF + m * 16); float ss = 0.f;
#pragma unroll
                for (int bj = 0; bj < 2; ++bj) { const int col = col0 + bj * HALF; const size_t off = row * 2048 + col;
                    const f32x4 v0 = acc[ai][bj][m][0] + xv[m][bj][0], v1 = acc[ai][bj][m][1] + xv[m][bj][1];
                    ss += (v0[0] * v0[0] + v0[1] * v0[1]) + (v0[2] * v0[2] + v0[3] * v0[3]) + (v1[0] * v1[0] + v1[1] * v1[1]) + (v1[2] * v1[2] + v1[3] * v1[3]);
                    u32x4 w; w.x = cvt_pk_bf16(v0[0], v0[1]); w.y = cvt_pk_bf16(v0[2], v0[3]); w.z = cvt_pk_bf16(v1[0], v1[1]); w.w = cvt_pk_bf16(v1[2], v1[3]);
                    *(u32x4*)(xg + off) = w; }
                ss += __shfl_xor(ss, 16); ss += __shfl_xor(ss, 32);
                if (fq == 0) rowss[row * 32 + u.pn * 4 + wc] = ss; }
            asm volatile("" ::: "memory");
        }
    }
};
struct EpiI8 {
    static constexpr bool PERM = true, AFTER_DRAIN = false, MIDK = false;
    bf16_t* O; int ldc; const float* sa; const float* sb; int gcol0; unsigned char* g8; int ldg; const float* bg;
    __device__ __forceinline__ static unsigned gq(float x, unsigned w, int byte) { const float e = __builtin_amdgcn_exp2f(x), s255 = __builtin_amdgcn_rcpf(__builtin_fmaf(e, 1.f / 255.f, 1.f / 255.f));
        return __builtin_amdgcn_cvt_pk_u8_f32(__builtin_rintf(fmaxf(s255, 1.f)), byte, w); }
    __device__ __forceinline__ void operator()(const f32x4 (&acc)[2][2][4][2], const Unit& u, int wr, int wc, int fr, int fq) const {
        const int row0 = u.pm * BM + wr * 64 + fr, col0 = u.pn * BM + wc * 32 + 8 * fq;
        f32x4 sb0[2], sb1[2];
#pragma unroll
        for (int bj = 0; bj < 2; ++bj) { sb0[bj] = *(const f32x4*)(sb + col0 + bj * HALF); sb1[bj] = *(const f32x4*)(sb + col0 + bj * HALF + 4); }
        float rsc[2][4];
#pragma unroll
        for (int ai = 0; ai < 2; ++ai)
#pragma unroll
            for (int m = 0; m < 4; ++m) rsc[ai][m] = sa[row0 + ai * HALF + m * 16];
        if (u.pn * BM >= gcol0) {
            f32x4 bg0[2], bg1[2];
#pragma unroll
            for (int bj = 0; bj < 2; ++bj) { bg0[bj] = *(const f32x4*)(bg + col0 - gcol0 + bj * HALF) * -1.44269504089f; bg1[bj] = *(const f32x4*)(bg + col0 - gcol0 + bj * HALF + 4) * -1.44269504089f;
                sb0[bj] = sb0[bj] * -1.44269504089f; sb1[bj] = sb1[bj] * -1.44269504089f; }
            asm volatile("" ::: "memory");
#pragma unroll
            for (int ai = 0; ai < 2; ++ai)
#pragma unroll
                for (int m = 0; m < 4; ++m) { const int row = row0 + ai * HALF + m * 16; const float ra = rsc[ai][m]; unsigned char* rowp = g8 + (size_t)row * ldg + (col0 - gcol0);
#pragma unroll
                    for (int bj = 0; bj < 2; ++bj) { const i32x4 a0 = __builtin_bit_cast(i32x4, acc[ai][bj][m][0]), a1 = __builtin_bit_cast(i32x4, acc[ai][bj][m][1]);
                        u32x2 w; w.x = 0u; w.y = 0u;
#pragma unroll
                        for (int i = 0; i < 4; ++i) { w.x = gq(__builtin_fmaf((float)a0[i] * ra, sb0[bj][i], bg0[bj][i]), w.x, i); w.y = gq(__builtin_fmaf((float)a1[i] * ra, sb1[bj][i], bg1[bj][i]), w.y, i); }
                        *(u32x2*)(rowp + bj * HALF) = w; } }
            return; }
        asm volatile("" ::: "memory");
#pragma unroll
        for (int ai = 0; ai < 2; ++ai)
#pragma unroll
            for (int m = 0; m < 4; ++m) { const int row = row0 + ai * HALF + m * 16; const float ra = rsc[ai][m]; bf16_t* rowp = O + (size_t)row * ldc + col0;
#pragma unroll
                for (int bj = 0; bj < 2; ++bj) { const i32x4 a0 = __builtin_bit_cast(i32x4, acc[ai][bj][m][0]), a1 = __builtin_bit_cast(i32x4, acc[ai][bj][m][1]);
                    const f32x4 v0 = {(float)a0[0] * ra * sb0[bj][0], (float)a0[1] * ra * sb0[bj][1], (float)a0[2] * ra * sb0[bj][2], (float)a0[3] * ra * sb0[bj][3]};
                    const f32x4 v1 = {(float)a1[0] * ra * sb1[bj][0], (float)a1[1] * ra * sb1[bj][1], (float)a1[2] * ra * sb1[bj][2], (float)a1[3] * ra * sb1[bj][3]};
                    u32x4 w; w.x = cvt_pk_bf16(v0[0], v0[1]); w.y = cvt_pk_bf16(v0[2], v0[3]); w.z = cvt_pk_bf16(v1[0], v1[1]); w.w = cvt_pk_bf16(v1[2], v1[3]);
                    *(u32x4*)(rowp + bj * HALF) = w; } }
    }
};
}
constexpr int NWAVES = 8, NTHR = 512;
constexpr int BATCH = 2, SEQ = 4096, DM = 2048, T = BATCH * SEQ;
constexpr int NIN = 12800, MEML = 256, MROWS = BATCH * MEML;
constexpr int HG_H = 6, DIL_H = 12, MEM_H = 4;
constexpr int C_Q = 0, C_V = 768, C_ZF = 1536, C_ZB = 2304, C_HG = 3072, C_DQ = 3840, C_DK = 4608, C_DV = 5376, C_MQ = 6144, C_GATE = 6656;
constexpr int NEXP = 16384;
constexpr float EPS = 1e-6f;
constexpr size_t MiB = 1u << 20;
constexpr size_t WS_CTL = 0;
constexpr size_t WS_LBF = 64 * 1024, WS_LBB = WS_LBF + 4096, WS_ROWSS = 128 * 1024  , WS_SKB = 256 * 1024  , WS_DEC = 512 * 1024  ;
constexpr size_t WS_WIN = 1 * MiB;
constexpr size_t WS_MERGED = WS_WIN;
constexpr size_t WS_WUP = 51 * MiB, WS_WOUT = 59 * MiB, WS_WQ = 67 * MiB, WS_WKV = 75 * MiB;
constexpr size_t WS_KVM = 79 * MiB, WS_KVMT = 80 * MiB;
constexpr size_t WS_MEMN = 81 * MiB;
constexpr size_t WS_LSE = 83 * MiB;
constexpr size_t WS_D = 84 * MiB;
constexpr size_t WS_IDX = 85 * MiB, WS_GATE = 89 * MiB;
constexpr size_t WS_UQ = 93 * MiB, WS_VQ = 125 * MiB;
constexpr size_t WS_SU = 157 * MiB, WS_SV = 157 * MiB + 65536;
constexpr size_t WS_H = 221 * MiB;
constexpr size_t WS_OCAT = WS_H;
constexpr size_t WS_ST = 253 * MiB;
constexpr size_t WS_PROJ = 301 * MiB;
constexpr size_t WS_XG = WS_PROJ, WS_QP = WS_PROJ + 32 * MiB, WS_SC = WS_PROJ + 64 * MiB;
constexpr size_t WS_RSP = 501 * MiB;
constexpr size_t WS_XQ = WS_PROJ + 128 * MiB;
constexpr size_t WS_SX = WS_PROJ + 144 * MiB;
constexpr size_t WS_PA = WS_PROJ + 145 * MiB;
constexpr size_t WS_G8 = 162 * MiB;
constexpr size_t WS_SA = 160 * MiB, WS_SB = 160 * MiB + 65536;
constexpr size_t WS_CMAX = 502 * MiB + 512 * 1024;
constexpr size_t WS_BAR = 502 * MiB;
constexpr size_t BAR_REGION = 20480, BAR_ZERO = 640 * 1024;
constexpr size_t WS_END = 503 * MiB;
constexpr int LDS_BYTES = 152576;
#define GAS __attribute__((address_space(1)))
#define LAS __attribute__((address_space(3)))
typedef unsigned short bf16;
typedef unsigned v4u __attribute__((ext_vector_type(4)));
typedef unsigned v2u __attribute__((ext_vector_type(2)));
typedef float f32x4 __attribute__((ext_vector_type(4)));
typedef float f32x16 __attribute__((ext_vector_type(16)));
typedef short bf16x8 __attribute__((ext_vector_type(8)));
__device__ __forceinline__ float bf2f(unsigned short h) { return __uint_as_float(((unsigned)h) << 16); }
typedef __bf16 hwbf2 __attribute__((ext_vector_type(2)));
typedef float f32x2_ __attribute__((ext_vector_type(2)));
__device__ __forceinline__ unsigned pk2(float lo, float hi) { const f32x2_ v = {lo, hi}; return __builtin_bit_cast(unsigned, __builtin_convertvector(v, hwbf2)); }
__device__ __forceinline__ unsigned f2bf(float f) { return pk2(f, f) & 0xffffu; }
__device__ __forceinline__ float wave_sum(float v) {
#pragma unroll
    for (int o = 1; o < 64; o <<= 1) v += __shfl_xor(v, o);
    return v;
}
__device__ __forceinline__ float wave_max(float v) {
#pragma unroll
    for (int o = 1; o < 64; o <<= 1) v = fmaxf(v, __shfl_xor(v, o));
    return v;
}
__device__ __forceinline__ float row_rstd(const float* rsp, int t) {
    const f32x4* q = (const f32x4*)(rsp + (size_t)t * 32); float s = 0.f;
#pragma unroll
    for (int i = 0; i < 8; ++i) { const f32x4 v = q[i]; s += (v.x + v.y) + (v.z + v.w); }
    return rsqrtf(s * (1.f / 2048.f) + 1e-6f);
}
__device__ __forceinline__ float sigmoidf_(float x) { return __builtin_amdgcn_rcpf(1.0f + __expf(-x)); }

struct P {
    const GAS float *x, *mem, *g_mix, *w_in, *b_gate, *lbf_l, *lbb_l, *g_hg, *w_kv, *g_mem, *w_up, *w_out, *g_ffn, *w_q, *subk, *pu, *pv, *g_final;
    GAS float* out; GAS float* dst10; GAS unsigned char* ws; int ph_lo, ph_hi;
};
#define WSP(T_, off) ((T_*)(GAS T_*)(p.ws + (off)))

__device__ __forceinline__ void p0_transpose_item(const float* W, int K, int N, bf16* WT, float* scr, int item, int lane, const float* ks = nullptr) {
    const int nblk = N / 32, kb = item / nblk, nb = item % nblk, k0 = 64 * kb, n0 = 32 * nb;
#pragma unroll
    for (int i = 0; i < 8; ++i) { const int kk = 8 * i + (lane >> 3), nq = (lane & 7) * 4; const f32x4 v = *(const f32x4*)(W + (size_t)(k0 + kk) * N + n0 + nq);
        const float sc = ks ? ks[k0 + kk] : 1.f; float* d = scr + kk * 33 + nq; d[0] = v.x * sc; d[1] = v.y * sc; d[2] = v.z * sc; d[3] = v.w * sc; }
    asm volatile("s_waitcnt lgkmcnt(0)" ::: "memory");
    const int c = lane & 7;
#pragma unroll
    for (int j = 0; j < 4; ++j) { const int n = (lane >> 3) + 8 * j; const float* s = scr + (8 * c) * 33 + n;
        v4u o; o.x = pk2(s[0 * 33], s[1 * 33]); o.y = pk2(s[2 * 33], s[3 * 33]); o.z = pk2(s[4 * 33], s[5 * 33]); o.w = pk2(s[6 * 33], s[7 * 33]);
        *(v4u*)(WT + (size_t)(n0 + n) * K + k0 + 8 * c) = o; }
    asm volatile("s_waitcnt lgkmcnt(0)" ::: "memory");
}
__device__ __forceinline__ void rms_row_to_bf16(const float* xrow, const float* g, bf16* orow, int lane) {
    const f32x4* xr = (const f32x4*)xrow + lane; const f32x4* gr = (const f32x4*)g + lane;
    f32x4 v[8]; float s = 0.f;
#pragma unroll
    for (int j = 0; j < 8; ++j) { v[j] = xr[64 * j]; s += (v[j].x * v[j].x + v[j].y * v[j].y) + (v[j].z * v[j].z + v[j].w * v[j].w); }
    const float rstd = rsqrtf(wave_sum(s) * (1.f / DM) + EPS);
    v2u* o8 = (v2u*)orow + lane;
#pragma unroll
    for (int j = 0; j < 8; ++j) { const f32x4 gg = gr[64 * j]; v2u w; w.x = pk2(v[j].x * rstd * gg.x, v[j].y * rstd * gg.y); w.y = pk2(v[j].z * rstd * gg.z, v[j].w * rstd * gg.w); o8[64 * j] = w; }
}
__device__ __forceinline__ unsigned q8b(float v, float inv) { return (unsigned)((int)rintf(v * inv)) & 0xffu; }
__device__ __forceinline__ void rms_row_to_i8(const float* xrow, const float* g, unsigned char* orow, float* scale, int lane) {
    const f32x4* xr = (const f32x4*)xrow + lane; const f32x4* gr = (const f32x4*)g + lane;
    f32x4 v[8]; float s = 0.f;
#pragma unroll
    for (int j = 0; j < 8; ++j) { v[j] = xr[64 * j]; s += (v[j].x * v[j].x + v[j].y * v[j].y) + (v[j].z * v[j].z + v[j].w * v[j].w); }
    const float rstd = rsqrtf(wave_sum(s) * (1.f / DM) + EPS); float m = 0.f;
#pragma unroll
    for (int j = 0; j < 8; ++j) { const f32x4 gg = gr[64 * j]; v[j] = v[j] * rstd * gg; m = fmaxf(fmaxf(m, fmaxf(fabsf(v[j].x), fabsf(v[j].y))), fmaxf(fabsf(v[j].z), fabsf(v[j].w))); }
    m = fmaxf(wave_max(m), 1e-30f); const float inv = 127.f / m;
    unsigned* o = (unsigned*)orow + lane;
#pragma unroll
    for (int j = 0; j < 8; ++j) o[64 * j] = q8b(v[j].x, inv) | (q8b(v[j].y, inv) << 8) | (q8b(v[j].z, inv) << 16) | (q8b(v[j].w, inv) << 24);
    if (lane == 0) *scale = m * (1.f / 127.f);
}
__device__ __forceinline__ void p0_qtranspose_item(const float* W, int K, int N, unsigned char* W8T, const unsigned* cmax, float* sb, float* scr, int item, int lane) {
    const int nblk = N / 32, kb = item / nblk, nb = item % nblk, k0 = 64 * kb, n0 = 32 * nb;
#pragma unroll
    for (int i = 0; i < 8; ++i) { const int kk = 8 * i + (lane >> 3), nq = (lane & 7) * 4; const f32x4 v = *(const f32x4*)(W + (size_t)(k0 + kk) * N + n0 + nq);
        float* d = scr + kk * 33 + nq; d[0] = v.x; d[1] = v.y; d[2] = v.z; d[3] = v.w; }
    asm volatile("s_waitcnt lgkmcnt(0)" ::: "memory");
    const int c = lane & 7;
#pragma unroll
    for (int j = 0; j < 4; ++j) { const int n = (lane >> 3) + 8 * j; const float* s = scr + (8 * c) * 33 + n;
        const float m = fmaxf(__uint_as_float(cmax[n0 + n]), 1e-30f), inv = 127.f / m;
        v2u o; o.x = q8b(s[0 * 33], inv) | (q8b(s[1 * 33], inv) << 8) | (q8b(s[2 * 33], inv) << 16) | (q8b(s[3 * 33], inv) << 24);
        o.y = q8b(s[4 * 33], inv) | (q8b(s[5 * 33], inv) << 8) | (q8b(s[6 * 33], inv) << 16) | (q8b(s[7 * 33], inv) << 24);
        *(v2u*)(W8T + (size_t)(n0 + n) * K + k0 + 8 * c) = o;
        if (kb == 0 && c == 0) sb[n0 + n] = m * (1.f / 127.f); }
    asm volatile("s_waitcnt lgkmcnt(0)" ::: "memory");
}
__device__ __forceinline__ void p0_win_strip(const P& p, unsigned char* lds, int strip) {
    const int tid = tidx(), lane = tid & 63, wave = tid >> 6;
    const int n0 = strip * 32 + 4 * (lane & 7), kbase = 256 * wave + 32 * (lane >> 3);
    const float* wp = ((const float*)p.w_in) + (size_t)kbase * NIN + n0;
    f32x4 v[32];
#pragma unroll
    for (int i = 0; i < 32; ++i) v[i] = __builtin_nontemporal_load((const f32x4*)(wp + (size_t)i * NIN));
    f32x4 m = {0.f, 0.f, 0.f, 0.f};
#pragma unroll
    for (int i = 0; i < 32; ++i) { m.x = fmaxf(m.x, fabsf(v[i].x)); m.y = fmaxf(m.y, fabsf(v[i].y)); m.z = fmaxf(m.z, fabsf(v[i].z)); m.w = fmaxf(m.w, fabsf(v[i].w)); }
#pragma unroll
    for (int d = 8; d < 64; d <<= 1) { m.x = fmaxf(m.x, __shfl_xor(m.x, d)); m.y = fmaxf(m.y, __shfl_xor(m.y, d)); m.z = fmaxf(m.z, __shfl_xor(m.z, d)); m.w = fmaxf(m.w, __shfl_xor(m.w, d)); }
    float* red = (float*)lds;
    __syncthreads();
    if (lane < 8) *(f32x4*)(red + wave * 32 + 4 * lane) = m;
    __syncthreads();
    f32x4 mm = *(const f32x4*)(red + 4 * (lane & 7));
#pragma unroll
    for (int w = 1; w < 8; ++w) { const f32x4 t = *(const f32x4*)(red + w * 32 + 4 * (lane & 7)); mm.x = fmaxf(mm.x, t.x); mm.y = fmaxf(mm.y, t.y); mm.z = fmaxf(mm.z, t.z); mm.w = fmaxf(mm.w, t.w); }
    mm.x = fmaxf(mm.x, 1e-30f); mm.y = fmaxf(mm.y, 1e-30f); mm.z = fmaxf(mm.z, 1e-30f); mm.w = fmaxf(mm.w, 1e-30f);
    if (wave == 0 && lane < 8) *(f32x4*)(WSP(float, WS_SB) + n0) = mm * (1.f / 127.f);
    const float inv[4] = {127.f / mm.x, 127.f / mm.y, 127.f / mm.z, 127.f / mm.w};
    unsigned char* w8 = (unsigned char*)(p.ws + WS_WIN);
#pragma unroll
    for (int c = 0; c < 4; ++c) { unsigned d[8];
#pragma unroll
        for (int q = 0; q < 8; ++q) d[q] = q8b(v[4 * q][c], inv[c]) | (q8b(v[4 * q + 1][c], inv[c]) << 8) | (q8b(v[4 * q + 2][c], inv[c]) << 16) | (q8b(v[4 * q + 3][c], inv[c]) << 24);
        v4u lo, hi; lo.x = d[0]; lo.y = d[1]; lo.z = d[2]; lo.w = d[3]; hi.x = d[4]; hi.y = d[5]; hi.z = d[6]; hi.w = d[7];
        unsigned char* o = w8 + (size_t)(n0 + c) * DM + kbase; *(v4u*)o = lo; *(v4u*)(o + 16) = hi; }
}
__device__ __forceinline__ void phase0(const P& p, unsigned char* lds, int vcu, int G, int bx) {
    const int tid = tidx(), lane = tid & 63, wave = tid >> 6;
    float* scr = (float*)(lds + wave * 16384);
    const int gw = vcu * NWAVES + wave, NGW = G * NWAVES;
    for (int strip = bx; strip < NIN / 32; strip += G) p0_win_strip(p, lds, strip);
    __syncthreads();
    constexpr int I_KV = (DM / 64) * (1024 / 32);
    for (int it = gw; it < I_KV; it += NGW) p0_transpose_item(((const float*)p.w_kv), DM, 1024, WSP(bf16, WS_WKV), scr, it, lane);
    const int nstr2 = NIN / 32 - G;
    const bool wsplit = (G == 256);
    const int xcnt = wsplit ? (bx < nstr2 ? 18 : 50) : T / G, xbase = wsplit ? (bx < nstr2 ? bx * 18 : nstr2 * 18 + (bx - nstr2) * 50) : bx * (T / G);
    for (int r = wave; r < xcnt; r += 16) {
        const int m = xbase + r, m2 = m + 8; const bool two = r + 8 < xcnt;
        const f32x4* xa = (const f32x4*)(((const float*)p.x) + (size_t)m * DM) + lane; const f32x4* xb = (const f32x4*)(((const float*)p.x) + (size_t)(two ? m2 : m) * DM) + lane; const f32x4* gr = (const f32x4*)((const float*)p.g_mix) + lane;
        f32x4 va[8], vb[8]; float sa_ = 0.f, sb_ = 0.f;
#pragma unroll
        for (int j = 0; j < 8; ++j) { va[j] = __builtin_nontemporal_load(xa + 64 * j); vb[j] = __builtin_nontemporal_load(xb + 64 * j); }
#pragma unroll
        for (int j = 0; j < 8; ++j) { sa_ += (va[j].x * va[j].x + va[j].y * va[j].y) + (va[j].z * va[j].z + va[j].w * va[j].w); sb_ += (vb[j].x * vb[j].x + vb[j].y * vb[j].y) + (vb[j].z * vb[j].z + vb[j].w * vb[j].w); }
        const float ra = rsqrtf(wave_sum(sa_) * (1.f / DM) + EPS), rb = rsqrtf(wave_sum(sb_) * (1.f / DM) + EPS); float ma = 0.f, mb = 0.f;
#pragma unroll
        for (int j = 0; j < 8; ++j) { const f32x4 gg = gr[64 * j]; va[j] = va[j] * ra * gg; vb[j] = vb[j] * rb * gg;
            ma = fmaxf(fmaxf(ma, fmaxf(fabsf(va[j].x), fabsf(va[j].y))), fmaxf(fabsf(va[j].z), fabsf(va[j].w))); mb = fmaxf(fmaxf(mb, fmaxf(fabsf(vb[j].x), fabsf(vb[j].y))), fmaxf(fabsf(vb[j].z), fabsf(vb[j].w))); }
        ma = fmaxf(wave_max(ma), 1e-30f); mb = fmaxf(wave_max(mb), 1e-30f); const float ia = 127.f / ma, ib = 127.f / mb;
        unsigned* oa = (unsigned*)((unsigned char*)(p.ws + WS_H) + (size_t)m * DM) + lane; unsigned* ob = (unsigned*)((unsigned char*)(p.ws + WS_H) + (size_t)m2 * DM) + lane;
#pragma unroll
        for (int j = 0; j < 8; ++j) { oa[64 * j] = q8b(va[j].x, ia) | (q8b(va[j].y, ia) << 8) | (q8b(va[j].z, ia) << 16) | (q8b(va[j].w, ia) << 24);
            if (two) ob[64 * j] = q8b(vb[j].x, ib) | (q8b(vb[j].y, ib) << 8) | (q8b(vb[j].z, ib) << 16) | (q8b(vb[j].w, ib) << 24); }
        if (lane == 0) { WSP(float, WS_SA)[m] = ma * (1.f / 127.f); if (two) WSP(float, WS_SA)[m2] = mb * (1.f / 127.f); }
    }
    for (int m = gw; m < MROWS; m += NGW) rms_row_to_bf16(((const float*)p.mem) + (size_t)m * DM, ((const float*)p.g_mem), WSP(bf16, WS_MEMN) + (size_t)m * DM, lane);
    const size_t gt = (size_t)vcu * NTHR + tid, NGT = (size_t)G * NTHR;
    for (size_t i = gt; i < 32768; i += NGT) WSP(bf16, WS_SKB)[i] = (bf16)f2bf(((const float*)p.subk)[i]);
    for (size_t i = gt; i < 768; i += NGT) { WSP(float, WS_LBF)[i] = 1.0f / (1.0f + __expf(((const float*)p.lbf_l)[768 + i] - ((const float*)p.lbf_l)[i])); WSP(float, WS_LBB)[i] = 1.0f / (1.0f + __expf(((const float*)p.lbb_l)[768 + i] - ((const float*)p.lbb_l)[i])); }
}
__device__ __forceinline__ void phase0b(const P& p, unsigned char* lds, int vcu, int G) {}
__device__ __forceinline__ void tail_prep(const P& p, unsigned char* lds, int wi, int nw) {
    const int tid = tidx(), lane = tid & 63, wave = tid >> 6;
    float* scr = (float*)(lds + wave * 16384);
    const int gw = wi * NWAVES + wave, NGW = nw * NWAVES;
    for (int r4 = gw * 4; r4 < 2 * NEXP; r4 += NGW * 4) {
        f32x4 v[4][8];
#pragma unroll
        for (int q = 0; q < 4; ++q) { const int r2 = r4 + q, isv = r2 >= NEXP, row = isv ? r2 - NEXP : r2; const f32x4* xr = (const f32x4*)((isv ? ((const float*)p.pv) : ((const float*)p.pu)) + (size_t)row * DM) + lane;
#pragma unroll
            for (int j = 0; j < 8; ++j) v[q][j] = __builtin_nontemporal_load(xr + 64 * j); }
#pragma unroll
        for (int q = 0; q < 4; ++q) { const int r2 = r4 + q, isv = r2 >= NEXP, row = isv ? r2 - NEXP : r2; float m = 0.f;
            if (!isv) {
#pragma unroll
                for (int j = 0; j < 8; ++j) v[q][j] = v[q][j] * ((const f32x4*)((const float*)p.g_ffn))[64 * j + lane]; }
#pragma unroll
            for (int j = 0; j < 8; ++j) m = fmaxf(fmaxf(m, fmaxf(fabsf(v[q][j].x), fabsf(v[q][j].y))), fmaxf(fabsf(v[q][j].z), fabsf(v[q][j].w)));
            m = fmaxf(wave_max(m), 1e-30f); const float inv = 127.f / m;
            unsigned* o = (unsigned*)(p.ws + (isv ? WS_VQ : WS_UQ) + (size_t)(lane >> 5) * (NEXP * 128) + (size_t)row * 128) + (lane & 31);
#pragma unroll
            for (int j = 0; j < 8; ++j) o[(size_t)j * (2 * NEXP * 128 / 4)] = q8b(v[q][j].x, inv) | (q8b(v[q][j].y, inv) << 8) | (q8b(v[q][j].z, inv) << 16) | (q8b(v[q][j].w, inv) << 24);
            if (lane == 0) WSP(float, isv ? WS_SV : WS_SU)[row] = m * (1.f / 127.f); }
    }
    constexpr int I_SQ = (DM / 64) * (DM / 32);
    for (int it = gw; it < 3 * I_SQ; it += NGW) {
        if (it < I_SQ) p0_transpose_item(((const float*)p.w_up), DM, DM, WSP(bf16, WS_WUP), scr, it, lane);
        else if (it < 2 * I_SQ) p0_transpose_item(((const float*)p.w_out), DM, DM, WSP(bf16, WS_WOUT), scr, it - I_SQ, lane);
        else p0_transpose_item(((const float*)p.w_q), DM, DM, WSP(bf16, WS_WQ), scr, it - 2 * I_SQ, lane, (const float*)p.g_ffn);
    }
}
typedef GAS unsigned gu32;
typedef GAS unsigned long long gu64;
#define RLX_AGENT __ATOMIC_RELAXED, __HIP_MEMORY_SCOPE_AGENT
__device__ __forceinline__ unsigned long long rt() { return __builtin_amdgcn_s_memrealtime(); }
#define XB_TMO      128
#define XB_XCNT(j)  (256  + 64 * (j))
#define XB_XSUB(j)  (1280 + 64 * (j))
#define XB_XGEN(j)  (2304 + 64 * (j))
#define XB_TOP      3328
#define XB_TOPGEN   3392
#define XCD_BAR_WORDS 3456
#define XB_SPIN_CAP (1u << 21)

__device__ __forceinline__ unsigned xb_ld(unsigned* p)              { return __hip_atomic_load(p, __ATOMIC_RELAXED, __HIP_MEMORY_SCOPE_AGENT); }
__device__ __forceinline__ unsigned xb_add(unsigned* p, unsigned v) { return __hip_atomic_fetch_add(p, v, __ATOMIC_RELAXED, __HIP_MEMORY_SCOPE_AGENT); }
__device__ __forceinline__ unsigned xb_xcc_id() { return (unsigned)__builtin_amdgcn_s_getreg((3 << 11) | 20) & 0xFu; }
#define XB_SPIN(cond, bar) do { unsigned _sp = 0; while (cond) { __builtin_amdgcn_s_sleep(1); \
    if ((++_sp & 255u) == 0u) { if (xb_ld(&(bar)[XB_TMO])) break; if (_sp > XB_SPIN_CAP) { atomicAdd(&(bar)[XB_TMO], 1u); break; } } } } while (0)

struct XcdBarrier {
    unsigned* bar; unsigned x;
    volatile LAS unsigned* st;
};

__device__ __forceinline__ XcdBarrier xcd_barrier_post(unsigned* bar, volatile LAS unsigned* st) {
    XcdBarrier b; b.bar = bar; b.x = xb_xcc_id(); b.st = st;
    if (threadIdx.x == 0) (void)xb_add(&bar[XB_XCNT(b.x)], 1u);
    return b;
}
__device__ __forceinline__ void xcd_barrier_complete(unsigned* bar, unsigned x, unsigned& nloc, unsigned& nx) {
    const unsigned G = gridDim.x * gridDim.y * gridDim.z;
    unsigned sum, cnt, mine, sp = 0u;
    for (;;) {
        sum = 0u; cnt = 0u; mine = 0u;
#pragma unroll
        for (unsigned j = 0; j < 16; ++j) { const unsigned c = xb_ld(&bar[XB_XCNT(j)]); sum += c; cnt += (c > 0u) ? 1u : 0u; mine = (j == x) ? c : mine; }
        if (sum == G) break;
        __builtin_amdgcn_s_sleep(1);
        if ((++sp & 255u) == 0u) { if (xb_ld(&bar[XB_TMO])) break; if (sp > XB_SPIN_CAP) { atomicAdd(&bar[XB_TMO], 1u); break; } }
    }
    nloc = mine > 0u ? mine : 1u; nx = cnt > 0u ? cnt : 1u;
}

template <bool REL = true, bool ACQ = true> __device__ __forceinline__ void xcd_barrier(const XcdBarrier& b) {
    asm volatile("s_waitcnt vmcnt(0)" ::: "memory");
    __syncthreads();
    if (threadIdx.x == 0) {
        unsigned* bar = b.bar;
        __builtin_amdgcn_s_waitcnt(0);
        unsigned nloc = b.st[0], nx = b.st[1];
        if (nloc == 0u) { xcd_barrier_complete(bar, b.x, nloc, nx); b.st[0] = nloc; b.st[1] = nx; }
        const unsigned old = xb_add(&bar[XB_XSUB(b.x)], 1u);
        const unsigned gen = old / nloc;
        if (old + 1u == (gen + 1u) * nloc) {
            if constexpr (REL) __builtin_amdgcn_fence(__ATOMIC_RELEASE, "agent");
            asm volatile("s_waitcnt vmcnt(0)" ::: "memory");
            (void)xb_add(&bar[XB_TOP], 1u);
        }
        const unsigned target = (gen + 1u) * nx;
        XB_SPIN((int)(xb_ld(&bar[XB_TOP]) - target) < 0, bar);
        if constexpr (ACQ) __builtin_amdgcn_fence(__ATOMIC_ACQUIRE, "agent");
        asm volatile("s_waitcnt vmcnt(0)" ::: "memory");
    }
    __syncthreads();
}
__device__ __forceinline__ f32x16 mfma32(bf16x8 a, bf16x8 b, f32x16 c) { return __builtin_amdgcn_mfma_f32_32x32x16_bf16(a, b, c, 0, 0, 0); }
__device__ __forceinline__ f32x4 mfma16(bf16x8 a, bf16x8 b, f32x4 c) { return __builtin_amdgcn_mfma_f32_16x16x32_bf16(a, b, c, 0, 0, 0); }
template <int CTRL> __device__ __forceinline__ float dppf(float v) { return __builtin_bit_cast(float, __builtin_amdgcn_update_dpp(0, __builtin_bit_cast(int, v), CTRL, 0xf, 0xf, true)); }
__device__ __forceinline__ float sum8(float v) { v += dppf<0xB1>(v); v += dppf<0x4E>(v); v += dppf<0x141>(v); return v; }
__device__ __forceinline__ float max8(float v) { v = fmaxf(v, dppf<0xB1>(v)); v = fmaxf(v, dppf<0x4E>(v)); v = fmaxf(v, dppf<0x141>(v)); return v; }
__device__ __forceinline__ f32x16 zero16() { f32x16 z; for (int i = 0; i < 16; ++i) z[i] = 0.f; return z; }

__device__ __forceinline__ void h1_load(const P& p, int item, unsigned short (&zr)[16], unsigned short (&vr)[16], float& lbv) {
    const int tid = tidx(), c = tid & 127, tq = tid >> 7;
    const int n = item & 63, dir = (item >> 6) & 1, bh = item >> 7, b = bh / 6, h = bh % 6;
    const bf16* proj = WSP(const bf16, WS_PROJ) + (size_t)(b * SEQ + n * 64) * NIN;
    const int zc = (dir ? C_ZB : C_ZF) + h * 128 + c, vc = C_V + h * 128 + c;
    lbv = WSP(const float, dir ? WS_LBB : WS_LBF)[h * 128 + c];
#pragma unroll
    for (int i = 0; i < 16; ++i) { const int s = tq * 16 + i; zr[i] = proj[(size_t)s * NIN + zc]; vr[i] = proj[(size_t)s * NIN + vc]; }
}
__device__ __forceinline__ void h1_item(const P& p, unsigned char* lds, int item, const unsigned short (&zr)[16], const unsigned short (&vr)[16], const float lb) {
    const int tid = tidx(), lane = tid & 63, wave = tid >> 6, c = tid & 127, tq = tid >> 7;
    const int n = item & 63, dir = (item >> 6) & 1, bh = item >> 7, b = bh / 6, h = bh % 6, chain = bh * 2 + dir;
    const bf16* proj = WSP(const bf16, WS_PROJ) + (size_t)(b * SEQ + n * 64) * NIN;
    const int zc = (dir ? C_ZB : C_ZF) + h * 128 + c, vc = C_V + h * 128 + c;
    float* segs = (float*)lds;
    bf16* KhT = (bf16*)(lds + 2048);
    bf16* VT = (bf16*)(lds + 2048 + 18432);
    float fv[16]; float seg = 1.f;
#pragma unroll
    for (int i = 0; i < 16; ++i) { const int s = tq * 16 + i; const float z = bf2f(zr[i]); const float f = lb + (1.f - lb) * sigmoidf_(z);
        fv[i] = f; seg *= f; VT[c * 72 + s] = vr[i]; }
    segs[tq * 128 + c] = seg;
    __syncthreads();
    const float s0 = segs[c], s1 = segs[128 + c], s2 = segs[256 + c], s3 = segs[384 + c];
    if (dir == 0) { float run = (tq < 1 ? s1 : 1.f) * (tq < 2 ? s2 : 1.f) * (tq < 3 ? s3 : 1.f);
#pragma unroll
        for (int i = 15; i >= 0; --i) { KhT[c * 72 + tq * 16 + i] = (bf16)f2bf((1.f - fv[i]) * run); run *= fv[i]; } }
    else { float run = (tq > 0 ? s0 : 1.f) * (tq > 1 ? s1 : 1.f) * (tq > 2 ? s2 : 1.f);
#pragma unroll
        for (int i = 0; i < 16; ++i) { KhT[c * 72 + tq * 16 + i] = (bf16)f2bf((1.f - fv[i]) * run); run *= fv[i]; } }
    if (tq == 0) WSP(float, WS_D)[(size_t)(chain * 64 + n) * 128 + c] = (s0 * s1) * (s2 * s3);
    __syncthreads();
    const int r32 = lane & 31, hi = lane >> 5, dvt = wave >> 1, c0 = (wave & 1) * 64;
    f32x16 acc0 = zero16(), acc1 = zero16();
#pragma unroll
    for (int ks = 0; ks < 4; ++ks) {
        const bf16x8 a = *(const bf16x8*)(VT + (dvt * 32 + r32) * 72 + ks * 16 + hi * 8);
        const bf16x8 b0 = *(const bf16x8*)(KhT + (c0 + r32) * 72 + ks * 16 + hi * 8), b1 = *(const bf16x8*)(KhT + (c0 + 32 + r32) * 72 + ks * 16 + hi * 8);
        acc0 = mfma32(b0, a, acc0); acc1 = mfma32(b1, a, acc1); }
    bf16* st = WSP(bf16, WS_ST) + (size_t)(chain * 64 + n) * 16384 + (size_t)(dvt * 32 + r32) * 128 + c0 + 4 * hi;
#pragma unroll
    for (int q = 0; q < 4; ++q) { v2u w0, w1; w0.x = pk2(acc0[4 * q], acc0[4 * q + 1]); w0.y = pk2(acc0[4 * q + 2], acc0[4 * q + 3]); w1.x = pk2(acc1[4 * q], acc1[4 * q + 1]); w1.y = pk2(acc1[4 * q + 2], acc1[4 * q + 3]);
        *(v2u*)(st + 8 * q) = w0; *(v2u*)(st + 32 + 8 * q) = w1; }
    __syncthreads();
}

__device__ __forceinline__ void h2_scan(const P& p, int bx, int G, bf16* sdst) {
    const int gt = bx * NTHR + tidx(), NGT = G * NTHR;
    for (int w = gt; w < 24 * 4096; w += NGT) {
        const int chain = w >> 12, e4 = w & 4095, c4 = (e4 & 31) * 4, dir = chain & 1;
        float run[4] = {0.f, 0.f, 0.f, 0.f};
        for (int k0 = 0; k0 < 64; k0 += 8) {
            v2u L[8]; f32x4 d[8];
#pragma unroll
            for (int j = 0; j < 8; ++j) { const int n = dir ? 63 - (k0 + j) : (k0 + j);
                L[j] = *(const v2u*)(WSP(const bf16, WS_ST) + (size_t)(chain * 64 + n) * 16384 + e4 * 4);
                d[j] = *(const f32x4*)(WSP(const float, WS_D) + (size_t)(chain * 64 + n) * 128 + c4); }
#pragma unroll
            for (int j = 0; j < 8; ++j) { const int n = dir ? 63 - (k0 + j) : (k0 + j);
                v2u o; o.x = pk2(run[0], run[1]); o.y = pk2(run[2], run[3]);
                *(v2u*)(sdst + (size_t)(chain * 64 + n) * 16384 + e4 * 4) = o;
                run[0] = d[j].x * run[0] + __uint_as_float(L[j].x << 16); run[1] = d[j].y * run[1] + __uint_as_float(L[j].x & 0xffff0000u);
                run[2] = d[j].z * run[2] + __uint_as_float(L[j].y << 16); run[3] = d[j].w * run[3] + __uint_as_float(L[j].y & 0xffff0000u); }
        }
    }
}

__device__ __forceinline__ void h3_load_z(const P& p, int item, unsigned short (&zf)[16], unsigned short (&zb)[16], float& lbf, float& lbb) {
    const int tid = tidx(), c = tid & 127, tq = tid >> 7;
    const int n = item & 63, bh = item >> 6, b = bh / 6, h = bh % 6;
    const bf16* proj = WSP(const bf16, WS_PROJ) + (size_t)(b * SEQ + n * 64) * NIN + h * 128 + c;
    lbf = WSP(const float, WS_LBF)[h * 128 + c]; lbb = WSP(const float, WS_LBB)[h * 128 + c];
#pragma unroll
    for (int i = 0; i < 16; ++i) { const size_t o = (size_t)(tq * 16 + i) * NIN; zf[i] = proj[o + C_ZF]; zb[i] = proj[o + C_ZB]; }
}
__device__ __forceinline__ void h3_load_vq(const P& p, int item, unsigned short (&vr)[16], unsigned short (&qr)[16]) {
    const int tid = tidx(), c = tid & 127, tq = tid >> 7;
    const int n = item & 63, bh = item >> 6, b = bh / 6, h = bh % 6;
    const bf16* proj = WSP(const bf16, WS_PROJ) + (size_t)(b * SEQ + n * 64) * NIN + h * 128 + c;
#pragma unroll
    for (int i = 0; i < 16; ++i) { const size_t o = (size_t)(tq * 16 + i) * NIN; vr[i] = proj[o + C_V]; qr[i] = proj[o + C_Q]; }
}
__device__ __forceinline__ void h3_item(const P& p, unsigned char* lds, int item, const unsigned short (&zfr)[16], const unsigned short (&zbr)[16], const unsigned short (&vr)[16], const unsigned short (&qr)[16], const float lbF, const float lbB,
                                        const bool more, const int item_next, unsigned short (&nv)[16], unsigned short (&nq)[16]) {
    const int tid = tidx(), lane = tid & 63, wave = tid >> 6, c = tid & 127, tq = tid >> 7;
    const int n = item & 63, bh = item >> 6, b = bh / 6, h = bh % 6;
    const size_t row0 = (size_t)(b * SEQ + n * 64);
    const bf16* proj = WSP(const bf16, WS_PROJ) + row0 * NIN;
    float* SEG = (float*)lds;
    bf16* QF = (bf16*)(lds + 4096);
    bf16* QB = (bf16*)(lds + 4096 + 17408);
    bf16* KF = (bf16*)(lds + 4096 + 2 * 17408);
    bf16* KB = (bf16*)(lds + 4096 + 3 * 17408);
    bf16* VT = (bf16*)(lds + 4096 + 4 * 17408);
    bf16* A2 = (bf16*)(lds + 4096 + 4 * 17408 + 18432);
    float* OB = (float*)(lds + 4096);
    bf16x8 sfr[8], sbr[8];
    { const int r32p = lane & 31, hip = lane >> 5, dtp = wave & 3;
      const bf16* stf = WSP(const bf16, WS_ST) + (size_t)((bh * 2 + 0) * 64 + n) * 16384 + (size_t)(dtp * 32 + r32p) * 128 + hip * 8;
      const bf16* stb = WSP(const bf16, WS_ST) + (size_t)((bh * 2 + 1) * 64 + n) * 16384 + (size_t)(dtp * 32 + r32p) * 128 + hip * 8;
#pragma unroll
      for (int ks = 0; ks < 8; ++ks) { sfr[ks] = *(const bf16x8*)(stf + ks * 16); sbr[ks] = *(const bf16x8*)(stb + ks * 16); } }
    const v4u g0 = *(const v4u*)(proj + (size_t)(tid >> 3) * NIN + C_HG + h * 128 + (tid & 7) * 16), g1 = *(const v4u*)(proj + (size_t)(tid >> 3) * NIN + C_HG + h * 128 + (tid & 7) * 16 + 8);
    float ffv[16], fbv[16];
    { float sf = 1.f, sb = 1.f;
#pragma unroll
      for (int i = 0; i < 16; ++i) { const int s = tq * 16 + i;
        const float zf = bf2f(zfr[i]), zb = bf2f(zbr[i]);
        const float ff = lbF + (1.f - lbF) * sigmoidf_(zf), fb = lbB + (1.f - lbB) * sigmoidf_(zb);
        ffv[i] = ff; sf *= ff; fbv[i] = fb; sb *= fb;
        VT[c * 72 + s] = vr[i]; }
      SEG[tq * 128 + c] = sf; SEG[512 + tq * 128 + c] = sb; }
    __syncthreads();
    {
      float runf = (tq > 0 ? SEG[c] : 1.f) * (tq > 1 ? SEG[128 + c] : 1.f) * (tq > 2 ? SEG[256 + c] : 1.f);
      float runb = (tq < 1 ? SEG[512 + 128 + c] : 1.f) * (tq < 2 ? SEG[512 + 256 + c] : 1.f) * (tq < 3 ? SEG[512 + 384 + c] : 1.f);
      float bb[16];
#pragma unroll
      for (int i = 15; i >= 0; --i) { runb *= fbv[i]; bb[i] = runb; }
#pragma unroll
      for (int i = 0; i < 16; ++i) { const int s = tq * 16 + i; runf *= ffv[i];
        const float q = bf2f(qr[i]);
        QF[s * 136 + c] = (bf16)f2bf(q * runf); KF[s * 136 + c] = (bf16)f2bf((1.f - ffv[i]) * __builtin_amdgcn_rcpf(runf));
        QB[s * 136 + c] = (bf16)f2bf(q * bb[i]); KB[s * 136 + c] = (bf16)f2bf((1.f - fbv[i]) * __builtin_amdgcn_rcpf(bb[i])); } }
    if (more) h3_load_vq(p, item_next, nv, nq);
    __syncthreads();
    const int r32 = lane & 31, hi = lane >> 5;
    {
      const int dir = wave >> 2, ti = (wave >> 1) & 1, si = wave & 1;
      const bf16* Qd = dir ? QB : QF; const bf16* Kd = dir ? KB : KF;
      f32x16 a = zero16();
#pragma unroll
      for (int ks = 0; ks < 8; ++ks) a = mfma32(*(const bf16x8*)(Qd + (ti * 32 + r32) * 136 + ks * 16 + hi * 8), *(const bf16x8*)(Kd + (si * 32 + r32) * 136 + ks * 16 + hi * 8), a);
#pragma unroll
      for (int r = 0; r < 16; ++r) { const int t = ti * 32 + (r & 3) + 8 * (r >> 2) + 4 * hi, s = si * 32 + r32;
        const bool keep = dir ? (s >= t) : (s <= t);
        A2[t * 136 + dir * 64 + s] = (bf16)f2bf(keep ? a[r] : 0.f); } }
    __syncthreads();
    f32x16 o = zero16();
    const int tt = wave >> 2, dt = wave & 3;
    {
#pragma unroll
      for (int ks = 0; ks < 8; ++ks) {
        o = mfma32(*(const bf16x8*)(QF + (tt * 32 + r32) * 136 + ks * 16 + hi * 8), sfr[ks], o);
        o = mfma32(*(const bf16x8*)(QB + (tt * 32 + r32) * 136 + ks * 16 + hi * 8), sbr[ks], o);
        o = mfma32(*(const bf16x8*)(A2 + (tt * 32 + r32) * 136 + ks * 16 + hi * 8), *(const bf16x8*)(VT + (dt * 32 + r32) * 72 + (ks & 3) * 16 + hi * 8), o); } }
    __syncthreads();
#pragma unroll
    for (int r = 0; r < 16; ++r) OB[(tt * 32 + (r & 3) + 8 * (r >> 2) + 4 * hi) * 132 + dt * 32 + r32] = o[r];
    __syncthreads();
    { const int t = tid >> 3, sub = tid & 7;
      float v[16]; float ss = 0.f;
#pragma unroll
      for (int k = 0; k < 4; ++k) { const f32x4 x = *(const f32x4*)(OB + t * 132 + sub * 16 + 4 * k); v[4 * k] = x.x; v[4 * k + 1] = x.y; v[4 * k + 2] = x.z; v[4 * k + 3] = x.w; ss += (x.x * x.x + x.y * x.y) + (x.z * x.z + x.w * x.w); }
      const float rstd = rsqrtf(sum8(ss) * (1.f / 128.f) + EPS);
      float gz[16]; gz[0] = __uint_as_float(g0.x << 16); gz[1] = __uint_as_float(g0.x & 0xffff0000u); gz[2] = __uint_as_float(g0.y << 16); gz[3] = __uint_as_float(g0.y & 0xffff0000u);
      gz[4] = __uint_as_float(g0.z << 16); gz[5] = __uint_as_float(g0.z & 0xffff0000u); gz[6] = __uint_as_float(g0.w << 16); gz[7] = __uint_as_float(g0.w & 0xffff0000u);
      gz[8] = __uint_as_float(g1.x << 16); gz[9] = __uint_as_float(g1.x & 0xffff0000u); gz[10] = __uint_as_float(g1.y << 16); gz[11] = __uint_as_float(g1.y & 0xffff0000u);
      gz[12] = __uint_as_float(g1.z << 16); gz[13] = __uint_as_float(g1.z & 0xffff0000u); gz[14] = __uint_as_float(g1.w << 16); gz[15] = __uint_as_float(g1.w & 0xffff0000u);
      float o[16];
#pragma unroll
      for (int k = 0; k < 16; ++k) o[k] = v[k] * rstd * ((const float*)p.g_hg)[sub * 16 + k] * (gz[k] * sigmoidf_(gz[k]));
      v4u w0, w1; w0.x = pk2(o[0], o[1]); w0.y = pk2(o[2], o[3]); w0.z = pk2(o[4], o[5]); w0.w = pk2(o[6], o[7]); w1.x = pk2(o[8], o[9]); w1.y = pk2(o[10], o[11]); w1.z = pk2(o[12], o[13]); w1.w = pk2(o[14], o[15]);
      bf16* orow = WSP(bf16, WS_OCAT) + (row0 + t) * DM + h * 128 + sub * 16;
      *(v4u*)orow = w0; *(v4u*)(orow + 8) = w1; }
    __syncthreads();
}
__device__ __forceinline__ float max4x(float v) { v = fmaxf(v, __shfl_xor(v, 16)); return fmaxf(v, __shfl_xor(v, 32)); }
__device__ __forceinline__ float sum4x(float v) { v += __shfl_xor(v, 16); return v + __shfl_xor(v, 32); }
__device__ __forceinline__ bf16x8 pack_p(const f32x4 a, const f32x4 b) {
    v4u w; w.x = pk2(a.x, a.y); w.y = pk2(a.z, a.w); w.z = pk2(b.x, b.y); w.w = pk2(b.z, b.w); return __builtin_bit_cast(bf16x8, w); }
__device__ __forceinline__ bf16x8 ld_vt2(const bf16* p0, const bf16* p1) { const v2u a = *(const v2u*)p0, b = *(const v2u*)p1; v4u w; w.x = a.x; w.y = a.y; w.z = b.x; w.w = b.y; return __builtin_bit_cast(bf16x8, w); }
struct DilRegs { v4u kv[4], vv[4]; bf16x8 q0, q1; };
__device__ __forceinline__ void dil_decode(int item, int& b, int& head, int& r, int& Ls, int& cres, int& i0) {
    const int blk = item & 31, bh = item >> 5; b = bh / 12; head = bh % 12; const int g = head >> 2;
    r = (g == 0) ? 1 : (g == 1 ? 4 : 16); Ls = SEQ / r; const int nblk = Ls / 128; cres = blk / nblk; i0 = (blk % nblk) * 128;
}
__device__ __forceinline__ void dil_load(const P& p, int item, DilRegs& R) {
    const int tid = tidx(), lane = tid & 63, wave = tid >> 6, fr = lane & 15, h = lane >> 4;
    int b, head, r, Ls, cres, i0; dil_decode(item, b, head, r, Ls, cres, i0);
    const bf16* proj = WSP(const bf16, WS_PROJ) + (size_t)(b * SEQ) * NIN;
#pragma unroll
    for (int k = 0; k < 4; ++k) { const int idx = tid + 512 * k, row = idx >> 3, ch = idx & 7; const int j = i0 - 64 + row;
        v4u kv = {0u, 0u, 0u, 0u}, vv = {0u, 0u, 0u, 0u};
        if (j >= 0 && j < Ls) { const size_t tok = (size_t)(cres + r * j); kv = *(const v4u*)(proj + tok * NIN + C_DK + head * 64 + ch * 8); vv = *(const v4u*)(proj + tok * NIN + C_DV + head * 64 + ch * 8); }
        R.kv[k] = kv; R.vv[k] = vv; }
    const bf16* qp = proj + (size_t)(cres + r * (i0 + 16 * wave + fr)) * NIN + C_DQ + head * 64 + 8 * h;
    R.q0 = *(const bf16x8*)qp; R.q1 = *(const bf16x8*)(qp + 32);
}
__device__ __forceinline__ void dil_item(const P& p, unsigned char* lds, int item, const DilRegs& R) {
    const int tid = tidx(), lane = tid & 63, wave = tid >> 6, fr = lane & 15, h = lane >> 4;
    int b, head, r, Ls, cres, i0; dil_decode(item, b, head, r, Ls, cres, i0);
    bf16* Ks = (bf16*)lds;
    bf16* VT = (bf16*)(lds + 36864);
#pragma unroll
    for (int k = 0; k < 4; ++k) { const int idx = tid + 512 * k, row = idx >> 3, ch = idx & 7; const v4u kv = R.kv[k], vv = R.vv[k];
        *(v4u*)(Ks + row * 72 + ch * 8) = kv;
        bf16* vt = VT + (ch * 8) * 280 + row;
        vt[0] = (bf16)(vv.x & 0xffff); vt[280] = (bf16)(vv.x >> 16); vt[560] = (bf16)(vv.y & 0xffff); vt[840] = (bf16)(vv.y >> 16);
        vt[1120] = (bf16)(vv.z & 0xffff); vt[1400] = (bf16)(vv.z >> 16); vt[1680] = (bf16)(vv.w & 0xffff); vt[1960] = (bf16)(vv.w >> 16); }
    { const int d = tid >> 3, c2 = (tid & 7) * 2; *(unsigned*)(VT + d * 280 + 256 + c2) = 0u; }
    __syncthreads();
    const int iq = i0 + 16 * wave + fr;
    const bf16x8 q0 = R.q0, q1 = R.q1;
    f32x4 sc[10];
#pragma unroll
    for (int j = 0; j < 9; ++j) { const bf16* kr = Ks + (16 * (wave + j) + fr) * 72 + 8 * h;
        f32x4 s4 = {0.f, 0.f, 0.f, 0.f}; s4 = mfma16(*(const bf16x8*)kr, q0, s4); sc[j] = mfma16(*(const bf16x8*)(kr + 32), q1, s4);
        if (j % 3 == 2) asm volatile("" ::: "memory"); }
    const float slope = exp2f(-8.0f * (float)(head + 1) / 12.0f) * (float)r;
    float m = -3.0e38f;
#pragma unroll
    for (int j = 0; j < 9; ++j)
#pragma unroll
        for (int e = 0; e < 4; ++e) { const int dj = -64 + 16 * j + 4 * h + e - fr, jk = iq + dj, adj = dj < 0 ? -dj : dj;
            const bool ok = (adj <= 64) && (jk >= 0) && (jk < Ls);
            sc[j][e] = ok ? sc[j][e] * 0.125f - slope * (float)adj : -1.0e30f; m = fmaxf(m, sc[j][e]); }
    m = max4x(m); float l = 0.f;
#pragma unroll
    for (int j = 0; j < 9; ++j)
#pragma unroll
        for (int e = 0; e < 4; ++e) { const float pe = sc[j][e] > -1.0e29f ? __expf(sc[j][e] - m) : 0.f; sc[j][e] = pe; l += pe; }
    l = sum4x(l); const float inv = 1.0f / l;
#pragma unroll
    for (int j = 0; j < 9; ++j) sc[j] = sc[j] * inv;
    sc[9] = (f32x4){0.f, 0.f, 0.f, 0.f};
    if (h == 0) WSP(float, WS_LSE)[(size_t)(b * 12 + head) * SEQ + cres + r * iq] = m + __logf(l);
    f32x4 o[4];
#pragma unroll
    for (int dt = 0; dt < 4; ++dt) o[dt] = (f32x4){0.f, 0.f, 0.f, 0.f};
#pragma unroll
    for (int ks = 0; ks < 5; ++ks) { const bf16x8 pa = pack_p(sc[2 * ks], sc[2 * ks + 1]);
        const bf16* v0 = VT + fr * 280 + 16 * (wave + 2 * ks) + 4 * h;
#pragma unroll
        for (int dt = 0; dt < 4; ++dt) o[dt] = mfma16(ld_vt2(v0 + dt * 16 * 280, v0 + dt * 16 * 280 + 16), pa, o[dt]);
        asm volatile("" ::: "memory"); }
    { const size_t tok = (size_t)(b * SEQ + cres + r * iq);
      bf16* orow = WSP(bf16, WS_OCAT) + tok * DM + 768 + head * 64 + 4 * h;
#pragma unroll
      for (int dt = 0; dt < 4; ++dt) { v2u w; w.x = pk2(o[dt][0], o[dt][1]); w.y = pk2(o[dt][2], o[dt][3]); *(v2u*)(orow + dt * 16) = w; } }
    __syncthreads();
}

__device__ __forceinline__ void mem_item(const P& p, unsigned char* lds, int item) {
    const int tid = tidx(), lane = tid & 63, wave = tid >> 6, fr = lane & 15, h = lane >> 4;
    const int blk = item & 31, bh = item >> 5, b = bh >> 2, head = bh & 3;
    const size_t row0 = (size_t)(b * SEQ + blk * 128);
    const bf16* qp = WSP(const bf16, WS_PROJ) + (row0 + 16 * wave + fr) * NIN + C_MQ + head * 128 + 8 * h;
    bf16x8 qf[4];
#pragma unroll
    for (int kk = 0; kk < 4; ++kk) qf[kk] = *(const bf16x8*)(qp + 32 * kk);
    bf16* Ks = (bf16*)lds;
    bf16* VT = (bf16*)(lds + 69632);
#pragma unroll
    for (int k = 0; k < 8; ++k) { const int idx = tid + 512 * k;
        { const int row = idx >> 4, ch = idx & 15; *(v4u*)(Ks + row * 136 + ch * 8) = *(const v4u*)(WSP(const bf16, WS_KVM) + (size_t)(b * MEML + row) * 1024 + head * 128 + ch * 8); }
        { const int d = idx >> 5, ch = idx & 31; *(v4u*)(VT + d * 264 + ch * 8) = *(const v4u*)(WSP(const bf16, WS_KVMT) + (size_t)(512 + head * 128 + d) * 512 + b * MEML + ch * 8); } }
    __syncthreads();
    f32x4 sc[16]; float m = -3.0e38f;
#pragma unroll
    for (int j = 0; j < 16; ++j) { const bf16* kr = Ks + (16 * j + fr) * 136 + 8 * h; f32x4 s4 = {0.f, 0.f, 0.f, 0.f};
#pragma unroll
        for (int kk = 0; kk < 4; ++kk) s4 = mfma16(*(const bf16x8*)(kr + 32 * kk), qf[kk], s4);
        sc[j] = s4 * 0.08838834764831845f; m = fmaxf(fmaxf(m, fmaxf(sc[j][0], sc[j][1])), fmaxf(sc[j][2], sc[j][3]));
        if ((j & 1) == 1) asm volatile("" ::: "memory"); }
    m = max4x(m); float l = 0.f;
#pragma unroll
    for (int j = 0; j < 16; ++j)
#pragma unroll
        for (int e = 0; e < 4; ++e) { sc[j][e] = __expf(sc[j][e] - m); l += sc[j][e]; }
    l = sum4x(l); const float inv = 1.0f / l;
    f32x4 o[8];
#pragma unroll
    for (int dt = 0; dt < 8; ++dt) o[dt] = (f32x4){0.f, 0.f, 0.f, 0.f};
#pragma unroll
    for (int ks = 0; ks < 8; ++ks) { const bf16x8 pa = pack_p(sc[2 * ks] * inv, sc[2 * ks + 1] * inv);
        const bf16* v0 = VT + fr * 264 + 32 * ks + 4 * h;
#pragma unroll
        for (int dt = 0; dt < 8; ++dt) o[dt] = mfma16(ld_vt2(v0 + dt * 16 * 264, v0 + dt * 16 * 264 + 16), pa, o[dt]);
        asm volatile("" ::: "memory"); }
    { bf16* orow = WSP(bf16, WS_OCAT) + (row0 + 16 * wave + fr) * DM + 1536 + head * 128 + 4 * h;
#pragma unroll
      for (int dt = 0; dt < 8; ++dt) { v2u w; w.x = pk2(o[dt][0], o[dt][1]); w.y = pk2(o[dt][2], o[dt][3]); *(v2u*)(orow + dt * 16) = w; } }
    __syncthreads();
}

__device__ __forceinline__ void dil_alpha_rows(const P& p, int vcu, int G) {
    const int gt = vcu * NTHR + tidx(), NGT = G * NTHR;
    constexpr int NTASK = T * 96;
    for (int id0 = gt; id0 < NTASK; id0 += 6 * NGT) {
        float l0[6], l1[6], l2[6]; v4u v[6]; int g6[6];
#pragma unroll
        for (int k = 0; k < 6; ++k) { const int id = id0 + k * NGT; g6[k] = -1;
            if (id < NTASK) { const int t = id / 96, ch = id - t * 96, head = ch >> 3, j = head & 3, b = t / SEQ, s = t - b * SEQ; g6[k] = head >> 2;
                const float* L = WSP(const float, WS_LSE) + (size_t)(b * 12 + j) * SEQ + s; l0[k] = L[0]; l1[k] = L[4 * SEQ]; l2[k] = L[8 * SEQ];
                v[k] = *(const v4u*)(WSP(const bf16, WS_OCAT) + (size_t)t * DM + 768 + ch * 8); } }
#pragma unroll
        for (int k = 0; k < 6; ++k) if (g6[k] >= 0) { const int id = id0 + k * NGT, t = id / 96, ch = id - t * 96;
            const float m = fmaxf(l0[k], fmaxf(l1[k], l2[k])), e0 = __expf(l0[k] - m), e1 = __expf(l1[k] - m), e2 = __expf(l2[k] - m);
            const float al = (g6[k] == 0 ? e0 : (g6[k] == 1 ? e1 : e2)) / (e0 + e1 + e2); v4u w = v[k];
            w.x = pk2(__uint_as_float(w.x << 16) * al, __uint_as_float(w.x & 0xffff0000u) * al); w.y = pk2(__uint_as_float(w.y << 16) * al, __uint_as_float(w.y & 0xffff0000u) * al);
            w.z = pk2(__uint_as_float(w.z << 16) * al, __uint_as_float(w.z & 0xffff0000u) * al); w.w = pk2(__uint_as_float(w.w << 16) * al, __uint_as_float(w.w & 0xffff0000u) * al);
            *(v4u*)(WSP(bf16, WS_OCAT) + (size_t)t * DM + 768 + ch * 8) = w; }
    }
}
__device__ __forceinline__ unsigned okey(float f) { const unsigned u = __float_as_uint(f); return u ^ ((unsigned)((int)u >> 31) | 0x80000000u); }
__device__ __forceinline__ float unkey(unsigned k) { const unsigned u = (k & 0x80000000u) ? (k ^ 0x80000000u) : ~k; return __uint_as_float(u); }
__device__ __forceinline__ unsigned umax_(unsigned a, unsigned b) { return a > b ? a : b; }
__device__ __forceinline__ unsigned umin_(unsigned a, unsigned b) { return a < b ? a : b; }
template <int CTRL> __device__ __forceinline__ unsigned dppu(unsigned v) { return (unsigned)__builtin_amdgcn_update_dpp(0, (int)v, CTRL, 0xf, 0xf, true); }
__device__ __forceinline__ void topk_rows(const P& p, int vcu, int G) {
    const int gt = vcu * NTHR + tidx(), NGT = G * NTHR;
    for (int gid = gt; gid < T * 16; gid += NGT) {
        const int row = gid >> 1, half = gid & 1, t = row >> 3, h = row & 7;
        const float* sc = WSP(const float, WS_SC) + (size_t)row * 256 + half * 128;
        unsigned v[16];
#pragma unroll
        for (int i = 0; i < 16; ++i) v[i] = 0u;
        for (int n4 = 0; n4 < 32; ++n4) { const f32x4 q = *(const f32x4*)(sc + n4 * 4);
#pragma unroll
            for (int e = 0; e < 4; ++e) { unsigned x = (okey(q[e]) & 0xffffff80u) | (unsigned)(127 - (n4 * 4 + e));
#pragma unroll
                for (int i = 0; i < 16; ++i) { const unsigned hi = umax_(v[i], x); x = umin_(v[i], x); v[i] = hi; } } }
        float s0[16], s1[16]; unsigned long long p0lo = 0ull, p0hi = 0ull, p1lo = 0ull, p1hi = 0ull;
#pragma unroll
        for (int i = 0; i < 16; ++i) { const unsigned o = dppu<0xB1>(v[i]); const unsigned k0 = half ? o : v[i], k1 = half ? v[i] : o;
            s0[i] = unkey(k0 & 0xffffff80u); s1[i] = unkey(k1 & 0xffffff80u);
            const unsigned long long a0 = (unsigned long long)(127u - (k0 & 127u)) << (8 * (i & 7)), a1 = (unsigned long long)(127u - (k1 & 127u)) << (8 * (i & 7));
            if (i < 8) { p0lo |= a0; p1lo |= a1; } else { p0hi |= a0; p1hi |= a1; } }
        unsigned bk[16];
#pragma unroll
        for (int k = 0; k < 16; ++k) bk[k] = 0u;
#pragma unroll
        for (int i = 0; i < 16; ++i)
#pragma unroll
            for (int j = 0; j < 16; ++j) if ((i + 1) * (j + 1) <= 16) {
                unsigned x = (okey(s0[i] + s1[j]) & 0xffffff00u) | (unsigned)(255 - (i * 16 + j));
#pragma unroll
                for (int k = 0; k < 16; ++k) { const unsigned hi = umax_(bk[k], x); x = umin_(bk[k], x); bk[k] = hi; } }
        const float rstd = row_rstd(WSP(const float, WS_RSP), t);
        const float m = unkey(bk[0] & 0xffffff00u) * rstd; float l = 0.f; float ev[16];
#pragma unroll
        for (int k = 0; k < 16; ++k) { ev[k] = __expf(unkey(bk[k] & 0xffffff00u) * rstd - m); l += ev[k]; }
        const float inv = 1.0f / l;
        int be[16];
#pragma unroll
        for (int k = 0; k < 16; ++k) { const int code = 255 - (int)(bk[k] & 255u), ci = code >> 4, cj = code & 15;
            const int a = (int)(((ci & 8) ? p0hi : p0lo) >> (8 * (ci & 7))) & 0xff, c = (int)(((cj & 8) ? p1hi : p1lo) >> (8 * (cj & 7))) & 0xff;
            be[k] = a * 128 + c; }
        int* io = WSP(int, WS_IDX) + (size_t)t * 128 + h * 16; float* go = WSP(float, WS_GATE) + (size_t)t * 128 + h * 16;
        if (half == 0) {
            *(int4*)io = make_int4(be[0], be[1], be[2], be[3]); *(int4*)(io + 4) = make_int4(be[4], be[5], be[6], be[7]);
            *(f32x4*)go = (f32x4){ev[0] * inv, ev[1] * inv, ev[2] * inv, ev[3] * inv}; *(f32x4*)(go + 4) = (f32x4){ev[4] * inv, ev[5] * inv, ev[6] * inv, ev[7] * inv};
        } else {
            *(int4*)(io + 8) = make_int4(be[8], be[9], be[10], be[11]); *(int4*)(io + 12) = make_int4(be[12], be[13], be[14], be[15]);
            *(f32x4*)(go + 8) = (f32x4){ev[8] * inv, ev[9] * inv, ev[10] * inv, ev[11] * inv}; *(f32x4*)(go + 12) = (f32x4){ev[12] * inv, ev[13] * inv, ev[14] * inv, ev[15] * inv};
        }
    }
}

__device__ __forceinline__ void unpack8(const v4u w, float* f) {
    f[0] = __uint_as_float(w.x << 16); f[1] = __uint_as_float(w.x & 0xffff0000u); f[2] = __uint_as_float(w.y << 16); f[3] = __uint_as_float(w.y & 0xffff0000u);
    f[4] = __uint_as_float(w.z << 16); f[5] = __uint_as_float(w.z & 0xffff0000u); f[6] = __uint_as_float(w.w << 16); f[7] = __uint_as_float(w.w & 0xffff0000u);
}
template <int CTRL> __device__ __forceinline__ float dpp_f(float v) { return __builtin_bit_cast(float, __builtin_amdgcn_update_dpp(0, __builtin_bit_cast(int, v), CTRL, 0xf, 0xf, true)); }
__device__ __forceinline__ float row16_sum(float v) {
    v += dpp_f<0xB1>(v); v += dpp_f<0x4E>(v); v += dpp_f<0x141>(v); v += dpp_f<0x140>(v); return v;
}
__device__ __forceinline__ float swap32_add(float x, float y) {
    auto r = __builtin_amdgcn_permlane32_swap(__float_as_uint(x), __float_as_uint(y), false, false); return __uint_as_float(r[0]) + __uint_as_float(r[1]); }
__device__ __forceinline__ float swap16_add(float x, float y) {
    auto r = __builtin_amdgcn_permlane16_swap(__float_as_uint(x), __float_as_uint(y), false, false); return __uint_as_float(r[0]) + __uint_as_float(r[1]); }
__device__ __forceinline__ float reduce4(float d0, float d1, float d2, float d3) { return row16_sum(swap16_add(swap32_add(d0, d2), swap32_add(d1, d3))); }
__device__ __forceinline__ float rl_f(float v, int l) { return __builtin_bit_cast(float, __builtin_amdgcn_readlane(__builtin_bit_cast(int, v), l)); }
__device__ __forceinline__ float wave_sum_dpp(float v) { const float r = row16_sum(v); return (rl_f(r, 0) + rl_f(r, 16)) + (rl_f(r, 32) + rl_f(r, 48)); }
__device__ __forceinline__ int sdot4(unsigned a, unsigned b, int c) { return __builtin_amdgcn_sdot4((int)a, (int)b, c, false); }
__device__ __forceinline__ unsigned q8(float v, float inv) { return (unsigned)((int)rintf(v * inv)) & 0xffu; }
#ifndef PEER_PB
#define PEER_PB 8
#endif
constexpr int PB = PEER_PB;
__device__ __forceinline__ void peer_rows(const P& p, int vcu, int G, float* dst) {
    const int lane = tidx() & 63, gw = vcu * NWAVES + (tidx() >> 6), NGW = G * NWAVES;
    const v4u* U = WSP(const v4u, WS_UQ); const v4u* V = WSP(const v4u, WS_VQ);
    for (int t = gw; t < T; t += NGW) {
        unsigned xq[8]; float sx;
        { const v4u* xp = WSP(const v4u, WS_XG) + (size_t)t * 256 + lane * 2; float f[32];
          unpack8(xp[0], f); unpack8(xp[1], f + 8); unpack8(xp[128], f + 16); unpack8(xp[129], f + 24);
          float m = 0.f;
#pragma unroll
          for (int i = 0; i < 32; ++i) m = fmaxf(m, fabsf(f[i]));
          m = wave_max(m); m = fmaxf(m, 1e-30f); sx = m * (1.f / 127.f); const float inv = 127.f / m;
#pragma unroll
          for (int i = 0; i < 8; ++i) xq[i] = q8(f[4 * i], inv) | (q8(f[4 * i + 1], inv) << 8) | (q8(f[4 * i + 2], inv) << 16) | (q8(f[4 * i + 3], inv) << 24); }
        const int ia = WSP(const int, WS_IDX)[(size_t)t * 128 + lane], ib = WSP(const int, WS_IDX)[(size_t)t * 128 + 64 + lane];
        const float ascale = row_rstd(WSP(const float, WS_RSP), t) * sx;
        float aa = 0.f, ab = 0.f;
#pragma unroll 1
        for (int e0 = 0; e0 < 128; e0 += PB) {
            v4u w[PB][2];
#pragma unroll
            for (int j = 0; j < PB; ++j) { const int e = e0 + j; const int row = __builtin_amdgcn_readlane(e < 64 ? ia : ib, e & 63);
                const v4u* r = U + (size_t)row * 128 + lane; w[j][0] = r[0]; w[j][1] = r[64]; }
            float d[PB];
#pragma unroll
            for (int j = 0; j < PB; ++j) { int a0 = 0, a1 = 0;
                a0 = sdot4(w[j][0].x, xq[0], a0); a1 = sdot4(w[j][0].y, xq[1], a1); a0 = sdot4(w[j][0].z, xq[2], a0); a1 = sdot4(w[j][0].w, xq[3], a1);
                a0 = sdot4(w[j][1].x, xq[4], a0); a1 = sdot4(w[j][1].y, xq[5], a1); a0 = sdot4(w[j][1].z, xq[6], a0); a1 = sdot4(w[j][1].w, xq[7], a1);
                d[j] = (float)(a0 + a1); }
#pragma unroll
            for (int j4 = 0; j4 < PB; j4 += 4) { const float r0 = reduce4(d[j4], d[j4 + 1], d[j4 + 2], d[j4 + 3]);
#pragma unroll
                for (int j = 0; j < 4; ++j) { const int e = e0 + j4 + j; const float v = rl_f(r0, 16 * j);
                    if (lane == (e & 63)) { if (e < 64) aa = v; else ab = v; } } }
        }
        float ha, hb;
        { const float* SU = WSP(const float, WS_SU); const float* SV = WSP(const float, WS_SV);
          const float ga = WSP(const float, WS_GATE)[(size_t)t * 128 + lane], gb = WSP(const float, WS_GATE)[(size_t)t * 128 + 64 + lane];
          aa *= ascale * SU[ia]; ab *= ascale * SU[ib];
          ha = 0.5f * aa * (1.0f + erff(aa * 0.70710678118f)) * ga * SV[ia]; hb = 0.5f * ab * (1.0f + erff(ab * 0.70710678118f)) * gb * SV[ib]; }
        float acc[32]; float csum = 0.f;
#pragma unroll
        for (int i = 0; i < 32; ++i) acc[i] = 0.f;
#pragma unroll 1
        for (int e0 = 0; e0 < 128; e0 += PB) {
            v4u w[PB][2];
#pragma unroll
            for (int j = 0; j < PB; ++j) { const int e = e0 + j; const int row = __builtin_amdgcn_readlane(e < 64 ? ia : ib, e & 63);
                const v4u* r = V + (size_t)row * 128 + lane; w[j][0] = r[0]; w[j][1] = r[64]; }
#pragma unroll
            for (int j = 0; j < PB; ++j) { const int e = e0 + j; const float h = rl_f(e < 64 ? ha : hb, e & 63); csum += h;
#pragma unroll
                for (int i = 0; i < 2; ++i) { const unsigned x0 = w[j][i].x, x1 = w[j][i].y, x2 = w[j][i].z, x3 = w[j][i].w;
                    acc[16 * i + 0] = fmaf(h, (float)(x0 & 0xffu), acc[16 * i + 0]); acc[16 * i + 1] = fmaf(h, (float)((x0 >> 8) & 0xffu), acc[16 * i + 1]);
                    acc[16 * i + 2] = fmaf(h, (float)((x0 >> 16) & 0xffu), acc[16 * i + 2]); acc[16 * i + 3] = fmaf(h, (float)(x0 >> 24), acc[16 * i + 3]);
                    acc[16 * i + 4] = fmaf(h, (float)(x1 & 0xffu), acc[16 * i + 4]); acc[16 * i + 5] = fmaf(h, (float)((x1 >> 8) & 0xffu), acc[16 * i + 5]);
                    acc[16 * i + 6] = fmaf(h, (float)((x1 >> 16) & 0xffu), acc[16 * i + 6]); acc[16 * i + 7] = fmaf(h, (float)(x1 >> 24), acc[16 * i + 7]);
                    acc[16 * i + 8] = fmaf(h, (float)(x2 & 0xffu), acc[16 * i + 8]); acc[16 * i + 9] = fmaf(h, (float)((x2 >> 8) & 0xffu), acc[16 * i + 9]);
                    acc[16 * i + 10] = fmaf(h, (float)((x2 >> 16) & 0xffu), acc[16 * i + 10]); acc[16 * i + 11] = fmaf(h, (float)(x2 >> 24), acc[16 * i + 11]);
                    acc[16 * i + 12] = fmaf(h, (float)(x3 & 0xffu), acc[16 * i + 12]); acc[16 * i + 13] = fmaf(h, (float)((x3 >> 8) & 0xffu), acc[16 * i + 13]);
                    acc[16 * i + 14] = fmaf(h, (float)((x3 >> 16) & 0xffu), acc[16 * i + 14]); acc[16 * i + 15] = fmaf(h, (float)(x3 >> 24), acc[16 * i + 15]); } }
        }
        const float* orow = ((float*)p.out) + (size_t)t * DM; float* drow = dst + (size_t)t * DM; float ss = 0.f; const float coff = 128.f * csum;
#pragma unroll
        for (int i = 0; i < 2; ++i)
#pragma unroll
            for (int k = 0; k < 4; ++k) { const f32x4 a = *(const f32x4*)(orow + i * 1024 + lane * 16 + 4 * k);
                float* c = acc + 16 * i + 4 * k; c[0] += a.x - coff; c[1] += a.y - coff; c[2] += a.z - coff; c[3] += a.w - coff;
                ss += (c[0] * c[0] + c[1] * c[1]) + (c[2] * c[2] + c[3] * c[3]); }
        const float r2 = rsqrtf(wave_sum_dpp(ss) * (1.f / DM) + EPS);
#pragma unroll
        for (int i = 0; i < 2; ++i)
#pragma unroll
            for (int k = 0; k < 4; ++k) { const f32x4 g = *(const f32x4*)(((const float*)p.g_final) + i * 1024 + lane * 16 + 4 * k); const float* c = acc + 16 * i + 4 * k;
                *(f32x4*)(drow + i * 1024 + lane * 16 + 4 * k) = (f32x4){c[0] * r2 * g.x, c[1] * r2 * g.y, c[2] * r2 * g.z, c[3] * r2 * g.w}; }
    }
}

struct PeerMap { int rho, nx, r, nloc, bal; };
__device__ __forceinline__ PeerMap peer_map(const XcdBarrier& b, volatile LAS unsigned* MISC) {
    if (tidx() == 0) {
        unsigned rho = 0, nx = 1, nloc = 1;
        xcd_barrier_complete(b.bar, b.x, nloc, nx);
        for (unsigned j = 0; j < b.x; ++j) if (xb_ld(&b.bar[XB_XCNT(j)])) ++rho;
        const unsigned r = xb_add(&b.bar[4096 + 64 * b.x], 1u);
        unsigned bal = 1u; for (unsigned j = 0; j < 16; ++j) { const unsigned c = xb_ld(&b.bar[XB_XCNT(j)]); if (c != 0u && c != nloc) bal = 0u; }
        if (nx * nloc != gridDim.x) bal = 0u;
        MISC[4] = rho; MISC[5] = nx; MISC[6] = r % nloc; MISC[7] = nloc; MISC[10] = bal;
    }
    __syncthreads();
    PeerMap m; m.rho = __builtin_amdgcn_readfirstlane((int)MISC[4]); m.nx = __builtin_amdgcn_readfirstlane((int)MISC[5]); m.r = __builtin_amdgcn_readfirstlane((int)MISC[6]);
    m.nloc = __builtin_amdgcn_readfirstlane((int)MISC[7]); m.bal = __builtin_amdgcn_readfirstlane((int)MISC[10]);
    return m;
}
__device__ __forceinline__ void xq_rows(const P& p, int vcu, int G) {
    const int lane = tidx() & 63, gw = vcu * NWAVES + (tidx() >> 6), NGW = G * NWAVES;
    for (int t = gw; t < T; t += NGW) {
        const v4u* xp = WSP(const v4u, WS_XG) + (size_t)t * 256 + lane * 4; float f[32];
        unpack8(xp[0], f); unpack8(xp[1], f + 8); unpack8(xp[2], f + 16); unpack8(xp[3], f + 24);
        float m = 0.f;
#pragma unroll
        for (int i = 0; i < 32; ++i) m = fmaxf(m, fabsf(f[i]));
        m = fmaxf(wave_max(m), 1e-30f); const float inv = 127.f / m;
        v4u o0, o1;
        o0.x = q8(f[0], inv) | (q8(f[1], inv) << 8) | (q8(f[2], inv) << 16) | (q8(f[3], inv) << 24); o0.y = q8(f[4], inv) | (q8(f[5], inv) << 8) | (q8(f[6], inv) << 16) | (q8(f[7], inv) << 24);
        o0.z = q8(f[8], inv) | (q8(f[9], inv) << 8) | (q8(f[10], inv) << 16) | (q8(f[11], inv) << 24); o0.w = q8(f[12], inv) | (q8(f[13], inv) << 8) | (q8(f[14], inv) << 16) | (q8(f[15], inv) << 24);
        o1.x = q8(f[16], inv) | (q8(f[17], inv) << 8) | (q8(f[18], inv) << 16) | (q8(f[19], inv) << 24); o1.y = q8(f[20], inv) | (q8(f[21], inv) << 8) | (q8(f[22], inv) << 16) | (q8(f[23], inv) << 24);
        o1.z = q8(f[24], inv) | (q8(f[25], inv) << 8) | (q8(f[26], inv) << 16) | (q8(f[27], inv) << 24); o1.w = q8(f[28], inv) | (q8(f[29], inv) << 8) | (q8(f[30], inv) << 16) | (q8(f[31], inv) << 24);
        v4u* xo = WSP(v4u, WS_XQ) + (size_t)t * 128 + lane * 2; xo[0] = o0; xo[1] = o1;
        if (lane == 0) WSP(float, WS_SX)[t] = m * (1.f / 127.f);
    }
}
__device__ __forceinline__ void peer_u_sliced(const P& p, const PeerMap& mp) {
    const int lane = tidx() & 63, wave = tidx() >> 6, g = lane >> 4, l = lane & 15;
    const int w0 = mp.r * NWAVES + wave, NW = mp.nloc * NWAVES;
    for (int s = mp.rho; s < 8; s += mp.nx) {
        const unsigned char* ub = (const unsigned char*)(p.ws + WS_UQ) + s * 256 + l * 16;
        float* pa = WSP(float, WS_PA) + (size_t)s * T * 128;
        for (int t = w0; t < T; t += NW) {
            const v4u xq = *(const v4u*)((const unsigned char*)(p.ws + WS_XQ) + (size_t)t * DM + s * 256 + l * 16);
            const int* ip = WSP(const int, WS_IDX) + (size_t)t * 128 + g;
            int idxv[32];
#pragma unroll
            for (int k = 0; k < 32; ++k) idxv[k] = ip[4 * k];
#pragma unroll
            for (int k0 = 0; k0 < 32; k0 += 16) {
                v4u w[16];
#pragma unroll
                for (int k = 0; k < 16; ++k) w[k] = *(const v4u*)(ub + (size_t)idxv[k0 + k] * DM);
#pragma unroll
                for (int k = 0; k < 16; ++k) { int a0 = sdot4(w[k].x, xq.x, 0), a1 = sdot4(w[k].y, xq.y, 0); a0 = sdot4(w[k].z, xq.z, a0); a1 = sdot4(w[k].w, xq.w, a1);
                    const float d = row16_sum((float)(a0 + a1));
                    if (l == 0) pa[(size_t)t * 128 + 4 * (k0 + k) + g] = d; }
            }
        }
    }
}
__device__ __forceinline__ unsigned permb(unsigned hi, unsigned lo, unsigned sel) { return __builtin_amdgcn_perm(hi, lo, sel); }
__device__ __forceinline__ void peer_v_sliced(const P& p, const PeerMap& mp, unsigned char* lds, float* ydst) {
    const int lane = tidx() & 63, wave = tidx() >> 6, g = lane >> 4, l = lane & 15;
    const int w0 = mp.r * NWAVES + wave, NW = mp.nloc * NWAVES;
    unsigned char* hl = lds + wave * 128;
    const float* SU = WSP(const float, WS_SU); const float* SV = WSP(const float, WS_SV); const float* PAb = WSP(const float, WS_PA);
    for (int s = mp.rho; s < 8; s += mp.nx) {
        const unsigned char* vb = (const unsigned char*)(p.ws + WS_VQ) + s * 256 + l * 16;
        for (int t = w0; t < T; t += NW) {
            const float ascale = row_rstd(WSP(const float, WS_RSP), t) * WSP(const float, WS_SX)[t];
            float sh;
            { const int ia = WSP(const int, WS_IDX)[(size_t)t * 128 + lane], ib = WSP(const int, WS_IDX)[(size_t)t * 128 + 64 + lane];
              float aa = 0.f, ab = 0.f;
#pragma unroll
              for (int q = 0; q < 8; ++q) { aa += PAb[((size_t)q * T + t) * 128 + lane]; ab += PAb[((size_t)q * T + t) * 128 + 64 + lane]; }
              aa *= ascale * SU[ia]; ab *= ascale * SU[ib];
              const float ha = 0.5f * aa * (1.0f + erff(aa * 0.70710678118f)) * WSP(const float, WS_GATE)[(size_t)t * 128 + lane] * SV[ia];
              const float hb = 0.5f * ab * (1.0f + erff(ab * 0.70710678118f)) * WSP(const float, WS_GATE)[(size_t)t * 128 + 64 + lane] * SV[ib];
              const float m = fmaxf(wave_max(fmaxf(fabsf(ha), fabsf(hb))), 1e-30f); sh = m * (1.f / 127.f); const float inv = 127.f / m;
              hl[(lane & 3) * 32 + (lane >> 2)] = (unsigned char)q8(ha, inv); hl[(lane & 3) * 32 + 16 + (lane >> 2)] = (unsigned char)q8(hb, inv); }
            const int* ip = WSP(const int, WS_IDX) + (size_t)t * 128 + g;
            int idxv[32];
#pragma unroll
            for (int k = 0; k < 32; ++k) idxv[k] = ip[4 * k];
            const v4u h0 = *(const v4u*)(hl + g * 32), h1 = *(const v4u*)(hl + g * 32 + 16);
            const unsigned hq[8] = {h0.x, h0.y, h0.z, h0.w, h1.x, h1.y, h1.z, h1.w};
            int acc[16];
#pragma unroll
            for (int j = 0; j < 16; ++j) acc[j] = 0;
#pragma unroll
            for (int k0 = 0; k0 < 32; k0 += 16) {
                v4u w[16];
#pragma unroll
                for (int k = 0; k < 16; ++k) w[k] = *(const v4u*)(vb + (size_t)idxv[k0 + k] * DM);
#pragma unroll
                for (int k4 = 0; k4 < 4; ++k4) { const unsigned hd = hq[(k0 >> 2) + k4];
#pragma unroll
                    for (int c4 = 0; c4 < 4; ++c4) {
                        const unsigned a = w[4 * k4][c4], b = w[4 * k4 + 1][c4], c = w[4 * k4 + 2][c4], d = w[4 * k4 + 3][c4];
                        const unsigned pq = permb(b, a, 0x05010400u), qq = permb(b, a, 0x07030602u), rq = permb(d, c, 0x05010400u), sq = permb(d, c, 0x07030602u);
                        acc[4 * c4 + 0] = sdot4(permb(rq, pq, 0x05040100u), hd, acc[4 * c4 + 0]); acc[4 * c4 + 1] = sdot4(permb(rq, pq, 0x07060302u), hd, acc[4 * c4 + 1]);
                        acc[4 * c4 + 2] = sdot4(permb(sq, qq, 0x05040100u), hd, acc[4 * c4 + 2]); acc[4 * c4 + 3] = sdot4(permb(sq, qq, 0x07060302u), hd, acc[4 * c4 + 3]); } }
            }
#pragma unroll
            for (int j = 0; j < 16; ++j) { acc[j] += __shfl_xor(acc[j], 16); acc[j] += __shfl_xor(acc[j], 32); }
            const size_t yo = (size_t)t * DM + s * 256 + l * 16 + 4 * g; const f32x4 x1v = *(const f32x4*)(((float*)p.out) + yo);
            f32x4 o;
            o.x = x1v.x + sh * (float)(g == 0 ? acc[0] : g == 1 ? acc[4] : g == 2 ? acc[8] : acc[12]);
            o.y = x1v.y + sh * (float)(g == 0 ? acc[1] : g == 1 ? acc[5] : g == 2 ? acc[9] : acc[13]);
            o.z = x1v.z + sh * (float)(g == 0 ? acc[2] : g == 1 ? acc[6] : g == 2 ? acc[10] : acc[14]);
            o.w = x1v.w + sh * (float)(g == 0 ? acc[3] : g == 1 ? acc[7] : g == 2 ? acc[11] : acc[15]);
            *(f32x4*)(ydst + yo) = o;
        }
    }
}
__device__ __forceinline__ void final_norm_rows(const P& p, int vcu, int G, float* dst) {
    const int lane = tidx() & 63, gw = vcu * NWAVES + (tidx() >> 6), NGW = G * NWAVES;
    for (int t = gw; t < T; t += NGW) {
        const f32x4* yr = (const f32x4*)(((float*)p.out) + (size_t)t * DM) + lane; const f32x4* gr = (const f32x4*)((const float*)p.g_final) + lane;
        f32x4 v[8]; float s = 0.f;
#pragma unroll
        for (int j = 0; j < 8; ++j) { v[j] = yr[64 * j]; s += (v[j].x * v[j].x + v[j].y * v[j].y) + (v[j].z * v[j].z + v[j].w * v[j].w); }
        const float rstd = rsqrtf(wave_sum(s) * (1.f / DM) + EPS);
        f32x4* o = (f32x4*)(dst + (size_t)t * DM) + lane;
#pragma unroll
        for (int j = 0; j < 8; ++j) o[64 * j] = v[j] * rstd * gr[64 * j];
    }
}

#define TK_CE(a, i, j) { const unsigned h_ = umax_(a[i], a[j]); a[j] = umin_(a[i], a[j]); a[i] = h_; }
__device__ __forceinline__ void sort16_desc(unsigned (&a)[16]) {
    TK_CE(a, 0, 13) TK_CE(a, 1, 12) TK_CE(a, 2, 15) TK_CE(a, 3, 14) TK_CE(a, 4, 8) TK_CE(a, 5, 6) TK_CE(a, 7, 11) TK_CE(a, 9, 10)
    TK_CE(a, 0, 5) TK_CE(a, 1, 7) TK_CE(a, 2, 9) TK_CE(a, 3, 4) TK_CE(a, 6, 13) TK_CE(a, 8, 14) TK_CE(a, 10, 15) TK_CE(a, 11, 12)
    TK_CE(a, 0, 1) TK_CE(a, 2, 3) TK_CE(a, 4, 5) TK_CE(a, 6, 8) TK_CE(a, 7, 9) TK_CE(a, 10, 11) TK_CE(a, 12, 13) TK_CE(a, 14, 15)
    TK_CE(a, 0, 2) TK_CE(a, 1, 3) TK_CE(a, 4, 10) TK_CE(a, 5, 11) TK_CE(a, 6, 7) TK_CE(a, 8, 9) TK_CE(a, 12, 14) TK_CE(a, 13, 15)
    TK_CE(a, 1, 2) TK_CE(a, 3, 12) TK_CE(a, 4, 6) TK_CE(a, 5, 7) TK_CE(a, 8, 10) TK_CE(a, 9, 11) TK_CE(a, 13, 14)
    TK_CE(a, 1, 4) TK_CE(a, 2, 6) TK_CE(a, 5, 8) TK_CE(a, 7, 10) TK_CE(a, 9, 13) TK_CE(a, 11, 14)
    TK_CE(a, 2, 4) TK_CE(a, 3, 6) TK_CE(a, 9, 12) TK_CE(a, 11, 13)
    TK_CE(a, 3, 5) TK_CE(a, 6, 8) TK_CE(a, 7, 9) TK_CE(a, 10, 12)
    TK_CE(a, 3, 4) TK_CE(a, 5, 6) TK_CE(a, 7, 8) TK_CE(a, 9, 10) TK_CE(a, 11, 12)
    TK_CE(a, 6, 7) TK_CE(a, 8, 9)
}
__device__ __forceinline__ void merge_top16(unsigned (&A)[16], const unsigned (&B)[16]) {
#pragma unroll
    for (int i = 0; i < 16; ++i) A[i] = umax_(A[i], B[15 - i]);
#pragma unroll
    for (int j = 8; j >= 1; j >>= 1)
#pragma unroll
        for (int i = 0; i < 16; ++i) if (!(i & j)) TK_CE(A, i, i + j)
}
__host__ __device__ constexpr int cand_index(int i, int j) {
    int n = 0;
    for (int a = 0; a < 16; ++a) for (int b = 0; b < 16; ++b) { if (a == i && b == j) return n; if ((a + 1) * (b + 1) <= 16) ++n; }
    return n;
}
struct EpiRoute {
    static constexpr bool PERM = true, AFTER_DRAIN = true, MIDK = false;
    const bf16* skp; const float* rsp; int* idx; float* gate;
    __device__ __forceinline__ void fused(pg8::f32x4 (&acc)[2][2][4][2], const pg8::Unit& u, int wr, int wc, int fr, int fq, PG8_LAS unsigned char* lds, int wid, int lane) const {
#pragma unroll
        for (int ai = 0; ai < 2; ++ai)
#pragma unroll
            for (int m = 0; m < 4; ++m) { const int row = ai * 128 + wr * 64 + m * 16 + fr;
#pragma unroll
                for (int bj = 0; bj < 2; ++bj) { const int col = bj * 128 + wc * 32 + 8 * fq; const pg8::f32x4 v0 = acc[ai][bj][m][0], v1 = acc[ai][bj][m][1];
                    pg8::u32x4 w; w.x = pg8::cvt_pk_bf16(v0[0], v0[1]); w.y = pg8::cvt_pk_bf16(v0[2], v0[3]); w.z = pg8::cvt_pk_bf16(v1[0], v1[1]); w.w = pg8::cvt_pk_bf16(v1[2], v1[3]);
                    *(PG8_LAS pg8::u32x4*)(lds + row * 528 + col * 2) = w; } }
        asm volatile("s_waitcnt lgkmcnt(0)" ::: "memory"); __builtin_amdgcn_s_barrier(); asm volatile("" ::: "memory");
        const int tk = lane & 31, hi = lane >> 5, trow = 32 * wid + tk;
        unsigned vv[2][16];
#pragma unroll
        for (int ph = 0; ph < 2; ++ph) {
            bf16x8 bq[8];
#pragma unroll
            for (int ks = 0; ks < 8; ++ks) bq[ks] = *(const PG8_LAS bf16x8*)(lds + trow * 528 + (ph * 128 + 16 * ks + 8 * hi) * 2);
#pragma unroll
            for (int nt = 0; nt < 4; ++nt) { f32x16 sc = zero16(); const bf16* ap = skp + (size_t)(ph * 128 + 32 * nt + tk) * 128 + 8 * hi;
#pragma unroll
                for (int ks = 0; ks < 8; ++ks) sc = mfma32(*(const bf16x8*)(ap + 16 * ks), bq[ks], sc);
                unsigned x[16];
#pragma unroll
                for (int r = 0; r < 16; ++r) x[r] = (okey(sc[r]) & 0xffffff80u) | (unsigned)(127 - (32 * nt + (r & 3) + 8 * (r >> 2) + 4 * hi));
                sort16_desc(x);
                if (nt == 0) {
#pragma unroll
                    for (int i = 0; i < 16; ++i) vv[ph][i] = x[i]; }
                else merge_top16(vv[ph], x); }
            unsigned ot[16];
#pragma unroll
            for (int i = 0; i < 16; ++i) ot[i] = (unsigned)__shfl_xor((int)vv[ph][i], 32);
            merge_top16(vv[ph], ot);
        }
        float s0[16], s1[16]; unsigned long long p0lo = 0ull, p0hi = 0ull, p1lo = 0ull, p1hi = 0ull;
#pragma unroll
        for (int i = 0; i < 16; ++i) { const unsigned k0 = vv[0][i], k1 = vv[1][i];
            s0[i] = unkey(k0 & 0xffffff80u); s1[i] = unkey(k1 & 0xffffff80u);
            const unsigned long long a0 = (unsigned long long)(127u - (k0 & 127u)) << (8 * (i & 7)), a1 = (unsigned long long)(127u - (k1 & 127u)) << (8 * (i & 7));
            if (i < 8) { p0lo |= a0; p1lo |= a1; } else { p0hi |= a0; p1hi |= a1; } }
        unsigned bk[16], c1[16], c2[16], c3a = 0u, c3b = 0u;
#pragma unroll
        for (int i = 0; i < 16; ++i)
#pragma unroll
            for (int j = 0; j < 16; ++j) if ((i + 1) * (j + 1) <= 16) {
                const unsigned x = (okey(s0[i] + s1[j]) & 0xffffff00u) | (unsigned)(255 - (i * 16 + j));
                const int n = cand_index(i, j);
                if (n < 16) bk[n & 15] = x; else if (n < 32) c1[n & 15] = x; else if (n < 48) c2[n & 15] = x; else if (n == 48) c3a = x; else c3b = x; }
        sort16_desc(bk); sort16_desc(c1); sort16_desc(c2); merge_top16(bk, c1); merge_top16(bk, c2);
#pragma unroll
        for (int k = 0; k < 16; ++k) { const unsigned hv = umax_(bk[k], c3a); c3a = umin_(bk[k], c3a); bk[k] = hv; }
#pragma unroll
        for (int k = 0; k < 16; ++k) { const unsigned hv = umax_(bk[k], c3b); c3b = umin_(bk[k], c3b); bk[k] = hv; }
        const int t = u.pm * 256 + trow, head = u.pn;
        const float rstd = row_rstd(rsp, t);
        const float mx = unkey(bk[0] & 0xffffff00u) * rstd; float l = 0.f; float ev[16];
#pragma unroll
        for (int k = 0; k < 16; ++k) { ev[k] = __expf(unkey(bk[k] & 0xffffff00u) * rstd - mx); l += ev[k]; }
        const float inv = 1.0f / l;
        int be[16];
#pragma unroll
        for (int k = 0; k < 16; ++k) { const int code = 255 - (int)(bk[k] & 255u), ci = code >> 4, cj = code & 15;
            const int a = (int)(((ci & 8) ? p0hi : p0lo) >> (8 * (ci & 7))) & 0xff, c = (int)(((cj & 8) ? p1hi : p1lo) >> (8 * (cj & 7))) & 0xff;
            be[k] = a * 128 + c; }
        int* io = idx + (size_t)t * 128 + head * 16; float* go = gate + (size_t)t * 128 + head * 16;
        if (hi == 0) {
            *(int4*)io = make_int4(be[0], be[1], be[2], be[3]); *(int4*)(io + 4) = make_int4(be[4], be[5], be[6], be[7]);
            *(f32x4*)go = (f32x4){ev[0] * inv, ev[1] * inv, ev[2] * inv, ev[3] * inv}; *(f32x4*)(go + 4) = (f32x4){ev[4] * inv, ev[5] * inv, ev[6] * inv, ev[7] * inv};
        } else {
            *(int4*)(io + 8) = make_int4(be[8], be[9], be[10], be[11]); *(int4*)(io + 12) = make_int4(be[12], be[13], be[14], be[15]);
            *(f32x4*)(go + 8) = (f32x4){ev[8] * inv, ev[9] * inv, ev[10] * inv, ev[11] * inv}; *(f32x4*)(go + 12) = (f32x4){ev[12] * inv, ev[13] * inv, ev[14] * inv, ev[15] * inv};
        }
    }
};

__device__ __forceinline__ void peer_fused(const P& p, const PeerMap& mp, unsigned char* lds, float* ybuf, float* dst) {
    const int lane = tidx() & 63, wave = tidx() >> 6, g = lane >> 4, l = lane & 15;
    unsigned char* wl = lds + wave * 14848;
    unsigned char* XQl = wl; float* PAl = (float*)(wl + 8192); int* IDl = (int*)(wl + 8192 + 2048); unsigned char* HQl = wl + 8192 + 4096;
    const float* SU = WSP(const float, WS_SU); const float* SV = WSP(const float, WS_SV);
    const int slot = mp.r * NWAVES + wave, nslots = mp.nloc * NWAVES;
    for (int q0 = slot; q0 * mp.nx + mp.rho < T; q0 += 4 * nslots) {
        int tk[4]; float ascale[4], sh[4], ssq[4];
#pragma unroll
        for (int j = 0; j < 4; ++j) { const int t = (q0 + j * nslots) * mp.nx + mp.rho; tk[j] = t < T ? t : -1; ssq[j] = 0.f; sh[j] = 0.f; ascale[j] = 0.f; }
#pragma unroll
        for (int j = 0; j < 4; ++j) if (tk[j] >= 0) { const int t = tk[j];
            const v4u* xp = WSP(const v4u, WS_XG) + (size_t)t * 256 + lane * 4; float f[32];
            unpack8(xp[0], f); unpack8(xp[1], f + 8); unpack8(xp[2], f + 16); unpack8(xp[3], f + 24);
            float m = 0.f;
#pragma unroll
            for (int i = 0; i < 32; ++i) m = fmaxf(m, fabsf(f[i]));
            m = fmaxf(wave_max(m), 1e-30f); const float inv = 127.f / m; ascale[j] = row_rstd(WSP(const float, WS_RSP), t) * m * (1.f / 127.f);
            v4u o0, o1;
            o0.x = q8(f[0], inv) | (q8(f[1], inv) << 8) | (q8(f[2], inv) << 16) | (q8(f[3], inv) << 24); o0.y = q8(f[4], inv) | (q8(f[5], inv) << 8) | (q8(f[6], inv) << 16) | (q8(f[7], inv) << 24);
            o0.z = q8(f[8], inv) | (q8(f[9], inv) << 8) | (q8(f[10], inv) << 16) | (q8(f[11], inv) << 24); o0.w = q8(f[12], inv) | (q8(f[13], inv) << 8) | (q8(f[14], inv) << 16) | (q8(f[15], inv) << 24);
            o1.x = q8(f[16], inv) | (q8(f[17], inv) << 8) | (q8(f[18], inv) << 16) | (q8(f[19], inv) << 24); o1.y = q8(f[20], inv) | (q8(f[21], inv) << 8) | (q8(f[22], inv) << 16) | (q8(f[23], inv) << 24);
            o1.z = q8(f[24], inv) | (q8(f[25], inv) << 8) | (q8(f[26], inv) << 16) | (q8(f[27], inv) << 24); o1.w = q8(f[28], inv) | (q8(f[29], inv) << 8) | (q8(f[30], inv) << 16) | (q8(f[31], inv) << 24);
            *(v4u*)(XQl + j * 2048 + lane * 32) = o0; *(v4u*)(XQl + j * 2048 + lane * 32 + 16) = o1;
            const int ia = WSP(const int, WS_IDX)[(size_t)t * 128 + lane], ib = WSP(const int, WS_IDX)[(size_t)t * 128 + 64 + lane];
            IDl[j * 128 + (lane & 3) * 32 + (lane >> 2)] = ia; IDl[j * 128 + (lane & 3) * 32 + 16 + (lane >> 2)] = ib;
            PAl[j * 128 + lane] = 0.f; PAl[j * 128 + 64 + lane] = 0.f; }
        for (int s = 0; s < 8; ++s) {
            const unsigned char* ub = (const unsigned char*)(p.ws + WS_UQ) + s * 256 + l * 16;
#pragma unroll
            for (int j = 0; j < 4; ++j) if (tk[j] >= 0) {
                const v4u xq = *(const v4u*)(XQl + j * 2048 + s * 256 + l * 16);
#pragma unroll
                for (int k0 = 0; k0 < 32; k0 += 16) {
                    int idxv[16];
#pragma unroll
                    for (int k4 = 0; k4 < 4; ++k4) { const int4 q = *(const int4*)(IDl + j * 128 + g * 32 + k0 + 4 * k4); idxv[4 * k4] = q.x; idxv[4 * k4 + 1] = q.y; idxv[4 * k4 + 2] = q.z; idxv[4 * k4 + 3] = q.w; }
                    v4u w[16];
#pragma unroll
                    for (int k = 0; k < 16; ++k) w[k] = *(const v4u*)(ub + (size_t)idxv[k] * DM);
#pragma unroll
                    for (int k = 0; k < 16; ++k) { int a0 = sdot4(w[k].x, xq.x, 0), a1 = sdot4(w[k].y, xq.y, 0); a0 = sdot4(w[k].z, xq.z, a0); a1 = sdot4(w[k].w, xq.w, a1);
                        const float d = row16_sum((float)(a0 + a1));
                        if (l == 0) PAl[j * 128 + 4 * (k0 + k) + g] += d; }
                }
            }
        }
#pragma unroll
        for (int j = 0; j < 4; ++j) if (tk[j] >= 0) { const int t = tk[j];
            const int ia = IDl[j * 128 + (lane & 3) * 32 + (lane >> 2)], ib = IDl[j * 128 + (lane & 3) * 32 + 16 + (lane >> 2)];
            const float aa = PAl[j * 128 + lane] * ascale[j] * SU[ia], ab = PAl[j * 128 + 64 + lane] * ascale[j] * SU[ib];
            const float ha = 0.5f * aa * (1.0f + erff(aa * 0.70710678118f)) * WSP(const float, WS_GATE)[(size_t)t * 128 + lane] * SV[ia];
            const float hb = 0.5f * ab * (1.0f + erff(ab * 0.70710678118f)) * WSP(const float, WS_GATE)[(size_t)t * 128 + 64 + lane] * SV[ib];
            const float m = fmaxf(wave_max(fmaxf(fabsf(ha), fabsf(hb))), 1e-30f); sh[j] = m * (1.f / 127.f); const float inv = 127.f / m;
            HQl[j * 128 + (lane & 3) * 32 + (lane >> 2)] = (unsigned char)q8(ha, inv); HQl[j * 128 + (lane & 3) * 32 + 16 + (lane >> 2)] = (unsigned char)q8(hb, inv); }
        for (int s = 0; s < 8; ++s) {
            const unsigned char* vb = (const unsigned char*)(p.ws + WS_VQ) + s * 256 + l * 16;
#pragma unroll
            for (int j = 0; j < 4; ++j) if (tk[j] >= 0) {
                const v4u h0 = *(const v4u*)(HQl + j * 128 + g * 32), h1 = *(const v4u*)(HQl + j * 128 + g * 32 + 16);
                const unsigned hq[8] = {h0.x, h0.y, h0.z, h0.w, h1.x, h1.y, h1.z, h1.w};
                int acc[16];
#pragma unroll
                for (int c = 0; c < 16; ++c) acc[c] = 0;
#pragma unroll
                for (int k0 = 0; k0 < 32; k0 += 16) {
                    int idxv[16];
#pragma unroll
                    for (int k4 = 0; k4 < 4; ++k4) { const int4 q = *(const int4*)(IDl + j * 128 + g * 32 + k0 + 4 * k4); idxv[4 * k4] = q.x; idxv[4 * k4 + 1] = q.y; idxv[4 * k4 + 2] = q.z; idxv[4 * k4 + 3] = q.w; }
                    v4u w[16];
#pragma unroll
                    for (int k = 0; k < 16; ++k) w[k] = *(const v4u*)(vb + (size_t)idxv[k] * DM);
#pragma unroll
                    for (int k4 = 0; k4 < 4; ++k4) { const unsigned hd = hq[(k0 >> 2) + k4];
#pragma unroll
                        for (int c4 = 0; c4 < 4; ++c4) {
                            const unsigned a = w[4 * k4][c4], b = w[4 * k4 + 1][c4], c = w[4 * k4 + 2][c4], d = w[4 * k4 + 3][c4];
                            const unsigned pq = permb(b, a, 0x05010400u), qq = permb(b, a, 0x07030602u), rq = permb(d, c, 0x05010400u), sq = permb(d, c, 0x07030602u);
                            acc[4 * c4 + 0] = sdot4(permb(rq, pq, 0x05040100u), hd, acc[4 * c4 + 0]); acc[4 * c4 + 1] = sdot4(permb(rq, pq, 0x07060302u), hd, acc[4 * c4 + 1]);
                            acc[4 * c4 + 2] = sdot4(permb(sq, qq, 0x05040100u), hd, acc[4 * c4 + 2]); acc[4 * c4 + 3] = sdot4(permb(sq, qq, 0x07060302u), hd, acc[4 * c4 + 3]); } }
                }
#pragma unroll
                for (int c = 0; c < 16; ++c) { acc[c] += __shfl_xor(acc[c], 16); acc[c] += __shfl_xor(acc[c], 32); }
                const size_t yo = (size_t)tk[j] * DM + s * 256 + l * 16 + 4 * g; const f32x4 x1v = *(const f32x4*)(((float*)p.out) + yo);
                f32x4 o;
                o.x = x1v.x + sh[j] * (float)(g == 0 ? acc[0] : g == 1 ? acc[4] : g == 2 ? acc[8] : acc[12]);
                o.y = x1v.y + sh[j] * (float)(g == 0 ? acc[1] : g == 1 ? acc[5] : g == 2 ? acc[9] : acc[13]);
                o.z = x1v.z + sh[j] * (float)(g == 0 ? acc[2] : g == 1 ? acc[6] : g == 2 ? acc[10] : acc[14]);
                o.w = x1v.w + sh[j] * (float)(g == 0 ? acc[3] : g == 1 ? acc[7] : g == 2 ? acc[11] : acc[15]);
                *(f32x4*)(ybuf + yo) = o;
                ssq[j] += (o.x * o.x + o.y * o.y) + (o.z * o.z + o.w * o.w);
            }
        }
        asm volatile("s_waitcnt vmcnt(0)" ::: "memory");
#pragma unroll
        for (int j = 0; j < 4; ++j) if (tk[j] >= 0) {
            const float rstd = rsqrtf(wave_sum(ssq[j]) * (1.f / DM) + EPS);
            const f32x4* yr = (const f32x4*)(ybuf + (size_t)tk[j] * DM) + lane; const f32x4* gr = (const f32x4*)((const float*)p.g_final) + lane; f32x4* o = (f32x4*)(dst + (size_t)tk[j] * DM) + lane;
            f32x4 v[8];
#pragma unroll
            for (int i = 0; i < 8; ++i) v[i] = __builtin_nontemporal_load(yr + 64 * i);
#pragma unroll
            for (int i = 0; i < 8; ++i) o[64 * i] = v[i] * rstd * gr[64 * i];
        }
    }
}

__device__ __forceinline__ void peer_fused16(const P& p, const PeerMap& mp, unsigned char* lds, float* ybuf, float* dst) {
    const int lane = tidx() & 63, wave = tidx() >> 6, g = lane >> 3, l = lane & 7;
    unsigned char* wl = lds + wave * 18944;
    unsigned char* XQl = wl; float* PAl = (float*)(wl + 8192); int* IDl = (int*)(wl + 16384); unsigned char* HQl = wl + 16384 + 2048; unsigned char* Yl = wl;
    const float* SU = WSP(const float, WS_SU); const float* SV = WSP(const float, WS_SV);
    const int slot = mp.r * NWAVES + wave, nslots = mp.nloc * NWAVES;
    for (int q0 = slot; q0 * mp.nx + mp.rho < T; q0 += 4 * nslots) {
        int tk[4]; float ascale[4], sh[4], ssq[4];
#pragma unroll
        for (int j = 0; j < 4; ++j) { const int t = (q0 + j * nslots) * mp.nx + mp.rho; tk[j] = t < T ? t : -1; ssq[j] = 0.f; sh[j] = 0.f; ascale[j] = 0.f; }
#pragma unroll
        for (int j = 0; j < 4; ++j) if (tk[j] >= 0) { const int t = tk[j];
            const v4u* xp = WSP(const v4u, WS_XG) + (size_t)t * 256 + lane * 4; float f[32];
            unpack8(xp[0], f); unpack8(xp[1], f + 8); unpack8(xp[2], f + 16); unpack8(xp[3], f + 24);
            float m = 0.f;
#pragma unroll
            for (int i = 0; i < 32; ++i) m = fmaxf(m, fabsf(f[i]));
            m = fmaxf(wave_max(m), 1e-30f); const float inv = 127.f / m; ascale[j] = row_rstd(WSP(const float, WS_RSP), t) * m * (1.f / 127.f);
            v4u o0, o1;
            o0.x = q8(f[0], inv) | (q8(f[1], inv) << 8) | (q8(f[2], inv) << 16) | (q8(f[3], inv) << 24); o0.y = q8(f[4], inv) | (q8(f[5], inv) << 8) | (q8(f[6], inv) << 16) | (q8(f[7], inv) << 24);
            o0.z = q8(f[8], inv) | (q8(f[9], inv) << 8) | (q8(f[10], inv) << 16) | (q8(f[11], inv) << 24); o0.w = q8(f[12], inv) | (q8(f[13], inv) << 8) | (q8(f[14], inv) << 16) | (q8(f[15], inv) << 24);
            o1.x = q8(f[16], inv) | (q8(f[17], inv) << 8) | (q8(f[18], inv) << 16) | (q8(f[19], inv) << 24); o1.y = q8(f[20], inv) | (q8(f[21], inv) << 8) | (q8(f[22], inv) << 16) | (q8(f[23], inv) << 24);
            o1.z = q8(f[24], inv) | (q8(f[25], inv) << 8) | (q8(f[26], inv) << 16) | (q8(f[27], inv) << 24); o1.w = q8(f[28], inv) | (q8(f[29], inv) << 8) | (q8(f[30], inv) << 16) | (q8(f[31], inv) << 24);
            *(v4u*)(XQl + j * 2048 + lane * 32) = o0; *(v4u*)(XQl + j * 2048 + lane * 32 + 16) = o1;
            const int ia = WSP(const int, WS_IDX)[(size_t)t * 128 + lane], ib = WSP(const int, WS_IDX)[(size_t)t * 128 + 64 + lane];
            IDl[j * 128 + (lane & 7) * 16 + (lane >> 3)] = ia; IDl[j * 128 + (lane & 7) * 16 + 8 + (lane >> 3)] = ib;
            PAl[j * 128 + lane] = 0.f; PAl[j * 128 + 64 + lane] = 0.f; }
        int pu[4][16];
#pragma unroll
        for (int j = 0; j < 4; ++j)
#pragma unroll
            for (int k = 0; k < 16; ++k) pu[j][k] = 0;
        for (int s = 0; s < 16; ++s) {
            const unsigned char* ub = (const unsigned char*)(p.ws + WS_UQ) + (size_t)s * (NEXP * 128) + l * 16;
#pragma unroll
            for (int j = 0; j < 4; ++j) if (tk[j] >= 0) {
                const v4u xq = *(const v4u*)(XQl + j * 2048 + s * 128 + l * 16);
                int idxv[16];
#pragma unroll
                for (int k4 = 0; k4 < 4; ++k4) { const int4 q = *(const int4*)(IDl + j * 128 + g * 16 + 4 * k4); idxv[4 * k4] = q.x; idxv[4 * k4 + 1] = q.y; idxv[4 * k4 + 2] = q.z; idxv[4 * k4 + 3] = q.w; }
                v4u w[16];
#pragma unroll
                for (int k = 0; k < 16; ++k) w[k] = *(const v4u*)(ub + (size_t)idxv[k] * 128);
#pragma unroll
                for (int k = 0; k < 16; ++k) { int a0 = sdot4(w[k].x, xq.x, pu[j][k]); a0 = sdot4(w[k].y, xq.y, a0); a0 = sdot4(w[k].z, xq.z, a0); pu[j][k] = sdot4(w[k].w, xq.w, a0); }
            }
        }
#pragma unroll
        for (int j = 0; j < 4; ++j) if (tk[j] >= 0) {
#pragma unroll
            for (int k = 0; k < 16; ++k) { const float d = sum8((float)pu[j][k]); if (l == 0) PAl[j * 128 + 8 * k + g] = d; } }
#pragma unroll
        for (int j = 0; j < 4; ++j) if (tk[j] >= 0) { const int t = tk[j]; int lane = tidx() & 63; asm volatile("" : "+v"(lane));
            const int ia = IDl[j * 128 + (lane & 7) * 16 + (lane >> 3)], ib = IDl[j * 128 + (lane & 7) * 16 + 8 + (lane >> 3)];
            const float aa = PAl[j * 128 + lane] * ascale[j] * SU[ia], ab = PAl[j * 128 + 64 + lane] * ascale[j] * SU[ib];
            const float ha = 0.5f * aa * (1.0f + erff(aa * 0.70710678118f)) * WSP(const float, WS_GATE)[(size_t)t * 128 + lane] * SV[ia];
            const float hb = 0.5f * ab * (1.0f + erff(ab * 0.70710678118f)) * WSP(const float, WS_GATE)[(size_t)t * 128 + 64 + lane] * SV[ib];
            const float m = fmaxf(wave_max(fmaxf(fabsf(ha), fabsf(hb))), 1e-30f); sh[j] = m * (1.f / 127.f); const float inv = 127.f / m;
            HQl[j * 128 + (lane & 7) * 16 + (lane >> 3)] = (unsigned char)q8(ha, inv); HQl[j * 128 + (lane & 7) * 16 + 8 + (lane >> 3)] = (unsigned char)q8(hb, inv); }
        for (int s = 0; s < 16; ++s) {
            const unsigned char* vb = (const unsigned char*)(p.ws + WS_VQ) + (size_t)s * (NEXP * 128) + l * 16;
#pragma unroll
            for (int j = 0; j < 4; ++j) if (tk[j] >= 0) {
                const v4u h0 = *(const v4u*)(HQl + j * 128 + g * 16);
                const unsigned hq[4] = {h0.x, h0.y, h0.z, h0.w};
                int acc[16];
#pragma unroll
                for (int c = 0; c < 16; ++c) acc[c] = 0;
                int idxv[16];
#pragma unroll
                for (int k4 = 0; k4 < 4; ++k4) { const int4 q = *(const int4*)(IDl + j * 128 + g * 16 + 4 * k4); idxv[4 * k4] = q.x; idxv[4 * k4 + 1] = q.y; idxv[4 * k4 + 2] = q.z; idxv[4 * k4 + 3] = q.w; }
                v4u w[16];
#pragma unroll
                for (int k = 0; k < 16; ++k) w[k] = *(const v4u*)(vb + (size_t)idxv[k] * 128);
#pragma unroll
                for (int k4 = 0; k4 < 4; ++k4) { const unsigned hd = hq[k4];
#pragma unroll
                    for (int c4 = 0; c4 < 4; ++c4) {
                        const unsigned a = w[4 * k4][c4], b = w[4 * k4 + 1][c4], c = w[4 * k4 + 2][c4], d = w[4 * k4 + 3][c4];
                        const unsigned pq = permb(b, a, 0x05010400u), qq = permb(b, a, 0x07030602u), rq = permb(d, c, 0x05010400u), sq = permb(d, c, 0x07030602u);
                        acc[4 * c4 + 0] = sdot4(permb(rq, pq, 0x05040100u), hd, acc[4 * c4 + 0]); acc[4 * c4 + 1] = sdot4(permb(rq, pq, 0x07060302u), hd, acc[4 * c4 + 1]);
                        acc[4 * c4 + 2] = sdot4(permb(sq, qq, 0x05040100u), hd, acc[4 * c4 + 2]); acc[4 * c4 + 3] = sdot4(permb(sq, qq, 0x07060302u), hd, acc[4 * c4 + 3]); } }
                int r8[8], r4[4];
#pragma unroll
                for (int c = 0; c < 8; ++c) { auto rr = __builtin_amdgcn_permlane32_swap((unsigned)acc[c], (unsigned)acc[c + 8], false, false); r8[c] = (int)rr[0] + (int)rr[1]; }
#pragma unroll
                for (int c = 0; c < 4; ++c) { auto rr = __builtin_amdgcn_permlane16_swap((unsigned)r8[c], (unsigned)r8[c + 4], false, false); r4[c] = (int)rr[0] + (int)rr[1]; }
                const bool b3 = (lane & 8) != 0;
                const int k0v = b3 ? r4[2] : r4[0], s0v = b3 ? r4[0] : r4[2], k1v = b3 ? r4[3] : r4[1], s1v = b3 ? r4[1] : r4[3];
                const int s0 = k0v + (int)dppu<0x128>((unsigned)s0v), s1 = k1v + (int)dppu<0x128>((unsigned)s1v);
                const size_t yo = (size_t)tk[j] * DM + s * 128 + l * 16 + 2 * g; const unsigned xb = *(const unsigned*)(WSP(const bf16, WS_XG) + yo);
                const float o0 = __uint_as_float(xb << 16) + sh[j] * (float)s0, o1 = __uint_as_float(xb & 0xffff0000u) + sh[j] * (float)s1;
                *(unsigned*)(Yl + j * 4096 + s * 256 + l * 32 + 4 * g) = pk2(o0, o1);
                ssq[j] += o0 * o0 + o1 * o1;
            }
        }
        asm volatile("s_waitcnt lgkmcnt(0)" ::: "memory");
#pragma unroll
        for (int j = 0; j < 4; ++j) if (tk[j] >= 0) {
            const float rstd = rsqrtf(wave_sum(ssq[j]) * (1.f / DM) + EPS);
            const float* gr = (const float*)p.g_final; float* o = dst + (size_t)tk[j] * DM;
#pragma unroll
            for (int i = 0; i < 4; ++i) { const int c8 = (i * 64 + lane) * 8; const v4u yv = *(const v4u*)(Yl + j * 4096 + c8 * 2);
                const f32x4 g0 = *(const f32x4*)(gr + c8), g1 = *(const f32x4*)(gr + c8 + 4);
                f32x4 r0, r1;
                r0.x = __uint_as_float(yv.x << 16) * rstd * g0.x; r0.y = __uint_as_float(yv.x & 0xffff0000u) * rstd * g0.y; r0.z = __uint_as_float(yv.y << 16) * rstd * g0.z; r0.w = __uint_as_float(yv.y & 0xffff0000u) * rstd * g0.w;
                r1.x = __uint_as_float(yv.z << 16) * rstd * g1.x; r1.y = __uint_as_float(yv.z & 0xffff0000u) * rstd * g1.y; r1.z = __uint_as_float(yv.w << 16) * rstd * g1.z; r1.w = __uint_as_float(yv.w & 0xffff0000u) * rstd * g1.w;
                *(f32x4*)(o + c8) = r0; *(f32x4*)(o + c8 + 4) = r1; }
        }
    }
}
#ifndef PROBE_IN
#define PROBE_IN 0
#endif
#ifndef MK_SPLIT
#define MK_SPLIT 0
#endif
constexpr int NPHASE = 9;
template <int LO, int HI> __global__ void __launch_bounds__(NTHR, 2) mk_fwd(P p0) {
    extern __shared__ __attribute__((aligned(16))) unsigned char lds[];
    const int G = gridDim.x, bx_hw = blockIdx.x;
    volatile LAS unsigned* MISC = (volatile LAS unsigned*)((LAS unsigned char*)lds + (LDS_BYTES - 64));
    if (threadIdx.x < 16) MISC[threadIdx.x] = 0u;
    __syncthreads();
    XcdBarrier xbar = xcd_barrier_post((unsigned*)(p0.ws + WS_BAR + (HI - LO == NPHASE ? 0 : (p0.ph_hi ? p0.ph_hi : LO)) * BAR_REGION), MISC);
    const PeerMap mp0 = peer_map(xbar, MISC);
    const int bx = (mp0.bal && mp0.nx == 8) ? mp0.r * 8 + mp0.rho : bx_hw;
    const int vcu = (G % 8 == 0) ? (bx % 8) * (G / 8) + bx / 8 : bx;
#define IN(k) (LO <= (k) && (k) < HI)
#define SEAM(k) do { if constexpr (IN(k) && IN((k) + 1)) { xcd_barrier(xbar); } } while (0)
    PG8_LAS unsigned char* glds = (PG8_LAS unsigned char*)lds;
    typedef pg8::EpiBf16<0> EB;
    if constexpr (IN(0)) { P p = p0; asm volatile("" : "+s"(p.ws)); if (p.ph_lo != 1) phase0(p, lds, vcu, G, bx); } SEAM(0);
    if constexpr (IN(1)) { P p = p0; asm volatile("" : "+s"(p.ws));
        const bool tailwg = (G == 256) && bx >= 80, tail_first = tailwg && (((bx - 80) & 1) == 0);
        if (tail_first && !(PROBE_IN & 64)) { tail_prep(p, lds, bx - 80, G - 80); __syncthreads(); }
        { pg8::Gemm g{WSP(const bf16, WS_H), WSP(const bf16, WS_WIN), T, NIN, DM / 2, DM / 2, DM / 2}; pg8::StaticOrder S; S.init(T, NIN, G, bx);
          pg8::EpiI8 E{WSP(bf16, WS_PROJ), NIN, WSP(const float, WS_SA), WSP(const float, WS_SB), C_GATE, WSP(unsigned char, WS_G8), 3 * DM, ((const float*)p.b_gate)}; pg8::gemm_phase<pg8::EpiI8, pg8::StaticOrder, true, true, true>(glds, g, S, E); }
#if PROBE_IN & 32
        { struct SameTile : pg8::StaticOrder { __device__ bool next(int i, pg8::Unit& u) const { if (i >= 7) return false; u.pm = c % 8; u.pn = 0; return true; } };
          pg8::Gemm g{WSP(const bf16, WS_H), WSP(const bf16, WS_WIN), T, NIN, DM / 2, DM / 2, DM / 2}; SameTile S; S.init(T, NIN, G, bx);
          pg8::EpiI8 E{WSP(bf16, WS_ST), 256, WSP(const float, WS_SA), WSP(const float, WS_SB), 1 << 30, nullptr, 0, nullptr}; pg8::gemm_phase<pg8::EpiI8, SameTile, true, true, true>(glds, g, S, E); }
#endif
        { pg8::Gemm g{WSP(const bf16, WS_MEMN), WSP(const bf16, WS_WKV), MROWS, 1024, DM, DM, DM}; pg8::StaticOrder S; S.init(MROWS, 1024, G, (bx + G - 64) % G);
          EB E{WSP(bf16, WS_KVM), 1024, nullptr, 0, 0, 1.f}; pg8::gemm_phase<EB, pg8::StaticOrder, true, true>(glds, g, S, E); }
        { pg8::Gemm g{WSP(const bf16, WS_WKV), WSP(const bf16, WS_MEMN), 1024, MROWS, DM, DM, DM}; pg8::StaticOrder S; S.init(1024, MROWS, G, (bx + G - 72) % G);
          EB E{WSP(bf16, WS_KVMT), MROWS, nullptr, 0, 0, 1.f}; pg8::gemm_phase<EB, pg8::StaticOrder, true, true>(glds, g, S, E); }
        if (!(PROBE_IN & 64)) { if (tailwg && !tail_first) tail_prep(p, lds, bx - 80, G - 80); else if (G != 256) tail_prep(p, lds, bx, G); }
    } SEAM(1);
    if constexpr (IN(2)) { P p = p0; asm volatile("" : "+s"(p.ws));
        if (PROBE_IN & 64) { tail_prep(p, lds, bx, G); __syncthreads(); }
        constexpr int N_DIL = BATCH * DIL_H * 32, N_H1 = BATCH * HG_H * 2 * 64, N_MEM = BATCH * MEM_H * 32;
        { DilRegs R; if (bx < N_DIL) dil_load(p, bx, R);
          for (int it = bx; it < N_DIL; it += G) { DilRegs Rn; const bool more = it + G < N_DIL; if (more) dil_load(p, it + G, Rn); dil_item(p, lds, it, R); if (more) R = Rn; } }
        { unsigned short zc[16], vc[16]; float lbc = 0.f; if (bx < N_H1) h1_load(p, bx, zc, vc, lbc);
          for (int it = bx; it < N_MEM; it += G) mem_item(p, lds, it);
          for (int it = bx; it < N_H1; it += G) { unsigned short zn[16], vn[16]; float lbn = 0.f; const bool more = it + G < N_H1; if (more) h1_load(p, it + G, zn, vn, lbn); h1_item(p, lds, it, zc, vc, lbc);
              if (more) { lbc = lbn;
#pragma unroll
                  for (int i = 0; i < 16; ++i) { zc[i] = zn[i]; vc[i] = vn[i]; } } } }
    } SEAM(2);
    constexpr int N_H3 = BATCH * HG_H * 64; constexpr bool H3_EARLY = IN(3) && IN(4);
    unsigned short a0[16], a1[16], a2[16], a3[16]; float lf0 = 0.f, lb0 = 0.f;
    if constexpr (IN(3)) { P p = p0; asm volatile("" : "+s"(p.ws));
        if constexpr (H3_EARLY) { if (bx < N_H3) { h3_load_z(p, bx, a0, a1, lf0, lb0); h3_load_vq(p, bx, a2, a3); } }
        if (PROBE_IN & 8) h2_scan(p, bx, G, WSP(bf16, WS_WIN)); h2_scan(p, bx, G, WSP(bf16, WS_ST)); } SEAM(3);
    if constexpr (IN(3) && IN(4)) { if (PROBE_IN & 128) { for (int i = 0; i < 8; ++i) xcd_barrier<!(PROBE_IN & 256), !(PROBE_IN & 512)>(xbar); } }
    if constexpr (IN(4)) { P p = p0; asm volatile("" : "+s"(p.ws)); { if constexpr (!H3_EARLY) { if (bx < N_H3) { h3_load_z(p, bx, a0, a1, lf0, lb0); h3_load_vq(p, bx, a2, a3); } }
          for (int it = bx; it < N_H3; it += G) { unsigned short n0[16], n1[16], n2[16], n3[16]; float lf1 = 0.f, lb1 = 0.f; const bool more = it + G < N_H3; if (more) h3_load_z(p, it + G, n0, n1, lf1, lb1); h3_item(p, lds, it, a0, a1, a2, a3, lf0, lb0, more, it + G, n2, n3);
              if (more) { lf0 = lf1; lb0 = lb1;
#pragma unroll
                  for (int i = 0; i < 16; ++i) { a0[i] = n0[i]; a1[i] = n1[i]; a2[i] = n2[i]; a3[i] = n3[i]; } } } }
        dil_alpha_rows(p, vcu, G); } SEAM(4);
    if constexpr (IN(5)) { P p = p0; asm volatile("" : "+s"(p.ws)); pg8::Gemm g{WSP(const bf16, WS_OCAT), WSP(const bf16, WS_WUP), T, DM, DM, DM, DM}; pg8::StaticOrder S; S.init(T, DM, G, bx);
        pg8::EpiUp E{WSP(const unsigned char, WS_G8), 3 * DM, WSP(bf16, WS_MERGED), 12, 24};
        pg8::gemm_phase<pg8::EpiUp, pg8::StaticOrder, false, true>(glds, g, S, E); } SEAM(5);
    if constexpr (IN(6)) { P p = p0; asm volatile("" : "+s"(p.ws)); pg8::Gemm g{WSP(const bf16, WS_MERGED), WSP(const bf16, WS_WOUT), T, DM, DM, DM, DM}; pg8::StaticOrder S; S.init(T, DM, G, bx);
        pg8::EpiOut E{((const float*)p.x), WSP(bf16, WS_XG), WSP(float, WS_RSP)};
        pg8::gemm_phase<pg8::EpiOut, pg8::StaticOrder, false, true>(glds, g, S, E); } SEAM(6);
    if constexpr (IN(7)) { P p = p0; asm volatile("" : "+s"(p.ws));
        pg8::Gemm g{WSP(const bf16, WS_XG), WSP(const bf16, WS_WQ), T, DM, DM, DM, DM}; pg8::StaticOrder S; S.init(T, DM, G, bx);
        EpiRoute E{WSP(const bf16, WS_SKB), WSP(const float, WS_RSP), WSP(int, WS_IDX), WSP(float, WS_GATE)};
        pg8::gemm_phase<EpiRoute, pg8::StaticOrder, false, true>(glds, g, S, E); } SEAM(7);
    if constexpr (IN(8)) { P p = p0; asm volatile("" : "+s"(p.ws)); const PeerMap mp = mp0; if (PROBE_IN & 1) peer_fused(p, mp, lds, WSP(float, WS_PROJ + 32 * MiB), WSP(float, WS_PROJ + 96 * MiB)); peer_fused16(p, mp, lds, ((float*)p.out), ((float*)p.dst10)); }
#undef IN
#undef SEAM
}

#if MK_SPLIT
#define MK_FOR_PH(X) X(0) X(1) X(2) X(3) X(4) X(5) X(6) X(7) X(8)
static bool set_lds() { bool ok = true;
#define X(k) ok = ok && (hipFuncSetAttribute((const void*)mk_fwd<k, k + 1>, hipFuncAttributeMaxDynamicSharedMemorySize, LDS_BYTES) == hipSuccess);
    MK_FOR_PH(X)
#undef X
    return ok; }
static void launch_split(const P& p, int grid, hipStream_t stream) {
#ifndef PROBE_REP
#define PROBE_REP 0
#endif
#define X(k) { P q = p; q.ph_hi = 0; if (k == 0) { q.ph_lo = 0; hipLaunchKernelGGL((mk_fwd<0, 1>), dim3(grid), dim3(NTHR), LDS_BYTES, stream, q); if ((PROBE_REP >> 15) & 1) { q.ph_hi = 15; hipLaunchKernelGGL((mk_fwd<0, 1>), dim3(grid), dim3(NTHR), LDS_BYTES, stream, q); } q.ph_lo = 1; q.ph_hi = 13; } if (((PROBE_REP >> k) & 1)) { P q2 = q; q2.ph_hi = 14; hipLaunchKernelGGL((mk_fwd<k, k + 1>), dim3(grid), dim3(NTHR), LDS_BYTES, stream, q2); } hipLaunchKernelGGL((mk_fwd<k, k + 1>), dim3(grid), dim3(NTHR), LDS_BYTES, stream, q); }
    MK_FOR_PH(X)
#undef X
}
#else
static bool set_lds() { return hipFuncSetAttribute((const void*)mk_fwd<0, NPHASE>, hipFuncAttributeMaxDynamicSharedMemorySize, LDS_BYTES) == hipSuccess; }
#endif

extern "C" void kernel_launch(void* const* d_in, const int* in_sizes, int n_in, void* d_out, int out_size, void* d_ws, size_t ws_size, hipStream_t stream) {
    static int grid = 0;
    if (grid == 0) {
        if (n_in != 18 || out_size != T * DM || ws_size < WS_END) { fprintf(stderr, "kernel_launch: unexpected shapes (n_in %d, out %d, ws %zu)\n", n_in, out_size, ws_size); grid = -1; return; }
        int dev = 0, cus = 0, per_cu = 0;
        (void)hipGetDevice(&dev); (void)hipDeviceGetAttribute(&cus, hipDeviceAttributeMultiprocessorCount, dev);
        if (!set_lds()) { fprintf(stderr, "kernel_launch: hipFuncSetAttribute failed\n"); grid = -1; return; }
        (void)per_cu; (void)hipGetLastError();
        grid = cus;
        if (grid != 256) { fprintf(stderr, "kernel_launch: built for a 256-CU device (one 256x256 GEMM unit per workgroup in the fused-epilogue phases); found %d CUs\n", cus); grid = -1; return; }
    }
    if (grid < 0) return;
    if (hipMemsetAsync((char*)d_ws + WS_BAR, 0, BAR_ZERO, stream) != hipSuccess) { fprintf(stderr, "kernel_launch: memset failed\n"); return; }
    P p{};
    p.x = (const GAS float*)d_in[0]; p.mem = (const GAS float*)d_in[1]; p.g_mix = (const GAS float*)d_in[2]; p.w_in = (const GAS float*)d_in[3]; p.b_gate = (const GAS float*)d_in[4];
    p.lbf_l = (const GAS float*)d_in[5]; p.lbb_l = (const GAS float*)d_in[6]; p.g_hg = (const GAS float*)d_in[7]; p.w_kv = (const GAS float*)d_in[8]; p.g_mem = (const GAS float*)d_in[9];
    p.w_up = (const GAS float*)d_in[10]; p.w_out = (const GAS float*)d_in[11]; p.g_ffn = (const GAS float*)d_in[12]; p.w_q = (const GAS float*)d_in[13]; p.subk = (const GAS float*)d_in[14];
    p.pu = (const GAS float*)d_in[15]; p.pv = (const GAS float*)d_in[16]; p.g_final = (const GAS float*)d_in[17];
    p.out = (GAS float*)d_out; p.dst10 = (GAS float*)d_out; p.ws = (GAS unsigned char*)d_ws;
#if MK_SPLIT
    launch_split(p, grid, stream);
#else
    p.ph_lo = 2; p.ph_hi = NPHASE;
    void* args[] = {&p};
    hipError_t e = hipLaunchCooperativeKernel((const void*)mk_fwd<0, NPHASE>, dim3(grid), dim3(NTHR), args, LDS_BYTES, stream);
    if (e != hipSuccess) fprintf(stderr, "kernel_launch: cooperative launch failed: %s (grid %d)\n", hipGetErrorString(e), grid);
#endif
}
```

```cpp
#include <hip/hip_runtime.h>
#include <cstdio>
#include <cstdint>
__device__ __forceinline__ int tidx() { int t = threadIdx.x; asm volatile("" : "+v"(t)); return t; }
namespace pg8 {
#define PG8_LAS __attribute__((address_space(3)))
typedef unsigned short bf16_t;
typedef short bf16x8 __attribute__((ext_vector_type(8)));
typedef float f32x4 __attribute__((ext_vector_type(4)));
typedef unsigned u32x4 __attribute__((ext_vector_type(4)));
typedef unsigned u32x2 __attribute__((ext_vector_type(2)));
constexpr int BM = 256, BK = 64, HALF = 128, HTB = HALF * BK * 2  , STAGE_BYTES = 8 * HTB, NXCD = 8, WGM = 8;

__host__ __device__ __forceinline__ int lds_byte(int r, int c) { const int st = (r >> 4) * 2 + (c >> 5), rr = r & 15, cc = c & 31, ob = rr * 64 + cc * 2; return st * 1024 + (ob ^ (((ob >> 9) & 1) << 5)); }
__host__ __device__ __forceinline__ void stage_rc(int b, int& R, int& C) { const int st = b / 1024, sb = b % 1024, swz = sb ^ (((sb >> 9) & 1) << 5); R = (st >> 1) * 16 + swz / 64; C = (st & 1) * 32 + (swz % 64) / 2; }
__host__ __device__ __forceinline__ int perm32(int rho) { const int n = rho >> 4, i = rho & 15; return 8 * (i >> 2) + 4 * n + (i & 3); }

struct Unit { int pm, pn; };
struct Gemm { const bf16_t* A; const bf16_t* Bt; int M, N, K, lda, ldb; };

struct StaticOrder {
    int nM, nN, nwg, G, c;
    __host__ __device__ void init(int M, int N, int G_, int c_) { nM = M / BM; nN = N / BM; nwg = nM * nN; G = G_; c = c_; }
    __host__ __device__ bool next(int i, Unit& u) const { return map((long)i * G + c, u); }
    __host__ __device__ bool map(long L, Unit& u) const {
        if (L >= nwg) return false;
        int wgid = (int)L; { const int q = nwg / NXCD, r = nwg % NXCD, xcd = wgid % NXCD, off = wgid / NXCD; wgid = (xcd < r ? xcd * (q + 1) : r * (q + 1) + (xcd - r) * q) + off; }
        const int nig = WGM * nN, gid = wgid / nig, fm = gid * WGM, gsz = (nM - fm) < WGM ? (nM - fm) : WGM;
        u.pm = fm + ((wgid % nig) % gsz); u.pn = (wgid % nig) / gsz; return true;
    }
    __device__ __forceinline__ void a_ready(const Unit&) const {}
    __device__ __forceinline__ void done(const Unit&) const {}
};
struct SplitOrder : StaticOrder {
    int NT, RA, RB;
    __host__ __device__ bool next(int i, Unit& u) const {
        if (c >= NT) { if (i >= RA) return false; return map((long)i * (G - NT) + (c - NT), u); }
        if (i >= RB) return false; return map((long)(G - NT) * RA + (long)i * NT + c, u);
    }
};


__device__ __forceinline__ unsigned cvt_pk_bf16(float lo, float hi) { unsigned r; asm volatile("v_cvt_pk_bf16_f32 %0, %1, %2" : "=v"(r) : "v"(lo), "v"(hi)); return r; }
typedef float f32x2 __attribute__((ext_vector_type(2)));
__device__ __forceinline__ f32x2 gelu_pk(f32x2 v) {
    const f32x2 av = __builtin_elementwise_abs(v), d = av * 0.2316418882f + 1.0f;
    f32x2 t; t.x = __builtin_amdgcn_rcpf(d.x); t.y = __builtin_amdgcn_rcpf(d.y);
    f32x2 q = t * 0.5307027145f + (-0.7265760135f); q = q * t + 0.7107068705f; q = q * t + (-0.142248368f); q = q * t + 0.127414796f; q = q * t;
    const f32x2 s = (v * v) * (-0.72134752044f);
    f32x2 e; e.x = __builtin_amdgcn_exp2f(s.x); e.y = __builtin_amdgcn_exp2f(s.y);
    const f32x2 m = v * (q * e), r = v - m;
    f32x2 o; o.x = v.x < 0.f ? m.x : r.x; o.y = v.y < 0.f ? m.y : r.y; return o;
}

template <int ACT  > struct EpiBf16 {
    static constexpr bool PERM = true, AFTER_DRAIN = false, MIDK = false; static_assert(ACT == 0 || ACT == 1, "EpiBf16: ACT is 0 (none) or 1 (gelu_pk)");
    bf16_t* O; int ldc; const float* bias; int split_cols; size_t split_stride; float scale0;
    __device__ __forceinline__ void operator()(const f32x4 (&acc)[2][2][4][2], const Unit& u, int wr, int wc, int fr, int fq) const {
        const int row0 = u.pm * BM + wr * 64 + fr; int colt = u.pn * BM; bf16_t* base = O;
        float sc = 1.f; if (split_cols) { const int t = colt / split_cols; base += (size_t)t * split_stride; colt -= t * split_cols; if (t == 0) sc = scale0; }
        const int col0 = colt + wc * 32 + 8 * fq, bcol0 = u.pn * BM + wc * 32 + 8 * fq;
        f32x4 bv[2][2];
#pragma unroll
        for (int bj = 0; bj < 2; ++bj)
#pragma unroll
            for (int n = 0; n < 2; ++n) bv[bj][n] = bias ? *(const f32x4*)(bias + bcol0 + bj * HALF + 4 * n) : (f32x4){0.f, 0.f, 0.f, 0.f};
#pragma unroll
        for (int ai = 0; ai < 2; ++ai)
#pragma unroll
            for (int m = 0; m < 4; ++m) { bf16_t* rowp = base + (size_t)(row0 + ai * HALF + m * 16) * ldc + col0;
#pragma unroll
                for (int bj = 0; bj < 2; ++bj) { f32x4 v0 = acc[ai][bj][m][0] + bv[bj][0], v1 = acc[ai][bj][m][1] + bv[bj][1];
                    if (ACT == 1) { f32x2 a = gelu_pk((f32x2){v0[0], v0[1]}), b = gelu_pk((f32x2){v0[2], v0[3]}), c = gelu_pk((f32x2){v1[0], v1[1]}), d = gelu_pk((f32x2){v1[2], v1[3]});
                        v0 = (f32x4){a.x, a.y, b.x, b.y}; v1 = (f32x4){c.x, c.y, d.x, d.y}; }
                    v0 = v0 * sc; v1 = v1 * sc; u32x4 w; w.x = cvt_pk_bf16(v0[0], v0[1]); w.y = cvt_pk_bf16(v0[2], v0[3]); w.z = cvt_pk_bf16(v1[0], v1[1]); w.w = cvt_pk_bf16(v1[2], v1[3]);
                    *(u32x4*)(rowp + bj * HALF) = w; } }
    }
};
typedef int i32x4 __attribute__((ext_vector_type(4)));
template <bool I8> __device__ __forceinline__ f32x4 mma_sel(bf16x8 a, bf16x8 b, f32x4 c) {
    if constexpr (I8) return __builtin_bit_cast(f32x4, __builtin_amdgcn_mfma_i32_16x16x64_i8(__builtin_bit_cast(i32x4, a), __builtin_bit_cast(i32x4, b), __builtin_bit_cast(i32x4, c), 0, 0, 0));
    else return __builtin_amdgcn_mfma_f32_16x16x32_bf16(a, b, c, 0, 0, 0);
}
template <class Epi, class Sched, bool ALIGN_EPI = false, bool SP2 = false, bool I8 = false>
__device__ __forceinline__ void gemm_phase(PG8_LAS unsigned char* lds, const Gemm g, const Sched& S, const Epi& E) {
    const int tid = tidx(), wid = __builtin_amdgcn_readfirstlane(tid >> 6), lane = tid & 63, wr = wid >> 2, wc = wid & 3, fr = lane & 15, fq = lane >> 4;
    const int K = g.K, nt = K / BK;
    unsigned voffA[2], voffB[2];
#pragma unroll
    for (int i = 0; i < 2; ++i) { int R, C; stage_rc(tid * 16 + i * 8192, R, C); const int Rb = Epi::PERM ? ((R & ~31) + perm32(R & 31)) : R;
        voffA[i] = (unsigned)(R * g.lda + C) * 2u; voffB[i] = (unsigned)(Rb * g.ldb + C) * 2u; }
    const size_t kstep = (size_t)(BK * 2);
    const size_t hstepA = (size_t)HALF * g.lda * 2, hstepB = (size_t)HALF * g.ldb * 2;
    const size_t tstepA = 2 * hstepA, tstepB = 2 * hstepB;
    const unsigned ldsw = (unsigned)wid * 1024u;
    const int aoff = lds_byte(wr * 64 + fr, fq * 8), boff = lds_byte(wc * 32 + fr, fq * 8);
#define PG8_SA(b, h) (((b) * 2 + (h)) * HTB)
#define PG8_SB(b, h) ((4 + (b) * 2 + (h)) * HTB)
#define PG8_STAGE(bufoff, gbase, voff) do { _Pragma("unroll") for (int _i = 0; _i < 2; ++_i) \
        __builtin_amdgcn_global_load_lds((const unsigned*)((const char*)(gbase) + (voff)[_i]), (PG8_LAS unsigned*)(lds + (bufoff) + ldsw + _i * 8192), 16, 0, 0); } while (0)
#define PG8_LDA(dst, b, h) do { _Pragma("unroll") for (int m = 0; m < 4; ++m) _Pragma("unroll") for (int k = 0; k < 2; ++k) dst[m][k] = *(const PG8_LAS bf16x8*)(lds + PG8_SA(b, h) + aoff + m * 2048 + k * 1024); } while (0)
#define PG8_LDB(dst, b, h) do { _Pragma("unroll") for (int n = 0; n < 2; ++n) _Pragma("unroll") for (int k = 0; k < 2; ++k) dst[n][k] = *(const PG8_LAS bf16x8*)(lds + PG8_SB(b, h) + boff + n * 2048 + k * 1024); } while (0)
#define PG8_MMA(ai, bj, At, Bt) do { __builtin_amdgcn_s_setprio(1); _Pragma("unroll") for (int m = 0; m < 4; ++m) _Pragma("unroll") for (int n = 0; n < 2; ++n) _Pragma("unroll") for (int k = 0; k < 2; ++k) \
        acc[ai][bj][m][n] = mma_sel<I8>(Bt[n][k], At[m][k], acc[ai][bj][m][n]); __builtin_amdgcn_s_setprio(0); } while (0)
#define PG8_WAIT_V(n) asm volatile("s_waitcnt vmcnt(" #n ")" ::: "memory")
#define PG8_WAIT_L(n) asm volatile("s_waitcnt lgkmcnt(" #n ")" ::: "memory")
#define PG8_BAR __builtin_amdgcn_s_barrier()
#define PG8_SCHED __builtin_amdgcn_sched_barrier(0)
    Unit cur, nxt; int ui = 0;
    if (!S.next(0, cur)) return;
    f32x4 acc[2][2][4][2];
#pragma unroll
    for (int a = 0; a < 2; ++a)
#pragma unroll
        for (int b = 0; b < 2; ++b)
#pragma unroll
            for (int m = 0; m < 4; ++m)
#pragma unroll
                for (int n = 0; n < 2; ++n) acc[a][b][m][n] = (f32x4){0.f, 0.f, 0.f, 0.f};
    bf16x8 At[4][2], B0[2][2], B1[2][2];
    const char* cA = (const char*)g.A + (size_t)cur.pm * tstepA; const char* cB = (const char*)g.Bt + (size_t)cur.pn * tstepB;
    S.a_ready(cur);
    if constexpr (SP2) {
        PG8_STAGE(PG8_SB(0, 0), cB, voffB); PG8_STAGE(PG8_SB(0, 1), cB + hstepB, voffB); PG8_STAGE(PG8_SA(0, 0), cA, voffA); PG8_STAGE(PG8_SA(0, 1), cA + hstepA, voffA);
        if (wr == 1) PG8_BAR;
        PG8_WAIT_V(2); PG8_BAR;
        PG8_STAGE(PG8_SB(1, 0), cB + kstep, voffB); PG8_STAGE(PG8_SA(1, 0), cA + kstep, voffA); PG8_STAGE(PG8_SB(1, 1), cB + hstepB + kstep, voffB);
        PG8_WAIT_V(6); PG8_BAR;
    } else {
        PG8_STAGE(PG8_SB(0, 0), cB, voffB); PG8_STAGE(PG8_SA(0, 0), cA, voffA); PG8_STAGE(PG8_SB(0, 1), cB + hstepB, voffB); PG8_STAGE(PG8_SA(0, 1), cA + hstepA, voffA);
        if (wr == 1) PG8_BAR;
        PG8_WAIT_V(4); PG8_BAR;
        PG8_STAGE(PG8_SB(1, 0), cB + kstep, voffB); PG8_STAGE(PG8_SA(1, 0), cA + kstep, voffA); PG8_STAGE(PG8_SB(1, 1), cB + hstepB + kstep, voffB);
        PG8_WAIT_V(6); PG8_BAR;
    }
    for (;;) {
        const bool has_next = S.next(ui + 1, nxt);
        const char* nA = has_next ? (const char*)g.A + (size_t)nxt.pm * tstepA : cA; const char* nB = has_next ? (const char*)g.Bt + (size_t)nxt.pn * tstepB : cB;
        for (int t = 0; t < nt; t += 2) {
            if constexpr (Epi::MIDK) { if (t == E.t1 || t == E.t2) E.mid(acc, cur, t == E.t1 ? 0 : 1, wr, wc, fr, fq); }
            const bool last = (t == nt - 2);
            const char* a1 = cA + (size_t)(t + 1) * kstep;
            const char* a2 = last ? nA : cA + (size_t)(t + 2) * kstep; const char* b2 = last ? nB : cB + (size_t)(t + 2) * kstep;
            const char* a3 = a2 + kstep; const char* b3 = b2 + kstep;
            if (last && has_next) S.a_ready(nxt);
            if constexpr (SP2) {
            PG8_LDB(B0, 0, 0); PG8_LDB(B1, 0, 1); PG8_SCHED; PG8_LDA(At, 0, 0); PG8_STAGE(PG8_SA(1, 1), a1 + hstepA, voffA);
            PG8_WAIT_V(8); PG8_WAIT_L(0); PG8_BAR; PG8_MMA(0, 0, At, B0); PG8_MMA(0, 1, At, B1); PG8_BAR; PG8_SCHED;
            PG8_LDA(At, 0, 1); PG8_STAGE(PG8_SB(0, 0), b2, voffB); PG8_STAGE(PG8_SB(0, 1), b2 + hstepB, voffB); PG8_STAGE(PG8_SA(0, 0), a2, voffA);
            PG8_WAIT_V(8); PG8_WAIT_L(0); PG8_BAR; PG8_MMA(1, 0, At, B0); PG8_MMA(1, 1, At, B1); PG8_BAR; PG8_SCHED;
            PG8_LDB(B0, 1, 0); PG8_LDB(B1, 1, 1); PG8_SCHED; PG8_LDA(At, 1, 0); PG8_STAGE(PG8_SA(0, 1), a2 + hstepA, voffA);
            PG8_WAIT_V(8); PG8_WAIT_L(0); PG8_BAR; PG8_MMA(0, 0, At, B0); PG8_MMA(0, 1, At, B1); PG8_BAR; PG8_SCHED;
            PG8_LDA(At, 1, 1); PG8_STAGE(PG8_SB(1, 0), b3, voffB); PG8_STAGE(PG8_SB(1, 1), b3 + hstepB, voffB); PG8_STAGE(PG8_SA(1, 0), a3, voffA);
            PG8_WAIT_V(8); PG8_WAIT_L(0); PG8_BAR; PG8_MMA(1, 0, At, B0); PG8_MMA(1, 1, At, B1); PG8_BAR; PG8_SCHED;
            } else {
            PG8_LDB(B0, 0, 0); PG8_SCHED; PG8_LDA(At, 0, 0); PG8_STAGE(PG8_SA(1, 1), a1 + hstepA, voffA);
            PG8_WAIT_L(8); PG8_BAR; PG8_WAIT_L(0); PG8_MMA(0, 0, At, B0); PG8_BAR; PG8_SCHED;
            PG8_LDB(B1, 0, 1); PG8_STAGE(PG8_SB(0, 0), b2, voffB);
            PG8_BAR; PG8_WAIT_L(0); PG8_MMA(0, 1, At, B1); PG8_BAR;
            PG8_LDA(At, 0, 1); PG8_STAGE(PG8_SA(0, 0), a2, voffA);
            PG8_BAR; PG8_WAIT_L(0); PG8_MMA(1, 0, At, B0); PG8_BAR; PG8_SCHED;
            PG8_STAGE(PG8_SB(0, 1), b2 + hstepB, voffB);
            PG8_WAIT_V(6); PG8_BAR; PG8_MMA(1, 1, At, B1); PG8_BAR;
            PG8_LDB(B0, 1, 0); PG8_SCHED; PG8_LDA(At, 1, 0); PG8_STAGE(PG8_SA(0, 1), a2 + hstepA, voffA);
            PG8_WAIT_L(8); PG8_BAR; PG8_WAIT_L(0); PG8_MMA(0, 0, At, B0); PG8_BAR; PG8_SCHED;
            PG8_LDB(B1, 1, 1); PG8_STAGE(PG8_SB(1, 0), b3, voffB);
            PG8_BAR; PG8_WAIT_L(0); PG8_MMA(0, 1, At, B1); PG8_BAR;
            PG8_LDA(At, 1, 1); PG8_STAGE(PG8_SA(1, 0), a3, voffA);
            PG8_BAR; PG8_WAIT_L(0); PG8_MMA(1, 0, At, B0); PG8_BAR; PG8_SCHED;
            PG8_STAGE(PG8_SB(1, 1), b3 + hstepB, voffB);
            PG8_WAIT_V(6); PG8_BAR; PG8_MMA(1, 1, At, B1); PG8_BAR;
            }
        }
        if constexpr (ALIGN_EPI) { if (wr == 0) PG8_BAR; }
        if constexpr (!Epi::AFTER_DRAIN) { E(acc, cur, wr, wc, fr, fq); S.done(cur); }
        if (!has_next) break;
#pragma unroll
        for (int a = 0; a < 2; ++a)
#pragma unroll
            for (int b = 0; b < 2; ++b)
#pragma unroll
                for (int m = 0; m < 4; ++m)
#pragma unroll
                    for (int n = 0; n < 2; ++n) acc[a][b][m][n] = (f32x4){0.f, 0.f, 0.f, 0.f};
        cur = nxt; cA = nA; cB = nB; ++ui;
        if constexpr (ALIGN_EPI) { if (wr == 1) PG8_BAR; }
    }
    PG8_WAIT_V(0);
    if constexpr (!ALIGN_EPI) { if (wr == 0) PG8_BAR; }
    PG8_BAR;
    if constexpr (Epi::AFTER_DRAIN) { E.fused(acc, cur, wr, wc, fr, fq, lds, wid, lane); S.done(cur); }
#undef PG8_SA
#undef PG8_SB
#undef PG8_STAGE
#undef PG8_LDA
#undef PG8_LDB
#undef PG8_MMA
#undef PG8_WAIT_V
#undef PG8_WAIT_L
#undef PG8_BAR
#undef PG8_SCHED
}
struct EpiF32 {
    static constexpr bool PERM = false, AFTER_DRAIN = false, MIDK = false;
    float* C; int ldc;
    __device__ __forceinline__ void operator()(const f32x4 (&acc)[2][2][4][2], const Unit& u, int wr, int wc, int fr, int fq) const {
        const int row0 = u.pm * BM + wr * 64 + fr, col0 = u.pn * BM + wc * 32 + 4 * fq;
#pragma unroll
        for (int ai = 0; ai < 2; ++ai)
#pragma unroll
            for (int m = 0; m < 4; ++m) { float* rowp = C + (size_t)(row0 + ai * HALF + m * 16) * ldc + col0;
#pragma unroll
                for (int bj = 0; bj < 2; ++bj)
#pragma unroll
                    for (int n = 0; n < 2; ++n) *(f32x4*)(rowp + bj * HALF + n * 16) = acc[ai][bj][m][n]; }
    }
};
__device__ __forceinline__ float bfu(unsigned short h) { return __uint_as_float(((unsigned)h) << 16); }
__device__ __forceinline__ float sigm(float x) { return 1.0f / (1.0f + __expf(-x)); }
struct EpiUp {
    static constexpr bool PERM = true, AFTER_DRAIN = false, MIDK = true;
    const unsigned char* g8; int ldg;
    bf16_t* merged; int t1, t2;
    __device__ __forceinline__ void mid(f32x4 (&acc)[2][2][4][2], const Unit& u, int which, int wr, int wc, int fr, int fq) const {
        int row0 = u.pm * BM + wr * 64 + fr, col0 = u.pn * BM + wc * 32 + 8 * fq;
        asm volatile("" : "+v"(row0), "+v"(col0));
#pragma unroll
        for (int ai = 0; ai < 2; ++ai) {
            u32x2 gd[4][2], gn[4][2];
#pragma unroll
            for (int m = 0; m < 4; ++m)
#pragma unroll
                for (int bj = 0; bj < 2; ++bj) { const unsigned char* gp = g8 + (size_t)(row0 + ai * HALF + m * 16) * ldg + col0 + bj * HALF;
                    gd[m][bj] = *(const u32x2*)(gp + which * 2048); gn[m][bj] = *(const u32x2*)(gp + (which + 1) * 2048); }
            asm volatile("" ::: "memory");
#pragma unroll
            for (int m = 0; m < 4; ++m)
#pragma unroll
                for (int bj = 0; bj < 2; ++bj) {
#pragma unroll
                    for (int i = 0; i < 4; ++i) {
                        acc[ai][bj][m][0][i] *= (float)((gd[m][bj].x >> (8 * i)) & 0xffu) * __builtin_amdgcn_rcpf((float)((gn[m][bj].x >> (8 * i)) & 0xffu));
                        acc[ai][bj][m][1][i] *= (float)((gd[m][bj].y >> (8 * i)) & 0xffu) * __builtin_amdgcn_rcpf((float)((gn[m][bj].y >> (8 * i)) & 0xffu)); } }
            asm volatile("" ::: "memory");
        }
    }
    __device__ __forceinline__ void operator()(const f32x4 (&acc)[2][2][4][2], const Unit& u, int wr, int wc, int fr, int fq) const {
        const int row0 = u.pm * BM + wr * 64 + fr, col0 = u.pn * BM + wc * 32 + 8 * fq;
        u32x2 g2[2][4][2];
#pragma unroll
        for (int ai = 0; ai < 2; ++ai)
#pragma unroll
            for (int m = 0; m < 4; ++m)
#pragma unroll
                for (int bj = 0; bj < 2; ++bj) g2[ai][m][bj] = *(const u32x2*)(g8 + (size_t)(row0 + ai * HALF + m * 16) * ldg + 2 * 2048 + col0 + bj * HALF);
#pragma unroll
        for (int ai = 0; ai < 2; ++ai)
#pragma unroll
            for (int m = 0; m < 4; ++m) { const size_t row = (size_t)(row0 + ai * HALF + m * 16);
#pragma unroll
                for (int bj = 0; bj < 2; ++bj) { const int col = col0 + bj * HALF;
                    f32x4 v0 = acc[ai][bj][m][0], v1 = acc[ai][bj][m][1];
#pragma unroll
                    for (int i = 0; i < 4; ++i) { v0[i] *= (float)((g2[ai][m][bj].x >> (8 * i)) & 0xffu) * (1.f / 255.f); v1[i] *= (float)((g2[ai][m][bj].y >> (8 * i)) & 0xffu) * (1.f / 255.f); }
                    u32x4 w; w.x = cvt_pk_bf16(v0[0], v0[1]); w.y = cvt_pk_bf16(v0[2], v0[3]); w.z = cvt_pk_bf16(v1[0], v1[1]); w.w = cvt_pk_bf16(v1[2], v1[3]);
                    *(u32x4*)(merged + row * 2048 + col) = w; } }
    }
};
struct EpiOut {
    static constexpr bool PERM = true, AFTER_DRAIN = false, MIDK = false;
    const float* x; bf16_t* xg; float* rowss;
    __device__ __forceinline__ void operator()(const f32x4 (&acc)[2][2][4][2], const Unit& u, int wr, int wc, int fr, int fq) const {
        const int row0 = u.pm * BM + wr * 64 + fr, col0 = u.pn * BM + wc * 32 + 8 * fq;
#pragma unroll
        for (int ai = 0; ai < 2; ++ai) {
            f32x4 xv[4][2][2];
#pragma unroll
            for (int m = 0; m < 4; ++m)
#pragma unroll
                for (int bj = 0; bj < 2; ++bj) { const float* xp = x + (size_t)(row0 + ai * HALF + m * 16) * 2048 + col0 + bj * HALF; xv[m][bj][0] = *(const f32x4*)xp; xv[m][bj][1] = *(const f32x4*)(xp + 4); }
            asm volatile("" ::: "memory");
#pragma unroll
            for (int m = 0; m < 4; ++m) { const size_t row = (size_t)(row0 + ai * HALF + m * 16); float ss = 0.f;
#pragma unroll
                for (int bj = 0; bj < 2; ++bj) { const int col = col0 + bj * HALF; const size_t off = row * 2048 + col;
                    const f32x4 v0 = acc[ai][bj][m][0] + xv[m][bj][0], v1 = acc[ai][bj][m][1] + xv[m][bj][1];
                    ss += (v0[0] * v0[0] + v0[1] * v0[1]) + (v0[2] * v0[2] + v0[3] * v0[3]) + (v1[0] * v1[0] + v1[1] * v1[1]) + (v1[2] * v1[2] + v1[3] * v1[3]);
                    u32x4 w; w.x = cvt_pk_bf16(v0[0], v0[1]); w.y = cvt_pk_bf16(v0[2], v0[3]); w.z = cvt_pk_bf16(v1[0], v1[1]); w.w = cvt_pk_bf16(v1[2], v1[3]);
                    *(u32x4*)(xg + off) = w; }
                ss += __shfl_xor(ss, 16); ss += __shfl_xor(ss, 32);
                if (fq == 0) rowss[row * 32 + u.pn * 4 + wc] = ss; }
            asm volatile("" ::: "memory");
        }
    }
};
struct EpiI8 {
    static constexpr bool PERM = true, AFTER_DRAIN = false, MIDK = false;
    bf16_t* O; int ldc; const float* sa; const float* sb; int gcol0; unsigned char* g8; int ldg; const float* bg;
    __device__ __forceinline__ static unsigned gq(float x, unsigned w, int byte) { const float e = __builtin_amdgcn_exp2f(x), s255 = __builtin_amdgcn_rcpf(__builtin_fmaf(e, 1.f / 255.f, 1.f / 255.f));
        return __builtin_amdgcn_cvt_pk_u8_f32(__builtin_rintf(fmaxf(s255, 1.f)), byte, w); }
    __device__ __forceinline__ void operator()(const f32x4 (&acc)[2][2][4][2], const Unit& u, int wr, int wc, int fr, int fq) const {
        const int row0 = u.pm * BM + wr * 64 + fr, col0 = u.pn * BM + wc * 32 + 8 * fq;
        f32x4 sb0[2], sb1[2];
#pragma unroll
        for (int bj = 0; bj < 2; ++bj) { sb0[bj] = *(const f32x4*)(sb + col0 + bj * HALF); sb1[bj] = *(const f32x4*)(sb + col0 + bj * HALF + 4); }
        float rsc[2][4];
#pragma unroll
        for (int ai = 0; ai < 2; ++ai)
#pragma unroll
            for (int m = 0; m < 4; ++m) rsc[ai][m] = sa[row0 + ai * HALF + m * 16];
        if (u.pn * BM >= gcol0) {
            f32x4 bg0[2], bg1[2];
#pragma unroll
            for (int bj = 0; bj < 2; ++bj) { bg0[bj] = *(const f32x4*)(bg + col0 - gcol0 + bj * HALF) * -1.44269504089f; bg1[bj] = *(const f32x4*)(bg + col0 - gcol0 + bj * HALF + 4) * -1.44269504089f;
                sb0[bj] = sb0[bj] * -1.44269504089f; sb1[bj] = sb1[bj] * -1.44269504089f; }
            asm volatile("" ::: "memory");
#pragma unroll
            for (int ai = 0; ai < 2; ++ai)
#pragma unroll
                for (int m = 0; m < 4; ++m) { const int row = row0 + ai * HALF + m * 16; const float ra = rsc[ai][m]; unsigned char* rowp = g8 + (size_t)row * ldg + (col0 - gcol0);
#pragma unroll
                    for (int bj = 0; bj < 2; ++bj) { const i32x4 a0 = __builtin_bit_cast(i32x4, acc[ai][bj][m][0]), a1 = __builtin_bit_cast(i32x4, acc[ai][bj][m][1]);
                        u32x2 w; w.x = 0u; w.y = 0u;
#pragma unroll
                        for (int i = 0; i < 4; ++i) { w.x = gq(__builtin_fmaf((float)a0[i] * ra, sb0[bj][i], bg0[bj][i]), w.x, i); w.y = gq(__builtin_fmaf((float)a1[i] * ra, sb1[bj][i], bg1[bj][i]), w.y, i); }
                        *(u32x2*)(rowp + bj * HALF) = w; } }
            return; }
        asm volatile("" ::: "memory");
#pragma unroll
        for (int ai = 0; ai < 2; ++ai)
#pragma unroll
            for (int m = 0; m < 4; ++m) { const int row = row0 + ai * HALF + m * 16; const float ra = rsc[ai][m]; bf16_t* rowp = O + (size_t)row * ldc + col0;
#pragma unroll
                for (int bj = 0; bj < 2; ++bj) { const i32x4 a0 = __builtin_bit_cast(i32x4, acc[ai][bj][m][0]), a1 = __builtin_bit_cast(i32x4, acc[ai][bj][m][1]);
                    const f32x4 v0 = {(float)a0[0] * ra * sb0[bj][0], (float)a0[1] * ra * sb0[bj][1], (float)a0[2] * ra * sb0[bj][2], (float)a0[3] * ra * sb0[bj][3]};
                    const f32x4 v1 = {(float)a1[0] * ra * sb1[bj][0], (float)a1[1] * ra * sb1[bj][1], (float)a1[2] * ra * sb1[bj][2], (float)a1[3] * ra * sb1[bj][3]};
                    u32x4 w; w.x = cvt_pk_bf16(v0[0], v0[1]); w.y = cvt_pk_bf16(v0[2], v0[3]); w.z = cvt_pk_bf16(v1[0], v1[1]); w.w = cvt_pk_bf16(v1[2], v1[3]);
                    *(u32x4*)(rowp + bj * HALF) = w; } }
    }
};
}
constexpr int NWAVES = 8, NTHR = 512;
constexpr int BATCH = 2, SEQ = 4096, DM = 2048, T = BATCH * SEQ;
constexpr int NIN = 12800, MEML = 256, MROWS = BATCH * MEML;
constexpr int HG_H = 6, DIL_H = 12, MEM_H = 4;
constexpr int C_Q = 0, C_V = 768, C_ZF = 1536, C_ZB = 2304, C_HG = 3072, C_DQ = 3840, C_DK = 4608, C_DV = 5376, C_MQ = 6144, C_GATE = 6656;
constexpr int NEXP = 16384;
constexpr float EPS = 1e-6f;
constexpr size_t MiB = 1u << 20;
constexpr size_t WS_CTL = 0;
constexpr size_t WS_LBF = 64 * 1024, WS_LBB = WS_LBF + 4096, WS_ROWSS = 128 * 1024  , WS_SKB = 256 * 1024  , WS_DEC = 512 * 1024  ;
constexpr size_t WS_WIN = 1 * MiB;
constexpr size_t WS_MERGED = WS_WIN;
constexpr size_t WS_WUP = 51 * MiB, WS_WOUT = 59 * MiB, WS_WQ = 67 * MiB, WS_WKV = 75 * MiB;
constexpr size_t WS_KVM = 79 * MiB, WS_KVMT = 80 * MiB;
constexpr size_t WS_MEMN = 81 * MiB;
constexpr size_t WS_LSE = 83 * MiB;
constexpr size_t WS_D = 84 * MiB;
constexpr size_t WS_IDX = 85 * MiB, WS_GATE = 89 * MiB;
constexpr size_t WS_UQ = 93 * MiB, WS_VQ = 125 * MiB;
constexpr size_t WS_SU = 157 * MiB, WS_SV = 157 * MiB + 65536;
constexpr size_t WS_H = 221 * MiB;
constexpr size_t WS_OCAT = WS_H;
constexpr size_t WS_ST = 253 * MiB;
constexpr size_t WS_PROJ = 301 * MiB;
constexpr size_t WS_XG = WS_PROJ, WS_QP = WS_PROJ + 32 * MiB, WS_SC = WS_PROJ + 64 * MiB;
constexpr size_t WS_RSP = 501 * MiB;
constexpr size_t WS_XQ = WS_PROJ + 128 * MiB;
constexpr size_t WS_SX = WS_PROJ + 144 * MiB;
constexpr size_t WS_PA = WS_PROJ + 145 * MiB;
constexpr size_t WS_G8 = 162 * MiB;
constexpr size_t WS_SA = 160 * MiB, WS_SB = 160 * MiB + 65536;
constexpr size_t WS_CMAX = 502 * MiB + 512 * 1024;
constexpr size_t WS_BAR = 502 * MiB;
constexpr size_t BAR_REGION = 20480, BAR_ZERO = 640 * 1024;
constexpr size_t WS_END = 503 * MiB;
constexpr int LDS_BYTES = 152576;
#define GAS __attribute__((address_space(1)))
#define LAS __attribute__((address_space(3)))
typedef unsigned short bf16;
typedef unsigned v4u __attribute__((ext_vector_type(4)));
typedef unsigned v2u __attribute__((ext_vector_type(2)));
typedef float f32x4 __attribute__((ext_vector_type(4)));
typedef float f32x16 __attribute__((ext_vector_type(16)));
typedef short bf16x8 __attribute__((ext_vector_type(8)));
__device__ __forceinline__ float bf2f(unsigned short h) { return __uint_as_float(((unsigned)h) << 16); }
typedef __bf16 hwbf2 __attribute__((ext_vector_type(2)));
typedef float f32x2_ __attribute__((ext_vector_type(2)));
__device__ __forceinline__ unsigned pk2(float lo, float hi) { const f32x2_ v = {lo, hi}; return __builtin_bit_cast(unsigned, __builtin_convertvector(v, hwbf2)); }
__device__ __forceinline__ unsigned f2bf(float f) { return pk2(f, f) & 0xffffu; }
__device__ __forceinline__ float wave_sum(float v) {
#pragma unroll
    for (int o = 1; o < 64; o <<= 1) v += __shfl_xor(v, o);
    return v;
}
__device__ __forceinline__ float wave_max(float v) {
#pragma unroll
    for (int o = 1; o < 64; o <<= 1) v = fmaxf(v, __shfl_xor(v, o));
    return v;
}
__device__ __forceinline__ float row_rstd(const float* rsp, int t) {
    const f32x4* q = (const f32x4*)(rsp + (size_t)t * 32); float s = 0.f;
#pragma unroll
    for (int i = 0; i < 8; ++i) { const f32x4 v = q[i]; s += (v.x + v.y) + (v.z + v.w); }
    return rsqrtf(s * (1.f / 2048.f) + 1e-6f);
}
__device__ __forceinline__ float sigmoidf_(float x) { return __builtin_amdgcn_rcpf(1.0f + __expf(-x)); }

struct P {
    const GAS float *x, *mem, *g_mix, *w_in, *b_gate, *lbf_l, *lbb_l, *g_hg, *w_kv, *g_mem, *w_up, *w_out, *g_ffn, *w_q, *subk, *pu, *pv, *g_final;
    GAS float* out; GAS float* dst10; GAS unsigned char* ws; int ph_lo, ph_hi;
};
#define WSP(T_, off) ((T_*)(GAS T_*)(p.ws + (off)))

__device__ __forceinline__ void p0_transpose_item(const float* W, int K, int N, bf16* WT, float* scr, int item, int lane, const float* ks = nullptr) {
    const int nblk = N / 32, kb = item / nblk, nb = item % nblk, k0 = 64 * kb, n0 = 32 * nb;
#pragma unroll
    for (int i = 0; i < 8; ++i) { const int kk = 8 * i + (lane >> 3), nq = (lane & 7) * 4; const f32x4 v = *(const f32x4*)(W + (size_t)(k0 + kk) * N + n0 + nq);
        const float sc = ks ? ks[k0 + kk] : 1.f; float* d = scr + kk * 33 + nq; d[0] = v.x * sc; d[1] = v.y * sc; d[2] = v.z * sc; d[3] = v.w * sc; }
    asm volatile("s_waitcnt lgkmcnt(0)" ::: "memory");
    const int c = lane & 7;
#pragma unroll
    for (int j = 0; j < 4; ++j) { const int n = (lane >> 3) + 8 * j; const float* s = scr + (8 * c) * 33 + n;
        v4u o; o.x = pk2(s[0 * 33], s[1 * 33]); o.y = pk2(s[2 * 33], s[3 * 33]); o.z = pk2(s[4 * 33], s[5 * 33]); o.w = pk2(s[6 * 33], s[7 * 33]);
        *(v4u*)(WT + (size_t)(n0 + n) * K + k0 + 8 * c) = o; }
    asm volatile("s_waitcnt lgkmcnt(0)" ::: "memory");
}
__device__ __forceinline__ void rms_row_to_bf16(const float* xrow, const float* g, bf16* orow, int lane) {
    const f32x4* xr = (const f32x4*)xrow + lane; const f32x4* gr = (const f32x4*)g + lane;
    f32x4 v[8]; float s = 0.f;
#pragma unroll
    for (int j = 0; j < 8; ++j) { v[j] = xr[64 * j]; s += (v[j].x * v[j].x + v[j].y * v[j].y) + (v[j].z * v[j].z + v[j].w * v[j].w); }
    const float rstd = rsqrtf(wave_sum(s) * (1.f / DM) + EPS);
    v2u* o8 = (v2u*)orow + lane;
#pragma unroll
    for (int j = 0; j < 8; ++j) { const f32x4 gg = gr[64 * j]; v2u w; w.x = pk2(v[j].x * rstd * gg.x, v[j].y * rstd * gg.y); w.y = pk2(v[j].z * rstd * gg.z, v[j].w * rstd * gg.w); o8[64 * j] = w; }
}
__device__ __forceinline__ unsigned q8b(float v, float inv) { return (unsigned)((int)rintf(v * inv)) & 0xffu; }
__device__ __forceinline__ void rms_row_to_i8(const float* xrow, const float* g, unsigned char* orow, float* scale, int lane) {
    const f32x4* xr = (const f32x4*)xrow + lane; const f32x4* gr = (const f32x4*)g + lane;
    f32x4 v[8]; float s = 0.f;
#pragma unroll
    for (int j = 0; j < 8; ++j) { v[j] = xr[64 * j]; s += (v[j].x * v[j].x + v[j].y * v[j].y) + (v[j].z * v[j].z + v[j].w * v[j].w); }
    const float rstd = rsqrtf(wave_sum(s) * (1.f / DM) + EPS); float m = 0.f;
#pragma unroll
    for (int j = 0; j < 8; ++j) { const f32x4 gg = gr[64 * j]; v[j] = v[j] * rstd * gg; m = fmaxf(fmaxf(m, fmaxf(fabsf(v[j].x), fabsf(v[j].y))), fmaxf(fabsf(v[j].z), fabsf(v[j].w))); }
    m = fmaxf(wave_max(m), 1e-30f); const float inv = 127.f / m;
    unsigned* o = (unsigned*)orow + lane;
#pragma unroll
    for (int j = 0; j < 8; ++j) o[64 * j] = q8b(v[j].x, inv) | (q8b(v[j].y, inv) << 8) | (q8b(v[j].z, inv) << 16) | (q8b(v[j].w, inv) << 24);
    if (lane == 0) *scale = m * (1.f / 127.f);
}
__device__ __forceinline__ void p0_qtranspose_item(const float* W, int K, int N, unsigned char* W8T, const unsigned* cmax, float* sb, float* scr, int item, int lane) {
    const int nblk = N / 32, kb = item / nblk, nb = item % nblk, k0 = 64 * kb, n0 = 32 * nb;
#pragma unroll
    for (int i = 0; i < 8; ++i) { const int kk = 8 * i + (lane >> 3), nq = (lane & 7) * 4; const f32x4 v = *(const f32x4*)(W + (size_t)(k0 + kk) * N + n0 + nq);
        float* d = scr + kk * 33 + nq; d[0] = v.x; d[1] = v.y; d[2] = v.z; d[3] = v.w; }
    asm volatile("s_waitcnt lgkmcnt(0)" ::: "memory");
    const int c = lane & 7;
#pragma unroll
    for (int j = 0; j < 4; ++j) { const int n = (lane >> 3) + 8 * j; const float* s = scr + (8 * c) * 33 + n;
        const float m = fmaxf(__uint_as_float(cmax[n0 + n]), 1e-30f), inv = 127.f / m;
        v2u o; o.x = q8b(s[0 * 33], inv) | (q8b(s[1 * 33], inv) << 8) | (q8b(s[2 * 33], inv) << 16) | (q8b(s[3 * 33], inv) << 24);
        o.y = q8b(s[4 * 33], inv) | (q8b(s[5 * 33], inv) << 8) | (q8b(s[6 * 33], inv) << 16) | (q8b(s[7 * 33], inv) << 24);
        *(v2u*)(W8T + (size_t)(n0 + n) * K + k0 + 8 * c) = o;
        if (kb == 0 && c == 0) sb[n0 + n] = m * (1.f / 127.f); }
    asm volatile("s_waitcnt lgkmcnt(0)" ::: "memory");
}
__device__ __forceinline__ void p0_win_strip(const P& p, unsigned char* lds, int strip) {
    const int tid = tidx(), lane = tid & 63, wave = tid >> 6;
    const int n0 = strip * 32 + 4 * (lane & 7), kbase = 256 * wave + 32 * (lane >> 3);
    const float* wp = ((const float*)p.w_in) + (size_t)kbase * NIN + n0;
    f32x4 v[32];
#pragma unroll
    for (int i = 0; i < 32; ++i) v[i] = __builtin_nontemporal_load((const f32x4*)(wp + (size_t)i * NIN));
    f32x4 m = {0.f, 0.f, 0.f, 0.f};
#pragma unroll
    for (int i = 0; i < 32; ++i) { m.x = fmaxf(m.x, fabsf(v[i].x)); m.y = fmaxf(m.y, fabsf(v[i].y)); m.z = fmaxf(m.z, fabsf(v[i].z)); m.w = fmaxf(m.w, fabsf(v[i].w)); }
#pragma unroll
    for (int d = 8; d < 64; d <<= 1) { m.x = fmaxf(m.x, __shfl_xor(m.x, d)); m.y = fmaxf(m.y, __shfl_xor(m.y, d)); m.z = fmaxf(m.z, __shfl_xor(m.z, d)); m.w = fmaxf(m.w, __shfl_xor(m.w, d)); }
    float* red = (float*)lds;
    __syncthreads();
    if (lane < 8) *(f32x4*)(red + wave * 32 + 4 * lane) = m;
    __syncthreads();
    f32x4 mm = *(const f32x4*)(red + 4 * (lane & 7));
#pragma unroll
    for (int w = 1; w < 8; ++w) { const f32x4 t = *(const f32x4*)(red + w * 32 + 4 * (lane & 7)); mm.x = fmaxf(mm.x, t.x); mm.y = fmaxf(mm.y, t.y); mm.z = fmaxf(mm.z, t.z); mm.w = fmaxf(mm.w, t.w); }
    mm.x = fmaxf(mm.x, 1e-30f); mm.y = fmaxf(mm.y, 1e-30f); mm.z = fmaxf(mm.z, 1e-30f); mm.w = fmaxf(mm.w, 1e-30f);
    if (wave == 0 && lane < 8) *(f32x4*)(WSP(float, WS_SB) + n0) = mm * (1.f / 127.f);
    const float inv[4] = {127.f / mm.x, 127.f / mm.y, 127.f / mm.z, 127.f / mm.w};
    unsigned char* w8 = (unsigned char*)(p.ws + WS_WIN);
#pragma unroll
    for (int c = 0; c < 4; ++c) { unsigned d[8];
#pragma unroll
        for (int q = 0; q < 8; ++q) d[q] = q8b(v[4 * q][c], inv[c]) | (q8b(v[4 * q + 1][c], inv[c]) << 8) | (q8b(v[4 * q + 2][c], inv[c]) << 16) | (q8b(v[4 * q + 3][c], inv[c]) << 24);
        v4u lo, hi; lo.x = d[0]; lo.y = d[1]; lo.z = d[2]; lo.w = d[3]; hi.x = d[4]; hi.y = d[5]; hi.z = d[6]; hi.w = d[7];
        unsigned char* o = w8 + (size_t)(n0 + c) * DM + kbase; *(v4u*)o = lo; *(v4u*)(o + 16) = hi; }
}
__device__ __forceinline__ void phase0(const P& p, unsigned char* lds, int vcu, int G, int bx) {
    const int tid = tidx(), lane = tid & 63, wave = tid >> 6;
    float* scr = (float*)(lds + wave * 16384);
    const int gw = vcu * NWAVES + wave, NGW = G * NWAVES;
    for (int strip = bx; strip < NIN / 32; strip += G) p0_win_strip(p, lds, strip);
    __syncthreads();
    constexpr int I_KV = (DM / 64) * (1024 / 32);
    for (int it = gw; it < I_KV; it += NGW) p0_transpose_item(((const float*)p.w_kv), DM, 1024, WSP(bf16, WS_WKV), scr, it, lane);
    const int nstr2 = NIN / 32 - G;
    const bool wsplit = (G == 256);
    const int xcnt = wsplit ? (bx < nstr2 ? 18 : 50) : T / G, xbase = wsplit ? (bx < nstr2 ? bx * 18 : nstr2 * 18 + (bx - nstr2) * 50) : bx * (T / G);
    for (int r = wave; r < xcnt; r += 16) {
        const int m = xbase + r, m2 = m + 8; const bool two = r + 8 < xcnt;
        const f32x4* xa = (const f32x4*)(((const float*)p.x) + (size_t)m * DM) + lane; const f32x4* xb = (const f32x4*)(((const float*)p.x) + (size_t)(two ? m2 : m) * DM) + lane; const f32x4* gr = (const f32x4*)((const float*)p.g_mix) + lane;
        f32x4 va[8], vb[8]; float sa_ = 0.f, sb_ = 0.f;
#pragma unroll
        for (int j = 0; j < 8; ++j) { va[j] = __builtin_nontemporal_load(xa + 64 * j); vb[j] = __builtin_nontemporal_load(xb + 64 * j); }
#pragma unroll
        for (int j = 0; j < 8; ++j) { sa_ += (va[j].x * va[j].x + va[j].y * va[j].y) + (va[j].z * va[j].z + va[j].w * va[j].w); sb_ += (vb[j].x * vb[j].x + vb[j].y * vb[j].y) + (vb[j].z * vb[j].z + vb[j].w * vb[j].w); }
        const float ra = rsqrtf(wave_sum(sa_) * (1.f / DM) + EPS), rb = rsqrtf(wave_sum(sb_) * (1.f / DM) + EPS); float ma = 0.f, mb = 0.f;
#pragma unroll
        for (int j = 0; j < 8; ++j) { const f32x4 gg = gr[64 * j]; va[j] = va[j] * ra * gg; vb[j] = vb[j] * rb * gg;
            ma = fmaxf(fmaxf(ma, fmaxf(fabsf(va[j].x), fabsf(va[j].y))), fmaxf(fabsf(va[j].z), fabsf(va[j].w))); mb = fmaxf(fmaxf(mb, fmaxf(fabsf(vb[j].x), fabsf(vb[j].y))), fmaxf(fabsf(vb[j].z), fabsf(vb[j].w))); }
        ma = fmaxf(wave_max(ma), 1e-30f); mb = fmaxf(wave_max(mb), 1e-30f); const float ia = 127.f / ma, ib = 127.f / mb;
        unsigned* oa = (unsigned*)((unsigned char*)(p.ws + WS_H) + (size_t)m * DM) + lane; unsigned* ob = (unsigned*)((unsigned char*)(p.ws + WS_H) + (size_t)m2 * DM) + lane;
#pragma unroll
        for (int j = 0; j < 8; ++j) { oa[64 * j] = q8b(va[j].x, ia) | (q8b(va[j].y, ia) << 8) | (q8b(va[j].z, ia) << 16) | (q8b(va[j].w, ia) << 24);
            if (two) ob[64 * j] = q8b(vb[j].x, ib) | (q8b(vb[j].y, ib) << 8) | (q8b(vb[j].z, ib) << 16) | (q8b(vb[j].w, ib) << 24); }
        if (lane == 0) { WSP(float, WS_SA)[m] = ma * (1.f / 127.f); if (two) WSP(float, WS_SA)[m2] = mb * (1.f / 127.f); }
    }
    for (int m = gw; m < MROWS; m += NGW) rms_row_to_bf16(((const float*)p.mem) + (size_t)m * DM, ((const float*)p.g_mem), WSP(bf16, WS_MEMN) + (size_t)m * DM, lane);
    const size_t gt = (size_t)vcu * NTHR + tid, NGT = (size_t)G * NTHR;
    for (size_t i = gt; i < 32768; i += NGT) WSP(bf16, WS_SKB)[i] = (bf16)f2bf(((const float*)p.subk)[i]);
    for (size_t i = gt; i < 768; i += NGT) { WSP(float, WS_LBF)[i] = 1.0f / (1.0f + __expf(((const float*)p.lbf_l)[768 + i] - ((const float*)p.lbf_l)[i])); WSP(float, WS_LBB)[i] = 1.0f / (1.0f + __expf(((const float*)p.lbb_l)[768 + i] - ((const float*)p.lbb_l)[i])); }
}
__device__ __forceinline__ void phase0b(const P& p, unsigned char* lds, int vcu, int G) {}
__device__ __forceinline__ void tail_prep(const P& p, unsigned char* lds, int wi, int nw) {
    const int tid = tidx(), lane = tid & 63, wave = tid >> 6;
    float* scr = (float*)(lds + wave * 16384);
    const int gw = wi * NWAVES + wave, NGW = nw * NWAVES;
    for (int r4 = gw * 4; r4 < 2 * NEXP; r4 += NGW * 4) {
        f32x4 v[4][8];
#pragma unroll
        for (int q = 0; q < 4; ++q) { const int r2 = r4 + q, isv = r2 >= NEXP, row = isv ? r2 - NEXP : r2; const f32x4* xr = (const f32x4*)((isv ? ((const float*)p.pv) : ((const float*)p.pu)) + (size_t)row * DM) + lane;
#pragma unroll
            for (int j = 0; j < 8; ++j) v[q][j] = __builtin_nontemporal_load(xr + 64 * j); }
#pragma unroll
        for (int q = 0; q < 4; ++q) { const int r2 = r4 + q, isv = r2 >= NEXP, row = isv ? r2 - NEXP : r2; float m = 0.f;
            if (!isv) {
#pragma unroll
                for (int j = 0; j < 8; ++j) v[q][j] = v[q][j] * ((const f32x4*)((const float*)p.g_ffn))[64 * j + lane]; }
#pragma unroll
            for (int j = 0; j < 8; ++j) m = fmaxf(fmaxf(m, fmaxf(fabsf(v[q][j].x), fabsf(v[q][j].y))), fmaxf(fabsf(v[q][j].z), fabsf(v[q][j].w)));
            m = fmaxf(wave_max(m), 1e-30f); const float inv = 127.f / m;
            unsigned* o = (unsigned*)(p.ws + (isv ? WS_VQ : WS_UQ) + (size_t)(lane >> 5) * (NEXP * 128) + (size_t)row * 128) + (lane & 31);
#pragma unroll
            for (int j = 0; j < 8; ++j) o[(size_t)j * (2 * NEXP * 128 / 4)] = q8b(v[q][j].x, inv) | (q8b(v[q][j].y, inv) << 8) | (q8b(v[q][j].z, inv) << 16) | (q8b(v[q][j].w, inv) << 24);
            if (lane == 0) WSP(float, isv ? WS_SV : WS_SU)[row] = m * (1.f / 127.f); }
    }
    constexpr int I_SQ = (DM / 64) * (DM / 32);
    for (int it = gw; it < 3 * I_SQ; it += NGW) {
        if (it < I_SQ) p0_transpose_item(((const float*)p.w_up), DM, DM, WSP(bf16, WS_WUP), scr, it, lane);
        else if (it < 2 * I_SQ) p0_transpose_item(((const float*)p.w_out), DM, DM, WSP(bf16, WS_WOUT), scr, it - I_SQ, lane);
        else p0_transpose_item(((const float*)p.w_q), DM, DM, WSP(bf16, WS_WQ), scr, it - 2 * I_SQ, lane, (const float*)p.g_ffn);
    }
}
typedef GAS unsigned gu32;
typedef GAS unsigned long long gu64;
#define RLX_AGENT __ATOMIC_RELAXED, __HIP_MEMORY_SCOPE_AGENT
__device__ __forceinline__ unsigned long long rt() { return __builtin_amdgcn_s_memrealtime(); }
#define XB_TMO      128
#define XB_XCNT(j)  (256  + 64 * (j))
#define XB_XSUB(j)  (1280 + 64 * (j))
#define XB_XGEN(j)  (2304 + 64 * (j))
#define XB_TOP      3328
#define XB_TOPGEN   3392
#define XCD_BAR_WORDS 3456
#define XB_SPIN_CAP (1u << 21)

__device__ __forceinline__ unsigned xb_ld(unsigned* p)              { return __hip_atomic_load(p, __ATOMIC_RELAXED, __HIP_MEMORY_SCOPE_AGENT); }
__device__ __forceinline__ unsigned xb_add(unsigned* p, unsigned v) { return __hip_atomic_fetch_add(p, v, __ATOMIC_RELAXED, __HIP_MEMORY_SCOPE_AGENT); }
__device__ __forceinline__ unsigned xb_xcc_id() { return (unsigned)__builtin_amdgcn_s_getreg((3 << 11) | 20) & 0xFu; }
#define XB_SPIN(cond, bar) do { unsigned _sp = 0; while (cond) { __builtin_amdgcn_s_sleep(1); \
    if ((++_sp & 255u) == 0u) { if (xb_ld(&(bar)[XB_TMO])) break; if (_sp > XB_SPIN_CAP) { atomicAdd(&(bar)[XB_TMO], 1u); break; } } } } while (0)

struct XcdBarrier {
    unsigned* bar; unsigned x;
    volatile LAS unsigned* st;
};

__device__ __forceinline__ XcdBarrier xcd_barrier_post(unsigned* bar, volatile LAS unsigned* st) {
    XcdBarrier b; b.bar = bar; b.x = xb_xcc_id(); b.st = st;
    if (threadIdx.x == 0) (void)xb_add(&bar[XB_XCNT(b.x)], 1u);
    return b;
}
__device__ __forceinline__ void xcd_barrier_complete(unsigned* bar, unsigned x, unsigned& nloc, unsigned& nx) {
    const unsigned G = gridDim.x * gridDim.y * gridDim.z;
    unsigned sum, cnt, mine, sp = 0u;
    for (;;) {
        sum = 0u; cnt = 0u; mine = 0u;
#pragma unroll
        for (unsigned j = 0; j < 16; ++j) { const unsigned c = xb_ld(&bar[XB_XCNT(j)]); sum += c; cnt += (c > 0u) ? 1u : 0u; mine = (j == x) ? c : mine; }
        if (sum == G) break;
        __builtin_amdgcn_s_sleep(1);
        if ((++sp & 255u) == 0u) { if (xb_ld(&bar[XB_TMO])) break; if (sp > XB_SPIN_CAP) { atomicAdd(&bar[XB_TMO], 1u); break; } }
    }
    nloc = mine > 0u ? mine : 1u; nx = cnt > 0u ? cnt : 1u;
}

template <bool REL = true, bool ACQ = true> __device__ __forceinline__ void xcd_barrier(const XcdBarrier& b) {
    asm volatile("s_waitcnt vmcnt(0)" ::: "memory");
    __syncthreads();
    if (threadIdx.x == 0) {
        unsigned* bar = b.bar;
        __builtin_amdgcn_s_waitcnt(0);
        unsigned nloc = b.st[0], nx = b.st[1];
        if (nloc == 0u) { xcd_barrier_complete(bar, b.x, nloc, nx); b.st[0] = nloc; b.st[1] = nx; }
        const unsigned old = xb_add(&bar[XB_XSUB(b.x)], 1u);
        const unsigned gen = old / nloc;
        if (old + 1u == (gen + 1u) * nloc) {
            if constexpr (REL) __builtin_amdgcn_fence(__ATOMIC_RELEASE, "agent");
            asm volatile("s_waitcnt vmcnt(0)" ::: "memory");
            (void)xb_add(&bar[XB_TOP], 1u);
        }
        const unsigned target = (gen + 1u) * nx;
        XB_SPIN((int)(xb_ld(&bar[XB_TOP]) - target) < 0, bar);
        if constexpr (ACQ) __builtin_amdgcn_fence(__ATOMIC_ACQUIRE, "agent");
        asm volatile("s_waitcnt vmcnt(0)" ::: "memory");
    }
    __syncthreads();
}
__device__ __forceinline__ f32x16 mfma32(bf16x8 a, bf16x8 b, f32x16 c) { return __builtin_amdgcn_mfma_f32_32x32x16_bf16(a, b, c, 0, 0, 0); }
__device__ __forceinline__ f32x4 mfma16(bf16x8 a, bf16x8 b, f32x4 c) { return __builtin_amdgcn_mfma_f32_16x16x32_bf16(a, b, c, 0, 0, 0); }
template <int CTRL> __device__ __forceinline__ float dppf(float v) { return __builtin_bit_cast(float, __builtin_amdgcn_update_dpp(0, __builtin_bit_cast(int, v), CTRL, 0xf, 0xf, true)); }
__device__ __forceinline__ float sum8(float v) { v += dppf<0xB1>(v); v += dppf<0x4E>(v); v += dppf<0x141>(v); return v; }
__device__ __forceinline__ float max8(float v) { v = fmaxf(v, dppf<0xB1>(v)); v = fmaxf(v, dppf<0x4E>(v)); v = fmaxf(v, dppf<0x141>(v)); return v; }
__device__ __forceinline__ f32x16 zero16() { f32x16 z; for (int i = 0; i < 16; ++i) z[i] = 0.f; return z; }

__device__ __forceinline__ void h1_load(const P& p, int item, unsigned short (&zr)[16], unsigned short (&vr)[16], float& lbv) {
    const int tid = tidx(), c = tid & 127, tq = tid >> 7;
    const int n = item & 63, dir = (item >> 6) & 1, bh = item >> 7, b = bh / 6, h = bh % 6;
    const bf16* proj = WSP(const bf16, WS_PROJ) + (size_t)(b * SEQ + n * 64) * NIN;
    const int zc = (dir ? C_ZB : C_ZF) + h * 128 + c, vc = C_V + h * 128 + c;
    lbv = WSP(const float, dir ? WS_LBB : WS_LBF)[h * 128 + c];
#pragma unroll
    for (int i = 0; i < 16; ++i) { const int s = tq * 16 + i; zr[i] = proj[(size_t)s * NIN + zc]; vr[i] = proj[(size_t)s * NIN + vc]; }
}
__device__ __forceinline__ void h1_item(const P& p, unsigned char* lds, int item, const unsigned short (&zr)[16], const unsigned short (&vr)[16], const float lb) {
    const int tid = tidx(), lane = tid & 63, wave = tid >> 6, c = tid & 127, tq = tid >> 7;
    const int n = item & 63, dir = (item >> 6) & 1, bh = item >> 7, b = bh / 6, h = bh % 6, chain = bh * 2 + dir;
    const bf16* proj = WSP(const bf16, WS_PROJ) + (size_t)(b * SEQ + n * 64) * NIN;
    const int zc = (dir ? C_ZB : C_ZF) + h * 128 + c, vc = C_V + h * 128 + c;
    float* segs = (float*)lds;
    bf16* KhT = (bf16*)(lds + 2048);
    bf16* VT = (bf16*)(lds + 2048 + 18432);
    float fv[16]; float seg = 1.f;
#pragma unroll
    for (int i = 0; i < 16; ++i) { const int s = tq * 16 + i; const float z = bf2f(zr[i]); const float f = lb + (1.f - lb) * sigmoidf_(z);
        fv[i] = f; seg *= f; VT[c * 72 + s] = vr[i]; }
    segs[tq * 128 + c] = seg;
    __syncthreads();
    const float s0 = segs[c], s1 = segs[128 + c], s2 = segs[256 + c], s3 = segs[384 + c];
    if (dir == 0) { float run = (tq < 1 ? s1 : 1.f) * (tq < 2 ? s2 : 1.f) * (tq < 3 ? s3 : 1.f);
#pragma unroll
        for (int i = 15; i >= 0; --i) { KhT[c * 72 + tq * 16 + i] = (bf16)f2bf((1.f - fv[i]) * run); run *= fv[i]; } }
    else { float run = (tq > 0 ? s0 : 1.f) * (tq > 1 ? s1 : 1.f) * (tq > 2 ? s2 : 1.f);
#pragma unroll
        for (int i = 0; i < 16; ++i) { KhT[c * 72 + tq * 16 + i] = (bf16)f2bf((1.f - fv[i]) * run); run *= fv[i]; } }
    if (tq == 0) WSP(float, WS_D)[(size_t)(chain * 64 + n) * 128 + c] = (s0 * s1) * (s2 * s3);
    __syncthreads();
    const int r32 = lane & 31, hi = lane >> 5, dvt = wave >> 1, c0 = (wave & 1) * 64;
    f32x16 acc0 = zero16(), acc1 = zero16();
#pragma unroll
    for (int ks = 0; ks < 4; ++ks) {
        const bf16x8 a = *(const bf16x8*)(VT + (dvt * 32 + r32) * 72 + ks * 16 + hi * 8);
        const bf16x8 b0 = *(const bf16x8*)(KhT + (c0 + r32) * 72 + ks * 16 + hi * 8), b1 = *(const bf16x8*)(KhT + (c0 + 32 + r32) * 72 + ks * 16 + hi * 8);
        acc0 = mfma32(b0, a, acc0); acc1 = mfma32(b1, a, acc1); }
    bf16* st = WSP(bf16, WS_ST) + (size_t)(chain * 64 + n) * 16384 + (size_t)(dvt * 32 + r32) * 128 + c0 + 4 * hi;
#pragma unroll
    for (int q = 0; q < 4; ++q) { v2u w0, w1; w0.x = pk2(acc0[4 * q], acc0[4 * q + 1]); w0.y = pk2(acc0[4 * q + 2], acc0[4 * q + 3]); w1.x = pk2(acc1[4 * q], acc1[4 * q + 1]); w1.y = pk2(acc1[4 * q + 2], acc1[4 * q + 3]);
        *(v2u*)(st + 8 * q) = w0; *(v2u*)(st + 32 + 8 * q) = w1; }
    __syncthreads();
}

__device__ __forceinline__ void h2_scan(const P& p, int bx, int G, bf16* sdst) {
    const int gt = bx * NTHR + tidx(), NGT = G * NTHR;
    for (int w = gt; w < 24 * 4096; w += NGT) {
        const int chain = w >> 12, e4 = w & 4095, c4 = (e4 & 31) * 4, dir = chain & 1;
        float run[4] = {0.f, 0.f, 0.f, 0.f};
        for (int k0 = 0; k0 < 64; k0 += 8) {
            v2u L[8]; f32x4 d[8];
#pragma unroll
            for (int j = 0; j < 8; ++j) { const int n = dir ? 63 - (k0 + j) : (k0 + j);
                L[j] = *(const v2u*)(WSP(const bf16, WS_ST) + (size_t)(chain * 64 + n) * 16384 + e4 * 4);
                d[j] = *(const f32x4*)(WSP(const float, WS_D) + (size_t)(chain * 64 + n) * 128 + c4); }
#pragma unroll
            for (int j = 0; j < 8; ++j) { const int n = dir ? 63 - (k0 + j) : (k0 + j);
                v2u o; o.x = pk2(run[0], run[1]); o.y = pk2(run[2], run[3]);
                *(v2u*)(sdst + (size_t)(chain * 64 + n) * 16384 + e4 * 4) = o;
                run[0] = d[j].x * run[0] + __uint_as_float(L[j].x << 16); run[1] = d[j].y * run[1] + __uint_as_float(L[j].x & 0xffff0000u);
                run[2] = d[j].z * run[2] + __uint_as_float(L[j].y << 16); run[3] = d[j].w * run[3] + __uint_as_float(L[j].y & 0xffff0000u); }
        }
    }
}

__device__ __forceinline__ void h3_load_z(const P& p, int item, unsigned short (&zf)[16], unsigned short (&zb)[16], float& lbf, float& lbb) {
    const int tid = tidx(), c = tid & 127, tq = tid >> 7;
    const int n = item & 63, bh = item >> 6, b = bh / 6, h = bh % 6;
    const bf16* proj = WSP(const bf16, WS_PROJ) + (size_t)(b * SEQ + n * 64) * NIN + h * 128 + c;
    lbf = WSP(const float, WS_LBF)[h * 128 + c]; lbb = WSP(const float, WS_LBB)[h * 128 + c];
#pragma unroll
    for (int i = 0; i < 16; ++i) { const size_t o = (size_t)(tq * 16 + i) * NIN; zf[i] = proj[o + C_ZF]; zb[i] = proj[o + C_ZB]; }
}
__device__ __forceinline__ void h3_load_vq(const P& p, int item, unsigned short (&vr)[16], unsigned short (&qr)[16]) {
    const int tid = tidx(), c = tid & 127, tq = tid >> 7;
    const int n = item & 63, bh = item >> 6, b = bh / 6, h = bh % 6;
    const bf16* proj = WSP(const bf16, WS_PROJ) + (size_t)(b * SEQ + n * 64) * NIN + h * 128 + c;
#pragma unroll
    for (int i = 0; i < 16; ++i) { const size_t o = (size_t)(tq * 16 + i) * NIN; vr[i] = proj[o + C_V]; qr[i] = proj[o + C_Q]; }
}
__device__ __forceinline__ void h3_item(const P& p, unsigned char* lds, int item, const unsigned short (&zfr)[16], const unsigned short (&zbr)[16], const unsigned short (&vr)[16], const unsigned short (&qr)[16], const float lbF, const float lbB,
                                        const bool more, const int item_next, unsigned short (&nv)[16], unsigned short (&nq)[16]) {
    const int tid = tidx(), lane = tid & 63, wave = tid >> 6, c = tid & 127, tq = tid >> 7;
    const int n = item & 63, bh = item >> 6, b = bh / 6, h = bh % 6;
    const size_t row0 = (size_t)(b * SEQ + n * 64);
    const bf16* proj = WSP(const bf16, WS_PROJ) + row0 * NIN;
    float* SEG = (float*)lds;
    bf16* QF = (bf16*)(lds + 4096);
    bf16* QB = (bf16*)(lds + 4096 + 17408);
    bf16* KF = (bf16*)(lds + 4096 + 2 * 17408);
    bf16* KB = (bf16*)(lds + 4096 + 3 * 17408);
    bf16* VT = (bf16*)(lds + 4096 + 4 * 17408);
    bf16* A2 = (bf16*)(lds + 4096 + 4 * 17408 + 18432);
    float* OB = (float*)(lds + 4096);
    bf16x8 sfr[8], sbr[8];
    { const int r32p = lane & 31, hip = lane >> 5, dtp = wave & 3;
      const bf16* stf = WSP(const bf16, WS_ST) + (size_t)((bh * 2 + 0) * 64 + n) * 16384 + (size_t)(dtp * 32 + r32p) * 128 + hip * 8;
      const bf16* stb = WSP(const bf16, WS_ST) + (size_t)((bh * 2 + 1) * 64 + n) * 16384 + (size_t)(dtp * 32 + r32p) * 128 + hip * 8;
#pragma unroll
      for (int ks = 0; ks < 8; ++ks) { sfr[ks] = *(const bf16x8*)(stf + ks * 16); sbr[ks] = *(const bf16x8*)(stb + ks * 16); } }
    const v4u g0 = *(const v4u*)(proj + (size_t)(tid >> 3) * NIN + C_HG + h * 128 + (tid & 7) * 16), g1 = *(const v4u*)(proj + (size_t)(tid >> 3) * NIN + C_HG + h * 128 + (tid & 7) * 16 + 8);
    float ffv[16], fbv[16];
    { float sf = 1.f, sb = 1.f;
#pragma unroll
      for (int i = 0; i < 16; ++i) { const int s = tq * 16 + i;
        const float zf = bf2f(zfr[i]), zb = bf2f(zbr[i]);
        const float ff = lbF + (1.f - lbF) * sigmoidf_(zf), fb = lbB + (1.f - lbB) * sigmoidf_(zb);
        ffv[i] = ff; sf *= ff; fbv[i] = fb; sb *= fb;
        VT[c * 72 + s] = vr[i]; }
      SEG[tq * 128 + c] = sf; SEG[512 + tq * 128 + c] = sb; }
    __syncthreads();
    {
      float runf = (tq > 0 ? SEG[c] : 1.f) * (tq > 1 ? SEG[128 + c] : 1.f) * (tq > 2 ? SEG[256 + c] : 1.f);
      float runb = (tq < 1 ? SEG[512 + 128 + c] : 1.f) * (tq < 2 ? SEG[512 + 256 + c] : 1.f) * (tq < 3 ? SEG[512 + 384 + c] : 1.f);
      float bb[16];
#pragma unroll
      for (int i = 15; i >= 0; --i) { runb *= fbv[i]; bb[i] = runb; }
#pragma unroll
      for (int i = 0; i < 16; ++i) { const int s = tq * 16 + i; runf *= ffv[i];
        const float q = bf2f(qr[i]);
        QF[s * 136 + c] = (bf16)f2bf(q * runf); KF[s * 136 + c] = (bf16)f2bf((1.f - ffv[i]) * __builtin_amdgcn_rcpf(runf));
        QB[s * 136 + c] = (bf16)f2bf(q * bb[i]); KB[s * 136 + c] = (bf16)f2bf((1.f - fbv[i]) * __builtin_amdgcn_rcpf(bb[i])); } }
    if (more) h3_load_vq(p, item_next, nv, nq);
    __syncthreads();
    const int r32 = lane & 31, hi = lane >> 5;
    {
      const int dir = wave >> 2, ti = (wave >> 1) & 1, si = wave & 1;
      const bf16* Qd = dir ? QB : QF; const bf16* Kd = dir ? KB : KF;
      f32x16 a = zero16();
#pragma unroll
      for (int ks = 0; ks < 8; ++ks) a = mfma32(*(const bf16x8*)(Qd + (ti * 32 + r32) * 136 + ks * 16 + hi * 8), *(const bf16x8*)(Kd + (si * 32 + r32) * 136 + ks * 16 + hi * 8), a);
#pragma unroll
      for (int r = 0; r < 16; ++r) { const int t = ti * 32 + (r & 3) + 8 * (r >> 2) + 4 * hi, s = si * 32 + r32;
        const bool keep = dir ? (s >= t) : (s <= t);
        A2[t * 136 + dir * 64 + s] = (bf16)f2bf(keep ? a[r] : 0.f); } }
    __syncthreads();
    f32x16 o = zero16();
    const int tt = wave >> 2, dt = wave & 3;
    {
#pragma unroll
      for (int ks = 0; ks < 8; ++ks) {
        o = mfma32(*(const bf16x8*)(QF + (tt * 32 + r32) * 136 + ks * 16 + hi * 8), sfr[ks], o);
        o = mfma32(*(const bf16x8*)(QB + (tt * 32 + r32) * 136 + ks * 16 + hi * 8), sbr[ks], o);
        o = mfma32(*(const bf16x8*)(A2 + (tt * 32 + r32) * 136 + ks * 16 + hi * 8), *(const bf16x8*)(VT + (dt * 32 + r32) * 72 + (ks & 3) * 16 + hi * 8), o); } }
    __syncthreads();
#pragma unroll
    for (int r = 0; r < 16; ++r) OB[(tt * 32 + (r & 3) + 8 * (r >> 2) + 4 * hi) * 132 + dt * 32 + r32] = o[r];
    __syncthreads();
    { const int t = tid >> 3, sub = tid & 7;
      float v[16]; float ss = 0.f;
#pragma unroll
      for (int k = 0; k < 4; ++k) { const f32x4 x = *(const f32x4*)(OB + t * 132 + sub * 16 + 4 * k); v[4 * k] = x.x; v[4 * k + 1] = x.y; v[4 * k + 2] = x.z; v[4 * k + 3] = x.w; ss += (x.x * x.x + x.y * x.y) + (x.z * x.z + x.w * x.w); }
      const float rstd = rsqrtf(sum8(ss) * (1.f / 128.f) + EPS);
      float gz[16]; gz[0] = __uint_as_float(g0.x << 16); gz[1] = __uint_as_float(g0.x & 0xffff0000u); gz[2] = __uint_as_float(g0.y << 16); gz[3] = __uint_as_float(g0.y & 0xffff0000u);
      gz[4] = __uint_as_float(g0.z << 16); gz[5] = __uint_as_float(g0.z & 0xffff0000u); gz[6] = __uint_as_float(g0.w << 16); gz[7] = __uint_as_float(g0.w & 0xffff0000u);
      gz[8] = __uint_as_float(g1.x << 16); gz[9] = __uint_as_float(g1.x & 0xffff0000u); gz[10] = __uint_as_float(g1.y << 16); gz[11] = __uint_as_float(g1.y & 0xffff0000u);
      gz[12] = __uint_as_float(g1.z << 16); gz[13] = __uint_as_float(g1.z & 0xffff0000u); gz[14] = __uint_as_float(g1.w << 16); gz[15] = __uint_as_float(g1.w & 0xffff0000u);
      float o[16];
#pragma unroll
      for (int k = 0; k < 16; ++k) o[k] = v[k] * rstd * ((const float*)p.g_hg)[sub * 16 + k] * (gz[k] * sigmoidf_(gz[k]));
      v4u w0, w1; w0.x = pk2(o[0], o[1]); w0.y = pk2(o[2], o[3]); w0.z = pk2(o[4], o[5]); w0.w = pk2(o[6], o[7]); w1.x = pk2(o[8], o[9]); w1.y = pk2(o[10], o[11]); w1.z = pk2(o[12], o[13]); w1.w = pk2(o[14], o[15]);
      bf16* orow = WSP(bf16, WS_OCAT) + (row0 + t) * DM + h * 128 + sub * 16;
      *(v4u*)orow = w0; *(v4u*)(orow + 8) = w1; }
    __syncthreads();
}
__device__ __forceinline__ float max4x(float v) { v = fmaxf(v, __shfl_xor(v, 16)); return fmaxf(v, __shfl_xor(v, 32)); }
__device__ __forceinline__ float sum4x(float v) { v += __shfl_xor(v, 16); return v + __shfl_xor(v, 32); }
__device__ __forceinline__ bf16x8 pack_p(const f32x4 a, const f32x4 b) {
    v4u w; w.x = pk2(a.x, a.y); w.y = pk2(a.z, a.w); w.z = pk2(b.x, b.y); w.w = pk2(b.z, b.w); return __builtin_bit_cast(bf16x8, w); }
__device__ __forceinline__ bf16x8 ld_vt2(const bf16* p0, const bf16* p1) { const v2u a = *(const v2u*)p0, b = *(const v2u*)p1; v4u w; w.x = a.x; w.y = a.y; w.z = b.x; w.w = b.y; return __builtin_bit_cast(bf16x8, w); }
struct DilRegs { v4u kv[4], vv[4]; bf16x8 q0, q1; };
__device__ __forceinline__ void dil_decode(int item, int& b, int& head, int& r, int& Ls, int& cres, int& i0) {
    const int blk = item & 31, bh = item >> 5; b = bh / 12; head = bh % 12; const int g = head >> 2;
    r = (g == 0) ? 1 : (g == 1 ? 4 : 16); Ls = SEQ / r; const int nblk = Ls / 128; cres = blk / nblk; i0 = (blk % nblk) * 128;
}
__device__ __forceinline__ void dil_load(const P& p, int item, DilRegs& R) {
    const int tid = tidx(), lane = tid & 63, wave = tid >> 6, fr = lane & 15, h = lane >> 4;
    int b, head, r, Ls, cres, i0; dil_decode(item, b, head, r, Ls, cres, i0);
    const bf16* proj = WSP(const bf16, WS_PROJ) + (size_t)(b * SEQ) * NIN;
#pragma unroll
    for (int k = 0; k < 4; ++k) { const int idx = tid + 512 * k, row = idx >> 3, ch = idx & 7; const int j = i0 - 64 + row;
        v4u kv = {0u, 0u, 0u, 0u}, vv = {0u, 0u, 0u, 0u};
        if (j >= 0 && j < Ls) { const size_t tok = (size_t)(cres + r * j); kv = *(const v4u*)(proj + tok * NIN + C_DK + head * 64 + ch * 8); vv = *(const v4u*)(proj + tok * NIN + C_DV + head * 64 + ch * 8); }
        R.kv[k] = kv; R.vv[k] = vv; }
    const bf16* qp = proj + (size_t)(cres + r * (i0 + 16 * wave + fr)) * NIN + C_DQ + head * 64 + 8 * h;
    R.q0 = *(const bf16x8*)qp; R.q1 = *(const bf16x8*)(qp + 32);
}
__device__ __forceinline__ void dil_item(const P& p, unsigned char* lds, int item, const DilRegs& R) {
    const int tid = tidx(), lane = tid & 63, wave = tid >> 6, fr = lane & 15, h = lane >> 4;
    int b, head, r, Ls, cres, i0; dil_decode(item, b, head, r, Ls, cres, i0);
    bf16* Ks = (bf16*)lds;
    bf16* VT = (bf16*)(lds + 36864);
#pragma unroll
    for (int k = 0; k < 4; ++k) { const int idx = tid + 512 * k, row = idx >> 3, ch = idx & 7; const v4u kv = R.kv[k], vv = R.vv[k];
        *(v4u*)(Ks + row * 72 + ch * 8) = kv;
        bf16* vt = VT + (ch * 8) * 280 + row;
        vt[0] = (bf16)(vv.x & 0xffff); vt[280] = (bf16)(vv.x >> 16); vt[560] = (bf16)(vv.y & 0xffff); vt[840] = (bf16)(vv.y >> 16);
        vt[1120] = (bf16)(vv.z & 0xffff); vt[1400] = (bf16)(vv.z >> 16); vt[1680] = (bf16)(vv.w & 0xffff); vt[1960] = (bf16)(vv.w >> 16); }
    { const int d = tid >> 3, c2 = (tid & 7) * 2; *(unsigned*)(VT + d * 280 + 256 + c2) = 0u; }
    __syncthreads();
    const int iq = i0 + 16 * wave + fr;
    const bf16x8 q0 = R.q0, q1 = R.q1;
    f32x4 sc[10];
#pragma unroll
    for (int j = 0; j < 9; ++j) { const bf16* kr = Ks + (16 * (wave + j) + fr) * 72 + 8 * h;
        f32x4 s4 = {0.f, 0.f, 0.f, 0.f}; s4 = mfma16(*(const bf16x8*)kr, q0, s4); sc[j] = mfma16(*(const bf16x8*)(kr + 32), q1, s4);
        if (j % 3 == 2) asm volatile("" ::: "memory"); }
    const float slope = exp2f(-8.0f * (float)(head + 1) / 12.0f) * (float)r;
    float m = -3.0e38f;
#pragma unroll
    for (int j = 0; j < 9; ++j)
#pragma unroll
        for (int e = 0; e < 4; ++e) { const int dj = -64 + 16 * j + 4 * h + e - fr, jk = iq + dj, adj = dj < 0 ? -dj : dj;
            const bool ok = (adj <= 64) && (jk >= 0) && (jk < Ls);
            sc[j][e] = ok ? sc[j][e] * 0.125f - slope * (float)adj : -1.0e30f; m = fmaxf(m, sc[j][e]); }
    m = max4x(m); float l = 0.f;
#pragma unroll
    for (int j = 0; j < 9; ++j)
#pragma unroll
        for (int e = 0; e < 4; ++e) { const float pe = sc[j][e] > -1.0e29f ? __expf(sc[j][e] - m) : 0.f; sc[j][e] = pe; l += pe; }
    l = sum4x(l); const float inv = 1.0f / l;
#pragma unroll
    for (int j = 0; j < 9; ++j) sc[j] = sc[j] * inv;
    sc[9] = (f32x4){0.f, 0.f, 0.f, 0.f};
    if (h == 0) WSP(float, WS_LSE)[(size_t)(b * 12 + head) * SEQ + cres + r * iq] = m + __logf(l);
    f32x4 o[4];
#pragma unroll
    for (int dt = 0; dt < 4; ++dt) o[dt] = (f32x4){0.f, 0.f, 0.f, 0.f};
#pragma unroll
    for (int ks = 0; ks < 5; ++ks) { const bf16x8 pa = pack_p(sc[2 * ks], sc[2 * ks + 1]);
        const bf16* v0 = VT + fr * 280 + 16 * (wave + 2 * ks) + 4 * h;
#pragma unroll
        for (int dt = 0; dt < 4; ++dt) o[dt] = mfma16(ld_vt2(v0 + dt * 16 * 280, v0 + dt * 16 * 280 + 16), pa, o[dt]);
        asm volatile("" ::: "memory"); }
    { const size_t tok = (size_t)(b * SEQ + cres + r * iq);
      bf16* orow = WSP(bf16, WS_OCAT) + tok * DM + 768 + head * 64 + 4 * h;
#pragma unroll
      for (int dt = 0; dt < 4; ++dt) { v2u w; w.x = pk2(o[dt][0], o[dt][1]); w.y = pk2(o[dt][2], o[dt][3]); *(v2u*)(orow + dt * 16) = w; } }
    __syncthreads();
}

__device__ __forceinline__ void mem_item(const P& p, unsigned char* lds, int item) {
    const int tid = tidx(), lane = tid & 63, wave = tid >> 6, fr = lane & 15, h = lane >> 4;
    const int blk = item & 31, bh = item >> 5, b = bh >> 2, head = bh & 3;
    const size_t row0 = (size_t)(b * SEQ + blk * 128);
    const bf16* qp = WSP(const bf16, WS_PROJ) + (row0 + 16 * wave + fr) * NIN + C_MQ + head * 128 + 8 * h;
    bf16x8 qf[4];
#pragma unroll
    for (int kk = 0; kk < 4; ++kk) qf[kk] = *(const bf16x8*)(qp + 32 * kk);
    bf16* Ks = (bf16*)lds;
    bf16* VT = (bf16*)(lds + 69632);
#pragma unroll
    for (int k = 0; k < 8; ++k) { const int idx = tid + 512 * k;
        { const int row = idx >> 4, ch = idx & 15; *(v4u*)(Ks + row * 136 + ch * 8) = *(const v4u*)(WSP(const bf16, WS_KVM) + (size_t)(b * MEML + row) * 1024 + head * 128 + ch * 8); }
        { const int d = idx >> 5, ch = idx & 31; *(v4u*)(VT + d * 264 + ch * 8) = *(const v4u*)(WSP(const bf16, WS_KVMT) + (size_t)(512 + head * 128 + d) * 512 + b * MEML + ch * 8); } }
    __syncthreads();
    f32x4 sc[16]; float m = -3.0e38f;
#pragma unroll
    for (int j = 0; j < 16; ++j) { const bf16* kr = Ks + (16 * j + fr) * 136 + 8 * h; f32x4 s4 = {0.f, 0.f, 0.f, 0.f};
#pragma unroll
        for (int kk = 0; kk < 4; ++kk) s4 = mfma16(*(const bf16x8*)(kr + 32 * kk), qf[kk], s4);
        sc[j] = s4 * 0.08838834764831845f; m = fmaxf(fmaxf(m, fmaxf(sc[j][0], sc[j][1])), fmaxf(sc[j][2], sc[j][3]));
        if ((j & 1) == 1) asm volatile("" ::: "memory"); }
    m = max4x(m); float l = 0.f;
#pragma unroll
    for (int j = 0; j < 16; ++j)
#pragma unroll
        for (int e = 0; e < 4; ++e) { sc[j][e] = __expf(sc[j][e] - m); l += sc[j][e]; }
    l = sum4x(l); const float inv = 1.0f / l;
    f32x4 o[8];
#pragma unroll
    for (int dt = 0; dt < 8; ++dt) o[dt] = (f32x4){0.f, 0.f, 0.f, 0.f};
#pragma unroll
    for (int ks = 0; ks < 8; ++ks) { const bf16x8 pa = pack_p(sc[2 * ks] * inv, sc[2 * ks + 1] * inv);
        const bf16* v0 = VT + fr * 264 + 32 * ks + 4 * h;
#pragma unroll
        for (int dt = 0; dt < 8; ++dt) o[dt] = mfma16(ld_vt2(v0 + dt * 16 * 264, v0 + dt * 16 * 264 + 16), pa, o[dt]);
        asm volatile("" ::: "memory"); }
    { bf16* orow = WSP(bf16, WS_OCAT) + (row0 + 16 * wave + fr) * DM + 1536 + head * 128 + 4 * h;
#pragma unroll
      for (int dt = 0; dt < 8; ++dt) { v2u w; w.x = pk2(o[dt][0], o[dt][1]); w.y = pk2(o[dt][2], o[dt][3]); *(v2u*)(orow + dt * 16) = w; } }
    __syncthreads();
}

__device__ __forceinline__ void dil_alpha_rows(const P& p, int vcu, int G) {
    const int gt = vcu * NTHR + tidx(), NGT = G * NTHR;
    constexpr int NTASK = T * 96;
    for (int id0 = gt; id0 < NTASK; id0 += 6 * NGT) {
        float l0[6], l1[6], l2[6]; v4u v[6]; int g6[6];
#pragma unroll
        for (int k = 0; k < 6; ++k) { const int id = id0 + k * NGT; g6[k] = -1;
            if (id < NTASK) { const int t = id / 96, ch = id - t * 96, head = ch >> 3, j = head & 3, b = t / SEQ, s = t - b * SEQ; g6[k] = head >> 2;
                const float* L = WSP(const float, WS_LSE) + (size_t)(b * 12 + j) * SEQ + s; l0[k] = L[0]; l1[k] = L[4 * SEQ]; l2[k] = L[8 * SEQ];
                v[k] = *(const v4u*)(WSP(const bf16, WS_OCAT) + (size_t)t * DM + 768 + ch * 8); } }
#pragma unroll
        for (int k = 0; k < 6; ++k) if (g6[k] >= 0) { const int id = id0 + k * NGT, t = id / 96, ch = id - t * 96;
            const float m = fmaxf(l0[k], fmaxf(l1[k], l2[k])), e0 = __expf(l0[k] - m), e1 = __expf(l1[k] - m), e2 = __expf(l2[k] - m);
            const float al = (g6[k] == 0 ? e0 : (g6[k] == 1 ? e1 : e2)) / (e0 + e1 + e2); v4u w = v[k];
            w.x = pk2(__uint_as_float(w.x << 16) * al, __uint_as_float(w.x & 0xffff0000u) * al); w.y = pk2(__uint_as_float(w.y << 16) * al, __uint_as_float(w.y & 0xffff0000u) * al);
            w.z = pk2(__uint_as_float(w.z << 16) * al, __uint_as_float(w.z & 0xffff0000u) * al); w.w = pk2(__uint_as_float(w.w << 16) * al, __uint_as_float(w.w & 0xffff0000u) * al);
            *(v4u*)(WSP(bf16, WS_OCAT) + (size_t)t * DM + 768 + ch * 8) = w; }
    }
}
__device__ __forceinline__ unsigned okey(float f) { const unsigned u = __float_as_uint(f); return u ^ ((unsigned)((int)u >> 31) | 0x80000000u); }
__device__ __forceinline__ float unkey(unsigned k) { const unsigned u = (k & 0x80000000u) ? (k ^ 0x80000000u) : ~k; return __uint_as_float(u); }
__device__ __forceinline__ unsigned umax_(unsigned a, unsigned b) { return a > b ? a : b; }
__device__ __forceinline__ unsigned umin_(unsigned a, unsigned b) { return a < b ? a : b; }
template <int CTRL> __device__ __forceinline__ unsigned dppu(unsigned v) { return (unsigned)__builtin_amdgcn_update_dpp(0, (int)v, CTRL, 0xf, 0xf, true); }
__device__ __forceinline__ void topk_rows(const P& p, int vcu, int G) {
    const int gt = vcu * NTHR + tidx(), NGT = G * NTHR;
    for (int gid = gt; gid < T * 16; gid += NGT) {
        const int row = gid >> 1, half = gid & 1, t = row >> 3, h = row & 7;
        const float* sc = WSP(const float, WS_SC) + (size_t)row * 256 + half * 128;
        unsigned v[16];
#pragma unroll
        for (int i = 0; i < 16; ++i) v[i] = 0u;
        for (int n4 = 0; n4 < 32; ++n4) { const f32x4 q = *(const f32x4*)(sc + n4 * 4);
#pragma unroll
            for (int e = 0; e < 4; ++e) { unsigned x = (okey(q[e]) & 0xffffff80u) | (unsigned)(127 - (n4 * 4 + e));
#pragma unroll
                for (int i = 0; i < 16; ++i) { const unsigned hi = umax_(v[i], x); x = umin_(v[i], x); v[i] = hi; } } }
        float s0[16], s1[16]; unsigned long long p0lo = 0ull, p0hi = 0ull, p1lo = 0ull, p1hi = 0ull;
#pragma unroll
        for (int i = 0; i < 16; ++i) { const unsigned o = dppu<0xB1>(v[i]); const unsigned k0 = half ? o : v[i], k1 = half ? v[i] : o;
            s0[i] = unkey(k0 & 0xffffff80u); s1[i] = unkey(k1 & 0xffffff80u);
            const unsigned long long a0 = (unsigned long long)(127u - (k0 & 127u)) << (8 * (i & 7)), a1 = (unsigned long long)(127u - (k1 & 127u)) << (8 * (i & 7));
            if (i < 8) { p0lo |= a0; p1lo |= a1; } else { p0hi |= a0; p1hi |= a1; } }
        unsigned bk[16];
#pragma unroll
        for (int k = 0; k < 16; ++k) bk[k] = 0u;
#pragma unroll
        for (int i = 0; i < 16; ++i)
#pragma unroll
            for (int j = 0; j < 16; ++j) if ((i + 1) * (j + 1) <= 16) {
                unsigned x = (okey(s0[i] + s1[j]) & 0xffffff00u) | (unsigned)(255 - (i * 16 + j));
#pragma unroll
                for (int k = 0; k < 16; ++k) { const unsigned hi = umax_(bk[k], x); x = umin_(bk[k], x); bk[k] = hi; } }
        const float rstd = row_rstd(WSP(const float, WS_RSP), t);
        const float m = unkey(bk[0] & 0xffffff00u) * rstd; float l = 0.f; float ev[16];
#pragma unroll
        for (int k = 0; k < 16; ++k) { ev[k] = __expf(unkey(bk[k] & 0xffffff00u) * rstd - m); l += ev[k]; }
        const float inv = 1.0f / l;
        int be[16];
#pragma unroll
        for (int k = 0; k < 16; ++k) { const int code = 255 - (int)(bk[k] & 255u), ci = code >> 4, cj = code & 15;
            const int a = (int)(((ci & 8) ? p0hi : p0lo) >> (8 * (ci & 7))) & 0xff, c = (int)(((cj & 8) ? p1hi : p1lo) >> (8 * (cj & 7))) & 0xff;
            be[k] = a * 128 + c; }
        int* io = WSP(int, WS_IDX) + (size_t)t * 128 + h * 16; float* go = WSP(float, WS_GATE) + (size_t)t * 128 + h * 16;
        if (half == 0) {
            *(int4*)io = make_int4(be[0], be[1], be[2], be[3]); *(int4*)(io + 4) = make_int4(be[4], be[5], be[6], be[7]);
            *(f32x4*)go = (f32x4){ev[0] * inv, ev[1] * inv, ev[2] * inv, ev[3] * inv}; *(f32x4*)(go + 4) = (f32x4){ev[4] * inv, ev[5] * inv, ev[6] * inv, ev[7] * inv};
        } else {
            *(int4*)(io + 8) = make_int4(be[8], be[9], be[10], be[11]); *(int4*)(io + 12) = make_int4(be[12], be[13], be[14], be[15]);
            *(f32x4*)(go + 8) = (f32x4){ev[8] * inv, ev[9] * inv, ev[10] * inv, ev[11] * inv}; *(f32x4*)(go + 12) = (f32x4){ev[12] * inv, ev[13] * inv, ev[14] * inv, ev[15] * inv};
        }
    }
}

__device__ __forceinline__ void unpack8(const v4u w, float* f) {
    f[0] = __uint_as_float(w.x << 16); f[1] = __uint_as_float(w.x & 0xffff0000u); f[2] = __uint_as_float(w.y << 16); f[3] = __uint_as_float(w.y & 0xffff0000u);
    f[4] = __uint_as_float(w.z << 16); f[5] = __uint_as_float(w.z & 0xffff0000u); f[6] = __uint_as_float(w.w << 16); f[7] = __uint_as_float(w.w & 0xffff0000u);
}
template <int CTRL> __device__ __forceinline__ float dpp_f(float v) { return __builtin_bit_cast(float, __builtin_amdgcn_update_dpp(0, __builtin_bit_cast(int, v), CTRL, 0xf, 0xf, true)); }
__device__ __forceinline__ float row16_sum(float v) {
    v += dpp_f<0xB1>(v); v += dpp_f<0x4E>(v); v += dpp_f<0x141>(v); v += dpp_f<0x140>(v); return v;
}
__device__ __forceinline__ float swap32_add(float x, float y) {
    auto r = __builtin_amdgcn_permlane32_swap(__float_as_uint(x), __float_as_uint(y), false, false); return __uint_as_float(r[0]) + __uint_as_float(r[1]); }
__device__ __forceinline__ float swap16_add(float x, float y) {
    auto r = __builtin_amdgcn_permlane16_swap(__float_as_uint(x), __float_as_uint(y), false, false); return __uint_as_float(r[0]) + __uint_as_float(r[1]); }
__device__ __forceinline__ float reduce4(float d0, float d1, float d2, float d3) { return row16_sum(swap16_add(swap32_add(d0, d2), swap32_add(d1, d3))); }
__device__ __forceinline__ float rl_f(float v, int l) { return __builtin_bit_cast(float, __builtin_amdgcn_readlane(__builtin_bit_cast(int, v), l)); }
__device__ __forceinline__ float wave_sum_dpp(float v) { const float r = row16_sum(v); return (rl_f(r, 0) + rl_f(r, 16)) + (rl_f(r, 32) + rl_f(r, 48)); }
__device__ __forceinline__ int sdot4(unsigned a, unsigned b, int c) { return __builtin_amdgcn_sdot4((int)a, (int)b, c, false); }
__device__ __forceinline__ unsigned q8(float v, float inv) { return (unsigned)((int)rintf(v * inv)) & 0xffu; }
#ifndef PEER_PB
#define PEER_PB 8
#endif
constexpr int PB = PEER_PB;
__device__ __forceinline__ void peer_rows(const P& p, int vcu, int G, float* dst) {
    const int lane = tidx() & 63, gw = vcu * NWAVES + (tidx() >> 6), NGW = G * NWAVES;
    const v4u* U = WSP(const v4u, WS_UQ); const v4u* V = WSP(const v4u, WS_VQ);
    for (int t = gw; t < T; t += NGW) {
        unsigned xq[8]; float sx;
        { const v4u* xp = WSP(const v4u, WS_XG) + (size_t)t * 256 + lane * 2; float f[32];
          unpack8(xp[0], f); unpack8(xp[1], f + 8); unpack8(xp[128], f + 16); unpack8(xp[129], f + 24);
          float m = 0.f;
#pragma unroll
          for (int i = 0; i < 32; ++i) m = fmaxf(m, fabsf(f[i]));
          m = wave_max(m); m = fmaxf(m, 1e-30f); sx = m * (1.f / 127.f); const float inv = 127.f / m;
#pragma unroll
          for (int i = 0; i < 8; ++i) xq[i] = q8(f[4 * i], inv) | (q8(f[4 * i + 1], inv) << 8) | (q8(f[4 * i + 2], inv) << 16) | (q8(f[4 * i + 3], inv) << 24); }
        const int ia = WSP(const int, WS_IDX)[(size_t)t * 128 + lane], ib = WSP(const int, WS_IDX)[(size_t)t * 128 + 64 + lane];
        const float ascale = row_rstd(WSP(const float, WS_RSP), t) * sx;
        float aa = 0.f, ab = 0.f;
#pragma unroll 1
        for (int e0 = 0; e0 < 128; e0 += PB) {
            v4u w[PB][2];
#pragma unroll
            for (int j = 0; j < PB; ++j) { const int e = e0 + j; const int row = __builtin_amdgcn_readlane(e < 64 ? ia : ib, e & 63);
                const v4u* r = U + (size_t)row * 128 + lane; w[j][0] = r[0]; w[j][1] = r[64]; }
            float d[PB];
#pragma unroll
            for (int j = 0; j < PB; ++j) { int a0 = 0, a1 = 0;
                a0 = sdot4(w[j][0].x, xq[0], a0); a1 = sdot4(w[j][0].y, xq[1], a1); a0 = sdot4(w[j][0].z, xq[2], a0); a1 = sdot4(w[j][0].w, xq[3], a1);
                a0 = sdot4(w[j][1].x, xq[4], a0); a1 = sdot4(w[j][1].y, xq[5], a1); a0 = sdot4(w[j][1].z, xq[6], a0); a1 = sdot4(w[j][1].w, xq[7], a1);
                d[j] = (float)(a0 + a1); }
#pragma unroll
            for (int j4 = 0; j4 < PB; j4 += 4) { const float r0 = reduce4(d[j4], d[j4 + 1], d[j4 + 2], d[j4 + 3]);
#pragma unroll
                for (int j = 0; j < 4; ++j) { const int e = e0 + j4 + j; const float v = rl_f(r0, 16 * j);
                    if (lane == (e & 63)) { if (e < 64) aa = v; else ab = v; } } }
        }
        float ha, hb;
        { const float* SU = WSP(const float, WS_SU); const float* SV = WSP(const float, WS_SV);
          const float ga = WSP(const float, WS_GATE)[(size_t)t * 128 + lane], gb = WSP(const float, WS_GATE)[(size_t)t * 128 + 64 + lane];
          aa *= ascale * SU[ia]; ab *= ascale * SU[ib];
          ha = 0.5f * aa * (1.0f + erff(aa * 0.70710678118f)) * ga * SV[ia]; hb = 0.5f * ab * (1.0f + erff(ab * 0.70710678118f)) * gb * SV[ib]; }
        float acc[32]; float csum = 0.f;
#pragma unroll
        for (int i = 0; i < 32; ++i) acc[i] = 0.f;
#pragma unroll 1
        for (int e0 = 0; e0 < 128; e0 += PB) {
            v4u w[PB][2];
#pragma unroll
            for (int j = 0; j < PB; ++j) { const int e = e0 + j; const int row = __builtin_amdgcn_readlane(e < 64 ? ia : ib, e & 63);
                const v4u* r = V + (size_t)row * 128 + lane; w[j][0] = r[0]; w[j][1] = r[64]; }
#pragma unroll
            for (int j = 0; j < PB; ++j) { const int e = e0 + j; const float h = rl_f(e < 64 ? ha : hb, e & 63); csum += h;
#pragma unroll
                for (int i = 0; i < 2; ++i) { const unsigned x0 = w[j][i].x, x1 = w[j][i].y, x2 = w[j][i].z, x3 = w[j][i].w;
                    acc[16 * i + 0] = fmaf(h, (float)(x0 & 0xffu), acc[16 * i + 0]); acc[16 * i + 1] = fmaf(h, (float)((x0 >> 8) & 0xffu), acc[16 * i + 1]);
                    acc[16 * i + 2] = fmaf(h, (float)((x0 >> 16) & 0xffu), acc[16 * i + 2]); acc[16 * i + 3] = fmaf(h, (float)(x0 >> 24), acc[16 * i + 3]);
                    acc[16 * i + 4] = fmaf(h, (float)(x1 & 0xffu), acc[16 * i + 4]); acc[16 * i + 5] = fmaf(h, (float)((x1 >> 8) & 0xffu), acc[16 * i + 5]);
                    acc[16 * i + 6] = fmaf(h, (float)((x1 >> 16) & 0xffu), acc[16 * i + 6]); acc[16 * i + 7] = fmaf(h, (float)(x1 >> 24), acc[16 * i + 7]);
                    acc[16 * i + 8] = fmaf(h, (float)(x2 & 0xffu), acc[16 * i + 8]); acc[16 * i + 9] = fmaf(h, (float)((x2 >> 8) & 0xffu), acc[16 * i + 9]);
                    acc[16 * i + 10] = fmaf(h, (float)((x2 >> 16) & 0xffu), acc[16 * i + 10]); acc[16 * i + 11] = fmaf(h, (float)(x2 >> 24), acc[16 * i + 11]);
                    acc[16 * i + 12] = fmaf(h, (float)(x3 & 0xffu), acc[16 * i + 12]); acc[16 * i + 13] = fmaf(h, (float)((x3 >> 8) & 0xffu), acc[16 * i + 13]);
                    acc[16 * i + 14] = fmaf(h, (float)((x3 >> 16) & 0xffu), acc[16 * i + 14]); acc[16 * i + 15] = fmaf(h, (float)(x3 >> 24), acc[16 * i + 15]); } }
        }
        const float* orow = ((float*)p.out) + (size_t)t * DM; float* drow = dst + (size_t)t * DM; float ss = 0.f; const float coff = 128.f * csum;
#pragma unroll
        for (int i = 0; i < 2; ++i)
#pragma unroll
            for (int k = 0; k < 4; ++k) { const f32x4 a = *(const f32x4*)(orow + i * 1024 + lane * 16 + 4 * k);
                float* c = acc + 16 * i + 4 * k; c[0] += a.x - coff; c[1] += a.y - coff; c[2] += a.z - coff; c[3] += a.w - coff;
                ss += (c[0] * c[0] + c[1] * c[1]) + (c[2] * c[2] + c[3] * c[3]); }
        const float r2 = rsqrtf(wave_sum_dpp(ss) * (1.f / DM) + EPS);
#pragma unroll
        for (int i = 0; i < 2; ++i)
#pragma unroll
            for (int k = 0; k < 4; ++k) { const f32x4 g = *(const f32x4*)(((const float*)p.g_final) + i * 1024 + lane * 16 + 4 * k); const float* c = acc + 16 * i + 4 * k;
                *(f32x4*)(drow + i * 1024 + lane * 16 + 4 * k) = (f32x4){c[0] * r2 * g.x, c[1] * r2 * g.y, c[2] * r2 * g.z, c[3] * r2 * g.w}; }
    }
}

struct PeerMap { int rho, nx, r, nloc, bal; };
__device__ __forceinline__ PeerMap peer_map(const XcdBarrier& b, volatile LAS unsigned* MISC) {
    if (tidx() == 0) {
        unsigned rho = 0, nx = 1, nloc = 1;
        xcd_barrier_complete(b.bar, b.x, nloc, nx);
        for (unsigned j = 0; j < b.x; ++j) if (xb_ld(&b.bar[XB_XCNT(j)])) ++rho;
        const unsigned r = xb_add(&b.bar[4096 + 64 * b.x], 1u);
        unsigned bal = 1u; for (unsigned j = 0; j < 16; ++j) { const unsigned c = xb_ld(&b.bar[XB_XCNT(j)]); if (c != 0u && c != nloc) bal = 0u; }
        if (nx * nloc != gridDim.x) bal = 0u;
        MISC[4] = rho; MISC[5] = nx; MISC[6] = r % nloc; MISC[7] = nloc; MISC[10] = bal;
    }
    __syncthreads();
    PeerMap m; m.rho = __builtin_amdgcn_readfirstlane((int)MISC[4]); m.nx = __builtin_amdgcn_readfirstlane((int)MISC[5]); m.r = __builtin_amdgcn_readfirstlane((int)MISC[6]);
    m.nloc = __builtin_amdgcn_readfirstlane((int)MISC[7]); m.bal = __builtin_amdgcn_readfirstlane((int)MISC[10]);
    return m;
}
__device__ __forceinline__ void xq_rows(const P& p, int vcu, int G) {
    const int lane = tidx() & 63, gw = vcu * NWAVES + (tidx() >> 6), NGW = G * NWAVES;
    for (int t = gw; t < T; t += NGW) {
        const v4u* xp = WSP(const v4u, WS_XG) + (size_t)t * 256 + lane * 4; float f[32];
        unpack8(xp[0], f); unpack8(xp[1], f + 8); unpack8(xp[2], f + 16); unpack8(xp[3], f + 24);
        float m = 0.f;
#pragma unroll
        for (int i = 0; i < 32; ++i) m = fmaxf(m, fabsf(f[i]));
        m = fmaxf(wave_max(m), 1e-30f); const float inv = 127.f / m;
        v4u o0, o1;
        o0.x = q8(f[0], inv) | (q8(f[1], inv) << 8) | (q8(f[2], inv) << 16) | (q8(f[3], inv) << 24); o0.y = q8(f[4], inv) | (q8(f[5], inv) << 8) | (q8(f[6], inv) << 16) | (q8(f[7], inv) << 24);
        o0.z = q8(f[8], inv) | (q8(f[9], inv) << 8) | (q8(f[10], inv) << 16) | (q8(f[11], inv) << 24); o0.w = q8(f[12], inv) | (q8(f[13], inv) << 8) | (q8(f[14], inv) << 16) | (q8(f[15], inv) << 24);
        o1.x = q8(f[16], inv) | (q8(f[17], inv) << 8) | (q8(f[18], inv) << 16) | (q8(f[19], inv) << 24); o1.y = q8(f[20], inv) | (q8(f[21], inv) << 8) | (q8(f[22], inv) << 16) | (q8(f[23], inv) << 24);
        o1.z = q8(f[24], inv) | (q8(f[25], inv) << 8) | (q8(f[26], inv) << 16) | (q8(f[27], inv) << 24); o1.w = q8(f[28], inv) | (q8(f[29], inv) << 8) | (q8(f[30], inv) << 16) | (q8(f[31], inv) << 24);
        v4u* xo = WSP(v4u, WS_XQ) + (size_t)t * 128 + lane * 2; xo[0] = o0; xo[1] = o1;
        if (lane == 0) WSP(float, WS_SX)[t] = m * (1.f / 127.f);
    }
}
__device__ __forceinline__ void peer_u_sliced(const P& p, const PeerMap& mp) {
    const int lane = tidx() & 63, wave = tidx() >> 6, g = lane >> 4, l = lane & 15;
    const int w0 = mp.r * NWAVES + wave, NW = mp.nloc * NWAVES;
    for (int s = mp.rho; s < 8; s += mp.nx) {
        const unsigned char* ub = (const unsigned char*)(p.ws + WS_UQ) + s * 256 + l * 16;
        float* pa = WSP(float, WS_PA) + (size_t)s * T * 128;
        for (int t = w0; t < T; t += NW) {
            const v4u xq = *(const v4u*)((const unsigned char*)(p.ws + WS_XQ) + (size_t)t * DM + s * 256 + l * 16);
            const int* ip = WSP(const int, WS_IDX) + (size_t)t * 128 + g;
            int idxv[32];
#pragma unroll
            for (int k = 0; k < 32; ++k) idxv[k] = ip[4 * k];
#pragma unroll
            for (int k0 = 0; k0 < 32; k0 += 16) {
                v4u w[16];
#pragma unroll
                for (int k = 0; k < 16; ++k) w[k] = *(const v4u*)(ub + (size_t)idxv[k0 + k] * DM);
#pragma unroll
                for (int k = 0; k < 16; ++k) { int a0 = sdot4(w[k].x, xq.x, 0), a1 = sdot4(w[k].y, xq.y, 0); a0 = sdot4(w[k].z, xq.z, a0); a1 = sdot4(w[k].w, xq.w, a1);
                    const float d = row16_sum((float)(a0 + a1));
                    if (l == 0) pa[(size_t)t * 128 + 4 * (k0 + k) + g] = d; }
            }
        }
    }
}
__device__ __forceinline__ unsigned permb(unsigned hi, unsigned lo, unsigned sel) { return __builtin_amdgcn_perm(hi, lo, sel); }
__device__ __forceinline__ void peer_v_sliced(const P& p, const PeerMap& mp, unsigned char* lds, float* ydst) {
    const int lane = tidx() & 63, wave = tidx() >> 6, g = lane >> 4, l = lane & 15;
    const int w0 = mp.r * NWAVES + wave, NW = mp.nloc * NWAVES;
    unsigned char* hl = lds + wave * 128;
    const float* SU = WSP(const float, WS_SU); const float* SV = WSP(const float, WS_SV); const float* PAb = WSP(const float, WS_PA);
    for (int s = mp.rho; s < 8; s += mp.nx) {
        const unsigned char* vb = (const unsigned char*)(p.ws + WS_VQ) + s * 256 + l * 16;
        for (int t = w0; t < T; t += NW) {
            const float ascale = row_rstd(WSP(const float, WS_RSP), t) * WSP(const float, WS_SX)[t];
            float sh;
            { const int ia = WSP(const int, WS_IDX)[(size_t)t * 128 + lane], ib = WSP(const int, WS_IDX)[(size_t)t * 128 + 64 + lane];
              float aa = 0.f, ab = 0.f;
#pragma unroll
              for (int q = 0; q < 8; ++q) { aa += PAb[((size_t)q * T + t) * 128 + lane]; ab += PAb[((size_t)q * T + t) * 128 + 64 + lane]; }
              aa *= ascale * SU[ia]; ab *= ascale * SU[ib];
              const float ha = 0.5f * aa * (1.0f + erff(aa * 0.70710678118f)) * WSP(const float, WS_GATE)[(size_t)t * 128 + lane] * SV[ia];
              const float hb = 0.5f * ab * (1.0f + erff(ab * 0.70710678118f)) * WSP(const float, WS_GATE)[(size_t)t * 128 + 64 + lane] * SV[ib];
              const float m = fmaxf(wave_max(fmaxf(fabsf(ha), fabsf(hb))), 1e-30f); sh = m * (1.f / 127.f); const float inv = 127.f / m;
              hl[(lane & 3) * 32 + (lane >> 2)] = (unsigned char)q8(ha, inv); hl[(lane & 3) * 32 + 16 + (lane >> 2)] = (unsigned char)q8(hb, inv); }
            const int* ip = WSP(const int, WS_IDX) + (size_t)t * 128 + g;
            int idxv[32];
#pragma unroll
            for (int k = 0; k < 32; ++k) idxv[k] = ip[4 * k];
            const v4u h0 = *(const v4u*)(hl + g * 32), h1 = *(const v4u*)(hl + g * 32 + 16);
            const unsigned hq[8] = {h0.x, h0.y, h0.z, h0.w, h1.x, h1.y, h1.z, h1.w};
            int acc[16];
#pragma unroll
            for (int j = 0; j < 16; ++j) acc[j] = 0;
#pragma unroll
            for (int k0 = 0; k0 < 32; k0 += 16) {
                v4u w[16];
#pragma unroll
                for (int k = 0; k < 16; ++k) w[k] = *(const v4u*)(vb + (size_t)idxv[k0 + k] * DM);
#pragma unroll
                for (int k4 = 0; k4 < 4; ++k4) { const unsigned hd = hq[(k0 >> 2) + k4];
#pragma unroll
                    for (int c4 = 0; c4 < 4; ++c4) {
                        const unsigned a = w[4 * k4][c4], b = w[4 * k4 + 1][c4], c = w[4 * k4 + 2][c4], d = w[4 * k4 + 3][c4];
                        const unsigned pq = permb(b, a, 0x05010400u), qq = permb(b, a, 0x07030602u), rq = permb(d, c, 0x05010400u), sq = permb(d, c, 0x07030602u);
                        acc[4 * c4 + 0] = sdot4(permb(rq, pq, 0x05040100u), hd, acc[4 * c4 + 0]); acc[4 * c4 + 1] = sdot4(permb(rq, pq, 0x07060302u), hd, acc[4 * c4 + 1]);
                        acc[4 * c4 + 2] = sdot4(permb(sq, qq, 0x05040100u), hd, acc[4 * c4 + 2]); acc[4 * c4 + 3] = sdot4(permb(sq, qq, 0x07060302u), hd, acc[4 * c4 + 3]); } }
            }
#pragma unroll
            for (int j = 0; j < 16; ++j) { acc[j] += __shfl_xor(acc[j], 16); acc[j] += __shfl_xor(acc[j], 32); }
            const size_t yo = (size_t)t * DM + s * 256 + l * 16 + 4 * g; const f32x4 x1v = *(const f32x4*)(((float*)p.out) + yo);
            f32x4 o;
            o.x = x1v.x + sh * (float)(g == 0 ? acc[0] : g == 1 ? acc[4] : g == 2 ? acc[8] : acc[12]);
            o.y = x1v.y + sh * (float)(g == 0 ? acc[1] : g == 1 ? acc[5] : g == 2 ? acc[9] : acc[13]);
            o.z = x1v.z + sh * (float)(g == 0 ? acc[2] : g == 1 ? acc[6] : g == 2 ? acc[10] : acc[14]);
            o.w = x1v.w + sh * (float)(g == 0 ? acc[3] : g == 1 ? acc[7] : g == 2 ? acc[11] : acc[15]);
            *(f32x4*)(ydst + yo) = o;
        }
    }
}
__device__ __forceinline__ void final_norm_rows(const P& p, int vcu, int G, float* dst) {
    const int lane = tidx() & 63, gw = vcu * NWAVES + (tidx() >> 6), NGW = G * NWAVES;
    for (int t = gw; t < T; t += NGW) {
        const f32x4* yr = (const f32x4*)(((float*)p.out) + (size_t)t * DM) + lane; const f32x4* gr = (const f32x4*)((const float*)p.g_final) + lane;
        f32x4 v[8]; float s = 0.f;
#pragma unroll
        for (int j = 0; j < 8; ++j) { v[j] = yr[64 * j]; s += (v[j].x * v[j].x + v[j].y * v[j].y) + (v[j].z * v[j].z + v[j].w * v[j].w); }
        const float rstd = rsqrtf(wave_sum(s) * (1.f / DM) + EPS);
        f32x4* o = (f32x4*)(dst + (size_t)t * DM) + lane;
#pragma unroll
        for (int j = 0; j < 8; ++j) o[64 * j] = v[j] * rstd * gr[64 * j];
    }
}

#define TK_CE(a, i, j) { const unsigned h_ = umax_(a[i], a[j]); a[j] = umin_(a[i], a[j]); a[i] = h_; }
__device__ __forceinline__ void sort16_desc(unsigned (&a)[16]) {
    TK_CE(a, 0, 13) TK_CE(a, 1, 12) TK_CE(a, 2, 15) TK_CE(a, 3, 14) TK_CE(a, 4, 8) TK_CE(a, 5, 6) TK_CE(a, 7, 11) TK_CE(a, 9, 10)
    TK_CE(a, 0, 5) TK_CE(a, 1, 7) TK_CE(a, 2, 9) TK_CE(a, 3, 4) TK_CE(a, 6, 13) TK_CE(a, 8, 14) TK_CE(a, 10, 15) TK_CE(a, 11, 12)
    TK_CE(a, 0, 1) TK_CE(a, 2, 3) TK_CE(a, 4, 5) TK_CE(a, 6, 8) TK_CE(a, 7, 9) TK_CE(a, 10, 11) TK_CE(a, 12, 13) TK_CE(a, 14, 15)
    TK_CE(a, 0, 2) TK_CE(a, 1, 3) TK_CE(a, 4, 10) TK_CE(a, 5, 11) TK_CE(a, 6, 7) TK_CE(a, 8, 9) TK_CE(a, 12, 14) TK_CE(a, 13, 15)
    TK_CE(a, 1, 2) TK_CE(a, 3, 12) TK_CE(a, 4, 6) TK_CE(a, 5, 7) TK_CE(a, 8, 10) TK_CE(a, 9, 11) TK_CE(a, 13, 14)
    TK_CE(a, 1, 4) TK_CE(a, 2, 6) TK_CE(a, 5, 8) TK_CE(a, 7, 10) TK_CE(a, 9, 13) TK_CE(a, 11, 14)
    TK_CE(a, 2, 4) TK_CE(a, 3, 6) TK_CE(a, 9, 12) TK_CE(a, 11, 13)
    TK_CE(a, 3, 5) TK_CE(a, 6, 8) TK_CE(a, 7, 9) TK_CE(a, 10, 12)
    TK_CE(a, 3, 4) TK_CE(a, 5, 6) TK_CE(a, 7, 8) TK_CE(a, 9, 10) TK_CE(a, 11, 12)
    TK_CE(a, 6, 7) TK_CE(a, 8, 9)
}
__device__ __forceinline__ void merge_top16(unsigned (&A)[16], const unsigned (&B)[16]) {
#pragma unroll
    for (int i = 0; i < 16; ++i) A[i] = umax_(A[i], B[15 - i]);
#pragma unroll
    for (int j = 8; j >= 1; j >>= 1)
#pragma unroll
        for (int i = 0; i < 16; ++i) if (!(i & j)) TK_CE(A, i, i + j)
}
__host__ __device__ constexpr int cand_index(int i, int j) {
    int n = 0;
    for (int a = 0; a < 16; ++a) for (int b = 0; b < 16; ++b) { if (a == i && b == j) return n; if ((a + 1) * (b + 1) <= 16) ++n; }
    return n;
}
struct EpiRoute {
    static constexpr bool PERM = true, AFTER_DRAIN = true, MIDK = false;
    const bf16* skp; const float* rsp; int* idx; float* gate;
    __device__ __forceinline__ void fused(pg8::f32x4 (&acc)[2][2][4][2], const pg8::Unit& u, int wr, int wc, int fr, int fq, PG8_LAS unsigned char* lds, int wid, int lane) const {
#pragma unroll
        for (int ai = 0; ai < 2; ++ai)
#pragma unroll
            for (int m = 0; m < 4; ++m) { const int row = ai * 128 + wr * 64 + m * 16 + fr;
#pragma unroll
                for (int bj = 0; bj < 2; ++bj) { const int col = bj * 128 + wc * 32 + 8 * fq; const pg8::f32x4 v0 = acc[ai][bj][m][0], v1 = acc[ai][bj][m][1];
                    pg8::u32x4 w; w.x = pg8::cvt_pk_bf16(v0[0], v0[1]); w.y = pg8::cvt_pk_bf16(v0[2], v0[3]); w.z = pg8::cvt_pk_bf16(v1[0], v1[1]); w.w = pg8::cvt_pk_bf16(v1[2], v1[3]);
                    *(PG8_LAS pg8::u32x4*)(lds + row * 528 + col * 2) = w; } }
        asm volatile("s_waitcnt lgkmcnt(0)" ::: "memory"); __builtin_amdgcn_s_barrier(); asm volatile("" ::: "memory");
        const int tk = lane & 31, hi = lane >> 5, trow = 32 * wid + tk;
        unsigned vv[2][16];
#pragma unroll
        for (int ph = 0; ph < 2; ++ph) {
            bf16x8 bq[8];
#pragma unroll
            for (int ks = 0; ks < 8; ++ks) bq[ks] = *(const PG8_LAS bf16x8*)(lds + trow * 528 + (ph * 128 + 16 * ks + 8 * hi) * 2);
#pragma unroll
            for (int nt = 0; nt < 4; ++nt) { f32x16 sc = zero16(); const bf16* ap = skp + (size_t)(ph * 128 + 32 * nt + tk) * 128 + 8 * hi;
#pragma unroll
                for (int ks = 0; ks < 8; ++ks) sc = mfma32(*(const bf16x8*)(ap + 16 * ks), bq[ks], sc);
                unsigned x[16];
#pragma unroll
                for (int r = 0; r < 16; ++r) x[r] = (okey(sc[r]) & 0xffffff80u) | (unsigned)(127 - (32 * nt + (r & 3) + 8 * (r >> 2) + 4 * hi));
                sort16_desc(x);
                if (nt == 0) {
#pragma unroll
                    for (int i = 0; i < 16; ++i) vv[ph][i] = x[i]; }
                else merge_top16(vv[ph], x); }
            unsigned ot[16];
#pragma unroll
            for (int i = 0; i < 16; ++i) ot[i] = (unsigned)__shfl_xor((int)vv[ph][i], 32);
            merge_top16(vv[ph], ot);
        }
        float s0[16], s1[16]; unsigned long long p0lo = 0ull, p0hi = 0ull, p1lo = 0ull, p1hi = 0ull;
#pragma unroll
        for (int i = 0; i < 16; ++i) { const unsigned k0 = vv[0][i], k1 = vv[1][i];
            s0[i] = unkey(k0 & 0xffffff80u); s1[i] = unkey(k1 & 0xffffff80u);
            const unsigned long long a0 = (unsigned long long)(127u - (k0 & 127u)) << (8 * (i & 7)), a1 = (unsigned long long)(127u - (k1 & 127u)) << (8 * (i & 7));
            if (i < 8) { p0lo |= a0; p1lo |= a1; } else { p0hi |= a0; p1hi |= a1; } }
        unsigned bk[16], c1[16], c2[16], c3a = 0u, c3b = 0u;
#pragma unroll
        for (int i = 0; i < 16; ++i)
#pragma unroll
            for (int j = 0; j < 16; ++j) if ((i + 1) * (j + 1) <= 16) {
                const unsigned x = (okey(s0[i] + s1[j]) & 0xffffff00u) | (unsigned)(255 - (i * 16 + j));
                const int n = cand_index(i, j);
                if (n < 16) bk[n & 15] = x; else if (n < 32) c1[n & 15] = x; else if (n < 48) c2[n & 15] = x; else if (n == 48) c3a = x; else c3b = x; }
        sort16_desc(bk); sort16_desc(c1); sort16_desc(c2); merge_top16(bk, c1); merge_top16(bk, c2);
#pragma unroll
        for (int k = 0; k < 16; ++k) { const unsigned hv = umax_(bk[k], c3a); c3a = umin_(bk[k], c3a); bk[k] = hv; }
#pragma unroll
        for (int k = 0; k < 16; ++k) { const unsigned hv = umax_(bk[k], c3b); c3b = umin_(bk[k], c3b); bk[k] = hv; }
        const int t = u.pm * 256 + trow, head = u.pn;
        const float rstd = row_rstd(rsp, t);
        const float mx = unkey(bk[0] & 0xffffff00u) * rstd; float l = 0.f; float ev[16];
#pragma unroll
        for (int k = 0; k < 16; ++k) { ev[k] = __expf(unkey(bk[k] & 0xffffff00u) * rstd - mx); l += ev[k]; }
        const float inv = 1.0f / l;
        int be[16];
#pragma unroll
        for (int k = 0; k < 16; ++k) { const int code = 255 - (int)(bk[k] & 255u), ci = code >> 4, cj = code & 15;
            const int a = (int)(((ci & 8) ? p0hi : p0lo) >> (8 * (ci & 7))) & 0xff, c = (int)(((cj & 8) ? p1hi : p1lo) >> (8 * (cj & 7))) & 0xff;
            be[k] = a * 128 + c; }
        int* io = idx + (size_t)t * 128 + head * 16; float* go = gate + (size_t)t * 128 + head * 16;
        if (hi == 0) {
            *(int4*)io = make_int4(be[0], be[1], be[2], be[3]); *(int4*)(io + 4) = make_int4(be[4], be[5], be[6], be[7]);
            *(f32x4*)go = (f32x4){ev[0] * inv, ev[1] * inv, ev[2] * inv, ev[3] * inv}; *(f32x4*)(go + 4) = (f32x4){ev[4] * inv, ev[5] * inv, ev[6] * inv, ev[7] * inv};
        } else {
            *(int4*)(io + 8) = make_int4(be[8], be[9], be[10], be[11]); *(int4*)(io + 12) = make_int4(be[12], be[13], be[14], be[15]);
            *(f32x4*)(go + 8) = (f32x4){ev[8] * inv, ev[9] * inv, ev[10] * inv, ev[11] * inv}; *(f32x4*)(go + 12) = (f32x4){ev[12] * inv, ev[13] * inv, ev[14] * inv, ev[15] * inv};
        }
    }
};

__device__ __forceinline__ void peer_fused(const P& p, const PeerMap& mp, unsigned char* lds, float* ybuf, float* dst) {
    const int lane = tidx() & 63, wave = tidx() >> 6, g = lane >> 4, l = lane & 15;
    unsigned char* wl = lds + wave * 14848;
    unsigned char* XQl = wl; float* PAl = (float*)(wl + 8192); int* IDl = (int*)(wl + 8192 + 2048); unsigned char* HQl = wl + 8192 + 4096;
    const float* SU = WSP(const float, WS_SU); const float* SV = WSP(const float, WS_SV);
    const int slot = mp.r * NWAVES + wave, nslots = mp.nloc * NWAVES;
    for (int q0 = slot; q0 * mp.nx + mp.rho < T; q0 += 4 * nslots) {
        int tk[4]; float ascale[4], sh[4], ssq[4];
#pragma unroll
        for (int j = 0; j < 4; ++j) { const int t = (q0 + j * nslots) * mp.nx + mp.rho; tk[j] = t < T ? t : -1; ssq[j] = 0.f; sh[j] = 0.f; ascale[j] = 0.f; }
#pragma unroll
        for (int j = 0; j < 4; ++j) if (tk[j] >= 0) { const int t = tk[j];
            const v4u* xp = WSP(const v4u, WS_XG) + (size_t)t * 256 + lane * 4; float f[32];
            unpack8(xp[0], f); unpack8(xp[1], f + 8); unpack8(xp[2], f + 16); unpack8(xp[3], f + 24);
            float m = 0.f;
#pragma unroll
            for (int i = 0; i < 32; ++i) m = fmaxf(m, fabsf(f[i]));
            m = fmaxf(wave_max(m), 1e-30f); const float inv = 127.f / m; ascale[j] = row_rstd(WSP(const float, WS_RSP), t) * m * (1.f / 127.f);
            v4u o0, o1;
            o0.x = q8(f[0], inv) | (q8(f[1], inv) << 8) | (q8(f[2], inv) << 16) | (q8(f[3], inv) << 24); o0.y = q8(f[4], inv) | (q8(f[5], inv) << 8) | (q8(f[6], inv) << 16) | (q8(f[7], inv) << 24);
            o0.z = q8(f[8], inv) | (q8(f[9], inv) << 8) | (q8(f[10], inv) << 16) | (q8(f[11], inv) << 24); o0.w = q8(f[12], inv) | (q8(f[13], inv) << 8) | (q8(f[14], inv) << 16) | (q8(f[15], inv) << 24);
            o1.x = q8(f[16], inv) | (q8(f[17], inv) << 8) | (q8(f[18], inv) << 16) | (q8(f[19], inv) << 24); o1.y = q8(f[20], inv) | (q8(f[21], inv) << 8) | (q8(f[22], inv) << 16) | (q8(f[23], inv) << 24);
            o1.z = q8(f[24], inv) | (q8(f[25], inv) << 8) | (q8(f[26], inv) << 16) | (q8(f[27], inv) << 24); o1.w = q8(f[28], inv) | (q8(f[29], inv) << 8) | (q8(f[30], inv) << 16) | (q8(f[31], inv) << 24);
            *(v4u*)(XQl + j * 2048 + lane * 32) = o0; *(v4u*)(XQl + j * 2048 + lane * 32 + 16) = o1;
            const int ia = WSP(const int, WS_IDX)[(size_t)t * 128 + lane], ib = WSP(const int, WS_IDX)[(size_t)t * 128 + 64 + lane];
            IDl[j * 128 + (lane & 3) * 32 + (lane >> 2)] = ia; IDl[j * 128 + (lane & 3) * 32 + 16 + (lane >> 2)] = ib;
            PAl[j * 128 + lane] = 0.f; PAl[j * 128 + 64 + lane] = 0.f; }
        for (int s = 0; s < 8; ++s) {
            const unsigned char* ub = (const unsigned char*)(p.ws + WS_UQ) + s * 256 + l * 16;
#pragma unroll
            for (int j = 0; j < 4; ++j) if (tk[j] >= 0) {
                const v4u xq = *(const v4u*)(XQl + j * 2048 + s * 256 + l * 16);
#pragma unroll
                for (int k0 = 0; k0 < 32; k0 += 16) {
                    int idxv[16];
#pragma unroll
                    for (int k4 = 0; k4 < 4; ++k4) { const int4 q = *(const int4*)(IDl + j * 128 + g * 32 + k0 + 4 * k4); idxv[4 * k4] = q.x; idxv[4 * k4 + 1] = q.y; idxv[4 * k4 + 2] = q.z; idxv[4 * k4 + 3] = q.w; }
                    v4u w[16];
#pragma unroll
                    for (int k = 0; k < 16; ++k) w[k] = *(const v4u*)(ub + (size_t)idxv[k] * DM);
#pragma unroll
                    for (int k = 0; k < 16; ++k) { int a0 = sdot4(w[k].x, xq.x, 0), a1 = sdot4(w[k].y, xq.y, 0); a0 = sdot4(w[k].z, xq.z, a0); a1 = sdot4(w[k].w, xq.w, a1);
                        const float d = row16_sum((float)(a0 + a1));
                        if (l == 0) PAl[j * 128 + 4 * (k0 + k) + g] += d; }
                }
            }
        }
#pragma unroll
        for (int j = 0; j < 4; ++j) if (tk[j] >= 0) { const int t = tk[j];
            const int ia = IDl[j * 128 + (lane & 3) * 32 + (lane >> 2)], ib = IDl[j * 128 + (lane & 3) * 32 + 16 + (lane >> 2)];
            const float aa = PAl[j * 128 + lane] * ascale[j] * SU[ia], ab = PAl[j * 128 + 64 + lane] * ascale[j] * SU[ib];
            const float ha = 0.5f * aa * (1.0f + erff(aa * 0.70710678118f)) * WSP(const float, WS_GATE)[(size_t)t * 128 + lane] * SV[ia];
            const float hb = 0.5f * ab * (1.0f + erff(ab * 0.70710678118f)) * WSP(const float, WS_GATE)[(size_t)t * 128 + 64 + lane] * SV[ib];
            const float m = fmaxf(wave_max(fmaxf(fabsf(ha), fabsf(hb))), 1e-30f); sh[j] = m * (1.f / 127.f); const float inv = 127.f / m;
            HQl[j * 128 + (lane & 3) * 32 + (lane >> 2)] = (unsigned char)q8(ha, inv); HQl[j * 128 + (lane & 3) * 32 + 16 + (lane >> 2)] = (unsigned char)q8(hb, inv); }
        for (int s = 0; s < 8; ++s) {
            const unsigned char* vb = (const unsigned char*)(p.ws + WS_VQ) + s * 256 + l * 16;
#pragma unroll
            for (int j = 0; j < 4; ++j) if (tk[j] >= 0) {
                const v4u h0 = *(const v4u*)(HQl + j * 128 + g * 32), h1 = *(const v4u*)(HQl + j * 128 + g * 32 + 16);
                const unsigned hq[8] = {h0.x, h0.y, h0.z, h0.w, h1.x, h1.y, h1.z, h1.w};
                int acc[16];
#pragma unroll
                for (int c = 0; c < 16; ++c) acc[c] = 0;
#pragma unroll
                for (int k0 = 0; k0 < 32; k0 += 16) {
                    int idxv[16];
#pragma unroll
                    for (int k4 = 0; k4 < 4; ++k4) { const int4 q = *(const int4*)(IDl + j * 128 + g * 32 + k0 + 4 * k4); idxv[4 * k4] = q.x; idxv[4 * k4 + 1] = q.y; idxv[4 * k4 + 2] = q.z; idxv[4 * k4 + 3] = q.w; }
                    v4u w[16];
#pragma unroll
                    for (int k = 0; k < 16; ++k) w[k] = *(const v4u*)(vb + (size_t)idxv[k] * DM);
#pragma unroll
                    for (int k4 = 0; k4 < 4; ++k4) { const unsigned hd = hq[(k0 >> 2) + k4];
#pragma unroll
                        for (int c4 = 0; c4 < 4; ++c4) {
                            const unsigned a = w[4 * k4][c4], b = w[4 * k4 + 1][c4], c = w[4 * k4 + 2][c4], d = w[4 * k4 + 3][c4];
                            const unsigned pq = permb(b, a, 0x05010400u), qq = permb(b, a, 0x07030602u), rq = permb(d, c, 0x05010400u), sq = permb(d, c, 0x07030602u);
                            acc[4 * c4 + 0] = sdot4(permb(rq, pq, 0x05040100u), hd, acc[4 * c4 + 0]); acc[4 * c4 + 1] = sdot4(permb(rq, pq, 0x07060302u), hd, acc[4 * c4 + 1]);
                            acc[4 * c4 + 2] = sdot4(permb(sq, qq, 0x05040100u), hd, acc[4 * c4 + 2]); acc[4 * c4 + 3] = sdot4(permb(sq, qq, 0x07060302u), hd, acc[4 * c4 + 3]); } }
                }
#pragma unroll
                for (int c = 0; c < 16; ++c) { acc[c] += __shfl_xor(acc[c], 16); acc[c] += __shfl_xor(acc[c], 32); }
                const size_t yo = (size_t)tk[j] * DM + s * 256 + l * 16 + 4 * g; const f32x4 x1v = *(const f32x4*)(((float*)p.out) + yo);
                f32x4 o;
                o.x = x1v.x + sh[j] * (float)(g == 0 ? acc[0] : g == 1 ? acc[4] : g == 2 ? acc[8] : acc[12]);
                o.y = x1v.y + sh[j] * (float)(g == 0 ? acc[1] : g == 1 ? acc[5] : g == 2 ? acc[9] : acc[13]);
                o.z = x1v.z + sh[j] * (float)(g == 0 ? acc[2] : g == 1 ? acc[6] : g == 2 ? acc[10] : acc[14]);
                o.w = x1v.w + sh[j] * (float)(g == 0 ? acc[3] : g == 1 ? acc[7] : g == 2 ? acc[11] : acc[15]);
                *(f32x4*)(ybuf + yo) = o;
                ssq[j] += (o.x * o.x + o.y * o.y) + (o.z * o.z + o.w * o.w);
            }
        }
        asm volatile("s_waitcnt vmcnt(0)" ::: "memory");
#pragma unroll
        for (int j = 0; j < 4; ++j) if (tk[j] >= 0) {
            const float rstd = rsqrtf(wave_sum(ssq[j]) * (1.f / DM) + EPS);
            const f32x4* yr = (const f32x4*)(ybuf + (size_t)tk[j] * DM) + lane; const f32x4* gr = (const f32x4*)((const float*)p.g_final) + lane; f32x4* o = (f32x4*)(dst + (size_t)tk[j] * DM) + lane;
            f32x4 v[8];
#pragma unroll
            for (int i = 0; i < 8; ++i) v[i] = __builtin_nontemporal_load(yr + 64 * i);
#pragma unroll
            for (int i = 0; i < 8; ++i) o[64 * i] = v[i] * rstd * gr[64 * i];
        }
    }
}

__device__ __forceinline__ void peer_fused16(const P& p, const PeerMap& mp, unsigned char* lds, float* ybuf, float* dst) {
    const int lane = tidx() & 63, wave = tidx() >> 6, g = lane >> 3, l = lane & 7;
    unsigned char* wl = lds + wave * 18944;
    unsigned char* XQl = wl; float* PAl = (float*)(wl + 8192); int* IDl = (int*)(wl + 16384); unsigned char* HQl = wl + 16384 + 2048; unsigned char* Yl = wl;
    const float* SU = WSP(const float, WS_SU); const float* SV = WSP(const float, WS_SV);
    const int slot = mp.r * NWAVES + wave, nslots = mp.nloc * NWAVES;
    for (int q0 = slot; q0 * mp.nx + mp.rho < T; q0 += 4 * nslots) {
        int tk[4]; float ascale[4], sh[4], ssq[4];
#pragma unroll
        for (int j = 0; j < 4; ++j) { const int t = (q0 + j * nslots) * mp.nx + mp.rho; tk[j] = t < T ? t : -1; ssq[j] = 0.f; sh[j] = 0.f; ascale[j] = 0.f; }
#pragma unroll
        for (int j = 0; j < 4; ++j) if (tk[j] >= 0) { const int t = tk[j];
            const v4u* xp = WSP(const v4u, WS_XG) + (size_t)t * 256 + lane * 4; float f[32];
            unpack8(xp[0], f); unpack8(xp[1], f + 8); unpack8(xp[2], f + 16); unpack8(xp[3], f + 24);
            float m = 0.f;
#pragma unroll
            for (int i = 0; i < 32; ++i) m = fmaxf(m, fabsf(f[i]));
            m = fmaxf(wave_max(m), 1e-30f); const float inv = 127.f / m; ascale[j] = row_rstd(WSP(const float, WS_RSP), t) * m * (1.f / 127.f);
            v4u o0, o1;
            o0.x = q8(f[0], inv) | (q8(f[1], inv) << 8) | (q8(f[2], inv) << 16) | (q8(f[3], inv) << 24); o0.y = q8(f[4], inv) | (q8(f[5], inv) << 8) | (q8(f[6], inv) << 16) | (q8(f[7], inv) << 24);
            o0.z = q8(f[8], inv) | (q8(f[9], inv) << 8) | (q8(f[10], inv) << 16) | (q8(f[11], inv) << 24); o0.w = q8(f[12], inv) | (q8(f[13], inv) << 8) | (q8(f[14], inv) << 16) | (q8(f[15], inv) << 24);
            o1.x = q8(f[16], inv) | (q8(f[17], inv) << 8) | (q8(f[18], inv) << 16) | (q8(f[19], inv) << 24); o1.y = q8(f[20], inv) | (q8(f[21], inv) << 8) | (q8(f[22], inv) << 16) | (q8(f[23], inv) << 24);
            o1.z = q8(f[24], inv) | (q8(f[25], inv) << 8) | (q8(f[26], inv) << 16) | (q8(f[27], inv) << 24); o1.w = q8(f[28], inv) | (q8(f[29], inv) << 8) | (q8(f[30], inv) << 16) | (q8(f[31], inv) << 24);
            *(v4u*)(XQl + j * 2048 + lane * 32) = o0; *(v4u*)(XQl + j * 2048 + lane * 32 + 16) = o1;
            const int ia = WSP(const int, WS_IDX)[(size_t)t * 128 + lane], ib = WSP(const int, WS_IDX)[(size_t)t * 128 + 64 + lane];
            IDl[j * 128 + (lane & 7) * 16 + (lane >> 3)] = ia; IDl[j * 128 + (lane & 7) * 16 + 8 + (lane >> 3)] = ib;
            PAl[j * 128 + lane] = 0.f; PAl[j * 128 + 64 + lane] = 0.f; }
        int pu[4][16];
#pragma unroll
        for (int j = 0; j < 4; ++j)
#pragma unroll
            for (int k = 0; k < 16; ++k) pu[j][k] = 0;
        for (int s = 0; s < 16; ++s) {
            const unsigned char* ub = (const unsigned char*)(p.ws + WS_UQ) + (size_t)s * (NEXP * 128) + l * 16;
#pragma unroll
            for (int j = 0; j < 4; ++j) if (tk[j] >= 0) {
                const v4u xq = *(const v4u*)(XQl + j * 2048 + s * 128 + l * 16);
                int idxv[16];
#pragma unroll
                for (int k4 = 0; k4 < 4; ++k4) { const int4 q = *(const int4*)(IDl + j * 128 + g * 16 + 4 * k4); idxv[4 * k4] = q.x; idxv[4 * k4 + 1] = q.y; idxv[4 * k4 + 2] = q.z; idxv[4 * k4 + 3] = q.w; }
                v4u w[16];
#pragma unroll
                for (int k = 0; k < 16; ++k) w[k] = *(const v4u*)(ub + (size_t)idxv[k] * 128);
#pragma unroll
                for (int k = 0; k < 16; ++k) { int a0 = sdot4(w[k].x, xq.x, pu[j][k]); a0 = sdot4(w[k].y, xq.y, a0); a0 = sdot4(w[k].z, xq.z, a0); pu[j][k] = sdot4(w[k].w, xq.w, a0); }
            }
        }
#pragma unroll
        for (int j = 0; j < 4; ++j) if (tk[j] >= 0) {
#pragma unroll
            for (int k = 0; k < 16; ++k) { const float d = sum8((float)pu[j][k]); if (l == 0) PAl[j * 128 + 8 * k + g] = d; } }
#pragma unroll
        for (int j = 0; j < 4; ++j) if (tk[j] >= 0) { const int t = tk[j]; int lane = tidx() & 63; asm volatile("" : "+v"(lane));
            const int ia = IDl[j * 128 + (lane & 7) * 16 + (lane >> 3)], ib = IDl[j * 128 + (lane & 7) * 16 + 8 + (lane >> 3)];
            const float aa = PAl[j * 128 + lane] * ascale[j] * SU[ia], ab = PAl[j * 128 + 64 + lane] * ascale[j] * SU[ib];
            const float ha = 0.5f * aa * (1.0f + erff(aa * 0.70710678118f)) * WSP(const float, WS_GATE)[(size_t)t * 128 + lane] * SV[ia];
            const float hb = 0.5f * ab * (1.0f + erff(ab * 0.70710678118f)) * WSP(const float, WS_GATE)[(size_t)t * 128 + 64 + lane] * SV[ib];
            const float m = fmaxf(wave_max(fmaxf(fabsf(ha), fabsf(hb))), 1e-30f); sh[j] = m * (1.f / 127.f); const float inv = 127.f / m;
            HQl[j * 128 + (lane & 7) * 16 + (lane >> 3)] = (unsigned char)q8(ha, inv); HQl[j * 128 + (lane & 7) * 16 + 8 + (lane >> 3)] = (unsigned char)q8(hb, inv); }
        for (int s = 0; s < 16; ++s) {
            const unsigned char* vb = (const unsigned char*)(p.ws + WS_VQ) + (size_t)s * (NEXP * 128) + l * 16;
#pragma unroll
            for (int j = 0; j < 4; ++j) if (tk[j] >= 0) {
                const v4u h0 = *(const v4u*)(HQl + j * 128 + g * 16);
                const unsigned hq[4] = {h0.x, h0.y, h0.z, h0.w};
                int acc[16];
#pragma unroll
                for (int c = 0; c < 16; ++c) acc[c] = 0;
                int idxv[16];
#pragma unroll
                for (int k4 = 0; k4 < 4; ++k4) { const int4 q = *(const int4*)(IDl + j * 128 + g * 16 + 4 * k4); idxv[4 * k4] = q.x; idxv[4 * k4 + 1] = q.y; idxv[4 * k4 + 2] = q.z; idxv[4 * k4 + 3] = q.w; }
                v4u w[16];
#pragma unroll
                for (int k = 0; k < 16; ++k) w[k] = *(const v4u*)(vb + (size_t)idxv[k] * 128);
#pragma unroll
                for (int k4 = 0; k4 < 4; ++k4) { const unsigned hd = hq[k4];
#pragma unroll
                    for (int c4 = 0; c4 < 4; ++c4) {
                        const unsigned a = w[4 * k4][c4], b = w[4 * k4 + 1][c4], c = w[4 * k4 + 2][c4], d = w[4 * k4 + 3][c4];
                        const unsigned pq = permb(b, a, 0x05010400u), qq = permb(b, a, 0x07030602u), rq = permb(d, c, 0x05010400u), sq = permb(d, c, 0x07030602u);
                        acc[4 * c4 + 0] = sdot4(permb(rq, pq, 0x05040100u), hd, acc[4 * c4 + 0]); acc[4 * c4 + 1] = sdot4(permb(rq, pq, 0x07060302u), hd, acc[4 * c4 + 1]);
                        acc[4 * c4 + 2] = sdot4(permb(sq, qq, 0x05040100u), hd, acc[4 * c4 + 2]); acc[4 * c4 + 3] = sdot4(permb(sq, qq, 0x07060302u), hd, acc[4 * c4 + 3]); } }
                int r8[8], r4[4];
#pragma unroll
                for (int c = 0; c < 8; ++c) { auto rr = __builtin_amdgcn_permlane32_swap((unsigned)acc[c], (unsigned)acc[c + 8], false, false); r8[c] = (int)rr[0] + (int)rr[1]; }
#pragma unroll
                for (int c = 0; c < 4; ++c) { auto rr = __builtin_amdgcn_permlane16_swap((unsigned)r8[c], (unsigned)r8[c + 4], false, false); r4[c] = (int)rr[0] + (int)rr[1]; }
                const bool b3 = (lane & 8) != 0;
                const int k0v = b3 ? r4[2] : r4[0], s0v = b3 ? r4[0] : r4[2], k1v = b3 ? r4[3] : r4[1], s1v = b3 ? r4[1] : r4[3];
                const int s0 = k0v + (int)dppu<0x128>((unsigned)s0v), s1 = k1v + (int)dppu<0x128>((unsigned)s1v);
                const size_t yo = (size_t)tk[j] * DM + s * 128 + l * 16 + 2 * g; const unsigned xb = *(const unsigned*)(WSP(const bf16, WS_XG) + yo);
                const float o0 = __uint_as_float(xb << 16) + sh[j] * (float)s0, o1 = __uint_as_float(xb & 0xffff0000u) + sh[j] * (float)s1;
                *(unsigned*)(Yl + j * 4096 + s * 256 + l * 32 + 4 * g) = pk2(o0, o1);
                ssq[j] += o0 * o0 + o1 * o1;
            }
        }
        asm volatile("s_waitcnt lgkmcnt(0)" ::: "memory");
#pragma unroll
        for (int j = 0; j < 4; ++j) if (tk[j] >= 0) {
            const float rstd = rsqrtf(wave_sum(ssq[j]) * (1.f / DM) + EPS);
            const float* gr = (const float*)p.g_final; float* o = dst + (size_t)tk[j] * DM;
#pragma unroll
            for (int i = 0; i < 4; ++i) { const int c8 = (i * 64 + lane) * 8; const v4u yv = *(const v4u*)(Yl + j * 4096 + c8 * 2);
                const f32x4 g0 = *(const f32x4*)(gr + c8), g1 = *(const f32x4*)(gr + c8 + 4);
                f32x4 r0, r1;
                r0.x = __uint_as_float(yv.x << 16) * rstd * g0.x; r0.y = __uint_as_float(yv.x & 0xffff0000u) * rstd * g0.y; r0.z = __uint_as_float(yv.y << 16) * rstd * g0.z; r0.w = __uint_as_float(yv.y & 0xffff0000u) * rstd * g0.w;
                r1.x = __uint_as_float(yv.z << 16) * rstd * g1.x; r1.y = __uint_as_float(yv.z & 0xffff0000u) * rstd * g1.y; r1.z = __uint_as_float(yv.w << 16) * rstd * g1.z; r1.w = __uint_as_float(yv.w & 0xffff0000u) * rstd * g1.w;
                *(f32x4*)(o + c8) = r0; *(f32x4*)(o + c8 + 4) = r1; }
        }
    }
}
#ifndef PROBE_IN
#define PROBE_IN 0
#endif
#ifndef MK_SPLIT
#define MK_SPLIT 0
#endif
constexpr int NPHASE = 9;
template <int LO, int HI> __global__ void __launch_bounds__(NTHR, 2) mk_fwd(P p0) {
    extern __shared__ __attribute__((aligned(16))) unsigned char lds[];
    const int G = gridDim.x, bx_hw = blockIdx.x;
    volatile LAS unsigned* MISC = (volatile LAS unsigned*)((LAS unsigned char*)lds + (LDS_BYTES - 64));
    if (threadIdx.x < 16) MISC[threadIdx.x] = 0u;
    __syncthreads();
    XcdBarrier xbar = xcd_barrier_post((unsigned*)(p0.ws + WS_BAR + (HI - LO == NPHASE ? 0 : (p0.ph_hi ? p0.ph_hi : LO)) * BAR_REGION), MISC);
    const PeerMap mp0 = peer_map(xbar, MISC);
    const int bx = (mp0.bal && mp0.nx == 8) ? mp0.r * 8 + mp0.rho : bx_hw;
    const int vcu = (G % 8 == 0) ? (bx % 8) * (G / 8) + bx / 8 : bx;
#define IN(k) (LO <= (k) && (k) < HI)
#define SEAM(k) do { if constexpr (IN(k) && IN((k) + 1)) { xcd_barrier(xbar); } } while (0)
    PG8_LAS unsigned char* glds = (PG8_LAS unsigned char*)lds;
    typedef pg8::EpiBf16<0> EB;
    if constexpr (IN(0)) { P p = p0; asm volatile("" : "+s"(p.ws)); if (p.ph_lo != 1) phase0(p, lds, vcu, G, bx); } SEAM(0);
    if constexpr (IN(1)) { P p = p0; asm volatile("" : "+s"(p.ws));
        const bool tailwg = (G == 256) && bx >= 80, tail_first = tailwg && (((bx - 80) & 1) == 0);
        if (tail_first && !(PROBE_IN & 64)) { tail_prep(p, lds, bx - 80, G - 80); __syncthreads(); }
        { pg8::Gemm g{WSP(const bf16, WS_H), WSP(const bf16, WS_WIN), T, NIN, DM / 2, DM / 2, DM / 2}; pg8::StaticOrder S; S.init(T, NIN, G, bx);
          pg8::EpiI8 E{WSP(bf16, WS_PROJ), NIN, WSP(const float, WS_SA), WSP(const float, WS_SB), C_GATE, WSP(unsigned char, WS_G8), 3 * DM, ((const float*)p.b_gate)}; pg8::gemm_phase<pg8::EpiI8, pg8::StaticOrder, true, true, true>(glds, g, S, E); }
#if PROBE_IN & 32
        { struct SameTile : pg8::StaticOrder { __device__ bool next(int i, pg8::Unit& u) const { if (i >= 7) return false; u.pm = c % 8; u.pn = 0; return true; } };
          pg8::Gemm g{WSP(const bf16, WS_H), WSP(const bf16, WS_WIN), T, NIN, DM / 2, DM / 2, DM / 2}; SameTile S; S.init(T, NIN, G, bx);
          pg8::EpiI8 E{WSP(bf16, WS_ST), 256, WSP(const float, WS_SA), WSP(const float, WS_SB), 1 << 30, nullptr, 0, nullptr}; pg8::gemm_phase<pg8::EpiI8, SameTile, true, true, true>(glds, g, S, E); }
#endif
        { pg8::Gemm g{WSP(const bf16, WS_MEMN), WSP(const bf16, WS_WKV), MROWS, 1024, DM, DM, DM}; pg8::StaticOrder S; S.init(MROWS, 1024, G, (bx + G - 64) % G);
          EB E{WSP(bf16, WS_KVM), 1024, nullptr, 0, 0, 1.f}; pg8::gemm_phase<EB, pg8::StaticOrder, true, true>(glds, g, S, E); }
        { pg8::Gemm g{WSP(const bf16, WS_WKV), WSP(const bf16, WS_MEMN), 1024, MROWS, DM, DM, DM}; pg8::StaticOrder S; S.init(1024, MROWS, G, (bx + G - 72) % G);
          EB E{WSP(bf16, WS_KVMT), MROWS, nullptr, 0, 0, 1.f}; pg8::gemm_phase<EB, pg8::StaticOrder, true, true>(glds, g, S, E); }
        if (!(PROBE_IN & 64)) { if (tailwg && !tail_first) tail_prep(p, lds, bx - 80, G - 80); else if (G != 256) tail_prep(p, lds, bx, G); }
    } SEAM(1);
    if constexpr (IN(2)) { P p = p0; asm volatile("" : "+s"(p.ws));
        if (PROBE_IN & 64) { tail_prep(p, lds, bx, G); __syncthreads(); }
        constexpr int N_DIL = BATCH * DIL_H * 32, N_H1 = BATCH * HG_H * 2 * 64, N_MEM = BATCH * MEM_H * 32;
        { DilRegs R; if (bx < N_DIL) dil_load(p, bx, R);
          for (int it = bx; it < N_DIL; it += G) { DilRegs Rn; const bool more = it + G < N_DIL; if (more) dil_load(p, it + G, Rn); dil_item(p, lds, it, R); if (more) R = Rn; } }
        for (int it = bx; it < N_MEM; it += G) mem_item(p, lds, it);
        { unsigned short zc[16], vc[16]; float lbc = 0.f; if (bx < N_H1) h1_load(p, bx, zc, vc, lbc);
          for (int it = bx; it < N_H1; it += G) { unsigned short zn[16], vn[16]; float lbn = 0.f; const bool more = it + G < N_H1; if (more) h1_load(p, it + G, zn, vn, lbn); h1_item(p, lds, it, zc, vc, lbc);
              if (more) { lbc = lbn;
#pragma unroll
                  for (int i = 0; i < 16; ++i) { zc[i] = zn[i]; vc[i] = vn[i]; } } } }
    } SEAM(2);
    if constexpr (IN(3)) { P p = p0; asm volatile("" : "+s"(p.ws)); if (PROBE_IN & 8) h2_scan(p, bx, G, WSP(bf16, WS_WIN)); h2_scan(p, bx, G, WSP(bf16, WS_ST)); } SEAM(3);
    if constexpr (IN(3) && IN(4)) { if (PROBE_IN & 128) { for (int i = 0; i < 8; ++i) xcd_barrier<!(PROBE_IN & 256), !(PROBE_IN & 512)>(xbar); } }
    if constexpr (IN(4)) { P p = p0; asm volatile("" : "+s"(p.ws)); { constexpr int N_H3 = BATCH * HG_H * 64; unsigned short a0[16], a1[16], a2[16], a3[16]; float lf0 = 0.f, lb0 = 0.f; if (bx < N_H3) { h3_load_z(p, bx, a0, a1, lf0, lb0); h3_load_vq(p, bx, a2, a3); }
          for (int it = bx; it < N_H3; it += G) { unsigned short n0[16], n1[16], n2[16], n3[16]; float lf1 = 0.f, lb1 = 0.f; const bool more = it + G < N_H3; if (more) h3_load_z(p, it + G, n0, n1, lf1, lb1); h3_item(p, lds, it, a0, a1, a2, a3, lf0, lb0, more, it + G, n2, n3);
              if (more) { lf0 = lf1; lb0 = lb1;
#pragma unroll
                  for (int i = 0; i < 16; ++i) { a0[i] = n0[i]; a1[i] = n1[i]; a2[i] = n2[i]; a3[i] = n3[i]; } } } }
        dil_alpha_rows(p, vcu, G); } SEAM(4);
    if constexpr (IN(5)) { P p = p0; asm volatile("" : "+s"(p.ws)); pg8::Gemm g{WSP(const bf16, WS_OCAT), WSP(const bf16, WS_WUP), T, DM, DM, DM, DM}; pg8::StaticOrder S; S.init(T, DM, G, bx);
        pg8::EpiUp E{WSP(const unsigned char, WS_G8), 3 * DM, WSP(bf16, WS_MERGED), 12, 24};
        pg8::gemm_phase<pg8::EpiUp, pg8::StaticOrder, false, true>(glds, g, S, E); } SEAM(5);
    if constexpr (IN(6)) { P p = p0; asm volatile("" : "+s"(p.ws)); pg8::Gemm g{WSP(const bf16, WS_MERGED), WSP(const bf16, WS_WOUT), T, DM, DM, DM, DM}; pg8::StaticOrder S; S.init(T, DM, G, bx);
        pg8::EpiOut E{((const float*)p.x), WSP(bf16, WS_XG), WSP(float, WS_RSP)};
        pg8::gemm_phase<pg8::EpiOut, pg8::StaticOrder, false, true>(glds, g, S, E); } SEAM(6);
    if constexpr (IN(7)) { P p = p0; asm volatile("" : "+s"(p.ws));
        pg8::Gemm g{WSP(const bf16, WS_XG), WSP(const bf16, WS_WQ), T, DM, DM, DM, DM}; pg8::StaticOrder S; S.init(T, DM, G, bx);
        EpiRoute E{WSP(const bf16, WS_SKB), WSP(const float, WS_RSP), WSP(int, WS_IDX), WSP(float, WS_GATE)};
        pg8::gemm_phase<EpiRoute, pg8::StaticOrder, false, true>(glds, g, S, E); } SEAM(7);
    if constexpr (IN(8)) { P p = p0; asm volatile("" : "+s"(p.ws)); const PeerMap mp = mp0; if (PROBE_IN & 1) peer_fused(p, mp, lds, WSP(float, WS_PROJ + 32 * MiB), WSP(float, WS_PROJ + 96 * MiB)); peer_fused16(p, mp, lds, ((float*)p.out), ((float*)p.dst10)); }
#undef IN
#undef SEAM
}

#if MK_SPLIT
#define MK_FOR_PH(X) X(0) X(1) X(2) X(3) X(4) X(5) X(6) X(7) X(8)
static bool set_lds() { bool ok = true;
#define X(k) ok = ok && (hipFuncSetAttribute((const void*)mk_fwd<k, k + 1>, hipFuncAttributeMaxDynamicSharedMemorySize, LDS_BYTES) == hipSuccess);
    MK_FOR_PH(X)
#undef X
    return ok; }
static void launch_split(const P& p, int grid, hipStream_t stream) {
#ifndef PROBE_REP
#define PROBE_REP 0
#endif
#define X(k) { P q = p; q.ph_hi = 0; if (k == 0) { q.ph_lo = 0; hipLaunchKernelGGL((mk_fwd<0, 1>), dim3(grid), dim3(NTHR), LDS_BYTES, stream, q); if ((PROBE_REP >> 15) & 1) { q.ph_hi = 15; hipLaunchKernelGGL((mk_fwd<0, 1>), dim3(grid), dim3(NTHR), LDS_BYTES, stream, q); } q.ph_lo = 1; q.ph_hi = 13; } if (((PROBE_REP >> k) & 1)) { P q2 = q; q2.ph_hi = 14; hipLaunchKernelGGL((mk_fwd<k, k + 1>), dim3(grid), dim3(NTHR), LDS_BYTES, stream, q2); } hipLaunchKernelGGL((mk_fwd<k, k + 1>), dim3(grid), dim3(NTHR), LDS_BYTES, stream, q); }
    MK_FOR_PH(X)
#undef X
}
#else
static bool set_lds() { return hipFuncSetAttribute((const void*)mk_fwd<0, NPHASE>, hipFuncAttributeMaxDynamicSharedMemorySize, LDS_BYTES) == hipSuccess; }
#endif

extern "C" void kernel_launch(void* const* d_in, const int* in_sizes, int n_in, void* d_out, int out_size, void* d_ws, size_t ws_size, hipStream_t stream) {
    static int grid = 0;
    if (grid == 0) {
        if (n_in != 18 || out_size != T * DM || ws_size < WS_END) { fprintf(stderr, "kernel_launch: unexpected shapes (n_in %d, out %d, ws %zu)\n", n_in, out_size, ws_size); grid = -1; return; }
        int dev = 0, cus = 0, per_cu = 0;
        (void)hipGetDevice(&dev); (void)hipDeviceGetAttribute(&cus, hipDeviceAttributeMultiprocessorCount, dev);
        if (!set_lds()) { fprintf(stderr, "kernel_launch: hipFuncSetAttribute failed\n"); grid = -1; return; }
        (void)per_cu; (void)hipGetLastError();
        grid = cus;
        if (grid != 256) { fprintf(stderr, "kernel_launch: built for a 256-CU device (one 256x256 GEMM unit per workgroup in the fused-epilogue phases); found %d CUs\n", cus); grid = -1; return; }
    }
    if (grid < 0) return;
    if (hipMemsetAsync((char*)d_ws + WS_BAR, 0, BAR_ZERO, stream) != hipSuccess) { fprintf(stderr, "kernel_launch: memset failed\n"); return; }
    P p{};
    p.x = (const GAS float*)d_in[0]; p.mem = (const GAS float*)d_in[1]; p.g_mix = (const GAS float*)d_in[2]; p.w_in = (const GAS float*)d_in[3]; p.b_gate = (const GAS float*)d_in[4];
    p.lbf_l = (const GAS float*)d_in[5]; p.lbb_l = (const GAS float*)d_in[6]; p.g_hg = (const GAS float*)d_in[7]; p.w_kv = (const GAS float*)d_in[8]; p.g_mem = (const GAS float*)d_in[9];
    p.w_up = (const GAS float*)d_in[10]; p.w_out = (const GAS float*)d_in[11]; p.g_ffn = (const GAS float*)d_in[12]; p.w_q = (const GAS float*)d_in[13]; p.subk = (const GAS float*)d_in[14];
    p.pu = (const GAS float*)d_in[15]; p.pv = (const GAS float*)d_in[16]; p.g_final = (const GAS float*)d_in[17];
    p.out = (GAS float*)d_out; p.dst10 = (GAS float*)d_out; p.ws = (GAS unsigned char*)d_ws;
#if MK_SPLIT
    launch_split(p, grid, stream);
#else
    p.ph_lo = 2; p.ph_hi = NPHASE;
    void* args[] = {&p};
    hipError_t e = hipLaunchCooperativeKernel((const void*)mk_fwd<0, NPHASE>, dim3(grid), dim3(NTHR), args, LDS_BYTES, stream);
    if (e != hipSuccess) fprintf(stderr, "kernel_launch: cooperative launch failed: %s (grid %d)\n", hipGetErrorString(e), grid);
#endif
}
```

```cpp
#include <hip/hip_runtime.h>
#include <cstdio>
#include <cstdint>
__device__ __forceinline__ int tidx() { int t = threadIdx.x; asm volatile("" : "+v"(t)); return t; }
namespace pg8 {
#define PG8_LAS __attribute__((address_space(3)))
typedef unsigned short bf16_t;
typedef short bf16x8 __attribute__((ext_vector_type(8)));
typedef float f32x4 __attribute__((ext_vector_type(4)));
typedef unsigned u32x4 __attribute__((ext_vector_type(4)));
typedef unsigned u32x2 __attribute__((ext_vector_type(2)));
constexpr int BM = 256, BK = 64, HALF = 128, HTB = HALF * BK * 2  , STAGE_BYTES = 8 * HTB, NXCD = 8, WGM = 8;

__host__ __device__ __forceinline__ int lds_byte(int r, int c) { const int st = (r >> 4) * 2 + (c >> 5), rr = r & 15, cc = c & 31, ob = rr * 64 + cc * 2; return st * 1024 + (ob ^ (((ob >> 9) & 1) << 5)); }
__host__ __device__ __forceinline__ void stage_rc(int b, int& R, int& C) { const int st = b / 1024, sb = b % 1024, swz = sb ^ (((sb >> 9) & 1) << 5); R = (st >> 1) * 16 + swz / 64; C = (st & 1) * 32 + (swz % 64) / 2; }
__host__ __device__ __forceinline__ int perm32(int rho) { const int n = rho >> 4, i = rho & 15; return 8 * (i >> 2) + 4 * n + (i & 3); }

struct Unit { int pm, pn; };
struct Gemm { const bf16_t* A; const bf16_t* Bt; int M, N, K, lda, ldb; };

struct StaticOrder {
    int nM, nN, nwg, G, c;
    __host__ __device__ void init(int M, int N, int G_, int c_) { nM = M / BM; nN = N / BM; nwg = nM * nN; G = G_; c = c_; }
    __host__ __device__ bool next(int i, Unit& u) const { return map((long)i * G + c, u); }
    __host__ __device__ bool map(long L, Unit& u) const {
        if (L >= nwg) return false;
        int wgid = (int)L; { const int q = nwg / NXCD, r = nwg % NXCD, xcd = wgid % NXCD, off = wgid / NXCD; wgid = (xcd < r ? xcd * (q + 1) : r * (q + 1) + (xcd - r) * q) + off; }
        const int nig = WGM * nN, gid = wgid / nig, fm = gid * WGM, gsz = (nM - fm) < WGM ? (nM - fm) : WGM;
        u.pm = fm + ((wgid % nig) % gsz); u.pn = (wgid % nig) / gsz; return true;
    }
    __device__ __forceinline__ void a_ready(const Unit&) const {}
    __device__ __forceinline__ void done(const Unit&) const {}
};
struct SplitOrder : StaticOrder {
    int NT, RA, RB;
    __host__ __device__ bool next(int i, Unit& u) const {
        if (c >= NT) { if (i >= RA) return false; return map((long)i * (G - NT) + (c - NT), u); }
        if (i >= RB) return false; return map((long)(G - NT) * RA + (long)i * NT + c, u);
    }
};


__device__ __forceinline__ unsigned cvt_pk_bf16(float lo, float hi) { unsigned r; asm volatile("v_cvt_pk_bf16_f32 %0, %1, %2" : "=v"(r) : "v"(lo), "v"(hi)); return r; }
typedef float f32x2 __attribute__((ext_vector_type(2)));
__device__ __forceinline__ f32x2 gelu_pk(f32x2 v) {
    const f32x2 av = __builtin_elementwise_abs(v), d = av * 0.2316418882f + 1.0f;
    f32x2 t; t.x = __builtin_amdgcn_rcpf(d.x); t.y = __builtin_amdgcn_rcpf(d.y);
    f32x2 q = t * 0.5307027145f + (-0.7265760135f); q = q * t + 0.7107068705f; q = q * t + (-0.142248368f); q = q * t + 0.127414796f; q = q * t;
    const f32x2 s = (v * v) * (-0.72134752044f);
    f32x2 e; e.x = __builtin_amdgcn_exp2f(s.x); e.y = __builtin_amdgcn_exp2f(s.y);
    const f32x2 m = v * (q * e), r = v - m;
    f32x2 o; o.x = v.x < 0.f ? m.x : r.x; o.y = v.y < 0.f ? m.y : r.y; return o;
}

template <int ACT  > struct EpiBf16 {
    static constexpr bool PERM = true, AFTER_DRAIN = false, MIDK = false; static_assert(ACT == 0 || ACT == 1, "EpiBf16: ACT is 0 (none) or 1 (gelu_pk)");
    bf16_t* O; int ldc; const float* bias; int split_cols; size_t split_stride; float scale0;
    __device__ __forceinline__ void operator()(const f32x4 (&acc)[2][2][4][2], const Unit& u, int wr, int wc, int fr, int fq) const {
        const int row0 = u.pm * BM + wr * 64 + fr; int colt = u.pn * BM; bf16_t* base = O;
        float sc = 1.f; if (split_cols) { const int t = colt / split_cols; base += (size_t)t * split_stride; colt -= t * split_cols; if (t == 0) sc = scale0; }
        const int col0 = colt + wc * 32 + 8 * fq, bcol0 = u.pn * BM + wc * 32 + 8 * fq;
        f32x4 bv[2][2];
#pragma unroll
        for (int bj = 0; bj < 2; ++bj)
#pragma unroll
            for (int n = 0; n < 2; ++n) bv[bj][n] = bias ? *(const f32x4*)(bias + bcol0 + bj * HALF + 4 * n) : (f32x4){0.f, 0.f, 0.f, 0.f};
#pragma unroll
        for (int ai = 0; ai < 2; ++ai)
#pragma unroll
            for (int m = 0; m < 4; ++m) { bf16_t* rowp = base + (size_t)(row0 + ai * HALF + m * 16) * ldc + col0;
#pragma unroll
                for (int bj = 0; bj < 2; ++bj) { f32x4 v0 = acc[ai][bj][m][0] + bv[bj][0], v1 = acc[ai][bj][m][1] + bv[bj][1];
                    if (ACT == 1) { f32x2 a = gelu_pk((f32x2){v0[0], v0[1]}), b = gelu_pk((f32x2){v0[2], v0[3]}), c = gelu_pk((f32x2){v1[0], v1[1]}), d = gelu_pk((f32x2){v1[2], v1[3]});
                        v0 = (f32x4){a.x, a.y, b.x, b.y}; v1 = (f32x4){c.x, c.y, d.x, d.y}; }
                    v0 = v0 * sc; v1 = v1 * sc; u32x4 w; w.x = cvt_pk_bf16(v0[0], v0[1]); w.y = cvt_pk_bf16(v0[2], v0[3]); w.z = cvt_pk_bf16(v1[0], v1[1]); w.w = cvt_pk_bf16(v1[2], v1[3]);
                    *(u32x4*)(rowp + bj * HALF) = w; } }
    }
};
typedef int i32x4 __attribute__((ext_vector_type(4)));
template <bool I8> __device__ __forceinline__ f32x4 mma_sel(bf16x8 a, bf16x8 b, f32x4 c) {
    if constexpr (I8) return __builtin_bit_cast(f32x4, __builtin_amdgcn_mfma_i32_16x16x64_i8(__builtin_bit_cast(i32x4, a), __builtin_bit_cast(i32x4, b), __builtin_bit_cast(i32x4, c), 0, 0, 0));
    else return __builtin_amdgcn_mfma_f32_16x16x32_bf16(a, b, c, 0, 0, 0);
}
template <class Epi, class Sched, bool ALIGN_EPI = false, bool SP2 = false, bool I8 = false>
__device__ __forceinline__ void gemm_phase(PG8_LAS unsigned char* lds, const Gemm g, const Sched& S, const Epi& E) {
    const int tid = tidx(), wid = __builtin_amdgcn_readfirstlane(tid >> 6), lane = tid & 63, wr = wid >> 2, wc = wid & 3, fr = lane & 15, fq = lane >> 4;
    const int K = g.K, nt = K / BK;
    unsigned voffA[2], voffB[2];
#pragma unroll
    for (int i = 0; i < 2; ++i) { int R, C; stage_rc(tid * 16 + i * 8192, R, C); const int Rb = Epi::PERM ? ((R & ~31) + perm32(R & 31)) : R;
        voffA[i] = (unsigned)(R * g.lda + C) * 2u; voffB[i] = (unsigned)(Rb * g.ldb + C) * 2u; }
    const size_t kstep = (size_t)(BK * 2);
    const size_t hstepA = (size_t)HALF * g.lda * 2, hstepB = (size_t)HALF * g.ldb * 2;
    const size_t tstepA = 2 * hstepA, tstepB = 2 * hstepB;
    const unsigned ldsw = (unsigned)wid * 1024u;
    const int aoff = lds_byte(wr * 64 + fr, fq * 8), boff = lds_byte(wc * 32 + fr, fq * 8);
#define PG8_SA(b, h) (((b) * 2 + (h)) * HTB)
#define PG8_SB(b, h) ((4 + (b) * 2 + (h)) * HTB)
#define PG8_STAGE(bufoff, gbase, voff) do { _Pragma("unroll") for (int _i = 0; _i < 2; ++_i) \
        __builtin_amdgcn_global_load_lds((const unsigned*)((const char*)(gbase) + (voff)[_i]), (PG8_LAS unsigned*)(lds + (bufoff) + ldsw + _i * 8192), 16, 0, 0); } while (0)
#define PG8_LDA(dst, b, h) do { _Pragma("unroll") for (int m = 0; m < 4; ++m) _Pragma("unroll") for (int k = 0; k < 2; ++k) dst[m][k] = *(const PG8_LAS bf16x8*)(lds + PG8_SA(b, h) + aoff + m * 2048 + k * 1024); } while (0)
#define PG8_LDB(dst, b, h) do { _Pragma("unroll") for (int n = 0; n < 2; ++n) _Pragma("unroll") for (int k = 0; k < 2; ++k) dst[n][k] = *(const PG8_LAS bf16x8*)(lds + PG8_SB(b, h) + boff + n * 2048 + k * 1024); } while (0)
#define PG8_MMA(ai, bj, At, Bt) do { __builtin_amdgcn_s_setprio(1); _Pragma("unroll") for (int m = 0; m < 4; ++m) _Pragma("unroll") for (int n = 0; n < 2; ++n) _Pragma("unroll") for (int k = 0; k < 2; ++k) \
        acc[ai][bj][m][n] = mma_sel<I8>(Bt[n][k], At[m][k], acc[ai][bj][m][n]); __builtin_amdgcn_s_setprio(0); } while (0)
#define PG8_WAIT_V(n) asm volatile("s_waitcnt vmcnt(" #n ")" ::: "memory")
#define PG8_WAIT_L(n) asm volatile("s_waitcnt lgkmcnt(" #n ")" ::: "memory")
#define PG8_BAR __builtin_amdgcn_s_barrier()
#define PG8_SCHED __builtin_amdgcn_sched_barrier(0)
    Unit cur, nxt; int ui = 0;
    if (!S.next(0, cur)) return;
    f32x4 acc[2][2][4][2];
#pragma unroll
    for (int a = 0; a < 2; ++a)
#pragma unroll
        for (int b = 0; b < 2; ++b)
#pragma unroll
            for (int m = 0; m < 4; ++m)
#pragma unroll
                for (int n = 0; n < 2; ++n) acc[a][b][m][n] = (f32x4){0.f, 0.f, 0.f, 0.f};
    bf16x8 At[4][2], B0[2][2], B1[2][2];
    const char* cA = (const char*)g.A + (size_t)cur.pm * tstepA; const char* cB = (const char*)g.Bt + (size_t)cur.pn * tstepB;
    S.a_ready(cur);
    if constexpr (SP2) {
        PG8_STAGE(PG8_SB(0, 0), cB, voffB); PG8_STAGE(PG8_SB(0, 1), cB + hstepB, voffB); PG8_STAGE(PG8_SA(0, 0), cA, voffA); PG8_STAGE(PG8_SA(0, 1), cA + hstepA, voffA);
        if (wr == 1) PG8_BAR;
        PG8_WAIT_V(2); PG8_BAR;
        PG8_STAGE(PG8_SB(1, 0), cB + kstep, voffB); PG8_STAGE(PG8_SA(1, 0), cA + kstep, voffA); PG8_STAGE(PG8_SB(1, 1), cB + hstepB + kstep, voffB);
        PG8_WAIT_V(6); PG8_BAR;
    } else {
        PG8_STAGE(PG8_SB(0, 0), cB, voffB); PG8_STAGE(PG8_SA(0, 0), cA, voffA); PG8_STAGE(PG8_SB(0, 1), cB + hstepB, voffB); PG8_STAGE(PG8_SA(0, 1), cA + hstepA, voffA);
        if (wr == 1) PG8_BAR;
        PG8_WAIT_V(4); PG8_BAR;
        PG8_STAGE(PG8_SB(1, 0), cB + kstep, voffB); PG8_STAGE(PG8_SA(1, 0), cA + kstep, voffA); PG8_STAGE(PG8_SB(1, 1), cB + hstepB + kstep, voffB);
        PG8_WAIT_V(6); PG8_BAR;
    }
    for (;;) {
        const bool has_next = S.next(ui + 1, nxt);
        const char* nA = has_next ? (const char*)g.A + (size_t)nxt.pm * tstepA : cA; const char* nB = has_next ? (const char*)g.Bt + (size_t)nxt.pn * tstepB : cB;
        for (int t = 0; t < nt; t += 2) {
            if constexpr (Epi::MIDK) { if (t == E.t1 || t == E.t2) E.mid(acc, cur, t == E.t1 ? 0 : 1, wr, wc, fr, fq); }
            const bool last = (t == nt - 2);
            const char* a1 = cA + (size_t)(t + 1) * kstep;
            const char* a2 = last ? nA : cA + (size_t)(t + 2) * kstep; const char* b2 = last ? nB : cB + (size_t)(t + 2) * kstep;
            const char* a3 = a2 + kstep; const char* b3 = b2 + kstep;
            if (last && has_next) S.a_ready(nxt);
            if constexpr (SP2) {
            PG8_LDB(B0, 0, 0); PG8_LDB(B1, 0, 1); PG8_SCHED; PG8_LDA(At, 0, 0); PG8_STAGE(PG8_SA(1, 1), a1 + hstepA, voffA);
            PG8_WAIT_V(8); PG8_WAIT_L(0); PG8_BAR; PG8_MMA(0, 0, At, B0); PG8_MMA(0, 1, At, B1); PG8_BAR; PG8_SCHED;
            PG8_LDA(At, 0, 1); PG8_STAGE(PG8_SB(0, 0), b2, voffB); PG8_STAGE(PG8_SB(0, 1), b2 + hstepB, voffB); PG8_STAGE(PG8_SA(0, 0), a2, voffA);
            PG8_WAIT_V(8); PG8_WAIT_L(0); PG8_BAR; PG8_MMA(1, 0, At, B0); PG8_MMA(1, 1, At, B1); PG8_BAR; PG8_SCHED;
            PG8_LDB(B0, 1, 0); PG8_LDB(B1, 1, 1); PG8_SCHED; PG8_LDA(At, 1, 0); PG8_STAGE(PG8_SA(0, 1), a2 + hstepA, voffA);
            PG8_WAIT_V(8); PG8_WAIT_L(0); PG8_BAR; PG8_MMA(0, 0, At, B0); PG8_MMA(0, 1, At, B1); PG8_BAR; PG8_SCHED;
            PG8_LDA(At, 1, 1); PG8_STAGE(PG8_SB(1, 0), b3, voffB); PG8_STAGE(PG8_SB(1, 1), b3 + hstepB, voffB); PG8_STAGE(PG8_SA(1, 0), a3, voffA);
            PG8_WAIT_V(8); PG8_WAIT_L(0); PG8_BAR; PG8_MMA(1, 0, At, B0); PG8_MMA(1, 1, At, B1); PG8_BAR; PG8_SCHED;
            } else {
            PG8_LDB(B0, 0, 0); PG8_SCHED; PG8_LDA(At, 0, 0); PG8_STAGE(PG8_SA(1, 1), a1 + hstepA, voffA);
            PG8_WAIT_L(8); PG8_BAR; PG8_WAIT_L(0); PG8_MMA(0, 0, At, B0); PG8_BAR; PG8_SCHED;
            PG8_LDB(B1, 0, 1); PG8_STAGE(PG8_SB(0, 0), b2, voffB);
            PG8_BAR; PG8_WAIT_L(0); PG8_MMA(0, 1, At, B1); PG8_BAR;
            PG8_LDA(At, 0, 1); PG8_STAGE(PG8_SA(0, 0), a2, voffA);
            PG8_BAR; PG8_WAIT_L(0); PG8_MMA(1, 0, At, B0); PG8_BAR; PG8_SCHED;
            PG8_STAGE(PG8_SB(0, 1), b2 + hstepB, voffB);
            PG8_WAIT_V(6); PG8_BAR; PG8_MMA(1, 1, At, B1); PG8_BAR;
            PG8_LDB(B0, 1, 0); PG8_SCHED; PG8_LDA(At, 1, 0); PG8_STAGE(PG8_SA(0, 1), a2 + hstepA, voffA);
            PG8_WAIT_L(8); PG8_BAR; PG8_WAIT_L(0); PG8_MMA(0, 0, At, B0); PG8_BAR; PG8_SCHED;
            PG8_LDB(B1, 1, 1); PG8_STAGE(PG8_SB(1, 0), b3, voffB);
            PG8_BAR; PG8_WAIT_L(0); PG8_MMA(0, 1, At, B1); PG8_BAR;
            PG8_LDA(At, 1, 1); PG8_STAGE(PG8_SA(1, 0), a3, voffA);
            PG8_BAR; PG8_WAIT_L(0); PG8_MMA(1, 0, At, B0); PG8_BAR; PG8_SCHED;
            PG8_STAGE(PG8_SB(1, 1), b3 + hstepB, voffB);
            PG8_WAIT_V(6); PG8_BAR; PG8_MMA(1, 1, At, B1); PG8_BAR;
            }
        }
        if constexpr (ALIGN_EPI) { if (wr == 0) PG8_BAR; }
        if constexpr (!Epi::AFTER_DRAIN) { E(acc, cur, wr, wc, fr, fq); S.done(cur); }
        if (!has_next) break;
#pragma unroll
        for (int a = 0; a < 2; ++a)
#pragma unroll
            for (int b = 0; b < 2; ++b)
#pragma unroll
                for (int m = 0; m < 4; ++m)
#pragma unroll
                    for (int n = 0; n < 2; ++n) acc[a][b][m][n] = (f32x4){0.f, 0.f, 0.f, 0.f};
        cur = nxt; cA = nA; cB = nB; ++ui;
        if constexpr (ALIGN_EPI) { if (wr == 1) PG8_BAR; }
    }
    PG8_WAIT_V(0);
    if constexpr (!ALIGN_EPI) { if (wr == 0) PG8_BAR; }
    PG8_BAR;
    if constexpr (Epi::AFTER_DRAIN) { E.fused(acc, cur, wr, wc, fr, fq, lds, wid, lane); S.done(cur); }
#undef PG8_SA
#undef PG8_SB
#undef PG8_STAGE
#undef PG8_LDA
#undef PG8_LDB
#undef PG8_MMA
#undef PG8_WAIT_V
#undef PG8_WAIT_L
#undef PG8_BAR
#undef PG8_SCHED
}
struct EpiF32 {
    static constexpr bool PERM = false, AFTER_DRAIN = false, MIDK = false;
    float* C; int ldc;
    __device__ __forceinline__ void operator()(const f32x4 (&acc)[2][2][4][2], const Unit& u, int wr, int wc, int fr, int fq) const {
        const int row0 = u.pm * BM + wr * 64 + fr, col0 = u.pn * BM + wc * 32 + 4 * fq;
#pragma unroll
        for (int ai = 0; ai < 2; ++ai)
#pragma unroll
            for (int m = 0; m < 4; ++m) { float* rowp = C + (size_t)(row0 + ai * HALF + m * 16) * ldc + col0;
#pragma unroll
                for (int bj = 0; bj < 2; ++bj)
#pragma unroll
                    for (int n = 0; n < 2; ++n) *(f32x4*)(rowp + bj * HALF + n * 16) = acc[ai][bj][m][n]; }
    }
};
__device__ __forceinline__ float bfu(unsigned short h) { return __uint_as_float(((unsigned)h) << 16); }
__device__ __forceinline__ float sigm(float x) { return 1.0f / (1.0f + __expf(-x)); }
struct EpiUp {
    static constexpr bool PERM = true, AFTER_DRAIN = false, MIDK = true;
    const unsigned char* g8; int ldg;
    bf16_t* merged; int t1, t2;
    __device__ __forceinline__ void mid(f32x4 (&acc)[2][2][4][2], const Unit& u, int which, int wr, int wc, int fr, int fq) const {
        int row0 = u.pm * BM + wr * 64 + fr, col0 = u.pn * BM + wc * 32 + 8 * fq;
        asm volatile("" : "+v"(row0), "+v"(col0));
#pragma unroll
        for (int ai = 0; ai < 2; ++ai) {
            u32x2 gd[4][2], gn[4][2];
#pragma unroll
            for (int m = 0; m < 4; ++m)
#pragma unroll
                for (int bj = 0; bj < 2; ++bj) { const unsigned char* gp = g8 + (size_t)(row0 + ai * HALF + m * 16) * ldg + col0 + bj * HALF;
                    gd[m][bj] = *(const u32x2*)(gp + which * 2048); gn[m][bj] = *(const u32x2*)(gp + (which + 1) * 2048); }
            asm volatile("" ::: "memory");
#pragma unroll
            for (int m = 0; m < 4; ++m)
#pragma unroll
                for (int bj = 0; bj < 2; ++bj) {
#pragma unroll
                    for (int i = 0; i < 4; ++i) {
                        acc[ai][bj][m][0][i] *= (float)((gd[m][bj].x >> (8 * i)) & 0xffu) * __builtin_amdgcn_rcpf((float)((gn[m][bj].x >> (8 * i)) & 0xffu));
                        acc[ai][bj][m][1][i] *= (float)((gd[m][bj].y >> (8 * i)) & 0xffu) * __builtin_amdgcn_rcpf((float)((gn[m][bj].y >> (8 * i)) & 0xffu)); } }
            asm volatile("" ::: "memory");
        }
    }
    __device__ __forceinline__ void operator()(const f32x4 (&acc)[2][2][4][2], const Unit& u, int wr, int wc, int fr, int fq) const {
        const int row0 = u.pm * BM + wr * 64 + fr, col0 = u.pn * BM + wc * 32 + 8 * fq;
        u32x2 g2[2][4][2];
#pragma unroll
        for (int ai = 0; ai < 2; ++ai)
#pragma unroll
            for (int m = 0; m < 4; ++m)
#pragma unroll
                for (int bj = 0; bj < 2; ++bj) g2[ai][m][bj] = *(const u32x2*)(g8 + (size_t)(row0 + ai * HALF + m * 16) * ldg + 2 * 2048 + col0 + bj * HALF);
#pragma unroll
        for (int ai = 0; ai < 2; ++ai)
#pragma unroll
            for (int m = 0; m < 4; ++m) { const size_t row = (size_t)(row0 + ai * HALF + m * 16);
#pragma unroll
                for (int bj = 0; bj < 2; ++bj) { const int col = col0 + bj * HALF;
                    f32x4 v0 = acc[ai][bj][m][0], v1 = acc[ai][bj][m][1];
#pragma unroll
                    for (int i = 0; i < 4; ++i) { v0[i] *= (float)((g2[ai][m][bj].x >> (8 * i)) & 0xffu) * (1.f / 255.f); v1[i] *= (float)((g2[ai][m][bj].y >> (8 * i)) & 0xffu) * (1.f / 255.f); }
                    u32x4 w; w.x = cvt_pk_bf16(v0[0], v0[1]); w.y = cvt_pk_bf16(v0[2], v0[3]); w.z = cvt_pk_bf16(v1[0], v1[1]); w.w = cvt_pk_bf16(v1[2], v1[3]);
                    *(u32x4*)(merged + row * 2048 + col) = w; } }
    }
};
struct EpiOut {
    static constexpr bool PERM = true, AFTER_DRAIN = false, MIDK = false;
    const float* x; bf16_t* xg; float* rowss;
    __device__ __forceinline__ void operator()(const f32x4 (&acc)[2][2][4][2], const Unit& u, int wr, int wc, int fr, int fq) const {
        const int row0 = u.pm * BM + wr * 64 + fr, col0 = u.pn * BM + wc * 32 + 8 * fq;
#pragma unroll
        for (int ai = 0; ai < 2; ++ai) {
            f32x4 xv[4][2][2];
#pragma unroll
            for (int m = 0; m < 4; ++m)
#pragma unroll
                for (int bj = 0; bj < 2; ++bj) { const float* xp = x + (size_t)(row0 + ai * HALF + m * 16) * 2048 + col0 + bj * HALF; xv[m][bj][0] = *(const f32x4*)xp; xv[m][bj][1] = *(const f32x4*)(xp + 4); }
            asm volatile("" ::: "memory");
#pragma unroll
            for (int m = 0; m < 4; ++m) { const size_t row = (size_t)(row0 + ai * HALF + m * 16); float ss = 0.f;
#pragma unroll
                for (int bj = 0; bj < 2; ++bj) { const int col = col0 + bj * HALF; const size_t off = row * 2048 + col;
                    const f32x4 v0 = acc[ai][bj][m][0] + xv[m][bj][0], v1 = acc[ai][bj][m][1] + xv[m][bj][1];
                    ss += (v0[0] * v0[0] + v0[1] * v0[1]) + (v0[2] * v0[2] + v0[3] * v0[3]) + (v1[0] * v1[0] + v1[1] * v1[1]) + (v1[2] * v1[2] + v1[3] * v1[3]);
                    u32x4 w; w.x = cvt_pk_bf16(v0[0], v0[1]); w.y = cvt_pk_bf16(v0[2], v0[3]); w.z = cvt_pk_bf16(v1[0], v1[1]); w.w = cvt_pk_bf16(v1[2], v1[3]);
                    *(u32x4*)(xg + off) = w; }
                ss += __shfl_xor(ss, 16); ss += __shfl_xor(ss, 32);
                if (fq == 0) rowss[row * 32 + u.pn * 4 + wc] = ss; }
            asm volatile("" ::: "memory");
        }
    }
};
struct EpiI8 {
    static constexpr bool PERM = true, AFTER_DRAIN = false, MIDK = false;
    bf16_t* O; int ldc; const float* sa; const float* sb; int gcol0; unsigned char* g8; int ldg; const float* bg;
    __device__ __forceinline__ static unsigned gq(float x, unsigned w, int byte) { const float e = __builtin_amdgcn_exp2f(x), s255 = __builtin_amdgcn_rcpf(__builtin_fmaf(e, 1.f / 255.f, 1.f / 255.f));
        return __builtin_amdgcn_cvt_pk_u8_f32(__builtin_rintf(fmaxf(s255, 1.f)), byte, w); }
    __device__ __forceinline__ void operator()(const f32x4 (&acc)[2][2][4][2], const Unit& u, int wr, int wc, int fr, int fq) const {
        const int row0 = u.pm * BM + wr * 64 + fr, col0 = u.pn * BM + wc * 32 + 8 * fq;
        f32x4 sb0[2], sb1[2];
#pragma unroll
        for (int bj = 0; bj < 2; ++bj) { sb0[bj] = *(const f32x4*)(sb + col0 + bj * HALF); sb1[bj] = *(const f32x4*)(sb + col0 + bj * HALF + 4); }
        float rsc[2][4];
#pragma unroll
        for (int ai = 0; ai < 2; ++ai)
#pragma unroll
            for (int m = 0; m < 4; ++m) rsc[ai][m] = sa[row0 + ai * HALF + m * 16];
        if (u.pn * BM >= gcol0) {
            f32x4 bg0[2], bg1[2];
#pragma unroll
            for (int bj = 0; bj < 2; ++bj) { bg0[bj] = *(const f32x4*)(bg + col0 - gcol0 + bj * HALF) * -1.44269504089f; bg1[bj] = *(const f32x4*)(bg + col0 - gcol0 + bj * HALF + 4) * -1.44269504089f;
                sb0[bj] = sb0[bj] * -1.44269504089f; sb1[bj] = sb1[bj] * -1.44269504089f; }
            asm volatile("" ::: "memory");
#pragma unroll
            for (int ai = 0; ai < 2; ++ai)
#pragma unroll
                for (int m = 0; m < 4; ++m) { const int row = row0 + ai * HALF + m * 16; const float ra = rsc[ai][m]; unsigned char* rowp = g8 + (size_t)row * ldg + (col0 - gcol0);
#pragma unroll
                    for (int bj = 0; bj < 2; ++bj) { const i32x4 a0 = __builtin_bit_cast(i32x4, acc[ai][bj][m][0]), a1 = __builtin_bit_cast(i32x4, acc[ai][bj][m][1]);
                        u32x2 w; w.x = 0u; w.y = 0u;
#pragma unroll
                        for (int i = 0; i < 4; ++i) { w.x = gq(__builtin_fmaf((float)a0[i] * ra, sb0[bj][i], bg0[bj][i]), w.x, i); w.y = gq(__builtin_fmaf((float)a1[i] * ra, sb1[bj][i], bg1[bj][i]), w.y, i); }
                        *(u32x2*)(rowp + bj * HALF) = w; } }
            return; }
        asm volatile("" ::: "memory");
#pragma unroll
        for (int ai = 0; ai < 2; ++ai)
#pragma unroll
            for (int m = 0; m < 4; ++m) { const int row = row0 + ai * HALF + m * 16; const float ra = rsc[ai][m]; bf16_t* rowp = O + (size_t)row * ldc + col0;
#pragma unroll
                for (int bj = 0; bj < 2; ++bj) { const i32x4 a0 = __builtin_bit_cast(i32x4, acc[ai][bj][m][0]), a1 = __builtin_bit_cast(i32x4, acc[ai][bj][m][1]);
                    const f32x4 v0 = {(float)a0[0] * ra * sb0[bj][0], (float)a0[1] * ra * sb0[bj][1], (float)a0[2] * ra * sb0[bj][2], (float)a0[3] * ra * sb0[bj][3]};
                    const f32x4 v1 = {(float)a1[0] * ra * sb1[bj][0], (float)a1[1] * ra * sb1[bj][1], (float)a1[2] * ra * sb1[bj][2], (float)a1[3] * ra * sb1[bj][3]};
                    u32x4 w; w.x = cvt_pk_bf16(v0[0], v0[1]); w.y = cvt_pk_bf16(v0[2], v0[3]); w.z = cvt_pk_bf16(v1[0], v1[1]); w.w = cvt_pk_bf16(v1[2], v1[3]);
                    *(u32x4*)(rowp + bj * HALF) = w; } }
    }
};
}
constexpr int NWAVES = 8, NTHR = 512;
constexpr int BATCH = 2, SEQ = 4096, DM = 2048, T = BATCH * SEQ;
constexpr int NIN = 12800, MEML = 256, MROWS = BATCH * MEML;
constexpr int HG_H = 6, DIL_H = 12, MEM_H = 4;
constexpr int C_Q = 0, C_V = 768, C_ZF = 1536, C_ZB = 2304, C_HG = 3072, C_DQ = 3840, C_DK = 4608, C_DV = 5376, C_MQ = 6144, C_GATE = 6656;
constexpr int NEXP = 16384;
constexpr float EPS = 1e-6f;
constexpr size_t MiB = 1u << 20;
constexpr size_t WS_CTL = 0;
constexpr size_t WS_LBF = 64 * 1024, WS_LBB = WS_LBF + 4096, WS_ROWSS = 128 * 1024  , WS_SKB = 256 * 1024  , WS_DEC = 512 * 1024  ;
constexpr size_t WS_WIN = 1 * MiB;
constexpr size_t WS_MERGED = WS_WIN;
constexpr size_t WS_WUP = 51 * MiB, WS_WOUT = 59 * MiB, WS_WQ = 67 * MiB, WS_WKV = 75 * MiB;
constexpr size_t WS_KVM = 79 * MiB, WS_KVMT = 80 * MiB;
constexpr size_t WS_MEMN = 81 * MiB;
constexpr size_t WS_LSE = 83 * MiB;
constexpr size_t WS_D = 84 * MiB;
constexpr size_t WS_IDX = 85 * MiB, WS_GATE = 89 * MiB;
constexpr size_t WS_UQ = 93 * MiB, WS_VQ = 125 * MiB;
constexpr size_t WS_SU = 157 * MiB, WS_SV = 157 * MiB + 65536;
constexpr size_t WS_H = 221 * MiB;
constexpr size_t WS_OCAT = WS_H;
constexpr size_t WS_ST = 253 * MiB;
constexpr size_t WS_PROJ = 301 * MiB;
constexpr size_t WS_XG = WS_PROJ, WS_QP = WS_PROJ + 32 * MiB, WS_SC = WS_PROJ + 64 * MiB;
constexpr size_t WS_RSP = 501 * MiB;
constexpr size_t WS_XQ = WS_PROJ + 128 * MiB;
constexpr size_t WS_SX = WS_PROJ + 144 * MiB;
constexpr size_t WS_PA = WS_PROJ + 145 * MiB;
constexpr size_t WS_G8 = 162 * MiB;
constexpr size_t WS_SA = 160 * MiB, WS_SB = 160 * MiB + 65536;
constexpr size_t WS_CMAX = 502 * MiB + 512 * 1024;
constexpr size_t WS_BAR = 502 * MiB;
constexpr size_t BAR_REGION = 20480, BAR_ZERO = 640 * 1024;
constexpr size_t WS_END = 503 * MiB;
constexpr int LDS_BYTES = 152576;
#define GAS __attribute__((address_space(1)))
#define LAS __attribute__((address_space(3)))
typedef unsigned short bf16;
typedef unsigned v4u __attribute__((ext_vector_type(4)));
typedef unsigned v2u __attribute__((ext_vector_type(2)));
typedef float f32x4 __attribute__((ext_vector_type(4)));
typedef float f32x16 __attribute__((ext_vector_type(16)));
typedef short bf16x8 __attribute__((ext_vector_type(8)));
__device__ __forceinline__ float bf2f(unsigned short h) { return __uint_as_float(((unsigned)h) << 16); }
typedef __bf16 hwbf2 __attribute__((ext_vector_type(2)));
typedef float f32x2_ __attribute__((ext_vector_type(2)));
__device__ __forceinline__ unsigned pk2(float lo, float hi) { const f32x2_ v = {lo, hi}; return __builtin_bit_cast(unsigned, __builtin_convertvector(v, hwbf2)); }
__device__ __forceinline__ unsigned f2bf(float f) { return pk2(f, f) & 0xffffu; }
__device__ __forceinline__ float wave_sum(float v) {
#pragma unroll
    for (int o = 1; o < 64; o <<= 1) v += __shfl_xor(v, o);
    return v;
}
__device__ __forceinline__ float wave_max(float v) {
#pragma unroll
    for (int o = 1; o < 64; o <<= 1) v = fmaxf(v, __shfl_xor(v, o));
    return v;
}
__device__ __forceinline__ float row_rstd(const float* rsp, int t) {
    const f32x4* q = (const f32x4*)(rsp + (size_t)t * 32); float s = 0.f;
#pragma unroll
    for (int i = 0; i < 8; ++i) { const f32x4 v = q[i]; s += (v.x + v.y) + (v.z + v.w); }
    return rsqrtf(s * (1.f / 2048.f) + 1e-6f);
}
__device__ __forceinline__ float sigmoidf_(float x) { return __builtin_amdgcn_rcpf(1.0f + __expf(-x)); }

struct P {
    const GAS float *x, *mem, *g_mix, *w_in, *b_gate, *lbf_l, *lbb_l, *g_hg, *w_kv, *g_mem, *w_up, *w_out, *g_ffn, *w_q, *subk, *pu, *pv, *g_final;
    GAS float* out; GAS float* dst10; GAS unsigned char* ws; int ph_lo, ph_hi;
};
#define WSP(T_, off) ((T_*)(GAS T_*)(p.ws + (off)))

__device__ __forceinline__ void p0_transpose_item(const float* W, int K, int N, bf16* WT, float* scr, int item, int lane, const float* ks = nullptr) {
    const int nblk = N / 32, kb = item / nblk, nb = item % nblk, k0 = 64 * kb, n0 = 32 * nb;
#pragma unroll
    for (int i = 0; i < 8; ++i) { const int kk = 8 * i + (lane >> 3), nq = (lane & 7) * 4; const f32x4 v = *(const f32x4*)(W + (size_t)(k0 + kk) * N + n0 + nq);
        const float sc = ks ? ks[k0 + kk] : 1.f; float* d = scr + kk * 33 + nq; d[0] = v.x * sc; d[1] = v.y * sc; d[2] = v.z * sc; d[3] = v.w * sc; }
    asm volatile("s_waitcnt lgkmcnt(0)" ::: "memory");
    const int c = lane & 7;
#pragma unroll
    for (int j = 0; j < 4; ++j) { const int n = (lane >> 3) + 8 * j; const float* s = scr + (8 * c) * 33 + n;
        v4u o; o.x = pk2(s[0 * 33], s[1 * 33]); o.y = pk2(s[2 * 33], s[3 * 33]); o.z = pk2(s[4 * 33], s[5 * 33]); o.w = pk2(s[6 * 33], s[7 * 33]);
        *(v4u*)(WT + (size_t)(n0 + n) * K + k0 + 8 * c) = o; }
    asm volatile("s_waitcnt lgkmcnt(0)" ::: "memory");
}
__device__ __forceinline__ void rms_row_to_bf16(const float* xrow, const float* g, bf16* orow, int lane) {
    const f32x4* xr = (const f32x4*)xrow + lane; const f32x4* gr = (const f32x4*)g + lane;
    f32x4 v[8]; float s = 0.f;
#pragma unroll
    for (int j = 0; j < 8; ++j) { v[j] = xr[64 * j]; s += (v[j].x * v[j].x + v[j].y * v[j].y) + (v[j].z * v[j].z + v[j].w * v[j].w); }
    const float rstd = rsqrtf(wave_sum(s) * (1.f / DM) + EPS);
    v2u* o8 = (v2u*)orow + lane;
#pragma unroll
    for (int j = 0; j < 8; ++j) { const f32x4 gg = gr[64 * j]; v2u w; w.x = pk2(v[j].x * rstd * gg.x, v[j].y * rstd * gg.y); w.y = pk2(v[j].z * rstd * gg.z, v[j].w * rstd * gg.w); o8[64 * j] = w; }
}
__device__ __forceinline__ unsigned q8b(float v, float inv) { return (unsigned)((int)rintf(v * inv)) & 0xffu; }
__device__ __forceinline__ void rms_row_to_i8(const float* xrow, const float* g, unsigned char* orow, float* scale, int lane) {
    const f32x4* xr = (const f32x4*)xrow + lane; const f32x4* gr = (const f32x4*)g + lane;
    f32x4 v[8]; float s = 0.f;
#pragma unroll
    for (int j = 0; j < 8; ++j) { v[j] = xr[64 * j]; s += (v[j].x * v[j].x + v[j].y * v[j].y) + (v[j].z * v[j].z + v[j].w * v[j].w); }
    const float rstd = rsqrtf(wave_sum(s) * (1.f / DM) + EPS); float m = 0.f;
#pragma unroll
    for (int j = 0; j < 8; ++j) { const f32x4 gg = gr[64 * j]; v[j] = v[j] * rstd * gg; m = fmaxf(fmaxf(m, fmaxf(fabsf(v[j].x), fabsf(v[j].y))), fmaxf(fabsf(v[j].z), fabsf(v[j].w))); }
    m = fmaxf(wave_max(m), 1e-30f); const float inv = 127.f / m;
    unsigned* o = (unsigned*)orow + lane;
#pragma unroll
    for (int j = 0; j < 8; ++j) o[64 * j] = q8b(v[j].x, inv) | (q8b(v[j].y, inv) << 8) | (q8b(v[j].z, inv) << 16) | (q8b(v[j].w, inv) << 24);
    if (lane == 0) *scale = m * (1.f / 127.f);
}
__device__ __forceinline__ void p0_qtranspose_item(const float* W, int K, int N, unsigned char* W8T, const unsigned* cmax, float* sb, float* scr, int item, int lane) {
    const int nblk = N / 32, kb = item / nblk, nb = item % nblk, k0 = 64 * kb, n0 = 32 * nb;
#pragma unroll
    for (int i = 0; i < 8; ++i) { const int kk = 8 * i + (lane >> 3), nq = (lane & 7) * 4; const f32x4 v = *(const f32x4*)(W + (size_t)(k0 + kk) * N + n0 + nq);
        float* d = scr + kk * 33 + nq; d[0] = v.x; d[1] = v.y; d[2] = v.z; d[3] = v.w; }
    asm volatile("s_waitcnt lgkmcnt(0)" ::: "memory");
    const int c = lane & 7;
#pragma unroll
    for (int j = 0; j < 4; ++j) { const int n = (lane >> 3) + 8 * j; const float* s = scr + (8 * c) * 33 + n;
        const float m = fmaxf(__uint_as_float(cmax[n0 + n]), 1e-30f), inv = 127.f / m;
        v2u o; o.x = q8b(s[0 * 33], inv) | (q8b(s[1 * 33], inv) << 8) | (q8b(s[2 * 33], inv) << 16) | (q8b(s[3 * 33], inv) << 24);
        o.y = q8b(s[4 * 33], inv) | (q8b(s[5 * 33], inv) << 8) | (q8b(s[6 * 33], inv) << 16) | (q8b(s[7 * 33], inv) << 24);
        *(v2u*)(W8T + (size_t)(n0 + n) * K + k0 + 8 * c) = o;
        if (kb == 0 && c == 0) sb[n0 + n] = m * (1.f / 127.f); }
    asm volatile("s_waitcnt lgkmcnt(0)" ::: "memory");
}
__device__ __forceinline__ void p0_win_strip(const P& p, unsigned char* lds, int strip) {
    const int tid = tidx(), lane = tid & 63, wave = tid >> 6;
    const int n0 = strip * 32 + 4 * (lane & 7), kbase = 256 * wave + 32 * (lane >> 3);
    const float* wp = ((const float*)p.w_in) + (size_t)kbase * NIN + n0;
    f32x4 v[32];
#pragma unroll
    for (int i = 0; i < 32; ++i) v[i] = __builtin_nontemporal_load((const f32x4*)(wp + (size_t)i * NIN));
    f32x4 m = {0.f, 0.f, 0.f, 0.f};
#pragma unroll
    for (int i = 0; i < 32; ++i) { m.x = fmaxf(m.x, fabsf(v[i].x)); m.y = fmaxf(m.y, fabsf(v[i].y)); m.z = fmaxf(m.z, fabsf(v[i].z)); m.w = fmaxf(m.w, fabsf(v[i].w)); }
#pragma unroll
    for (int d = 8; d < 64; d <<= 1) { m.x = fmaxf(m.x, __shfl_xor(m.x, d)); m.y = fmaxf(m.y, __shfl_xor(m.y, d)); m.z = fmaxf(m.z, __shfl_xor(m.z, d)); m.w = fmaxf(m.w, __shfl_xor(m.w, d)); }
    float* red = (float*)lds;
    __syncthreads();
    if (lane < 8) *(f32x4*)(red + wave * 32 + 4 * lane) = m;
    __syncthreads();
    f32x4 mm = *(const f32x4*)(red + 4 * (lane & 7));
#pragma unroll
    for (int w = 1; w < 8; ++w) { const f32x4 t = *(const f32x4*)(red + w * 32 + 4 * (lane & 7)); mm.x = fmaxf(mm.x, t.x); mm.y = fmaxf(mm.y, t.y); mm.z = fmaxf(mm.z, t.z); mm.w = fmaxf(mm.w, t.w); }
    mm.x = fmaxf(mm.x, 1e-30f); mm.y = fmaxf(mm.y, 1e-30f); mm.z = fmaxf(mm.z, 1e-30f); mm.w = fmaxf(mm.w, 1e-30f);
    if (wave == 0 && lane < 8) *(f32x4*)(WSP(float, WS_SB) + n0) = mm * (1.f / 127.f);
    const float inv[4] = {127.f / mm.x, 127.f / mm.y, 127.f / mm.z, 127.f / mm.w};
    unsigned char* w8 = (unsigned char*)(p.ws + WS_WIN);
#pragma unroll
    for (int c = 0; c < 4; ++c) { unsigned d[8];
#pragma unroll
        for (int q = 0; q < 8; ++q) d[q] = q8b(v[4 * q][c], inv[c]) | (q8b(v[4 * q + 1][c], inv[c]) << 8) | (q8b(v[4 * q + 2][c], inv[c]) << 16) | (q8b(v[4 * q + 3][c], inv[c]) << 24);
        v4u lo, hi; lo.x = d[0]; lo.y = d[1]; lo.z = d[2]; lo.w = d[3]; hi.x = d[4]; hi.y = d[5]; hi.z = d[6]; hi.w = d[7];
        unsigned char* o = w8 + (size_t)(n0 + c) * DM + kbase; *(v4u*)o = lo; *(v4u*)(o + 16) = hi; }
}
__device__ __forceinline__ void phase0(const P& p, unsigned char* lds, int vcu, int G, int bx) {
    const int tid = tidx(), lane = tid & 63, wave = tid >> 6;
    float* scr = (float*)(lds + wave * 16384);
    const int gw = vcu * NWAVES + wave, NGW = G * NWAVES;
    for (int strip = bx; strip < NIN / 32; strip += G) p0_win_strip(p, lds, strip);
    __syncthreads();
    constexpr int I_KV = (DM / 64) * (1024 / 32);
    for (int it = gw; it < I_KV; it += NGW) p0_transpose_item(((const float*)p.w_kv), DM, 1024, WSP(bf16, WS_WKV), scr, it, lane);
    const int nstr2 = NIN / 32 - G;
    const bool wsplit = (G == 256);
    const int xcnt = wsplit ? (bx < nstr2 ? 18 : 50) : T / G, xbase = wsplit ? (bx < nstr2 ? bx * 18 : nstr2 * 18 + (bx - nstr2) * 50) : bx * (T / G);
    for (int r = wave; r < xcnt; r += 16) {
        const int m = xbase + r, m2 = m + 8; const bool two = r + 8 < xcnt;
        const f32x4* xa = (const f32x4*)(((const float*)p.x) + (size_t)m * DM) + lane; const f32x4* xb = (const f32x4*)(((const float*)p.x) + (size_t)(two ? m2 : m) * DM) + lane; const f32x4* gr = (const f32x4*)((const float*)p.g_mix) + lane;
        f32x4 va[8], vb[8]; float sa_ = 0.f, sb_ = 0.f;
#pragma unroll
        for (int j = 0; j < 8; ++j) { va[j] = __builtin_nontemporal_load(xa + 64 * j); vb[j] = __builtin_nontemporal_load(xb + 64 * j); }
#pragma unroll
        for (int j = 0; j < 8; ++j) { sa_ += (va[j].x * va[j].x + va[j].y * va[j].y) + (va[j].z * va[j].z + va[j].w * va[j].w); sb_ += (vb[j].x * vb[j].x + vb[j].y * vb[j].y) + (vb[j].z * vb[j].z + vb[j].w * vb[j].w); }
        const float ra = rsqrtf(wave_sum(sa_) * (1.f / DM) + EPS), rb = rsqrtf(wave_sum(sb_) * (1.f / DM) + EPS); float ma = 0.f, mb = 0.f;
#pragma unroll
        for (int j = 0; j < 8; ++j) { const f32x4 gg = gr[64 * j]; va[j] = va[j] * ra * gg; vb[j] = vb[j] * rb * gg;
            ma = fmaxf(fmaxf(ma, fmaxf(fabsf(va[j].x), fabsf(va[j].y))), fmaxf(fabsf(va[j].z), fabsf(va[j].w))); mb = fmaxf(fmaxf(mb, fmaxf(fabsf(vb[j].x), fabsf(vb[j].y))), fmaxf(fabsf(vb[j].z), fabsf(vb[j].w))); }
        ma = fmaxf(wave_max(ma), 1e-30f); mb = fmaxf(wave_max(mb), 1e-30f); const float ia = 127.f / ma, ib = 127.f / mb;
        unsigned* oa = (unsigned*)((unsigned char*)(p.ws + WS_H) + (size_t)m * DM) + lane; unsigned* ob = (unsigned*)((unsigned char*)(p.ws + WS_H) + (size_t)m2 * DM) + lane;
#pragma unroll
        for (int j = 0; j < 8; ++j) { oa[64 * j] = q8b(va[j].x, ia) | (q8b(va[j].y, ia) << 8) | (q8b(va[j].z, ia) << 16) | (q8b(va[j].w, ia) << 24);
            if (two) ob[64 * j] = q8b(vb[j].x, ib) | (q8b(vb[j].y, ib) << 8) | (q8b(vb[j].z, ib) << 16) | (q8b(vb[j].w, ib) << 24); }
        if (lane == 0) { WSP(float, WS_SA)[m] = ma * (1.f / 127.f); if (two) WSP(float, WS_SA)[m2] = mb * (1.f / 127.f); }
    }
    for (int m = gw; m < MROWS; m += NGW) rms_row_to_bf16(((const float*)p.mem) + (size_t)m * DM, ((const float*)p.g_mem), WSP(bf16, WS_MEMN) + (size_t)m * DM, lane);
    const size_t gt = (size_t)vcu * NTHR + tid, NGT = (size_t)G * NTHR;
    for (size_t i = gt; i < 32768; i += NGT) WSP(bf16, WS_SKB)[i] = (bf16)f2bf(((const float*)p.subk)[i]);
    for (size_t i = gt; i < 768; i += NGT) { WSP(float, WS_LBF)[i] = 1.0f / (1.0f + __expf(((const float*)p.lbf_l)[768 + i] - ((const float*)p.lbf_l)[i])); WSP(float, WS_LBB)[i] = 1.0f / (1.0f + __expf(((const float*)p.lbb_l)[768 + i] - ((const float*)p.lbb_l)[i])); }
}
__device__ __forceinline__ void phase0b(const P& p, unsigned char* lds, int vcu, int G) {}
__device__ __forceinline__ void tail_prep(const P& p, unsigned char* lds, int wi, int nw) {
    const int tid = tidx(), lane = tid & 63, wave = tid >> 6;
    float* scr = (float*)(lds + wave * 16384);
    const int gw = wi * NWAVES + wave, NGW = nw * NWAVES;
    for (int r4 = gw * 4; r4 < 2 * NEXP; r4 += NGW * 4) {
        f32x4 v[4][8];
#pragma unroll
        for (int q = 0; q < 4; ++q) { const int r2 = r4 + q, isv = r2 >= NEXP, row = isv ? r2 - NEXP : r2; const f32x4* xr = (const f32x4*)((isv ? ((const float*)p.pv) : ((const float*)p.pu)) + (size_t)row * DM) + lane;
#pragma unroll
            for (int j = 0; j < 8; ++j) v[q][j] = __builtin_nontemporal_load(xr + 64 * j); }
#pragma unroll
        for (int q = 0; q < 4; ++q) { const int r2 = r4 + q, isv = r2 >= NEXP, row = isv ? r2 - NEXP : r2; float m = 0.f;
            if (!isv) {
#pragma unroll
                for (int j = 0; j < 8; ++j) v[q][j] = v[q][j] * ((const f32x4*)((const float*)p.g_ffn))[64 * j + lane]; }
#pragma unroll
            for (int j = 0; j < 8; ++j) m = fmaxf(fmaxf(m, fmaxf(fabsf(v[q][j].x), fabsf(v[q][j].y))), fmaxf(fabsf(v[q][j].z), fabsf(v[q][j].w)));
            m = fmaxf(wave_max(m), 1e-30f); const float inv = 127.f / m;
            unsigned* o = (unsigned*)(p.ws + (isv ? WS_VQ : WS_UQ) + (size_t)(lane >> 5) * (NEXP * 128) + (size_t)row * 128) + (lane & 31);
#pragma unroll
            for (int j = 0; j < 8; ++j) o[(size_t)j * (2 * NEXP * 128 / 4)] = q8b(v[q][j].x, inv) | (q8b(v[q][j].y, inv) << 8) | (q8b(v[q][j].z, inv) << 16) | (q8b(v[q][j].w, inv) << 24);
            if (lane == 0) WSP(float, isv ? WS_SV : WS_SU)[row] = m * (1.f / 127.f); }
    }
    constexpr int I_SQ = (DM / 64) * (DM / 32);
    for (int it = gw; it < 3 * I_SQ; it += NGW) {
        if (it < I_SQ) p0_transpose_item(((const float*)p.w_up), DM, DM, WSP(bf16, WS_WUP), scr, it, lane);
        else if (it < 2 * I_SQ) p0_transpose_item(((const float*)p.w_out), DM, DM, WSP(bf16, WS_WOUT), scr, it - I_SQ, lane);
        else p0_transpose_item(((const float*)p.w_q), DM, DM, WSP(bf16, WS_WQ), scr, it - 2 * I_SQ, lane, (const float*)p.g_ffn);
    }
}
typedef GAS unsigned gu32;
typedef GAS unsigned long long gu64;
#define RLX_AGENT __ATOMIC_RELAXED, __HIP_MEMORY_SCOPE_AGENT
__device__ __forceinline__ unsigned long long rt() { return __builtin_amdgcn_s_memrealtime(); }
#define XB_TMO      128
#define XB_XCNT(j)  (256  + 64 * (j))
#define XB_XSUB(j)  (1280 + 64 * (j))
#define XB_XGEN(j)  (2304 + 64 * (j))
#define XB_TOP      3328
#define XB_TOPGEN   3392
#define XCD_BAR_WORDS 3456
#define XB_SPIN_CAP (1u << 21)

__device__ __forceinline__ unsigned xb_ld(unsigned* p)              { return __hip_atomic_load(p, __ATOMIC_RELAXED, __HIP_MEMORY_SCOPE_AGENT); }
__device__ __forceinline__ unsigned xb_add(unsigned* p, unsigned v) { return __hip_atomic_fetch_add(p, v, __ATOMIC_RELAXED, __HIP_MEMORY_SCOPE_AGENT); }
__device__ __forceinline__ unsigned xb_xcc_id() { return (unsigned)__builtin_amdgcn_s_getreg((3 << 11) | 20) & 0xFu; }
#define XB_SPIN(cond, bar) do { unsigned _sp = 0; while (cond) { __builtin_amdgcn_s_sleep(1); \
    if ((++_sp & 255u) == 0u) { if (xb_ld(&(bar)[XB_TMO])) break; if (_sp > XB_SPIN_CAP) { atomicAdd(&(bar)[XB_TMO], 1u); break; } } } } while (0)

struct XcdBarrier {
    unsigned* bar; unsigned x;
    volatile LAS unsigned* st;
};

__device__ __forceinline__ XcdBarrier xcd_barrier_post(unsigned* bar, volatile LAS unsigned* st) {
    XcdBarrier b; b.bar = bar; b.x = xb_xcc_id(); b.st = st;
    if (threadIdx.x == 0) (void)xb_add(&bar[XB_XCNT(b.x)], 1u);
    return b;
}
__device__ __forceinline__ void xcd_barrier_complete(unsigned* bar, unsigned x, unsigned& nloc, unsigned& nx) {
    const unsigned G = gridDim.x * gridDim.y * gridDim.z;
    unsigned sum, cnt, mine, sp = 0u;
    for (;;) {
        sum = 0u; cnt = 0u; mine = 0u;
#pragma unroll
        for (unsigned j = 0; j < 16; ++j) { const unsigned c = xb_ld(&bar[XB_XCNT(j)]); sum += c; cnt += (c > 0u) ? 1u : 0u; mine = (j == x) ? c : mine; }
        if (sum == G) break;
        __builtin_amdgcn_s_sleep(1);
        if ((++sp & 255u) == 0u) { if (xb_ld(&bar[XB_TMO])) break; if (sp > XB_SPIN_CAP) { atomicAdd(&bar[XB_TMO], 1u); break; } }
    }
    nloc = mine > 0u ? mine : 1u; nx = cnt > 0u ? cnt : 1u;
}

template <bool REL = true, bool ACQ = true> __device__ __forceinline__ void xcd_barrier(const XcdBarrier& b) {
    asm volatile("s_waitcnt vmcnt(0)" ::: "memory");
    __syncthreads();
    if (threadIdx.x == 0) {
        unsigned* bar = b.bar;
        __builtin_amdgcn_s_waitcnt(0);
        unsigned nloc = b.st[0], nx = b.st[1];
        if (nloc == 0u) { xcd_barrier_complete(bar, b.x, nloc, nx); b.st[0] = nloc; b.st[1] = nx; }
        const unsigned old = xb_add(&bar[XB_XSUB(b.x)], 1u);
        const unsigned gen = old / nloc;
        if (old + 1u == (gen + 1u) * nloc) {
            if constexpr (REL) __builtin_amdgcn_fence(__ATOMIC_RELEASE, "agent");
            asm volatile("s_waitcnt vmcnt(0)" ::: "memory");
            (void)xb_add(&bar[XB_TOP], 1u);
        }
        const unsigned target = (gen + 1u) * nx;
        XB_SPIN((int)(xb_ld(&bar[XB_TOP]) - target) < 0, bar);
        if constexpr (ACQ) __builtin_amdgcn_fence(__ATOMIC_ACQUIRE, "agent");
        asm volatile("s_waitcnt vmcnt(0)" ::: "memory");
    }
    __syncthreads();
}
__device__ __forceinline__ f32x16 mfma32(bf16x8 a, bf16x8 b, f32x16 c) { return __builtin_amdgcn_mfma_f32_32x32x16_bf16(a, b, c, 0, 0, 0); }
__device__ __forceinline__ f32x4 mfma16(bf16x8 a, bf16x8 b, f32x4 c) { return __builtin_amdgcn_mfma_f32_16x16x32_bf16(a, b, c, 0, 0, 0); }
template <int CTRL> __device__ __forceinline__ float dppf(float v) { return __builtin_bit_cast(float, __builtin_amdgcn_update_dpp(0, __builtin_bit_cast(int, v), CTRL, 0xf, 0xf, true)); }
__device__ __forceinline__ float sum8(float v) { v += dppf<0xB1>(v); v += dppf<0x4E>(v); v += dppf<0x141>(v); return v; }
__device__ __forceinline__ float max8(float v) { v = fmaxf(v, dppf<0xB1>(v)); v = fmaxf(v, dppf<0x4E>(v)); v = fmaxf(v, dppf<0x141>(v)); return v; }
__device__ __forceinline__ f32x16 zero16() { f32x16 z; for (int i = 0; i < 16; ++i) z[i] = 0.f; return z; }

__device__ __forceinline__ void h1_load(const P& p, int item, unsigned short (&zr)[16], unsigned short (&vr)[16], float& lbv) {
    const int tid = tidx(), c = tid & 127, tq = tid >> 7;
    const int n = item & 63, dir = (item >> 6) & 1, bh = item >> 7, b = bh / 6, h = bh % 6;
    const bf16* proj = WSP(const bf16, WS_PROJ) + (size_t)(b * SEQ + n * 64) * NIN;
    const int zc = (dir ? C_ZB : C_ZF) + h * 128 + c, vc = C_V + h * 128 + c;
    lbv = WSP(const float, dir ? WS_LBB : WS_LBF)[h * 128 + c];
#pragma unroll
    for (int i = 0; i < 16; ++i) { const int s = tq * 16 + i; zr[i] = proj[(size_t)s * NIN + zc]; vr[i] = proj[(size_t)s * NIN + vc]; }
}
__device__ __forceinline__ void h1_item(const P& p, unsigned char* lds, int item, const unsigned short (&zr)[16], const unsigned short (&vr)[16], const float lb) {
    const int tid = tidx(), lane = tid & 63, wave = tid >> 6, c = tid & 127, tq = tid >> 7;
    const int n = item & 63, dir = (item >> 6) & 1, bh = item >> 7, b = bh / 6, h = bh % 6, chain = bh * 2 + dir;
    const bf16* proj = WSP(const bf16, WS_PROJ) + (size_t)(b * SEQ + n * 64) * NIN;
    const int zc = (dir ? C_ZB : C_ZF) + h * 128 + c, vc = C_V + h * 128 + c;
    float* segs = (float*)lds;
    bf16* KhT = (bf16*)(lds + 2048);
    bf16* VT = (bf16*)(lds + 2048 + 18432);
    float fv[16]; float seg = 1.f;
#pragma unroll
    for (int i = 0; i < 16; ++i) { const int s = tq * 16 + i; const float z = bf2f(zr[i]); const float f = lb + (1.f - lb) * sigmoidf_(z);
        fv[i] = f; seg *= f; VT[c * 72 + s] = vr[i]; }
    segs[tq * 128 + c] = seg;
    __syncthreads();
    const float s0 = segs[c], s1 = segs[128 + c], s2 = segs[256 + c], s3 = segs[384 + c];
    if (dir == 0) { float run = (tq < 1 ? s1 : 1.f) * (tq < 2 ? s2 : 1.f) * (tq < 3 ? s3 : 1.f);
#pragma unroll
        for (int i = 15; i >= 0; --i) { KhT[c * 72 + tq * 16 + i] = (bf16)f2bf((1.f - fv[i]) * run); run *= fv[i]; } }
    else { float run = (tq > 0 ? s0 : 1.f) * (tq > 1 ? s1 : 1.f) * (tq > 2 ? s2 : 1.f);
#pragma unroll
        for (int i = 0; i < 16; ++i) { KhT[c * 72 + tq * 16 + i] = (bf16)f2bf((1.f - fv[i]) * run); run *= fv[i]; } }
    if (tq == 0) WSP(float, WS_D)[(size_t)(chain * 64 + n) * 128 + c] = (s0 * s1) * (s2 * s3);
    __syncthreads();
    const int r32 = lane & 31, hi = lane >> 5, dvt = wave >> 1, c0 = (wave & 1) * 64;
    f32x16 acc0 = zero16(), acc1 = zero16();
#pragma unroll
    for (int ks = 0; ks < 4; ++ks) {
        const bf16x8 a = *(const bf16x8*)(VT + (dvt * 32 + r32) * 72 + ks * 16 + hi * 8);
        const bf16x8 b0 = *(const bf16x8*)(KhT + (c0 + r32) * 72 + ks * 16 + hi * 8), b1 = *(const bf16x8*)(KhT + (c0 + 32 + r32) * 72 + ks * 16 + hi * 8);
        acc0 = mfma32(b0, a, acc0); acc1 = mfma32(b1, a, acc1); }
    bf16* st = WSP(bf16, WS_ST) + (size_t)(chain * 64 + n) * 16384 + (size_t)(dvt * 32 + r32) * 128 + c0 + 4 * hi;
#pragma unroll
    for (int q = 0; q < 4; ++q) { v2u w0, w1; w0.x = pk2(acc0[4 * q], acc0[4 * q + 1]); w0.y = pk2(acc0[4 * q + 2], acc0[4 * q + 3]); w1.x = pk2(acc1[4 * q], acc1[4 * q + 1]); w1.y = pk2(acc1[4 * q + 2], acc1[4 * q + 3]);
        *(v2u*)(st + 8 * q) = w0; *(v2u*)(st + 32 + 8 * q) = w1; }
    __syncthreads();
}

__device__ __forceinline__ void h1d_load(const P& p, int item, unsigned short (&zf)[16], unsigned short (&zb)[16], unsigned short (&vr)[16], float& lbf, float& lbb) {
    const int tid = tidx(), c = tid & 127, tq = tid >> 7;
    const int n = item & 63, bh = item >> 6, b = bh / 6, h = bh % 6;
    const bf16* proj = WSP(const bf16, WS_PROJ) + (size_t)(b * SEQ + n * 64) * NIN + h * 128 + c;
    lbf = WSP(const float, WS_LBF)[h * 128 + c]; lbb = WSP(const float, WS_LBB)[h * 128 + c];
#pragma unroll
    for (int i = 0; i < 16; ++i) { const size_t o = (size_t)(tq * 16 + i) * NIN; zf[i] = proj[o + C_ZF]; zb[i] = proj[o + C_ZB]; vr[i] = proj[o + C_V]; }
}
__device__ __forceinline__ void h1d_item(const P& p, unsigned char* lds, int item, const unsigned short (&zf)[16], const unsigned short (&zb)[16], const unsigned short (&vr)[16], const float lbf, const float lbb) {
    const int tid = tidx(), lane = tid & 63, wave = tid >> 6, c = tid & 127, tq = tid >> 7;
    const int n = item & 63, bh = item >> 6;
    float* segs = (float*)lds;
    bf16* KF = (bf16*)(lds + 4096);
    bf16* KB = (bf16*)(lds + 4096 + 18432);
    bf16* VT = (bf16*)(lds + 4096 + 2 * 18432);
    float ff[16], fb[16]; float sf = 1.f, sb = 1.f;
#pragma unroll
    for (int i = 0; i < 16; ++i) { const int s = tq * 16 + i;
        ff[i] = lbf + (1.f - lbf) * sigmoidf_(bf2f(zf[i])); fb[i] = lbb + (1.f - lbb) * sigmoidf_(bf2f(zb[i])); sf *= ff[i]; sb *= fb[i]; VT[c * 72 + s] = vr[i]; }
    segs[tq * 128 + c] = sf; segs[512 + tq * 128 + c] = sb;
    __syncthreads();
    { const float s0 = segs[c], s1 = segs[128 + c], s2 = segs[256 + c], s3 = segs[384 + c];
      float run = (tq < 1 ? s1 : 1.f) * (tq < 2 ? s2 : 1.f) * (tq < 3 ? s3 : 1.f);
#pragma unroll
      for (int i = 15; i >= 0; --i) { KF[c * 72 + tq * 16 + i] = (bf16)f2bf((1.f - ff[i]) * run); run *= ff[i]; }
      if (tq == 0) WSP(float, WS_D)[(size_t)((bh * 2 + 0) * 64 + n) * 128 + c] = (s0 * s1) * (s2 * s3); }
    { const float s0 = segs[512 + c], s1 = segs[512 + 128 + c], s2 = segs[512 + 256 + c], s3 = segs[512 + 384 + c];
      float run = (tq > 0 ? s0 : 1.f) * (tq > 1 ? s1 : 1.f) * (tq > 2 ? s2 : 1.f);
#pragma unroll
      for (int i = 0; i < 16; ++i) { KB[c * 72 + tq * 16 + i] = (bf16)f2bf((1.f - fb[i]) * run); run *= fb[i]; }
      if (tq == 1) WSP(float, WS_D)[(size_t)((bh * 2 + 1) * 64 + n) * 128 + c] = (s0 * s1) * (s2 * s3); }
    __syncthreads();
    const int r32 = lane & 31, hi = lane >> 5, dvt = wave >> 1, c0 = (wave & 1) * 64;
    f32x16 af0 = zero16(), af1 = zero16(), ab0 = zero16(), ab1 = zero16();
#pragma unroll
    for (int ks = 0; ks < 4; ++ks) {
        const bf16x8 a = *(const bf16x8*)(VT + (dvt * 32 + r32) * 72 + ks * 16 + hi * 8);
        const bf16x8 f0 = *(const bf16x8*)(KF + (c0 + r32) * 72 + ks * 16 + hi * 8), f1 = *(const bf16x8*)(KF + (c0 + 32 + r32) * 72 + ks * 16 + hi * 8);
        const bf16x8 b0 = *(const bf16x8*)(KB + (c0 + r32) * 72 + ks * 16 + hi * 8), b1 = *(const bf16x8*)(KB + (c0 + 32 + r32) * 72 + ks * 16 + hi * 8);
        af0 = mfma32(f0, a, af0); af1 = mfma32(f1, a, af1); ab0 = mfma32(b0, a, ab0); ab1 = mfma32(b1, a, ab1); }
    bf16* stf = WSP(bf16, WS_ST) + (size_t)((bh * 2 + 0) * 64 + n) * 16384 + (size_t)(dvt * 32 + r32) * 128 + c0 + 4 * hi;
    bf16* stb = WSP(bf16, WS_ST) + (size_t)((bh * 2 + 1) * 64 + n) * 16384 + (size_t)(dvt * 32 + r32) * 128 + c0 + 4 * hi;
#pragma unroll
    for (int q = 0; q < 4; ++q) { v2u w0, w1, w2, w3;
        w0.x = pk2(af0[4 * q], af0[4 * q + 1]); w0.y = pk2(af0[4 * q + 2], af0[4 * q + 3]); w1.x = pk2(af1[4 * q], af1[4 * q + 1]); w1.y = pk2(af1[4 * q + 2], af1[4 * q + 3]);
        w2.x = pk2(ab0[4 * q], ab0[4 * q + 1]); w2.y = pk2(ab0[4 * q + 2], ab0[4 * q + 3]); w3.x = pk2(ab1[4 * q], ab1[4 * q + 1]); w3.y = pk2(ab1[4 * q + 2], ab1[4 * q + 3]);
        *(v2u*)(stf + 8 * q) = w0; *(v2u*)(stf + 32 + 8 * q) = w1; *(v2u*)(stb + 8 * q) = w2; *(v2u*)(stb + 32 + 8 * q) = w3; }
    __syncthreads();
}

__device__ __forceinline__ void h2_scan(const P& p, int bx, int G, bf16* sdst) {
    const int gt = bx * NTHR + tidx(), NGT = G * NTHR;
    for (int w = gt; w < 24 * 4096; w += NGT) {
        const int chain = w >> 12, e4 = w & 4095, c4 = (e4 & 31) * 4, dir = chain & 1;
        float run[4] = {0.f, 0.f, 0.f, 0.f};
        for (int k0 = 0; k0 < 64; k0 += 8) {
            v2u L[8]; f32x4 d[8];
#pragma unroll
            for (int j = 0; j < 8; ++j) { const int n = dir ? 63 - (k0 + j) : (k0 + j);
                L[j] = *(const v2u*)(WSP(const bf16, WS_ST) + (size_t)(chain * 64 + n) * 16384 + e4 * 4);
                d[j] = *(const f32x4*)(WSP(const float, WS_D) + (size_t)(chain * 64 + n) * 128 + c4); }
#pragma unroll
            for (int j = 0; j < 8; ++j) { const int n = dir ? 63 - (k0 + j) : (k0 + j);
                v2u o; o.x = pk2(run[0], run[1]); o.y = pk2(run[2], run[3]);
                *(v2u*)(sdst + (size_t)(chain * 64 + n) * 16384 + e4 * 4) = o;
                run[0] = d[j].x * run[0] + __uint_as_float(L[j].x << 16); run[1] = d[j].y * run[1] + __uint_as_float(L[j].x & 0xffff0000u);
                run[2] = d[j].z * run[2] + __uint_as_float(L[j].y << 16); run[3] = d[j].w * run[3] + __uint_as_float(L[j].y & 0xffff0000u); }
        }
    }
}

__device__ __forceinline__ void h3_load_z(const P& p, int item, unsigned short (&zf)[16], unsigned short (&zb)[16], float& lbf, float& lbb) {
    const int tid = tidx(), c = tid & 127, tq = tid >> 7;
    const int n = item & 63, bh = item >> 6, b = bh / 6, h = bh % 6;
    const bf16* proj = WSP(const bf16, WS_PROJ) + (size_t)(b * SEQ + n * 64) * NIN + h * 128 + c;
    lbf = WSP(const float, WS_LBF)[h * 128 + c]; lbb = WSP(const float, WS_LBB)[h * 128 + c];
#pragma unroll
    for (int i = 0; i < 16; ++i) { const size_t o = (size_t)(tq * 16 + i) * NIN; zf[i] = proj[o + C_ZF]; zb[i] = proj[o + C_ZB]; }
}
__device__ __forceinline__ void h3_load_vq(const P& p, int item, unsigned short (&vr)[16], unsigned short (&qr)[16]) {
    const int tid = tidx(), c = tid & 127, tq = tid >> 7;
    const int n = item & 63, bh = item >> 6, b = bh / 6, h = bh % 6;
    const bf16* proj = WSP(const bf16, WS_PROJ) + (size_t)(b * SEQ + n * 64) * NIN + h * 128 + c;
#pragma unroll
    for (int i = 0; i < 16; ++i) { const size_t o = (size_t)(tq * 16 + i) * NIN; vr[i] = proj[o + C_V]; qr[i] = proj[o + C_Q]; }
}
__device__ __forceinline__ void h3_item(const P& p, unsigned char* lds, int item, const unsigned short (&zfr)[16], const unsigned short (&zbr)[16], const unsigned short (&vr)[16], const unsigned short (&qr)[16], const float lbF, const float lbB,
                                        const bool more, const int item_next, unsigned short (&nv)[16], unsigned short (&nq)[16]) {
    const int tid = tidx(), lane = tid & 63, wave = tid >> 6, c = tid & 127, tq = tid >> 7;
    const int n = item & 63, bh = item >> 6, b = bh / 6, h = bh % 6;
    const size_t row0 = (size_t)(b * SEQ + n * 64);
    const bf16* proj = WSP(const bf16, WS_PROJ) + row0 * NIN;
    float* SEG = (float*)lds;
    bf16* QF = (bf16*)(lds + 4096);
    bf16* QB = (bf16*)(lds + 4096 + 17408);
    bf16* KF = (bf16*)(lds + 4096 + 2 * 17408);
    bf16* KB = (bf16*)(lds + 4096 + 3 * 17408);
    bf16* VT = (bf16*)(lds + 4096 + 4 * 17408);
    bf16* A2 = (bf16*)(lds + 4096 + 4 * 17408 + 18432);
    float* OB = (float*)(lds + 4096);
    bf16x8 sfr[8], sbr[8];
    { const int r32p = lane & 31, hip = lane >> 5, dtp = wave & 3;
      const bf16* stf = WSP(const bf16, WS_ST) + (size_t)((bh * 2 + 0) * 64 + n) * 16384 + (size_t)(dtp * 32 + r32p) * 128 + hip * 8;
      const bf16* stb = WSP(const bf16, WS_ST) + (size_t)((bh * 2 + 1) * 64 + n) * 16384 + (size_t)(dtp * 32 + r32p) * 128 + hip * 8;
#pragma unroll
      for (int ks = 0; ks < 8; ++ks) { sfr[ks] = *(const bf16x8*)(stf + ks * 16); sbr[ks] = *(const bf16x8*)(stb + ks * 16); } }
    const v4u g0 = *(const v4u*)(proj + (size_t)(tid >> 3) * NIN + C_HG + h * 128 + (tid & 7) * 16), g1 = *(const v4u*)(proj + (size_t)(tid >> 3) * NIN + C_HG + h * 128 + (tid & 7) * 16 + 8);
    float ffv[16], fbv[16];
    { float sf = 1.f, sb = 1.f;
#pragma unroll
      for (int i = 0; i < 16; ++i) { const int s = tq * 16 + i;
        const float zf = bf2f(zfr[i]), zb = bf2f(zbr[i]);
        const float ff = lbF + (1.f - lbF) * sigmoidf_(zf), fb = lbB + (1.f - lbB) * sigmoidf_(zb);
        ffv[i] = ff; sf *= ff; fbv[i] = fb; sb *= fb;
        VT[c * 72 + s] = vr[i]; }
      SEG[tq * 128 + c] = sf; SEG[512 + tq * 128 + c] = sb; }
    __syncthreads();
    {
      float runf = (tq > 0 ? SEG[c] : 1.f) * (tq > 1 ? SEG[128 + c] : 1.f) * (tq > 2 ? SEG[256 + c] : 1.f);
      float runb = (tq < 1 ? SEG[512 + 128 + c] : 1.f) * (tq < 2 ? SEG[512 + 256 + c] : 1.f) * (tq < 3 ? SEG[512 + 384 + c] : 1.f);
      float bb[16];
#pragma unroll
      for (int i = 15; i >= 0; --i) { runb *= fbv[i]; bb[i] = runb; }
#pragma unroll
      for (int i = 0; i < 16; ++i) { const int s = tq * 16 + i; runf *= ffv[i];
        const float q = bf2f(qr[i]);
        QF[s * 136 + c] = (bf16)f2bf(q * runf); KF[s * 136 + c] = (bf16)f2bf((1.f - ffv[i]) * __builtin_amdgcn_rcpf(runf));
        QB[s * 136 + c] = (bf16)f2bf(q * bb[i]); KB[s * 136 + c] = (bf16)f2bf((1.f - fbv[i]) * __builtin_amdgcn_rcpf(bb[i])); } }
    if (more) h3_load_vq(p, item_next, nv, nq);
    __syncthreads();
    const int r32 = lane & 31, hi = lane >> 5;
    {
      const int dir = wave >> 2, ti = (wave >> 1) & 1, si = wave & 1;
      const bf16* Qd = dir ? QB : QF; const bf16* Kd = dir ? KB : KF;
      f32x16 a = zero16();
#pragma unroll
      for (int ks = 0; ks < 8; ++ks) a = mfma32(*(const bf16x8*)(Qd + (ti * 32 + r32) * 136 + ks * 16 + hi * 8), *(const bf16x8*)(Kd + (si * 32 + r32) * 136 + ks * 16 + hi * 8), a);
#pragma unroll
      for (int r = 0; r < 16; ++r) { const int t = ti * 32 + (r & 3) + 8 * (r >> 2) + 4 * hi, s = si * 32 + r32;
        const bool keep = dir ? (s >= t) : (s <= t);
        A2[t * 136 + dir * 64 + s] = (bf16)f2bf(keep ? a[r] : 0.f); } }
    __syncthreads();
    f32x16 o = zero16();
    const int tt = wave >> 2, dt = wave & 3;
    {
#pragma unroll
      for (int ks = 0; ks < 8; ++ks) {
        o = mfma32(*(const bf16x8*)(QF + (tt * 32 + r32) * 136 + ks * 16 + hi * 8), sfr[ks], o);
        o = mfma32(*(const bf16x8*)(QB + (tt * 32 + r32) * 136 + ks * 16 + hi * 8), sbr[ks], o);
        o = mfma32(*(const bf16x8*)(A2 + (tt * 32 + r32) * 136 + ks * 16 + hi * 8), *(const bf16x8*)(VT + (dt * 32 + r32) * 72 + (ks & 3) * 16 + hi * 8), o); } }
    __syncthreads();
#pragma unroll
    for (int r = 0; r < 16; ++r) OB[(tt * 32 + (r & 3) + 8 * (r >> 2) + 4 * hi) * 132 + dt * 32 + r32] = o[r];
    __syncthreads();
    { const int t = tid >> 3, sub = tid & 7;
      float v[16]; float ss = 0.f;
#pragma unroll
      for (int k = 0; k < 4; ++k) { const f32x4 x = *(const f32x4*)(OB + t * 132 + sub * 16 + 4 * k); v[4 * k] = x.x; v[4 * k + 1] = x.y; v[4 * k + 2] = x.z; v[4 * k + 3] = x.w; ss += (x.x * x.x + x.y * x.y) + (x.z * x.z + x.w * x.w); }
      const float rstd = rsqrtf(sum8(ss) * (1.f / 128.f) + EPS);
      float gz[16]; gz[0] = __uint_as_float(g0.x << 16); gz[1] = __uint_as_float(g0.x & 0xffff0000u); gz[2] = __uint_as_float(g0.y << 16); gz[3] = __uint_as_float(g0.y & 0xffff0000u);
      gz[4] = __uint_as_float(g0.z << 16); gz[5] = __uint_as_float(g0.z & 0xffff0000u); gz[6] = __uint_as_float(g0.w << 16); gz[7] = __uint_as_float(g0.w & 0xffff0000u);
      gz[8] = __uint_as_float(g1.x << 16); gz[9] = __uint_as_float(g1.x & 0xffff0000u); gz[10] = __uint_as_float(g1.y << 16); gz[11] = __uint_as_float(g1.y & 0xffff0000u);
      gz[12] = __uint_as_float(g1.z << 16); gz[13] = __uint_as_float(g1.z & 0xffff0000u); gz[14] = __uint_as_float(g1.w << 16); gz[15] = __uint_as_float(g1.w & 0xffff0000u);
      float o[16];
#pragma unroll
      for (int k = 0; k < 16; ++k) o[k] = v[k] * rstd * ((const float*)p.g_hg)[sub * 16 + k] * (gz[k] * sigmoidf_(gz[k]));
      v4u w0, w1; w0.x = pk2(o[0], o[1]); w0.y = pk2(o[2], o[3]); w0.z = pk2(o[4], o[5]); w0.w = pk2(o[6], o[7]); w1.x = pk2(o[8], o[9]); w1.y = pk2(o[10], o[11]); w1.z = pk2(o[12], o[13]); w1.w = pk2(o[14], o[15]);
      bf16* orow = WSP(bf16, WS_OCAT) + (row0 + t) * DM + h * 128 + sub * 16;
      *(v4u*)orow = w0; *(v4u*)(orow + 8) = w1; }
    __syncthreads();
}
__device__ __forceinline__ float max4x(float v) { v = fmaxf(v, __shfl_xor(v, 16)); return fmaxf(v, __shfl_xor(v, 32)); }
__device__ __forceinline__ float sum4x(float v) { v += __shfl_xor(v, 16); return v + __shfl_xor(v, 32); }
__device__ __forceinline__ bf16x8 pack_p(const f32x4 a, const f32x4 b) {
    v4u w; w.x = pk2(a.x, a.y); w.y = pk2(a.z, a.w); w.z = pk2(b.x, b.y); w.w = pk2(b.z, b.w); return __builtin_bit_cast(bf16x8, w); }
__device__ __forceinline__ bf16x8 ld_vt2(const bf16* p0, const bf16* p1) { const v2u a = *(const v2u*)p0, b = *(const v2u*)p1; v4u w; w.x = a.x; w.y = a.y; w.z = b.x; w.w = b.y; return __builtin_bit_cast(bf16x8, w); }
struct DilRegs { v4u kv[4], vv[4]; bf16x8 q0, q1; };
__device__ __forceinline__ void dil_decode(int item, int& b, int& head, int& r, int& Ls, int& cres, int& i0) {
    const int blk = item & 31, bh = item >> 5; b = bh / 12; head = bh % 12; const int g = head >> 2;
    r = (g == 0) ? 1 : (g == 1 ? 4 : 16); Ls = SEQ / r; const int nblk = Ls / 128; cres = blk / nblk; i0 = (blk % nblk) * 128;
}
__device__ __forceinline__ void dil_load(const P& p, int item, DilRegs& R) {
    const int tid = tidx(), lane = tid & 63, wave = tid >> 6, fr = lane & 15, h = lane >> 4;
    int b, head, r, Ls, cres, i0; dil_decode(item, b, head, r, Ls, cres, i0);
    const bf16* proj = WSP(const bf16, WS_PROJ) + (size_t)(b * SEQ) * NIN;
#pragma unroll
    for (int k = 0; k < 4; ++k) { const int idx = tid + 512 * k, row = idx >> 3, ch = idx & 7; const int j = i0 - 64 + row;
        v4u kv = {0u, 0u, 0u, 0u}, vv = {0u, 0u, 0u, 0u};
        if (j >= 0 && j < Ls) { const size_t tok = (size_t)(cres + r * j); kv = *(const v4u*)(proj + tok * NIN + C_DK + head * 64 + ch * 8); vv = *(const v4u*)(proj + tok * NIN + C_DV + head * 64 + ch * 8); }
        R.kv[k] = kv; R.vv[k] = vv; }
    const bf16* qp = proj + (size_t)(cres + r * (i0 + 16 * wave + fr)) * NIN + C_DQ + head * 64 + 8 * h;
    R.q0 = *(const bf16x8*)qp; R.q1 = *(const bf16x8*)(qp + 32);
}
__device__ __forceinline__ void dil_item(const P& p, unsigned char* lds, int item, const DilRegs& R) {
    const int tid = tidx(), lane = tid & 63, wave = tid >> 6, fr = lane & 15, h = lane >> 4;
    int b, head, r, Ls, cres, i0; dil_decode(item, b, head, r, Ls, cres, i0);
    bf16* Ks = (bf16*)lds;
    bf16* VT = (bf16*)(lds + 36864);
#pragma unroll
    for (int k = 0; k < 4; ++k) { const int idx = tid + 512 * k, row = idx >> 3, ch = idx & 7; const v4u kv = R.kv[k], vv = R.vv[k];
        *(v4u*)(Ks + row * 72 + ch * 8) = kv;
        bf16* vt = VT + (ch * 8) * 280 + row;
        vt[0] = (bf16)(vv.x & 0xffff); vt[280] = (bf16)(vv.x >> 16); vt[560] = (bf16)(vv.y & 0xffff); vt[840] = (bf16)(vv.y >> 16);
        vt[1120] = (bf16)(vv.z & 0xffff); vt[1400] = (bf16)(vv.z >> 16); vt[1680] = (bf16)(vv.w & 0xffff); vt[1960] = (bf16)(vv.w >> 16); }
    { const int d = tid >> 3, c2 = (tid & 7) * 2; *(unsigned*)(VT + d * 280 + 256 + c2) = 0u; }
    __syncthreads();
    const int iq = i0 + 16 * wave + fr;
    const bf16x8 q0 = R.q0, q1 = R.q1;
    f32x4 sc[10];
#pragma unroll
    for (int j = 0; j < 9; ++j) { const bf16* kr = Ks + (16 * (wave + j) + fr) * 72 + 8 * h;
        f32x4 s4 = {0.f, 0.f, 0.f, 0.f}; s4 = mfma16(*(const bf16x8*)kr, q0, s4); sc[j] = mfma16(*(const bf16x8*)(kr + 32), q1, s4);
        if (j % 3 == 2) asm volatile("" ::: "memory"); }
    const float slope = exp2f(-8.0f * (float)(head + 1) / 12.0f) * (float)r;
    float m = -3.0e38f;
#pragma unroll
    for (int j = 0; j < 9; ++j)
#pragma unroll
        for (int e = 0; e < 4; ++e) { const int dj = -64 + 16 * j + 4 * h + e - fr, jk = iq + dj, adj = dj < 0 ? -dj : dj;
            const bool ok = (adj <= 64) && (jk >= 0) && (jk < Ls);
            sc[j][e] = ok ? sc[j][e] * 0.125f - slope * (float)adj : -1.0e30f; m = fmaxf(m, sc[j][e]); }
    m = max4x(m); float l = 0.f;
#pragma unroll
    for (int j = 0; j < 9; ++j)
#pragma unroll
        for (int e = 0; e < 4; ++e) { const float pe = sc[j][e] > -1.0e29f ? __expf(sc[j][e] - m) : 0.f; sc[j][e] = pe; l += pe; }
    l = sum4x(l); const float inv = 1.0f / l;
#pragma unroll
    for (int j = 0; j < 9; ++j) sc[j] = sc[j] * inv;
    sc[9] = (f32x4){0.f, 0.f, 0.f, 0.f};
    if (h == 0) WSP(float, WS_LSE)[(size_t)(b * 12 + head) * SEQ + cres + r * iq] = m + __logf(l);
    f32x4 o[4];
#pragma unroll
    for (int dt = 0; dt < 4; ++dt) o[dt] = (f32x4){0.f, 0.f, 0.f, 0.f};
#pragma unroll
    for (int ks = 0; ks < 5; ++ks) { const bf16x8 pa = pack_p(sc[2 * ks], sc[2 * ks + 1]);
        const bf16* v0 = VT + fr * 280 + 16 * (wave + 2 * ks) + 4 * h;
#pragma unroll
        for (int dt = 0; dt < 4; ++dt) o[dt] = mfma16(ld_vt2(v0 + dt * 16 * 280, v0 + dt * 16 * 280 + 16), pa, o[dt]);
        asm volatile("" ::: "memory"); }
    { const size_t tok = (size_t)(b * SEQ + cres + r * iq);
      bf16* orow = WSP(bf16, WS_OCAT) + tok * DM + 768 + head * 64 + 4 * h;
#pragma unroll
      for (int dt = 0; dt < 4; ++dt) { v2u w; w.x = pk2(o[dt][0], o[dt][1]); w.y = pk2(o[dt][2], o[dt][3]); *(v2u*)(orow + dt * 16) = w; } }
    __syncthreads();
}

__device__ __forceinline__ void mem_item(const P& p, unsigned char* lds, int item) {
    const int tid = tidx(), lane = tid & 63, wave = tid >> 6, fr = lane & 15, h = lane >> 4;
    const int blk = item & 31, bh = item >> 5, b = bh >> 2, head = bh & 3;
    const size_t row0 = (size_t)(b * SEQ + blk * 128);
    const bf16* qp = WSP(const bf16, WS_PROJ) + (row0 + 16 * wave + fr) * NIN + C_MQ + head * 128 + 8 * h;
    bf16x8 qf[4];
#pragma unroll
    for (int kk = 0; kk < 4; ++kk) qf[kk] = *(const bf16x8*)(qp + 32 * kk);
    bf16* Ks = (bf16*)lds;
    bf16* VT = (bf16*)(lds + 69632);
#pragma unroll
    for (int k = 0; k < 8; ++k) { const int idx = tid + 512 * k;
        { const int row = idx >> 4, ch = idx & 15; *(v4u*)(Ks + row * 136 + ch * 8) = *(const v4u*)(WSP(const bf16, WS_KVM) + (size_t)(b * MEML + row) * 1024 + head * 128 + ch * 8); }
        { const int d = idx >> 5, ch = idx & 31; *(v4u*)(VT + d * 264 + ch * 8) = *(const v4u*)(WSP(const bf16, WS_KVMT) + (size_t)(512 + head * 128 + d) * 512 + b * MEML + ch * 8); } }
    __syncthreads();
    f32x4 sc[16]; float m = -3.0e38f;
#pragma unroll
    for (int j = 0; j < 16; ++j) { const bf16* kr = Ks + (16 * j + fr) * 136 + 8 * h; f32x4 s4 = {0.f, 0.f, 0.f, 0.f};
#pragma unroll
        for (int kk = 0; kk < 4; ++kk) s4 = mfma16(*(const bf16x8*)(kr + 32 * kk), qf[kk], s4);
        sc[j] = s4 * 0.08838834764831845f; m = fmaxf(fmaxf(m, fmaxf(sc[j][0], sc[j][1])), fmaxf(sc[j][2], sc[j][3]));
        if ((j & 1) == 1) asm volatile("" ::: "memory"); }
    m = max4x(m); float l = 0.f;
#pragma unroll
    for (int j = 0; j < 16; ++j)
#pragma unroll
        for (int e = 0; e < 4; ++e) { sc[j][e] = __expf(sc[j][e] - m); l += sc[j][e]; }
    l = sum4x(l); const float inv = 1.0f / l;
    f32x4 o[8];
#pragma unroll
    for (int dt = 0; dt < 8; ++dt) o[dt] = (f32x4){0.f, 0.f, 0.f, 0.f};
#pragma unroll
    for (int ks = 0; ks < 8; ++ks) { const bf16x8 pa = pack_p(sc[2 * ks] * inv, sc[2 * ks + 1] * inv);
        const bf16* v0 = VT + fr * 264 + 32 * ks + 4 * h;
#pragma unroll
        for (int dt = 0; dt < 8; ++dt) o[dt] = mfma16(ld_vt2(v0 + dt * 16 * 264, v0 + dt * 16 * 264 + 16), pa, o[dt]);
        asm volatile("" ::: "memory"); }
    { bf16* orow = WSP(bf16, WS_OCAT) + (row0 + 16 * wave + fr) * DM + 1536 + head * 128 + 4 * h;
#pragma unroll
      for (int dt = 0; dt < 8; ++dt) { v2u w; w.x = pk2(o[dt][0], o[dt][1]); w.y = pk2(o[dt][2], o[dt][3]); *(v2u*)(orow + dt * 16) = w; } }
    __syncthreads();
}

__device__ __forceinline__ void dil_alpha_rows(const P& p, int vcu, int G) {
    const int gt = vcu * NTHR + tidx(), NGT = G * NTHR;
    constexpr int NTASK = T * 96;
    for (int id0 = gt; id0 < NTASK; id0 += 6 * NGT) {
        float l0[6], l1[6], l2[6]; v4u v[6]; int g6[6];
#pragma unroll
        for (int k = 0; k < 6; ++k) { const int id = id0 + k * NGT; g6[k] = -1;
            if (id < NTASK) { const int t = id / 96, ch = id - t * 96, head = ch >> 3, j = head & 3, b = t / SEQ, s = t - b * SEQ; g6[k] = head >> 2;
                const float* L = WSP(const float, WS_LSE) + (size_t)(b * 12 + j) * SEQ + s; l0[k] = L[0]; l1[k] = L[4 * SEQ]; l2[k] = L[8 * SEQ];
                v[k] = *(const v4u*)(WSP(const bf16, WS_OCAT) + (size_t)t * DM + 768 + ch * 8); } }
#pragma unroll
        for (int k = 0; k < 6; ++k) if (g6[k] >= 0) { const int id = id0 + k * NGT, t = id / 96, ch = id - t * 96;
            const float m = fmaxf(l0[k], fmaxf(l1[k], l2[k])), e0 = __expf(l0[k] - m), e1 = __expf(l1[k] - m), e2 = __expf(l2[k] - m);
            const float al = (g6[k] == 0 ? e0 : (g6[k] == 1 ? e1 : e2)) / (e0 + e1 + e2); v4u w = v[k];
            w.x = pk2(__uint_as_float(w.x << 16) * al, __uint_as_float(w.x & 0xffff0000u) * al); w.y = pk2(__uint_as_float(w.y << 16) * al, __uint_as_float(w.y & 0xffff0000u) * al);
            w.z = pk2(__uint_as_float(w.z << 16) * al, __uint_as_float(w.z & 0xffff0000u) * al); w.w = pk2(__uint_as_float(w.w << 16) * al, __uint_as_float(w.w & 0xffff0000u) * al);
            *(v4u*)(WSP(bf16, WS_OCAT) + (size_t)t * DM + 768 + ch * 8) = w; }
    }
}
__device__ __forceinline__ unsigned okey(float f) { const unsigned u = __float_as_uint(f); return u ^ ((unsigned)((int)u >> 31) | 0x80000000u); }
__device__ __forceinline__ float unkey(unsigned k) { const unsigned u = (k & 0x80000000u) ? (k ^ 0x80000000u) : ~k; return __uint_as_float(u); }
__device__ __forceinline__ unsigned umax_(unsigned a, unsigned b) { return a > b ? a : b; }
__device__ __forceinline__ unsigned umin_(unsigned a, unsigned b) { return a < b ? a : b; }
template <int CTRL> __device__ __forceinline__ unsigned dppu(unsigned v) { return (unsigned)__builtin_amdgcn_update_dpp(0, (int)v, CTRL, 0xf, 0xf, true); }
__device__ __forceinline__ void topk_rows(const P& p, int vcu, int G) {
    const int gt = vcu * NTHR + tidx(), NGT = G * NTHR;
    for (int gid = gt; gid < T * 16; gid += NGT) {
        const int row = gid >> 1, half = gid & 1, t = row >> 3, h = row & 7;
        const float* sc = WSP(const float, WS_SC) + (size_t)row * 256 + half * 128;
        unsigned v[16];
#pragma unroll
        for (int i = 0; i < 16; ++i) v[i] = 0u;
        for (int n4 = 0; n4 < 32; ++n4) { const f32x4 q = *(const f32x4*)(sc + n4 * 4);
#pragma unroll
            for (int e = 0; e < 4; ++e) { unsigned x = (okey(q[e]) & 0xffffff80u) | (unsigned)(127 - (n4 * 4 + e));
#pragma unroll
                for (int i = 0; i < 16; ++i) { const unsigned hi = umax_(v[i], x); x = umin_(v[i], x); v[i] = hi; } } }
        float s0[16], s1[16]; unsigned long long p0lo = 0ull, p0hi = 0ull, p1lo = 0ull, p1hi = 0ull;
#pragma unroll
        for (int i = 0; i < 16; ++i) { const unsigned o = dppu<0xB1>(v[i]); const unsigned k0 = half ? o : v[i], k1 = half ? v[i] : o;
            s0[i] = unkey(k0 & 0xffffff80u); s1[i] = unkey(k1 & 0xffffff80u);
            const unsigned long long a0 = (unsigned long long)(127u - (k0 & 127u)) << (8 * (i & 7)), a1 = (unsigned long long)(127u - (k1 & 127u)) << (8 * (i & 7));
            if (i < 8) { p0lo |= a0; p1lo |= a1; } else { p0hi |= a0; p1hi |= a1; } }
        unsigned bk[16];
#pragma unroll
        for (int k = 0; k < 16; ++k) bk[k] = 0u;
#pragma unroll
        for (int i = 0; i < 16; ++i)
#pragma unroll
            for (int j = 0; j < 16; ++j) if ((i + 1) * (j + 1) <= 16) {
                unsigned x = (okey(s0[i] + s1[j]) & 0xffffff00u) | (unsigned)(255 - (i * 16 + j));
#pragma unroll
                for (int k = 0; k < 16; ++k) { const unsigned hi = umax_(bk[k], x); x = umin_(bk[k], x); bk[k] = hi; } }
        const float rstd = row_rstd(WSP(const float, WS_RSP), t);
        const float m = unkey(bk[0] & 0xffffff00u) * rstd; float l = 0.f; float ev[16];
#pragma unroll
        for (int k = 0; k < 16; ++k) { ev[k] = __expf(unkey(bk[k] & 0xffffff00u) * rstd - m); l += ev[k]; }
        const float inv = 1.0f / l;
        int be[16];
#pragma unroll
        for (int k = 0; k < 16; ++k) { const int code = 255 - (int)(bk[k] & 255u), ci = code >> 4, cj = code & 15;
            const int a = (int)(((ci & 8) ? p0hi : p0lo) >> (8 * (ci & 7))) & 0xff, c = (int)(((cj & 8) ? p1hi : p1lo) >> (8 * (cj & 7))) & 0xff;
            be[k] = a * 128 + c; }
        int* io = WSP(int, WS_IDX) + (size_t)t * 128 + h * 16; float* go = WSP(float, WS_GATE) + (size_t)t * 128 + h * 16;
        if (half == 0) {
            *(int4*)io = make_int4(be[0], be[1], be[2], be[3]); *(int4*)(io + 4) = make_int4(be[4], be[5], be[6], be[7]);
            *(f32x4*)go = (f32x4){ev[0] * inv, ev[1] * inv, ev[2] * inv, ev[3] * inv}; *(f32x4*)(go + 4) = (f32x4){ev[4] * inv, ev[5] * inv, ev[6] * inv, ev[7] * inv};
        } else {
            *(int4*)(io + 8) = make_int4(be[8], be[9], be[10], be[11]); *(int4*)(io + 12) = make_int4(be[12], be[13], be[14], be[15]);
            *(f32x4*)(go + 8) = (f32x4){ev[8] * inv, ev[9] * inv, ev[10] * inv, ev[11] * inv}; *(f32x4*)(go + 12) = (f32x4){ev[12] * inv, ev[13] * inv, ev[14] * inv, ev[15] * inv};
        }
    }
}

__device__ __forceinline__ void unpack8(const v4u w, float* f) {
    f[0] = __uint_as_float(w.x << 16); f[1] = __uint_as_float(w.x & 0xffff0000u); f[2] = __uint_as_float(w.y << 16); f[3] = __uint_as_float(w.y & 0xffff0000u);
    f[4] = __uint_as_float(w.z << 16); f[5] = __uint_as_float(w.z & 0xffff0000u); f[6] = __uint_as_float(w.w << 16); f[7] = __uint_as_float(w.w & 0xffff0000u);
}
template <int CTRL> __device__ __forceinline__ float dpp_f(float v) { return __builtin_bit_cast(float, __builtin_amdgcn_update_dpp(0, __builtin_bit_cast(int, v), CTRL, 0xf, 0xf, true)); }
__device__ __forceinline__ float row16_sum(float v) {
    v += dpp_f<0xB1>(v); v += dpp_f<0x4E>(v); v += dpp_f<0x141>(v); v += dpp_f<0x140>(v); return v;
}
__device__ __forceinline__ float swap32_add(float x, float y) {
    auto r = __builtin_amdgcn_permlane32_swap(__float_as_uint(x), __float_as_uint(y), false, false); return __uint_as_float(r[0]) + __uint_as_float(r[1]); }
__device__ __forceinline__ float swap16_add(float x, float y) {
    auto r = __builtin_amdgcn_permlane16_swap(__float_as_uint(x), __float_as_uint(y), false, false); return __uint_as_float(r[0]) + __uint_as_float(r[1]); }
__device__ __forceinline__ float reduce4(float d0, float d1, float d2, float d3) { return row16_sum(swap16_add(swap32_add(d0, d2), swap32_add(d1, d3))); }
__device__ __forceinline__ float rl_f(float v, int l) { return __builtin_bit_cast(float, __builtin_amdgcn_readlane(__builtin_bit_cast(int, v), l)); }
__device__ __forceinline__ float wave_sum_dpp(float v) { const float r = row16_sum(v); return (rl_f(r, 0) + rl_f(r, 16)) + (rl_f(r, 32) + rl_f(r, 48)); }
__device__ __forceinline__ int sdot4(unsigned a, unsigned b, int c) { return __builtin_amdgcn_sdot4((int)a, (int)b, c, false); }
__device__ __forceinline__ unsigned q8(float v, float inv) { return (unsigned)((int)rintf(v * inv)) & 0xffu; }
#ifndef PEER_PB
#define PEER_PB 8
#endif
constexpr int PB = PEER_PB;
__device__ __forceinline__ void peer_rows(const P& p, int vcu, int G, float* dst) {
    const int lane = tidx() & 63, gw = vcu * NWAVES + (tidx() >> 6), NGW = G * NWAVES;
    const v4u* U = WSP(const v4u, WS_UQ); const v4u* V = WSP(const v4u, WS_VQ);
    for (int t = gw; t < T; t += NGW) {
        unsigned xq[8]; float sx;
        { const v4u* xp = WSP(const v4u, WS_XG) + (size_t)t * 256 + lane * 2; float f[32];
          unpack8(xp[0], f); unpack8(xp[1], f + 8); unpack8(xp[128], f + 16); unpack8(xp[129], f + 24);
          float m = 0.f;
#pragma unroll
          for (int i = 0; i < 32; ++i) m = fmaxf(m, fabsf(f[i]));
          m = wave_max(m); m = fmaxf(m, 1e-30f); sx = m * (1.f / 127.f); const float inv = 127.f / m;
#pragma unroll
          for (int i = 0; i < 8; ++i) xq[i] = q8(f[4 * i], inv) | (q8(f[4 * i + 1], inv) << 8) | (q8(f[4 * i + 2], inv) << 16) | (q8(f[4 * i + 3], inv) << 24); }
        const int ia = WSP(const int, WS_IDX)[(size_t)t * 128 + lane], ib = WSP(const int, WS_IDX)[(size_t)t * 128 + 64 + lane];
        const float ascale = row_rstd(WSP(const float, WS_RSP), t) * sx;
        float aa = 0.f, ab = 0.f;
#pragma unroll 1
        for (int e0 = 0; e0 < 128; e0 += PB) {
            v4u w[PB][2];
#pragma unroll
            for (int j = 0; j < PB; ++j) { const int e = e0 + j; const int row = __builtin_amdgcn_readlane(e < 64 ? ia : ib, e & 63);
                const v4u* r = U + (size_t)row * 128 + lane; w[j][0] = r[0]; w[j][1] = r[64]; }
            float d[PB];
#pragma unroll
            for (int j = 0; j < PB; ++j) { int a0 = 0, a1 = 0;
                a0 = sdot4(w[j][0].x, xq[0], a0); a1 = sdot4(w[j][0].y, xq[1], a1); a0 = sdot4(w[j][0].z, xq[2], a0); a1 = sdot4(w[j][0].w, xq[3], a1);
                a0 = sdot4(w[j][1].x, xq[4], a0); a1 = sdot4(w[j][1].y, xq[5], a1); a0 = sdot4(w[j][1].z, xq[6], a0); a1 = sdot4(w[j][1].w, xq[7], a1);
                d[j] = (float)(a0 + a1); }
#pragma unroll
            for (int j4 = 0; j4 < PB; j4 += 4) { const float r0 = reduce4(d[j4], d[j4 + 1], d[j4 + 2], d[j4 + 3]);
#pragma unroll
                for (int j = 0; j < 4; ++j) { const int e = e0 + j4 + j; const float v = rl_f(r0, 16 * j);
                    if (lane == (e & 63)) { if (e < 64) aa = v; else ab = v; } } }
        }
        float ha, hb;
        { const float* SU = WSP(const float, WS_SU); const float* SV = WSP(const float, WS_SV);
          const float ga = WSP(const float, WS_GATE)[(size_t)t * 128 + lane], gb = WSP(const float, WS_GATE)[(size_t)t * 128 + 64 + lane];
          aa *= ascale * SU[ia]; ab *= ascale * SU[ib];
          ha = 0.5f * aa * (1.0f + erff(aa * 0.70710678118f)) * ga * SV[ia]; hb = 0.5f * ab * (1.0f + erff(ab * 0.70710678118f)) * gb * SV[ib]; }
        float acc[32]; float csum = 0.f;
#pragma unroll
        for (int i = 0; i < 32; ++i) acc[i] = 0.f;
#pragma unroll 1
        for (int e0 = 0; e0 < 128; e0 += PB) {
            v4u w[PB][2];
#pragma unroll
            for (int j = 0; j < PB; ++j) { const int e = e0 + j; const int row = __builtin_amdgcn_readlane(e < 64 ? ia : ib, e & 63);
                const v4u* r = V + (size_t)row * 128 + lane; w[j][0] = r[0]; w[j][1] = r[64]; }
#pragma unroll
            for (int j = 0; j < PB; ++j) { const int e = e0 + j; const float h = rl_f(e < 64 ? ha : hb, e & 63); csum += h;
#pragma unroll
                for (int i = 0; i < 2; ++i) { const unsigned x0 = w[j][i].x, x1 = w[j][i].y, x2 = w[j][i].z, x3 = w[j][i].w;
                    acc[16 * i + 0] = fmaf(h, (float)(x0 & 0xffu), acc[16 * i + 0]); acc[16 * i + 1] = fmaf(h, (float)((x0 >> 8) & 0xffu), acc[16 * i + 1]);
                    acc[16 * i + 2] = fmaf(h, (float)((x0 >> 16) & 0xffu), acc[16 * i + 2]); acc[16 * i + 3] = fmaf(h, (float)(x0 >> 24), acc[16 * i + 3]);
                    acc[16 * i + 4] = fmaf(h, (float)(x1 & 0xffu), acc[16 * i + 4]); acc[16 * i + 5] = fmaf(h, (float)((x1 >> 8) & 0xffu), acc[16 * i + 5]);
                    acc[16 * i + 6] = fmaf(h, (float)((x1 >> 16) & 0xffu), acc[16 * i + 6]); acc[16 * i + 7] = fmaf(h, (float)(x1 >> 24), acc[16 * i + 7]);
                    acc[16 * i + 8] = fmaf(h, (float)(x2 & 0xffu), acc[16 * i + 8]); acc[16 * i + 9] = fmaf(h, (float)((x2 >> 8) & 0xffu), acc[16 * i + 9]);
                    acc[16 * i + 10] = fmaf(h, (float)((x2 >> 16) & 0xffu), acc[16 * i + 10]); acc[16 * i + 11] = fmaf(h, (float)(x2 >> 24), acc[16 * i + 11]);
                    acc[16 * i + 12] = fmaf(h, (float)(x3 & 0xffu), acc[16 * i + 12]); acc[16 * i + 13] = fmaf(h, (float)((x3 >> 8) & 0xffu), acc[16 * i + 13]);
                    acc[16 * i + 14] = fmaf(h, (float)((x3 >> 16) & 0xffu), acc[16 * i + 14]); acc[16 * i + 15] = fmaf(h, (float)(x3 >> 24), acc[16 * i + 15]); } }
        }
        const float* orow = ((float*)p.out) + (size_t)t * DM; float* drow = dst + (size_t)t * DM; float ss = 0.f; const float coff = 128.f * csum;
#pragma unroll
        for (int i = 0; i < 2; ++i)
#pragma unroll
            for (int k = 0; k < 4; ++k) { const f32x4 a = *(const f32x4*)(orow + i * 1024 + lane * 16 + 4 * k);
                float* c = acc + 16 * i + 4 * k; c[0] += a.x - coff; c[1] += a.y - coff; c[2] += a.z - coff; c[3] += a.w - coff;
                ss += (c[0] * c[0] + c[1] * c[1]) + (c[2] * c[2] + c[3] * c[3]); }
        const float r2 = rsqrtf(wave_sum_dpp(ss) * (1.f / DM) + EPS);
#pragma unroll
        for (int i = 0; i < 2; ++i)
#pragma unroll
            for (int k = 0; k < 4; ++k) { const f32x4 g = *(const f32x4*)(((const float*)p.g_final) + i * 1024 + lane * 16 + 4 * k); const float* c = acc + 16 * i + 4 * k;
                *(f32x4*)(drow + i * 1024 + lane * 16 + 4 * k) = (f32x4){c[0] * r2 * g.x, c[1] * r2 * g.y, c[2] * r2 * g.z, c[3] * r2 * g.w}; }
    }
}

struct PeerMap { int rho, nx, r, nloc, bal; };
__device__ __forceinline__ PeerMap peer_map(const XcdBarrier& b, volatile LAS unsigned* MISC) {
    if (tidx() == 0) {
        unsigned rho = 0, nx = 1, nloc = 1;
        xcd_barrier_complete(b.bar, b.x, nloc, nx);
        for (unsigned j = 0; j < b.x; ++j) if (xb_ld(&b.bar[XB_XCNT(j)])) ++rho;
        const unsigned r = xb_add(&b.bar[4096 + 64 * b.x], 1u);
        unsigned bal = 1u; for (unsigned j = 0; j < 16; ++j) { const unsigned c = xb_ld(&b.bar[XB_XCNT(j)]); if (c != 0u && c != nloc) bal = 0u; }
        if (nx * nloc != gridDim.x) bal = 0u;
        MISC[4] = rho; MISC[5] = nx; MISC[6] = r % nloc; MISC[7] = nloc; MISC[10] = bal;
    }
    __syncthreads();
    PeerMap m; m.rho = __builtin_amdgcn_readfirstlane((int)MISC[4]); m.nx = __builtin_amdgcn_readfirstlane((int)MISC[5]); m.r = __builtin_amdgcn_readfirstlane((int)MISC[6]);
    m.nloc = __builtin_amdgcn_readfirstlane((int)MISC[7]); m.bal = __builtin_amdgcn_readfirstlane((int)MISC[10]);
    return m;
}
__device__ __forceinline__ void xq_rows(const P& p, int vcu, int G) {
    const int lane = tidx() & 63, gw = vcu * NWAVES + (tidx() >> 6), NGW = G * NWAVES;
    for (int t = gw; t < T; t += NGW) {
        const v4u* xp = WSP(const v4u, WS_XG) + (size_t)t * 256 + lane * 4; float f[32];
        unpack8(xp[0], f); unpack8(xp[1], f + 8); unpack8(xp[2], f + 16); unpack8(xp[3], f + 24);
        float m = 0.f;
#pragma unroll
        for (int i = 0; i < 32; ++i) m = fmaxf(m, fabsf(f[i]));
        m = fmaxf(wave_max(m), 1e-30f); const float inv = 127.f / m;
        v4u o0, o1;
        o0.x = q8(f[0], inv) | (q8(f[1], inv) << 8) | (q8(f[2], inv) << 16) | (q8(f[3], inv) << 24); o0.y = q8(f[4], inv) | (q8(f[5], inv) << 8) | (q8(f[6], inv) << 16) | (q8(f[7], inv) << 24);
        o0.z = q8(f[8], inv) | (q8(f[9], inv) << 8) | (q8(f[10], inv) << 16) | (q8(f[11], inv) << 24); o0.w = q8(f[12], inv) | (q8(f[13], inv) << 8) | (q8(f[14], inv) << 16) | (q8(f[15], inv) << 24);
        o1.x = q8(f[16], inv) | (q8(f[17], inv) << 8) | (q8(f[18], inv) << 16) | (q8(f[19], inv) << 24); o1.y = q8(f[20], inv) | (q8(f[21], inv) << 8) | (q8(f[22], inv) << 16) | (q8(f[23], inv) << 24);
        o1.z = q8(f[24], inv) | (q8(f[25], inv) << 8) | (q8(f[26], inv) << 16) | (q8(f[27], inv) << 24); o1.w = q8(f[28], inv) | (q8(f[29], inv) << 8) | (q8(f[30], inv) << 16) | (q8(f[31], inv) << 24);
        v4u* xo = WSP(v4u, WS_XQ) + (size_t)t * 128 + lane * 2; xo[0] = o0; xo[1] = o1;
        if (lane == 0) WSP(float, WS_SX)[t] = m * (1.f / 127.f);
    }
}
__device__ __forceinline__ void peer_u_sliced(const P& p, const PeerMap& mp) {
    const int lane = tidx() & 63, wave = tidx() >> 6, g = lane >> 4, l = lane & 15;
    const int w0 = mp.r * NWAVES + wave, NW = mp.nloc * NWAVES;
    for (int s = mp.rho; s < 8; s += mp.nx) {
        const unsigned char* ub = (const unsigned char*)(p.ws + WS_UQ) + s * 256 + l * 16;
        float* pa = WSP(float, WS_PA) + (size_t)s * T * 128;
        for (int t = w0; t < T; t += NW) {
            const v4u xq = *(const v4u*)((const unsigned char*)(p.ws + WS_XQ) + (size_t)t * DM + s * 256 + l * 16);
            const int* ip = WSP(const int, WS_IDX) + (size_t)t * 128 + g;
            int idxv[32];
#pragma unroll
            for (int k = 0; k < 32; ++k) idxv[k] = ip[4 * k];
#pragma unroll
            for (int k0 = 0; k0 < 32; k0 += 16) {
                v4u w[16];
#pragma unroll
                for (int k = 0; k < 16; ++k) w[k] = *(const v4u*)(ub + (size_t)idxv[k0 + k] * DM);
#pragma unroll
                for (int k = 0; k < 16; ++k) { int a0 = sdot4(w[k].x, xq.x, 0), a1 = sdot4(w[k].y, xq.y, 0); a0 = sdot4(w[k].z, xq.z, a0); a1 = sdot4(w[k].w, xq.w, a1);
                    const float d = row16_sum((float)(a0 + a1));
                    if (l == 0) pa[(size_t)t * 128 + 4 * (k0 + k) + g] = d; }
            }
        }
    }
}
__device__ __forceinline__ unsigned permb(unsigned hi, unsigned lo, unsigned sel) { return __builtin_amdgcn_perm(hi, lo, sel); }
__device__ __forceinline__ void peer_v_sliced(const P& p, const PeerMap& mp, unsigned char* lds, float* ydst) {
    const int lane = tidx() & 63, wave = tidx() >> 6, g = lane >> 4, l = lane & 15;
    const int w0 = mp.r * NWAVES + wave, NW = mp.nloc * NWAVES;
    unsigned char* hl = lds + wave * 128;
    const float* SU = WSP(const float, WS_SU); const float* SV = WSP(const float, WS_SV); const float* PAb = WSP(const float, WS_PA);
    for (int s = mp.rho; s < 8; s += mp.nx) {
        const unsigned char* vb = (const unsigned char*)(p.ws + WS_VQ) + s * 256 + l * 16;
        for (int t = w0; t < T; t += NW) {
            const float ascale = row_rstd(WSP(const float, WS_RSP), t) * WSP(const float, WS_SX)[t];
            float sh;
            { const int ia = WSP(const int, WS_IDX)[(size_t)t * 128 + lane], ib = WSP(const int, WS_IDX)[(size_t)t * 128 + 64 + lane];
              float aa = 0.f, ab = 0.f;
#pragma unroll
              for (int q = 0; q < 8; ++q) { aa += PAb[((size_t)q * T + t) * 128 + lane]; ab += PAb[((size_t)q * T + t) * 128 + 64 + lane]; }
              aa *= ascale * SU[ia]; ab *= ascale * SU[ib];
              const float ha = 0.5f * aa * (1.0f + erff(aa * 0.70710678118f)) * WSP(const float, WS_GATE)[(size_t)t * 128 + lane] * SV[ia];
              const float hb = 0.5f * ab * (1.0f + erff(ab * 0.70710678118f)) * WSP(const float, WS_GATE)[(size_t)t * 128 + 64 + lane] * SV[ib];
              const float m = fmaxf(wave_max(fmaxf(fabsf(ha), fabsf(hb))), 1e-30f); sh = m * (1.f / 127.f); const float inv = 127.f / m;
              hl[(lane & 3) * 32 + (lane >> 2)] = (unsigned char)q8(ha, inv); hl[(lane & 3) * 32 + 16 + (lane >> 2)] = (unsigned char)q8(hb, inv); }
            const int* ip = WSP(const int, WS_IDX) + (size_t)t * 128 + g;
            int idxv[32];
#pragma unroll
            for (int k = 0; k < 32; ++k) idxv[k] = ip[4 * k];
            const v4u h0 = *(const v4u*)(hl + g * 32), h1 = *(const v4u*)(hl + g * 32 + 16);
            const unsigned hq[8] = {h0.x, h0.y, h0.z, h0.w, h1.x, h1.y, h1.z, h1.w};
            int acc[16];
#pragma unroll
            for (int j = 0; j < 16; ++j) acc[j] = 0;
#pragma unroll
            for (int k0 = 0; k0 < 32; k0 += 16) {
                v4u w[16];
#pragma unroll
                for (int k = 0; k < 16; ++k) w[k] = *(const v4u*)(vb + (size_t)idxv[k0 + k] * DM);
#pragma unroll
                for (int k4 = 0; k4 < 4; ++k4) { const unsigned hd = hq[(k0 >> 2) + k4];
#pragma unroll
                    for (int c4 = 0; c4 < 4; ++c4) {
                        const unsigned a = w[4 * k4][c4], b = w[4 * k4 + 1][c4], c = w[4 * k4 + 2][c4], d = w[4 * k4 + 3][c4];
                        const unsigned pq = permb(b, a, 0x05010400u), qq = permb(b, a, 0x07030602u), rq = permb(d, c, 0x05010400u), sq = permb(d, c, 0x07030602u);
                        acc[4 * c4 + 0] = sdot4(permb(rq, pq, 0x05040100u), hd, acc[4 * c4 + 0]); acc[4 * c4 + 1] = sdot4(permb(rq, pq, 0x07060302u), hd, acc[4 * c4 + 1]);
                        acc[4 * c4 + 2] = sdot4(permb(sq, qq, 0x05040100u), hd, acc[4 * c4 + 2]); acc[4 * c4 + 3] = sdot4(permb(sq, qq, 0x07060302u), hd, acc[4 * c4 + 3]); } }
            }
#pragma unroll
            for (int j = 0; j < 16; ++j) { acc[j] += __shfl_xor(acc[j], 16); acc[j] += __shfl_xor(acc[j], 32); }
            const size_t yo = (size_t)t * DM + s * 256 + l * 16 + 4 * g; const f32x4 x1v = *(const f32x4*)(((float*)p.out) + yo);
            f32x4 o;
            o.x = x1v.x + sh * (float)(g == 0 ? acc[0] : g == 1 ? acc[4] : g == 2 ? acc[8] : acc[12]);
            o.y = x1v.y + sh * (float)(g == 0 ? acc[1] : g == 1 ? acc[5] : g == 2 ? acc[9] : acc[13]);
            o.z = x1v.z + sh * (float)(g == 0 ? acc[2] : g == 1 ? acc[6] : g == 2 ? acc[10] : acc[14]);
            o.w = x1v.w + sh * (float)(g == 0 ? acc[3] : g == 1 ? acc[7] : g == 2 ? acc[11] : acc[15]);
            *(f32x4*)(ydst + yo) = o;
        }
    }
}
__device__ __forceinline__ void final_norm_rows(const P& p, int vcu, int G, float* dst) {
    const int lane = tidx() & 63, gw = vcu * NWAVES + (tidx() >> 6), NGW = G * NWAVES;
    for (int t = gw; t < T; t += NGW) {
        const f32x4* yr = (const f32x4*)(((float*)p.out) + (size_t)t * DM) + lane; const f32x4* gr = (const f32x4*)((const float*)p.g_final) + lane;
        f32x4 v[8]; float s = 0.f;
#pragma unroll
        for (int j = 0; j < 8; ++j) { v[j] = yr[64 * j]; s += (v[j].x * v[j].x + v[j].y * v[j].y) + (v[j].z * v[j].z + v[j].w * v[j].w); }
        const float rstd = rsqrtf(wave_sum(s) * (1.f / DM) + EPS);
        f32x4* o = (f32x4*)(dst + (size_t)t * DM) + lane;
#pragma unroll
        for (int j = 0; j < 8; ++j) o[64 * j] = v[j] * rstd * gr[64 * j];
    }
}

#define TK_CE(a, i, j) { const unsigned h_ = umax_(a[i], a[j]); a[j] = umin_(a[i], a[j]); a[i] = h_; }
__device__ __forceinline__ void sort16_desc(unsigned (&a)[16]) {
    TK_CE(a, 0, 13) TK_CE(a, 1, 12) TK_CE(a, 2, 15) TK_CE(a, 3, 14) TK_CE(a, 4, 8) TK_CE(a, 5, 6) TK_CE(a, 7, 11) TK_CE(a, 9, 10)
    TK_CE(a, 0, 5) TK_CE(a, 1, 7) TK_CE(a, 2, 9) TK_CE(a, 3, 4) TK_CE(a, 6, 13) TK_CE(a, 8, 14) TK_CE(a, 10, 15) TK_CE(a, 11, 12)
    TK_CE(a, 0, 1) TK_CE(a, 2, 3) TK_CE(a, 4, 5) TK_CE(a, 6, 8) TK_CE(a, 7, 9) TK_CE(a, 10, 11) TK_CE(a, 12, 13) TK_CE(a, 14, 15)
    TK_CE(a, 0, 2) TK_CE(a, 1, 3) TK_CE(a, 4, 10) TK_CE(a, 5, 11) TK_CE(a, 6, 7) TK_CE(a, 8, 9) TK_CE(a, 12, 14) TK_CE(a, 13, 15)
    TK_CE(a, 1, 2) TK_CE(a, 3, 12) TK_CE(a, 4, 6) TK_CE(a, 5, 7) TK_CE(a, 8, 10) TK_CE(a, 9, 11) TK_CE(a, 13, 14)
    TK_CE(a, 1, 4) TK_CE(a, 2, 6) TK_CE(a, 5, 8) TK_CE(a, 7, 10) TK_CE(a, 9, 13) TK_CE(a, 11, 14)
    TK_CE(a, 2, 4) TK_CE(a, 3, 6) TK_CE(a, 9, 12) TK_CE(a, 11, 13)
    TK_CE(a, 3, 5) TK_CE(a, 6, 8) TK_CE(a, 7, 9) TK_CE(a, 10, 12)
    TK_CE(a, 3, 4) TK_CE(a, 5, 6) TK_CE(a, 7, 8) TK_CE(a, 9, 10) TK_CE(a, 11, 12)
    TK_CE(a, 6, 7) TK_CE(a, 8, 9)
}
__device__ __forceinline__ void merge_top16(unsigned (&A)[16], const unsigned (&B)[16]) {
#pragma unroll
    for (int i = 0; i < 16; ++i) A[i] = umax_(A[i], B[15 - i]);
#pragma unroll
    for (int j = 8; j >= 1; j >>= 1)
#pragma unroll
        for (int i = 0; i < 16; ++i) if (!(i & j)) TK_CE(A, i, i + j)
}
__host__ __device__ constexpr int cand_index(int i, int j) {
    int n = 0;
    for (int a = 0; a < 16; ++a) for (int b = 0; b < 16; ++b) { if (a == i && b == j) return n; if ((a + 1) * (b + 1) <= 16) ++n; }
    return n;
}
struct EpiRoute {
    static constexpr bool PERM = true, AFTER_DRAIN = true, MIDK = false;
    const bf16* skp; const float* rsp; int* idx; float* gate;
    __device__ __forceinline__ void fused(pg8::f32x4 (&acc)[2][2][4][2], const pg8::Unit& u, int wr, int wc, int fr, int fq, PG8_LAS unsigned char* lds, int wid, int lane) const {
#pragma unroll
        for (int ai = 0; ai < 2; ++ai)
#pragma unroll
            for (int m = 0; m < 4; ++m) { const int row = ai * 128 + wr * 64 + m * 16 + fr;
#pragma unroll
                for (int bj = 0; bj < 2; ++bj) { const int col = bj * 128 + wc * 32 + 8 * fq; const pg8::f32x4 v0 = acc[ai][bj][m][0], v1 = acc[ai][bj][m][1];
                    pg8::u32x4 w; w.x = pg8::cvt_pk_bf16(v0[0], v0[1]); w.y = pg8::cvt_pk_bf16(v0[2], v0[3]); w.z = pg8::cvt_pk_bf16(v1[0], v1[1]); w.w = pg8::cvt_pk_bf16(v1[2], v1[3]);
                    *(PG8_LAS pg8::u32x4*)(lds + row * 528 + col * 2) = w; } }
        asm volatile("s_waitcnt lgkmcnt(0)" ::: "memory"); __builtin_amdgcn_s_barrier(); asm volatile("" ::: "memory");
        const int tk = lane & 31, hi = lane >> 5, trow = 32 * wid + tk;
        unsigned vv[2][16];
#pragma unroll
        for (int ph = 0; ph < 2; ++ph) {
            bf16x8 bq[8];
#pragma unroll
            for (int ks = 0; ks < 8; ++ks) bq[ks] = *(const PG8_LAS bf16x8*)(lds + trow * 528 + (ph * 128 + 16 * ks + 8 * hi) * 2);
#pragma unroll
            for (int nt = 0; nt < 4; ++nt) { f32x16 sc = zero16(); const bf16* ap = skp + (size_t)(ph * 128 + 32 * nt + tk) * 128 + 8 * hi;
#pragma unroll
                for (int ks = 0; ks < 8; ++ks) sc = mfma32(*(const bf16x8*)(ap + 16 * ks), bq[ks], sc);
                unsigned x[16];
#pragma unroll
                for (int r = 0; r < 16; ++r) x[r] = (okey(sc[r]) & 0xffffff80u) | (unsigned)(127 - (32 * nt + (r & 3) + 8 * (r >> 2) + 4 * hi));
                sort16_desc(x);
                if (nt == 0) {
#pragma unroll
                    for (int i = 0; i < 16; ++i) vv[ph][i] = x[i]; }
                else merge_top16(vv[ph], x); }
            unsigned ot[16];
#pragma unroll
            for (int i = 0; i < 16; ++i) ot[i] = (unsigned)__shfl_xor((int)vv[ph][i], 32);
            merge_top16(vv[ph], ot);
        }
        float s0[16], s1[16]; unsigned long long p0lo = 0ull, p0hi = 0ull, p1lo = 0ull, p1hi = 0ull;
#pragma unroll
        for (int i = 0; i < 16; ++i) { const unsigned k0 = vv[0][i], k1 = vv[1][i];
            s0[i] = unkey(k0 & 0xffffff80u); s1[i] = unkey(k1 & 0xffffff80u);
            const unsigned long long a0 = (unsigned long long)(127u - (k0 & 127u)) << (8 * (i & 7)), a1 = (unsigned long long)(127u - (k1 & 127u)) << (8 * (i & 7));
            if (i < 8) { p0lo |= a0; p1lo |= a1; } else { p0hi |= a0; p1hi |= a1; } }
        unsigned bk[16], c1[16], c2[16], c3a = 0u, c3b = 0u;
#pragma unroll
        for (int i = 0; i < 16; ++i)
#pragma unroll
            for (int j = 0; j < 16; ++j) if ((i + 1) * (j + 1) <= 16) {
                const unsigned x = (okey(s0[i] + s1[j]) & 0xffffff00u) | (unsigned)(255 - (i * 16 + j));
                const int n = cand_index(i, j);
                if (n < 16) bk[n & 15] = x; else if (n < 32) c1[n & 15] = x; else if (n < 48) c2[n & 15] = x; else if (n == 48) c3a = x; else c3b = x; }
        sort16_desc(bk); sort16_desc(c1); sort16_desc(c2); merge_top16(bk, c1); merge_top16(bk, c2);
#pragma unroll
        for (int k = 0; k < 16; ++k) { const unsigned hv = umax_(bk[k], c3a); c3a = umin_(bk[k], c3a); bk[k] = hv; }
#pragma unroll
        for (int k = 0; k < 16; ++k) { const unsigned hv = umax_(bk[k], c3b); c3b = umin_(bk[k], c3b); bk[k] = hv; }
        const int t = u.pm * 256 + trow, head = u.pn;
        const float rstd = row_rstd(rsp, t);
        const float mx = unkey(bk[0] & 0xffffff00u) * rstd; float l = 0.f; float ev[16];
#pragma unroll
        for (int k = 0; k < 16; ++k) { ev[k] = __expf(unkey(bk[k] & 0xffffff00u) * rstd - mx); l += ev[k]; }
        const float inv = 1.0f / l;
        int be[16];
#pragma unroll
        for (int k = 0; k < 16; ++k) { const int code = 255 - (int)(bk[k] & 255u), ci = code >> 4, cj = code & 15;
            const int a = (int)(((ci & 8) ? p0hi : p0lo) >> (8 * (ci & 7))) & 0xff, c = (int)(((cj & 8) ? p1hi : p1lo) >> (8 * (cj & 7))) & 0xff;
            be[k] = a * 128 + c; }
        int* io = idx + (size_t)t * 128 + head * 16; float* go = gate + (size_t)t * 128 + head * 16;
        if (hi == 0) {
            *(int4*)io = make_int4(be[0], be[1], be[2], be[3]); *(int4*)(io + 4) = make_int4(be[4], be[5], be[6], be[7]);
            *(f32x4*)go = (f32x4){ev[0] * inv, ev[1] * inv, ev[2] * inv, ev[3] * inv}; *(f32x4*)(go + 4) = (f32x4){ev[4] * inv, ev[5] * inv, ev[6] * inv, ev[7] * inv};
        } else {
            *(int4*)(io + 8) = make_int4(be[8], be[9], be[10], be[11]); *(int4*)(io + 12) = make_int4(be[12], be[13], be[14], be[15]);
            *(f32x4*)(go + 8) = (f32x4){ev[8] * inv, ev[9] * inv, ev[10] * inv, ev[11] * inv}; *(f32x4*)(go + 12) = (f32x4){ev[12] * inv, ev[13] * inv, ev[14] * inv, ev[15] * inv};
        }
    }
};

__device__ __forceinline__ void peer_fused(const P& p, const PeerMap& mp, unsigned char* lds, float* ybuf, float* dst) {
    const int lane = tidx() & 63, wave = tidx() >> 6, g = lane >> 4, l = lane & 15;
    unsigned char* wl = lds + wave * 14848;
    unsigned char* XQl = wl; float* PAl = (float*)(wl + 8192); int* IDl = (int*)(wl + 8192 + 2048); unsigned char* HQl = wl + 8192 + 4096;
    const float* SU = WSP(const float, WS_SU); const float* SV = WSP(const float, WS_SV);
    const int slot = mp.r * NWAVES + wave, nslots = mp.nloc * NWAVES;
    for (int q0 = slot; q0 * mp.nx + mp.rho < T; q0 += 4 * nslots) {
        int tk[4]; float ascale[4], sh[4], ssq[4];
#pragma unroll
        for (int j = 0; j < 4; ++j) { const int t = (q0 + j * nslots) * mp.nx + mp.rho; tk[j] = t < T ? t : -1; ssq[j] = 0.f; sh[j] = 0.f; ascale[j] = 0.f; }
#pragma unroll
        for (int j = 0; j < 4; ++j) if (tk[j] >= 0) { const int t = tk[j];
            const v4u* xp = WSP(const v4u, WS_XG) + (size_t)t * 256 + lane * 4; float f[32];
            unpack8(xp[0], f); unpack8(xp[1], f + 8); unpack8(xp[2], f + 16); unpack8(xp[3], f + 24);
            float m = 0.f;
#pragma unroll
            for (int i = 0; i < 32; ++i) m = fmaxf(m, fabsf(f[i]));
            m = fmaxf(wave_max(m), 1e-30f); const float inv = 127.f / m; ascale[j] = row_rstd(WSP(const float, WS_RSP), t) * m * (1.f / 127.f);
            v4u o0, o1;
            o0.x = q8(f[0], inv) | (q8(f[1], inv) << 8) | (q8(f[2], inv) << 16) | (q8(f[3], inv) << 24); o0.y = q8(f[4], inv) | (q8(f[5], inv) << 8) | (q8(f[6], inv) << 16) | (q8(f[7], inv) << 24);
            o0.z = q8(f[8], inv) | (q8(f[9], inv) << 8) | (q8(f[10], inv) << 16) | (q8(f[11], inv) << 24); o0.w = q8(f[12], inv) | (q8(f[13], inv) << 8) | (q8(f[14], inv) << 16) | (q8(f[15], inv) << 24);
            o1.x = q8(f[16], inv) | (q8(f[17], inv) << 8) | (q8(f[18], inv) << 16) | (q8(f[19], inv) << 24); o1.y = q8(f[20], inv) | (q8(f[21], inv) << 8) | (q8(f[22], inv) << 16) | (q8(f[23], inv) << 24);
            o1.z = q8(f[24], inv) | (q8(f[25], inv) << 8) | (q8(f[26], inv) << 16) | (q8(f[27], inv) << 24); o1.w = q8(f[28], inv) | (q8(f[29], inv) << 8) | (q8(f[30], inv) << 16) | (q8(f[31], inv) << 24);
            *(v4u*)(XQl + j * 2048 + lane * 32) = o0; *(v4u*)(XQl + j * 2048 + lane * 32 + 16) = o1;
            const int ia = WSP(const int, WS_IDX)[(size_t)t * 128 + lane], ib = WSP(const int, WS_IDX)[(size_t)t * 128 + 64 + lane];
            IDl[j * 128 + (lane & 3) * 32 + (lane >> 2)] = ia; IDl[j * 128 + (lane & 3) * 32 + 16 + (lane >> 2)] = ib;
            PAl[j * 128 + lane] = 0.f; PAl[j * 128 + 64 + lane] = 0.f; }
        for (int s = 0; s < 8; ++s) {
            const unsigned char* ub = (const unsigned char*)(p.ws + WS_UQ) + s * 256 + l * 16;
#pragma unroll
            for (int j = 0; j < 4; ++j) if (tk[j] >= 0) {
                const v4u xq = *(const v4u*)(XQl + j * 2048 + s * 256 + l * 16);
#pragma unroll
                for (int k0 = 0; k0 < 32; k0 += 16) {
                    int idxv[16];
#pragma unroll
                    for (int k4 = 0; k4 < 4; ++k4) { const int4 q = *(const int4*)(IDl + j * 128 + g * 32 + k0 + 4 * k4); idxv[4 * k4] = q.x; idxv[4 * k4 + 1] = q.y; idxv[4 * k4 + 2] = q.z; idxv[4 * k4 + 3] = q.w; }
                    v4u w[16];
#pragma unroll
                    for (int k = 0; k < 16; ++k) w[k] = *(const v4u*)(ub + (size_t)idxv[k] * DM);
#pragma unroll
                    for (int k = 0; k < 16; ++k) { int a0 = sdot4(w[k].x, xq.x, 0), a1 = sdot4(w[k].y, xq.y, 0); a0 = sdot4(w[k].z, xq.z, a0); a1 = sdot4(w[k].w, xq.w, a1);
                        const float d = row16_sum((float)(a0 + a1));
                        if (l == 0) PAl[j * 128 + 4 * (k0 + k) + g] += d; }
                }
            }
        }
#pragma unroll
        for (int j = 0; j < 4; ++j) if (tk[j] >= 0) { const int t = tk[j];
            const int ia = IDl[j * 128 + (lane & 3) * 32 + (lane >> 2)], ib = IDl[j * 128 + (lane & 3) * 32 + 16 + (lane >> 2)];
            const float aa = PAl[j * 128 + lane] * ascale[j] * SU[ia], ab = PAl[j * 128 + 64 + lane] * ascale[j] * SU[ib];
            const float ha = 0.5f * aa * (1.0f + erff(aa * 0.70710678118f)) * WSP(const float, WS_GATE)[(size_t)t * 128 + lane] * SV[ia];
            const float hb = 0.5f * ab * (1.0f + erff(ab * 0.70710678118f)) * WSP(const float, WS_GATE)[(size_t)t * 128 + 64 + lane] * SV[ib];
            const float m = fmaxf(wave_max(fmaxf(fabsf(ha), fabsf(hb))), 1e-30f); sh[j] = m * (1.f / 127.f); const float inv = 127.f / m;
            HQl[j * 128 + (lane & 3) * 32 + (lane >> 2)] = (unsigned char)q8(ha, inv); HQl[j * 128 + (lane & 3) * 32 + 16 + (lane >> 2)] = (unsigned char)q8(hb, inv); }
        for (int s = 0; s < 8; ++s) {
            const unsigned char* vb = (const unsigned char*)(p.ws + WS_VQ) + s * 256 + l * 16;
#pragma unroll
            for (int j = 0; j < 4; ++j) if (tk[j] >= 0) {
                const v4u h0 = *(const v4u*)(HQl + j * 128 + g * 32), h1 = *(const v4u*)(HQl + j * 128 + g * 32 + 16);
                const unsigned hq[8] = {h0.x, h0.y, h0.z, h0.w, h1.x, h1.y, h1.z, h1.w};
                int acc[16];
#pragma unroll
                for (int c = 0; c < 16; ++c) acc[c] = 0;
#pragma unroll
                for (int k0 = 0; k0 < 32; k0 += 16) {
                    int idxv[16];
#pragma unroll
                    for (int k4 = 0; k4 < 4; ++k4) { const int4 q = *(const int4*)(IDl + j * 128 + g * 32 + k0 + 4 * k4); idxv[4 * k4] = q.x; idxv[4 * k4 + 1] = q.y; idxv[4 * k4 + 2] = q.z; idxv[4 * k4 + 3] = q.w; }
                    v4u w[16];
#pragma unroll
                    for (int k = 0; k < 16; ++k) w[k] = *(const v4u*)(vb + (size_t)idxv[k] * DM);
#pragma unroll
                    for (int k4 = 0; k4 < 4; ++k4) { const unsigned hd = hq[(k0 >> 2) + k4];
#pragma unroll
                        for (int c4 = 0; c4 < 4; ++c4) {
                            const unsigned a = w[4 * k4][c4], b = w[4 * k4 + 1][c4], c = w[4 * k4 + 2][c4], d = w[4 * k4 + 3][c4];
                            const unsigned pq = permb(b, a, 0x05010400u), qq = permb(b, a, 0x07030602u), rq = permb(d, c, 0x05010400u), sq = permb(d, c, 0x07030602u);
                            acc[4 * c4 + 0] = sdot4(permb(rq, pq, 0x05040100u), hd, acc[4 * c4 + 0]); acc[4 * c4 + 1] = sdot4(permb(rq, pq, 0x07060302u), hd, acc[4 * c4 + 1]);
                            acc[4 * c4 + 2] = sdot4(permb(sq, qq, 0x05040100u), hd, acc[4 * c4 + 2]); acc[4 * c4 + 3] = sdot4(permb(sq, qq, 0x07060302u), hd, acc[4 * c4 + 3]); } }
                }
#pragma unroll
                for (int c = 0; c < 16; ++c) { acc[c] += __shfl_xor(acc[c], 16); acc[c] += __shfl_xor(acc[c], 32); }
                const size_t yo = (size_t)tk[j] * DM + s * 256 + l * 16 + 4 * g; const f32x4 x1v = *(const f32x4*)(((float*)p.out) + yo);
                f32x4 o;
                o.x = x1v.x + sh[j] * (float)(g == 0 ? acc[0] : g == 1 ? acc[4] : g == 2 ? acc[8] : acc[12]);
                o.y = x1v.y + sh[j] * (float)(g == 0 ? acc[1] : g == 1 ? acc[5] : g == 2 ? acc[9] : acc[13]);
                o.z = x1v.z + sh[j] * (float)(g == 0 ? acc[2] : g == 1 ? acc[6] : g == 2 ? acc[10] : acc[14]);
                o.w = x1v.w + sh[j] * (float)(g == 0 ? acc[3] : g == 1 ? acc[7] : g == 2 ? acc[11] : acc[15]);
                *(f32x4*)(ybuf + yo) = o;
                ssq[j] += (o.x * o.x + o.y * o.y) + (o.z * o.z + o.w * o.w);
            }
        }
        asm volatile("s_waitcnt vmcnt(0)" ::: "memory");
#pragma unroll
        for (int j = 0; j < 4; ++j) if (tk[j] >= 0) {
            const float rstd = rsqrtf(wave_sum(ssq[j]) * (1.f / DM) + EPS);
            const f32x4* yr = (const f32x4*)(ybuf + (size_t)tk[j] * DM) + lane; const f32x4* gr = (const f32x4*)((const float*)p.g_final) + lane; f32x4* o = (f32x4*)(dst + (size_t)tk[j] * DM) + lane;
            f32x4 v[8];
#pragma unroll
            for (int i = 0; i < 8; ++i) v[i] = __builtin_nontemporal_load(yr + 64 * i);
#pragma unroll
            for (int i = 0; i < 8; ++i) o[64 * i] = v[i] * rstd * gr[64 * i];
        }
    }
}

__device__ __forceinline__ void peer_fused16(const P& p, const PeerMap& mp, unsigned char* lds, float* ybuf, float* dst) {
    const int lane = tidx() & 63, wave = tidx() >> 6, g = lane >> 3, l = lane & 7;
    unsigned char* wl = lds + wave * 18944;
    unsigned char* XQl = wl; float* PAl = (float*)(wl + 8192); int* IDl = (int*)(wl + 16384); unsigned char* HQl = wl + 16384 + 2048; unsigned char* Yl = wl;
    const float* SU = WSP(const float, WS_SU); const float* SV = WSP(const float, WS_SV);
    const int slot = mp.r * NWAVES + wave, nslots = mp.nloc * NWAVES;
    for (int q0 = slot; q0 * mp.nx + mp.rho < T; q0 += 4 * nslots) {
        int tk[4]; float ascale[4], sh[4], ssq[4];
#pragma unroll
        for (int j = 0; j < 4; ++j) { const int t = (q0 + j * nslots) * mp.nx + mp.rho; tk[j] = t < T ? t : -1; ssq[j] = 0.f; sh[j] = 0.f; ascale[j] = 0.f; }
#pragma unroll
        for (int j = 0; j < 4; ++j) if (tk[j] >= 0) { const int t = tk[j];
            const v4u* xp = WSP(const v4u, WS_XG) + (size_t)t * 256 + lane * 4; float f[32];
            unpack8(xp[0], f); unpack8(xp[1], f + 8); unpack8(xp[2], f + 16); unpack8(xp[3], f + 24);
            float m = 0.f;
#pragma unroll
            for (int i = 0; i < 32; ++i) m = fmaxf(m, fabsf(f[i]));
            m = fmaxf(wave_max(m), 1e-30f); const float inv = 127.f / m; ascale[j] = row_rstd(WSP(const float, WS_RSP), t) * m * (1.f / 127.f);
            v4u o0, o1;
            o0.x = q8(f[0], inv) | (q8(f[1], inv) << 8) | (q8(f[2], inv) << 16) | (q8(f[3], inv) << 24); o0.y = q8(f[4], inv) | (q8(f[5], inv) << 8) | (q8(f[6], inv) << 16) | (q8(f[7], inv) << 24);
            o0.z = q8(f[8], inv) | (q8(f[9], inv) << 8) | (q8(f[10], inv) << 16) | (q8(f[11], inv) << 24); o0.w = q8(f[12], inv) | (q8(f[13], inv) << 8) | (q8(f[14], inv) << 16) | (q8(f[15], inv) << 24);
            o1.x = q8(f[16], inv) | (q8(f[17], inv) << 8) | (q8(f[18], inv) << 16) | (q8(f[19], inv) << 24); o1.y = q8(f[20], inv) | (q8(f[21], inv) << 8) | (q8(f[22], inv) << 16) | (q8(f[23], inv) << 24);
            o1.z = q8(f[24], inv) | (q8(f[25], inv) << 8) | (q8(f[26], inv) << 16) | (q8(f[27], inv) << 24); o1.w = q8(f[28], inv) | (q8(f[29], inv) << 8) | (q8(f[30], inv) << 16) | (q8(f[31], inv) << 24);
            *(v4u*)(XQl + j * 2048 + lane * 32) = o0; *(v4u*)(XQl + j * 2048 + lane * 32 + 16) = o1;
            const int ia = WSP(const int, WS_IDX)[(size_t)t * 128 + lane], ib = WSP(const int, WS_IDX)[(size_t)t * 128 + 64 + lane];
            IDl[j * 128 + (lane & 7) * 16 + (lane >> 3)] = ia; IDl[j * 128 + (lane & 7) * 16 + 8 + (lane >> 3)] = ib;
            PAl[j * 128 + lane] = 0.f; PAl[j * 128 + 64 + lane] = 0.f; }
        int pu[4][16];
#pragma unroll
        for (int j = 0; j < 4; ++j)
#pragma unroll
            for (int k = 0; k < 16; ++k) pu[j][k] = 0;
        for (int s = 0; s < 16; ++s) {
            const unsigned char* ub = (const unsigned char*)(p.ws + WS_UQ) + (size_t)s * (NEXP * 128) + l * 16;
#pragma unroll
            for (int j = 0; j < 4; ++j) if (tk[j] >= 0) {
                const v4u xq = *(const v4u*)(XQl + j * 2048 + s * 128 + l * 16);
                int idxv[16];
#pragma unroll
                for (int k4 = 0; k4 < 4; ++k4) { const int4 q = *(const int4*)(IDl + j * 128 + g * 16 + 4 * k4); idxv[4 * k4] = q.x; idxv[4 * k4 + 1] = q.y; idxv[4 * k4 + 2] = q.z; idxv[4 * k4 + 3] = q.w; }
                v4u w[16];
#pragma unroll
                for (int k = 0; k < 16; ++k) w[k] = *(const v4u*)(ub + (size_t)idxv[k] * 128);
#pragma unroll
                for (int k = 0; k < 16; ++k) { int a0 = sdot4(w[k].x, xq.x, pu[j][k]); a0 = sdot4(w[k].y, xq.y, a0); a0 = sdot4(w[k].z, xq.z, a0); pu[j][k] = sdot4(w[k].w, xq.w, a0); }
            }
        }
#pragma unroll
        for (int j = 0; j < 4; ++j) if (tk[j] >= 0) {
#pragma unroll
            for (int k = 0; k < 16; ++k) { const float d = sum8((float)pu[j][k]); if (l == 0) PAl[j * 128 + 8 * k + g] = d; } }
#pragma unroll
        for (int j = 0; j < 4; ++j) if (tk[j] >= 0) { const int t = tk[j]; int lane = tidx() & 63; asm volatile("" : "+v"(lane));
            const int ia = IDl[j * 128 + (lane & 7) * 16 + (lane >> 3)], ib = IDl[j * 128 + (lane & 7) * 16 + 8 + (lane >> 3)];
            const float aa = PAl[j * 128 + lane] * ascale[j] * SU[ia], ab = PAl[j * 128 + 64 + lane] * ascale[j] * SU[ib];
            const float ha = 0.5f * aa * (1.0f + erff(aa * 0.70710678118f)) * WSP(const float, WS_GATE)[(size_t)t * 128 + lane] * SV[ia];
            const float hb = 0.5f * ab * (1.0f + erff(ab * 0.70710678118f)) * WSP(const float, WS_GATE)[(size_t)t * 128 + 64 + lane] * SV[ib];
            const float m = fmaxf(wave_max(fmaxf(fabsf(ha), fabsf(hb))), 1e-30f); sh[j] = m * (1.f / 127.f); const float inv = 127.f / m;
            HQl[j * 128 + (lane & 7) * 16 + (lane >> 3)] = (unsigned char)q8(ha, inv); HQl[j * 128 + (lane & 7) * 16 + 8 + (lane >> 3)] = (unsigned char)q8(hb, inv); }
        for (int s = 0; s < 16; ++s) {
            const unsigned char* vb = (const unsigned char*)(p.ws + WS_VQ) + (size_t)s * (NEXP * 128) + l * 16;
#pragma unroll
            for (int j = 0; j < 4; ++j) if (tk[j] >= 0) {
                const v4u h0 = *(const v4u*)(HQl + j * 128 + g * 16);
                const unsigned hq[4] = {h0.x, h0.y, h0.z, h0.w};
                int acc[16];
#pragma unroll
                for (int c = 0; c < 16; ++c) acc[c] = 0;
                int idxv[16];
#pragma unroll
                for (int k4 = 0; k4 < 4; ++k4) { const int4 q = *(const int4*)(IDl + j * 128 + g * 16 + 4 * k4); idxv[4 * k4] = q.x; idxv[4 * k4 + 1] = q.y; idxv[4 * k4 + 2] = q.z; idxv[4 * k4 + 3] = q.w; }
                v4u w[16];
#pragma unroll
                for (int k = 0; k < 16; ++k) w[k] = *(const v4u*)(vb + (size_t)idxv[k] * 128);
#pragma unroll
                for (int k4 = 0; k4 < 4; ++k4) { const unsigned hd = hq[k4];
#pragma unroll
                    for (int c4 = 0; c4 < 4; ++c4) {
                        const unsigned a = w[4 * k4][c4], b = w[4 * k4 + 1][c4], c = w[4 * k4 + 2][c4], d = w[4 * k4 + 3][c4];
                        const unsigned pq = permb(b, a, 0x05010400u), qq = permb(b, a, 0x07030602u), rq = permb(d, c, 0x05010400u), sq = permb(d, c, 0x07030602u);
                        acc[4 * c4 + 0] = sdot4(permb(rq, pq, 0x05040100u), hd, acc[4 * c4 + 0]); acc[4 * c4 + 1] = sdot4(permb(rq, pq, 0x07060302u), hd, acc[4 * c4 + 1]);
                        acc[4 * c4 + 2] = sdot4(permb(sq, qq, 0x05040100u), hd, acc[4 * c4 + 2]); acc[4 * c4 + 3] = sdot4(permb(sq, qq, 0x07060302u), hd, acc[4 * c4 + 3]); } }
                int r8[8], r4[4];
#pragma unroll
                for (int c = 0; c < 8; ++c) { auto rr = __builtin_amdgcn_permlane32_swap((unsigned)acc[c], (unsigned)acc[c + 8], false, false); r8[c] = (int)rr[0] + (int)rr[1]; }
#pragma unroll
                for (int c = 0; c < 4; ++c) { auto rr = __builtin_amdgcn_permlane16_swap((unsigned)r8[c], (unsigned)r8[c + 4], false, false); r4[c] = (int)rr[0] + (int)rr[1]; }
                const bool b3 = (lane & 8) != 0;
                const int k0v = b3 ? r4[2] : r4[0], s0v = b3 ? r4[0] : r4[2], k1v = b3 ? r4[3] : r4[1], s1v = b3 ? r4[1] : r4[3];
                const int s0 = k0v + (int)dppu<0x128>((unsigned)s0v), s1 = k1v + (int)dppu<0x128>((unsigned)s1v);
                const size_t yo = (size_t)tk[j] * DM + s * 128 + l * 16 + 2 * g; const unsigned xb = *(const unsigned*)(WSP(const bf16, WS_XG) + yo);
                const float o0 = __uint_as_float(xb << 16) + sh[j] * (float)s0, o1 = __uint_as_float(xb & 0xffff0000u) + sh[j] * (float)s1;
                *(unsigned*)(Yl + j * 4096 + s * 256 + l * 32 + 4 * g) = pk2(o0, o1);
                ssq[j] += o0 * o0 + o1 * o1;
            }
        }
        asm volatile("s_waitcnt lgkmcnt(0)" ::: "memory");
#pragma unroll
        for (int j = 0; j < 4; ++j) if (tk[j] >= 0) {
            const float rstd = rsqrtf(wave_sum(ssq[j]) * (1.f / DM) + EPS);
            const float* gr = (const float*)p.g_final; float* o = dst + (size_t)tk[j] * DM;
#pragma unroll
            for (int i = 0; i < 4; ++i) { const int c8 = (i * 64 + lane) * 8; const v4u yv = *(const v4u*)(Yl + j * 4096 + c8 * 2);
                const f32x4 g0 = *(const f32x4*)(gr + c8), g1 = *(const f32x4*)(gr + c8 + 4);
                f32x4 r0, r1;
                r0.x = __uint_as_float(yv.x << 16) * rstd * g0.x; r0.y = __uint_as_float(yv.x & 0xffff0000u) * rstd * g0.y; r0.z = __uint_as_float(yv.y << 16) * rstd * g0.z; r0.w = __uint_as_float(yv.y & 0xffff0000u) * rstd * g0.w;
                r1.x = __uint_as_float(yv.z << 16) * rstd * g1.x; r1.y = __uint_as_float(yv.z & 0xffff0000u) * rstd * g1.y; r1.z = __uint_as_float(yv.w << 16) * rstd * g1.z; r1.w = __uint_as_float(yv.w & 0xffff0000u) * rstd * g1.w;
                *(f32x4*)(o + c8) = r0; *(f32x4*)(o + c8 + 4) = r1; }
        }
    }
}
#ifndef PROBE_IN
#define PROBE_IN 0
#endif
#ifndef MK_SPLIT
#define MK_SPLIT 0
#endif
constexpr int NPHASE = 9;
template <int LO, int HI> __global__ void __launch_bounds__(NTHR, 2) mk_fwd(P p0) {
    extern __shared__ __attribute__((aligned(16))) unsigned char lds[];
    const int G = gridDim.x, bx_hw = blockIdx.x;
    volatile LAS unsigned* MISC = (volatile LAS unsigned*)((LAS unsigned char*)lds + (LDS_BYTES - 64));
    if (threadIdx.x < 16) MISC[threadIdx.x] = 0u;
    __syncthreads();
    XcdBarrier xbar = xcd_barrier_post((unsigned*)(p0.ws + WS_BAR + (HI - LO == NPHASE ? 0 : (p0.ph_hi ? p0.ph_hi : LO)) * BAR_REGION), MISC);
    const PeerMap mp0 = peer_map(xbar, MISC);
    const int bx = (mp0.bal && mp0.nx == 8) ? mp0.r * 8 + mp0.rho : bx_hw;
    const int vcu = (G % 8 == 0) ? (bx % 8) * (G / 8) + bx / 8 : bx;
#define IN(k) (LO <= (k) && (k) < HI)
#define SEAM(k) do { if constexpr (IN(k) && IN((k) + 1)) { xcd_barrier(xbar); } } while (0)
    PG8_LAS unsigned char* glds = (PG8_LAS unsigned char*)lds;
    typedef pg8::EpiBf16<0> EB;
    if constexpr (IN(0)) { P p = p0; asm volatile("" : "+s"(p.ws)); if (p.ph_lo != 1) phase0(p, lds, vcu, G, bx); } SEAM(0);
    if constexpr (IN(1)) { P p = p0; asm volatile("" : "+s"(p.ws));
        const bool tailwg = (G == 256) && bx >= 80, tail_first = tailwg && (((bx - 80) & 1) == 0);
        if (tail_first && !(PROBE_IN & 64)) { tail_prep(p, lds, bx - 80, G - 80); __syncthreads(); }
        { pg8::Gemm g{WSP(const bf16, WS_H), WSP(const bf16, WS_WIN), T, NIN, DM / 2, DM / 2, DM / 2}; pg8::StaticOrder S; S.init(T, NIN, G, bx);
          pg8::EpiI8 E{WSP(bf16, WS_PROJ), NIN, WSP(const float, WS_SA), WSP(const float, WS_SB), C_GATE, WSP(unsigned char, WS_G8), 3 * DM, ((const float*)p.b_gate)}; pg8::gemm_phase<pg8::EpiI8, pg8::StaticOrder, true, true, true>(glds, g, S, E); }
#if PROBE_IN & 32
        { struct SameTile : pg8::StaticOrder { __device__ bool next(int i, pg8::Unit& u) const { if (i >= 7) return false; u.pm = c % 8; u.pn = 0; return true; } };
          pg8::Gemm g{WSP(const bf16, WS_H), WSP(const bf16, WS_WIN), T, NIN, DM / 2, DM / 2, DM / 2}; SameTile S; S.init(T, NIN, G, bx);
          pg8::EpiI8 E{WSP(bf16, WS_ST), 256, WSP(const float, WS_SA), WSP(const float, WS_SB), 1 << 30, nullptr, 0, nullptr}; pg8::gemm_phase<pg8::EpiI8, SameTile, true, true, true>(glds, g, S, E); }
#endif
        { pg8::Gemm g{WSP(const bf16, WS_MEMN), WSP(const bf16, WS_WKV), MROWS, 1024, DM, DM, DM}; pg8::StaticOrder S; S.init(MROWS, 1024, G, (bx + G - 64) % G);
          EB E{WSP(bf16, WS_KVM), 1024, nullptr, 0, 0, 1.f}; pg8::gemm_phase<EB, pg8::StaticOrder, true, true>(glds, g, S, E); }
        { pg8::Gemm g{WSP(const bf16, WS_WKV), WSP(const bf16, WS_MEMN), 1024, MROWS, DM, DM, DM}; pg8::StaticOrder S; S.init(1024, MROWS, G, (bx + G - 72) % G);
          EB E{WSP(bf16, WS_KVMT), MROWS, nullptr, 0, 0, 1.f}; pg8::gemm_phase<EB, pg8::StaticOrder, true, true>(glds, g, S, E); }
        if (!(PROBE_IN & 64)) { if (tailwg && !tail_first) tail_prep(p, lds, bx - 80, G - 80); else if (G != 256) tail_prep(p, lds, bx, G); }
    } SEAM(1);
    if constexpr (IN(2)) { P p = p0; asm volatile("" : "+s"(p.ws));
        if (PROBE_IN & 64) { tail_prep(p, lds, bx, G); __syncthreads(); }
        constexpr int N_DIL = BATCH * DIL_H * 32, N_H1 = BATCH * HG_H * 2 * 64, N_MEM = BATCH * MEM_H * 32;
        { DilRegs R; if (bx < N_DIL) dil_load(p, bx, R);
          for (int it = bx; it < N_DIL; it += G) { DilRegs Rn; const bool more = it + G < N_DIL; if (more) dil_load(p, it + G, Rn); dil_item(p, lds, it, R); if (more) R = Rn; } }
        for (int it = bx; it < N_MEM; it += G) mem_item(p, lds, it);
        { constexpr int N_H1D = BATCH * HG_H * 64;
          unsigned short zf0[16], zb0[16], vc[16]; float lf = 0.f, lb = 0.f; if (bx < N_H1D) h1d_load(p, bx, zf0, zb0, vc, lf, lb);
          for (int it = bx; it < N_H1D; it += G) { unsigned short zf1[16], zb1[16], vn[16]; float lfn = 0.f, lbn = 0.f; const bool more = it + G < N_H1D; if (more) h1d_load(p, it + G, zf1, zb1, vn, lfn, lbn); h1d_item(p, lds, it, zf0, zb0, vc, lf, lb);
              if (more) { lf = lfn; lb = lbn;
#pragma unroll
                  for (int i = 0; i < 16; ++i) { zf0[i] = zf1[i]; zb0[i] = zb1[i]; vc[i] = vn[i]; } } } }
    } SEAM(2);
    if constexpr (IN(3)) { P p = p0; asm volatile("" : "+s"(p.ws)); if (PROBE_IN & 8) h2_scan(p, bx, G, WSP(bf16, WS_WIN)); h2_scan(p, bx, G, WSP(bf16, WS_ST)); } SEAM(3);
    if constexpr (IN(3) && IN(4)) { if (PROBE_IN & 128) { for (int i = 0; i < 8; ++i) xcd_barrier<!(PROBE_IN & 256), !(PROBE_IN & 512)>(xbar); } }
    if constexpr (IN(4)) { P p = p0; asm volatile("" : "+s"(p.ws)); { constexpr int N_H3 = BATCH * HG_H * 64; unsigned short a0[16], a1[16], a2[16], a3[16]; float lf0 = 0.f, lb0 = 0.f; if (bx < N_H3) { h3_load_z(p, bx, a0, a1, lf0, lb0); h3_load_vq(p, bx, a2, a3); }
          for (int it = bx; it < N_H3; it += G) { unsigned short n0[16], n1[16], n2[16], n3[16]; float lf1 = 0.f, lb1 = 0.f; const bool more = it + G < N_H3; if (more) h3_load_z(p, it + G, n0, n1, lf1, lb1); h3_item(p, lds, it, a0, a1, a2, a3, lf0, lb0, more, it + G, n2, n3);
              if (more) { lf0 = lf1; lb0 = lb1;
#pragma unroll
                  for (int i = 0; i < 16; ++i) { a0[i] = n0[i]; a1[i] = n1[i]; a2[i] = n2[i]; a3[i] = n3[i]; } } } }
        dil_alpha_rows(p, vcu, G); } SEAM(4);
    if constexpr (IN(5)) { P p = p0; asm volatile("" : "+s"(p.ws)); pg8::Gemm g{WSP(const bf16, WS_OCAT), WSP(const bf16, WS_WUP), T, DM, DM, DM, DM}; pg8::StaticOrder S; S.init(T, DM, G, bx);
        pg8::EpiUp E{WSP(const unsigned char, WS_G8), 3 * DM, WSP(bf16, WS_MERGED), 12, 24};
        pg8::gemm_phase<pg8::EpiUp, pg8::StaticOrder, false, true>(glds, g, S, E); } SEAM(5);
    if constexpr (IN(6)) { P p = p0; asm volatile("" : "+s"(p.ws)); pg8::Gemm g{WSP(const bf16, WS_MERGED), WSP(const bf16, WS_WOUT), T, DM, DM, DM, DM}; pg8::StaticOrder S; S.init(T, DM, G, bx);
        pg8::EpiOut E{((const float*)p.x), WSP(bf16, WS_XG), WSP(float, WS_RSP)};
        pg8::gemm_phase<pg8::EpiOut, pg8::StaticOrder, false, true>(glds, g, S, E); } SEAM(6);
    if constexpr (IN(7)) { P p = p0; asm volatile("" : "+s"(p.ws));
        pg8::Gemm g{WSP(const bf16, WS_XG), WSP(const bf16, WS_WQ), T, DM, DM, DM, DM}; pg8::StaticOrder S; S.init(T, DM, G, bx);
        EpiRoute E{WSP(const bf16, WS_SKB), WSP(const float, WS_RSP), WSP(int, WS_IDX), WSP(float, WS_GATE)};
        pg8::gemm_phase<EpiRoute, pg8::StaticOrder, false, true>(glds, g, S, E); } SEAM(7);
    if constexpr (IN(8)) { P p = p0; asm volatile("" : "+s"(p.ws)); const PeerMap mp = mp0; if (PROBE_IN & 1) peer_fused(p, mp, lds, WSP(float, WS_PROJ + 32 * MiB), WSP(float, WS_PROJ + 96 * MiB)); peer_fused16(p, mp, lds, ((float*)p.out), ((float*)p.dst10)); }
#undef IN
#undef SEAM
}

#if MK_SPLIT
#define MK_FOR_PH(X) X(0) X(1) X(2) X(3) X(4) X(5) X(6) X(7) X(8)
static bool set_lds() { bool ok = true;
#define X(k) ok = ok && (hipFuncSetAttribute((const void*)mk_fwd<k, k + 1>, hipFuncAttributeMaxDynamicSharedMemorySize, LDS_BYTES) == hipSuccess);
    MK_FOR_PH(X)
#undef X
    return ok; }
static void launch_split(const P& p, int grid, hipStream_t stream) {
#ifndef PROBE_REP
#define PROBE_REP 0
#endif
#define X(k) { P q = p; q.ph_hi = 0; if (k == 0) { q.ph_lo = 0; hipLaunchKernelGGL((mk_fwd<0, 1>), dim3(grid), dim3(NTHR), LDS_BYTES, stream, q); if ((PROBE_REP >> 15) & 1) { q.ph_hi = 15; hipLaunchKernelGGL((mk_fwd<0, 1>), dim3(grid), dim3(NTHR), LDS_BYTES, stream, q); } q.ph_lo = 1; q.ph_hi = 13; } if (((PROBE_REP >> k) & 1)) { P q2 = q; q2.ph_hi = 14; hipLaunchKernelGGL((mk_fwd<k, k + 1>), dim3(grid), dim3(NTHR), LDS_BYTES, stream, q2); } hipLaunchKernelGGL((mk_fwd<k, k + 1>), dim3(grid), dim3(NTHR), LDS_BYTES, stream, q); }
    MK_FOR_PH(X)
#undef X
}
#else
static bool set_lds() { return hipFuncSetAttribute((const void*)mk_fwd<0, NPHASE>, hipFuncAttributeMaxDynamicSharedMemorySize, LDS_BYTES) == hipSuccess; }
#endif

extern "C" void kernel_launch(void* const* d_in, const int* in_sizes, int n_in, void* d_out, int out_size, void* d_ws, size_t ws_size, hipStream_t stream) {
    static int grid = 0;
    if (grid == 0) {
        if (n_in != 18 || out_size != T * DM || ws_size < WS_END) { fprintf(stderr, "kernel_launch: unexpected shapes (n_in %d, out %d, ws %zu)\n", n_in, out_size, ws_size); grid = -1; return; }
        int dev = 0, cus = 0, per_cu = 0;
        (void)hipGetDevice(&dev); (void)hipDeviceGetAttribute(&cus, hipDeviceAttributeMultiprocessorCount, dev);
        if (!set_lds()) { fprintf(stderr, "kernel_launch: hipFuncSetAttribute failed\n"); grid = -1; return; }
        (void)per_cu; (void)hipGetLastError();
        grid = cus;
        if (grid != 256) { fprintf(stderr, "kernel_launch: built for a 256-CU device (one 256x256 GEMM unit per workgroup in the fused-epilogue phases); found %d CUs\n", cus); grid = -1; return; }
    }
    if (grid < 0) return;
    if (hipMemsetAsync((char*)d_ws + WS_BAR, 0, BAR_ZERO, stream) != hipSuccess) { fprintf(stderr, "kernel_launch: memset failed\n"); return; }
    P p{};
    p.x = (const GAS float*)d_in[0]; p.mem = (const GAS float*)d_in[1]; p.g_mix = (const GAS float*)d_in[2]; p.w_in = (const GAS float*)d_in[3]; p.b_gate = (const GAS float*)d_in[4];
    p.lbf_l = (const GAS float*)d_in[5]; p.lbb_l = (const GAS float*)d_in[6]; p.g_hg = (const GAS float*)d_in[7]; p.w_kv = (const GAS float*)d_in[8]; p.g_mem = (const GAS float*)d_in[9];
    p.w_up = (const GAS float*)d_in[10]; p.w_out = (const GAS float*)d_in[11]; p.g_ffn = (const GAS float*)d_in[12]; p.w_q = (const GAS float*)d_in[13]; p.subk = (const GAS float*)d_in[14];
    p.pu = (const GAS float*)d_in[15]; p.pv = (const GAS float*)d_in[16]; p.g_final = (const GAS float*)d_in[17];
    p.out = (GAS float*)d_out; p.dst10 = (GAS float*)d_out; p.ws = (GAS unsigned char*)d_ws;
#if MK_SPLIT
    launch_split(p, grid, stream);
#else
    p.ph_lo = 2; p.ph_hi = NPHASE;
    void* args[] = {&p};
    hipError_t e = hipLaunchCooperativeKernel((const void*)mk_fwd<0, NPHASE>, dim3(grid), dim3(NTHR), args, LDS_BYTES, stream);
    if (e != hipSuccess) fprintf(stderr, "kernel_launch: cooperative launch failed: %s (grid %d)\n", hipGetErrorString(e), grid);
#endif
}
```

```cpp
#include <hip/hip_runtime.h>
#include <cstdio>
#include <cstdint>
__device__ __forceinline__ int tidx() { int t = threadIdx.x; asm volatile("" : "+v"(t)); return t; }
namespace pg8 {
#define PG8_LAS __attribute__((address_space(3)))
typedef unsigned short bf16_t;
typedef short bf16x8 __attribute__((ext_vector_type(8)));
typedef float f32x4 __attribute__((ext_vector_type(4)));
typedef unsigned u32x4 __attribute__((ext_vector_type(4)));
typedef unsigned u32x2 __attribute__((ext_vector_type(2)));
constexpr int BM = 256, BK = 64, HALF = 128, HTB = HALF * BK * 2  , STAGE_BYTES = 8 * HTB, NXCD = 8, WGM = 8;

__host__ __device__ __forceinline__ int lds_byte(int r, int c) { const int st = (r >> 4) * 2 + (c >> 5), rr = r & 15, cc = c & 31, ob = rr * 64 + cc * 2; return st * 1024 + (ob ^ (((ob >> 9) & 1) << 5)); }
__host__ __device__ __forceinline__ void stage_rc(int b, int& R, int& C) { const int st = b / 1024, sb = b % 1024, swz = sb ^ (((sb >> 9) & 1) << 5); R = (st >> 1) * 16 + swz / 64; C = (st & 1) * 32 + (swz % 64) / 2; }
__host__ __device__ __forceinline__ int perm32(int rho) { const int n = rho >> 4, i = rho & 15; return 8 * (i >> 2) + 4 * n + (i & 3); }

struct Unit { int pm, pn; };
struct Gemm { const bf16_t* A; const bf16_t* Bt; int M, N, K, lda, ldb; size_t ksA = 0, ksB = 0; };

struct StaticOrder {
    int nM, nN, nwg, G, c;
    __host__ __device__ void init(int M, int N, int G_, int c_) { nM = M / BM; nN = N / BM; nwg = nM * nN; G = G_; c = c_; }
    __host__ __device__ bool next(int i, Unit& u) const { return map((long)i * G + c, u); }
    __host__ __device__ bool map(long L, Unit& u) const {
        if (L >= nwg) return false;
        int wgid = (int)L; { const int q = nwg / NXCD, r = nwg % NXCD, xcd = wgid % NXCD, off = wgid / NXCD; wgid = (xcd < r ? xcd * (q + 1) : r * (q + 1) + (xcd - r) * q) + off; }
        const int nig = WGM * nN, gid = wgid / nig, fm = gid * WGM, gsz = (nM - fm) < WGM ? (nM - fm) : WGM;
        u.pm = fm + ((wgid % nig) % gsz); u.pn = (wgid % nig) / gsz; return true;
    }
    __device__ __forceinline__ void a_ready(const Unit&) const {}
    __device__ __forceinline__ void done(const Unit&) const {}
};
struct SplitOrder : StaticOrder {
    int NT, RA, RB;
    __host__ __device__ bool next(int i, Unit& u) const {
        if (c >= NT) { if (i >= RA) return false; return map((long)i * (G - NT) + (c - NT), u); }
        if (i >= RB) return false; return map((long)(G - NT) * RA + (long)i * NT + c, u);
    }
};


__device__ __forceinline__ unsigned cvt_pk_bf16(float lo, float hi) { unsigned r; asm volatile("v_cvt_pk_bf16_f32 %0, %1, %2" : "=v"(r) : "v"(lo), "v"(hi)); return r; }
typedef float f32x2 __attribute__((ext_vector_type(2)));
__device__ __forceinline__ f32x2 gelu_pk(f32x2 v) {
    const f32x2 av = __builtin_elementwise_abs(v), d = av * 0.2316418882f + 1.0f;
    f32x2 t; t.x = __builtin_amdgcn_rcpf(d.x); t.y = __builtin_amdgcn_rcpf(d.y);
    f32x2 q = t * 0.5307027145f + (-0.7265760135f); q = q * t + 0.7107068705f; q = q * t + (-0.142248368f); q = q * t + 0.127414796f; q = q * t;
    const f32x2 s = (v * v) * (-0.72134752044f);
    f32x2 e; e.x = __builtin_amdgcn_exp2f(s.x); e.y = __builtin_amdgcn_exp2f(s.y);
    const f32x2 m = v * (q * e), r = v - m;
    f32x2 o; o.x = v.x < 0.f ? m.x : r.x; o.y = v.y < 0.f ? m.y : r.y; return o;
}

template <int ACT  > struct EpiBf16 {
    static constexpr bool PERM = true, AFTER_DRAIN = false, MIDK = false; static_assert(ACT == 0 || ACT == 1, "EpiBf16: ACT is 0 (none) or 1 (gelu_pk)");
    bf16_t* O; int ldc; const float* bias; int split_cols; size_t split_stride; float scale0;
    __device__ __forceinline__ void operator()(const f32x4 (&acc)[2][2][4][2], const Unit& u, int wr, int wc, int fr, int fq) const {
        const int row0 = u.pm * BM + wr * 64 + fr; int colt = u.pn * BM; bf16_t* base = O;
        float sc = 1.f; if (split_cols) { const int t = colt / split_cols; base += (size_t)t * split_stride; colt -= t * split_cols; if (t == 0) sc = scale0; }
        const int col0 = colt + wc * 32 + 8 * fq, bcol0 = u.pn * BM + wc * 32 + 8 * fq;
        f32x4 bv[2][2];
#pragma unroll
        for (int bj = 0; bj < 2; ++bj)
#pragma unroll
            for (int n = 0; n < 2; ++n) bv[bj][n] = bias ? *(const f32x4*)(bias + bcol0 + bj * HALF + 4 * n) : (f32x4){0.f, 0.f, 0.f, 0.f};
#pragma unroll
        for (int ai = 0; ai < 2; ++ai)
#pragma unroll
            for (int m = 0; m < 4; ++m) { bf16_t* rowp = base + (size_t)(row0 + ai * HALF + m * 16) * ldc + col0;
#pragma unroll
                for (int bj = 0; bj < 2; ++bj) { f32x4 v0 = acc[ai][bj][m][0] + bv[bj][0], v1 = acc[ai][bj][m][1] + bv[bj][1];
                    if (ACT == 1) { f32x2 a = gelu_pk((f32x2){v0[0], v0[1]}), b = gelu_pk((f32x2){v0[2], v0[3]}), c = gelu_pk((f32x2){v1[0], v1[1]}), d = gelu_pk((f32x2){v1[2], v1[3]});
                        v0 = (f32x4){a.x, a.y, b.x, b.y}; v1 = (f32x4){c.x, c.y, d.x, d.y}; }
                    v0 = v0 * sc; v1 = v1 * sc; u32x4 w; w.x = cvt_pk_bf16(v0[0], v0[1]); w.y = cvt_pk_bf16(v0[2], v0[3]); w.z = cvt_pk_bf16(v1[0], v1[1]); w.w = cvt_pk_bf16(v1[2], v1[3]);
                    *(u32x4*)(rowp + bj * HALF) = w; } }
    }
};
typedef int i32x4 __attribute__((ext_vector_type(4)));
template <bool I8> __device__ __forceinline__ f32x4 mma_sel(bf16x8 a, bf16x8 b, f32x4 c) {
    if constexpr (I8) return __builtin_bit_cast(f32x4, __builtin_amdgcn_mfma_i32_16x16x64_i8(__builtin_bit_cast(i32x4, a), __builtin_bit_cast(i32x4, b), __builtin_bit_cast(i32x4, c), 0, 0, 0));
    else return __builtin_amdgcn_mfma_f32_16x16x32_bf16(a, b, c, 0, 0, 0);
}
template <class Epi, class Sched, bool ALIGN_EPI = false, bool SP2 = false, bool I8 = false>
__device__ __forceinline__ void gemm_phase(PG8_LAS unsigned char* lds, const Gemm g, const Sched& S, const Epi& E) {
    const int tid = tidx(), wid = __builtin_amdgcn_readfirstlane(tid >> 6), lane = tid & 63, wr = wid >> 2, wc = wid & 3, fr = lane & 15, fq = lane >> 4;
    const int K = g.K, nt = K / BK;
    unsigned voffA[2], voffB[2];
#pragma unroll
    for (int i = 0; i < 2; ++i) { int R, C; stage_rc(tid * 16 + i * 8192, R, C); const int Rb = Epi::PERM ? ((R & ~31) + perm32(R & 31)) : R;
        voffA[i] = (unsigned)(R * g.lda + C) * 2u; voffB[i] = (unsigned)(Rb * g.ldb + C) * 2u; }
    const size_t kstepA = g.ksA ? g.ksA : (size_t)(BK * 2), kstepB = g.ksB ? g.ksB : (size_t)(BK * 2);
    const size_t hstepA = (size_t)HALF * g.lda * 2, hstepB = (size_t)HALF * g.ldb * 2;
    const size_t tstepA = 2 * hstepA, tstepB = 2 * hstepB;
    const unsigned ldsw = (unsigned)wid * 1024u;
    const int aoff = lds_byte(wr * 64 + fr, fq * 8), boff = lds_byte(wc * 32 + fr, fq * 8);
#define PG8_SA(b, h) (((b) * 2 + (h)) * HTB)
#define PG8_SB(b, h) ((4 + (b) * 2 + (h)) * HTB)
#define PG8_STAGE(bufoff, gbase, voff) do { _Pragma("unroll") for (int _i = 0; _i < 2; ++_i) \
        __builtin_amdgcn_global_load_lds((const unsigned*)((const char*)(gbase) + (voff)[_i]), (PG8_LAS unsigned*)(lds + (bufoff) + ldsw + _i * 8192), 16, 0, 0); } while (0)
#define PG8_LDA(dst, b, h) do { _Pragma("unroll") for (int m = 0; m < 4; ++m) _Pragma("unroll") for (int k = 0; k < 2; ++k) dst[m][k] = *(const PG8_LAS bf16x8*)(lds + PG8_SA(b, h) + aoff + m * 2048 + k * 1024); } while (0)
#define PG8_LDB(dst, b, h) do { _Pragma("unroll") for (int n = 0; n < 2; ++n) _Pragma("unroll") for (int k = 0; k < 2; ++k) dst[n][k] = *(const PG8_LAS bf16x8*)(lds + PG8_SB(b, h) + boff + n * 2048 + k * 1024); } while (0)
#define PG8_MMA(ai, bj, At, Bt) do { __builtin_amdgcn_s_setprio(1); _Pragma("unroll") for (int m = 0; m < 4; ++m) _Pragma("unroll") for (int n = 0; n < 2; ++n) _Pragma("unroll") for (int k = 0; k < 2; ++k) \
        acc[ai][bj][m][n] = mma_sel<I8>(Bt[n][k], At[m][k], acc[ai][bj][m][n]); __builtin_amdgcn_s_setprio(0); } while (0)
#define PG8_WAIT_V(n) asm volatile("s_waitcnt vmcnt(" #n ")" ::: "memory")
#define PG8_WAIT_L(n) asm volatile("s_waitcnt lgkmcnt(" #n ")" ::: "memory")
#define PG8_BAR __builtin_amdgcn_s_barrier()
#define PG8_SCHED __builtin_amdgcn_sched_barrier(0)
    Unit cur, nxt; int ui = 0;
    if (!S.next(0, cur)) return;
    f32x4 acc[2][2][4][2];
#pragma unroll
    for (int a = 0; a < 2; ++a)
#pragma unroll
        for (int b = 0; b < 2; ++b)
#pragma unroll
            for (int m = 0; m < 4; ++m)
#pragma unroll
                for (int n = 0; n < 2; ++n) acc[a][b][m][n] = (f32x4){0.f, 0.f, 0.f, 0.f};
    bf16x8 At[4][2], B0[2][2], B1[2][2];
    const char* cA = (const char*)g.A + (size_t)cur.pm * tstepA; const char* cB = (const char*)g.Bt + (size_t)cur.pn * tstepB;
    S.a_ready(cur);
    if constexpr (SP2) {
        PG8_STAGE(PG8_SB(0, 0), cB, voffB); PG8_STAGE(PG8_SB(0, 1), cB + hstepB, voffB); PG8_STAGE(PG8_SA(0, 0), cA, voffA); PG8_STAGE(PG8_SA(0, 1), cA + hstepA, voffA);
        if (wr == 1) PG8_BAR;
        PG8_WAIT_V(2); PG8_BAR;
        PG8_STAGE(PG8_SB(1, 0), cB + kstepB, voffB); PG8_STAGE(PG8_SA(1, 0), cA + kstepA, voffA); PG8_STAGE(PG8_SB(1, 1), cB + hstepB + kstepB, voffB);
        PG8_WAIT_V(6); PG8_BAR;
    } else {
        PG8_STAGE(PG8_SB(0, 0), cB, voffB); PG8_STAGE(PG8_SA(0, 0), cA, voffA); PG8_STAGE(PG8_SB(0, 1), cB + hstepB, voffB); PG8_STAGE(PG8_SA(0, 1), cA + hstepA, voffA);
        if (wr == 1) PG8_BAR;
        PG8_WAIT_V(4); PG8_BAR;
        PG8_STAGE(PG8_SB(1, 0), cB + kstepB, voffB); PG8_STAGE(PG8_SA(1, 0), cA + kstepA, voffA); PG8_STAGE(PG8_SB(1, 1), cB + hstepB + kstepB, voffB);
        PG8_WAIT_V(6); PG8_BAR;
    }
    for (;;) {
        const bool has_next = S.next(ui + 1, nxt);
        const char* nA = has_next ? (const char*)g.A + (size_t)nxt.pm * tstepA : cA; const char* nB = has_next ? (const char*)g.Bt + (size_t)nxt.pn * tstepB : cB;
        for (int t = 0; t < nt; t += 2) {
            if constexpr (Epi::MIDK) { if (t == E.t1 || t == E.t2) E.mid(acc, cur, t == E.t1 ? 0 : 1, wr, wc, fr, fq); }
            const bool last = (t == nt - 2);
            const char* a1 = cA + (size_t)(t + 1) * kstepA;
            const char* a2 = last ? nA : cA + (size_t)(t + 2) * kstepA; const char* b2 = last ? nB : cB + (size_t)(t + 2) * kstepB;
            const char* a3 = a2 + kstepA; const char* b3 = b2 + kstepB;
            if (last && has_next) S.a_ready(nxt);
            if constexpr (SP2) {
            PG8_LDB(B0, 0, 0); PG8_LDB(B1, 0, 1); PG8_SCHED; PG8_LDA(At, 0, 0); PG8_STAGE(PG8_SA(1, 1), a1 + hstepA, voffA);
            PG8_WAIT_V(8); PG8_WAIT_L(0); PG8_BAR; PG8_MMA(0, 0, At, B0); PG8_MMA(0, 1, At, B1); PG8_BAR; PG8_SCHED;
            PG8_LDA(At, 0, 1); PG8_STAGE(PG8_SB(0, 0), b2, voffB); PG8_STAGE(PG8_SB(0, 1), b2 + hstepB, voffB); PG8_STAGE(PG8_SA(0, 0), a2, voffA);
            PG8_WAIT_V(8); PG8_WAIT_L(0); PG8_BAR; PG8_MMA(1, 0, At, B0); PG8_MMA(1, 1, At, B1); PG8_BAR; PG8_SCHED;
            PG8_LDB(B0, 1, 0); PG8_LDB(B1, 1, 1); PG8_SCHED; PG8_LDA(At, 1, 0); PG8_STAGE(PG8_SA(0, 1), a2 + hstepA, voffA);
            PG8_WAIT_V(8); PG8_WAIT_L(0); PG8_BAR; PG8_MMA(0, 0, At, B0); PG8_MMA(0, 1, At, B1); PG8_BAR; PG8_SCHED;
            PG8_LDA(At, 1, 1); PG8_STAGE(PG8_SB(1, 0), b3, voffB); PG8_STAGE(PG8_SB(1, 1), b3 + hstepB, voffB); PG8_STAGE(PG8_SA(1, 0), a3, voffA);
            PG8_WAIT_V(8); PG8_WAIT_L(0); PG8_BAR; PG8_MMA(1, 0, At, B0); PG8_MMA(1, 1, At, B1); PG8_BAR; PG8_SCHED;
            } else {
            PG8_LDB(B0, 0, 0); PG8_SCHED; PG8_LDA(At, 0, 0); PG8_STAGE(PG8_SA(1, 1), a1 + hstepA, voffA);
            PG8_WAIT_L(8); PG8_BAR; PG8_WAIT_L(0); PG8_MMA(0, 0, At, B0); PG8_BAR; PG8_SCHED;
            PG8_LDB(B1, 0, 1); PG8_STAGE(PG8_SB(0, 0), b2, voffB);
            PG8_BAR; PG8_WAIT_L(0); PG8_MMA(0, 1, At, B1); PG8_BAR;
            PG8_LDA(At, 0, 1); PG8_STAGE(PG8_SA(0, 0), a2, voffA);
            PG8_BAR; PG8_WAIT_L(0); PG8_MMA(1, 0, At, B0); PG8_BAR; PG8_SCHED;
            PG8_STAGE(PG8_SB(0, 1), b2 + hstepB, voffB);
            PG8_WAIT_V(6); PG8_BAR; PG8_MMA(1, 1, At, B1); PG8_BAR;
            PG8_LDB(B0, 1, 0); PG8_SCHED; PG8_LDA(At, 1, 0); PG8_STAGE(PG8_SA(0, 1), a2 + hstepA, voffA);
            PG8_WAIT_L(8); PG8_BAR; PG8_WAIT_L(0); PG8_MMA(0, 0, At, B0); PG8_BAR; PG8_SCHED;
            PG8_LDB(B1, 1, 1); PG8_STAGE(PG8_SB(1, 0), b3, voffB);
            PG8_BAR; PG8_WAIT_L(0); PG8_MMA(0, 1, At, B1); PG8_BAR;
            PG8_LDA(At, 1, 1); PG8_STAGE(PG8_SA(1, 0), a3, voffA);
            PG8_BAR; PG8_WAIT_L(0); PG8_MMA(1, 0, At, B0); PG8_BAR; PG8_SCHED;
            PG8_STAGE(PG8_SB(1, 1), b3 + hstepB, voffB);
            PG8_WAIT_V(6); PG8_BAR; PG8_MMA(1, 1, At, B1); PG8_BAR;
            }
        }
        if constexpr (ALIGN_EPI) { if (wr == 0) PG8_BAR; }
        if constexpr (!Epi::AFTER_DRAIN) { E(acc, cur, wr, wc, fr, fq); S.done(cur); }
        if (!has_next) break;
#pragma unroll
        for (int a = 0; a < 2; ++a)
#pragma unroll
            for (int b = 0; b < 2; ++b)
#pragma unroll
                for (int m = 0; m < 4; ++m)
#pragma unroll
                    for (int n = 0; n < 2; ++n) acc[a][b][m][n] = (f32x4){0.f, 0.f, 0.f, 0.f};
        cur = nxt; cA = nA; cB = nB; ++ui;
        if constexpr (ALIGN_EPI) { if (wr == 1) PG8_BAR; }
    }
    PG8_WAIT_V(0);
    if constexpr (!ALIGN_EPI) { if (wr == 0) PG8_BAR; }
    PG8_BAR;
    if constexpr (Epi::AFTER_DRAIN) { E.fused(acc, cur, wr, wc, fr, fq, lds, wid, lane); S.done(cur); }
#undef PG8_SA
#undef PG8_SB
#undef PG8_STAGE
#undef PG8_LDA
#undef PG8_LDB
#undef PG8_MMA
#undef PG8_WAIT_V
#undef PG8_WAIT_L
#undef PG8_BAR
#undef PG8_SCHED
}
struct EpiF32 {
    static constexpr bool PERM = false, AFTER_DRAIN = false, MIDK = false;
    float* C; int ldc;
    __device__ __forceinline__ void operator()(const f32x4 (&acc)[2][2][4][2], const Unit& u, int wr, int wc, int fr, int fq) const {
        const int row0 = u.pm * BM + wr * 64 + fr, col0 = u.pn * BM + wc * 32 + 4 * fq;
#pragma unroll
        for (int ai = 0; ai < 2; ++ai)
#pragma unroll
            for (int m = 0; m < 4; ++m) { float* rowp = C + (size_t)(row0 + ai * HALF + m * 16) * ldc + col0;
#pragma unroll
                for (int bj = 0; bj < 2; ++bj)
#pragma unroll
                    for (int n = 0; n < 2; ++n) *(f32x4*)(rowp + bj * HALF + n * 16) = acc[ai][bj][m][n]; }
    }
};
__device__ __forceinline__ float bfu(unsigned short h) { return __uint_as_float(((unsigned)h) << 16); }
__device__ __forceinline__ float sigm(float x) { return 1.0f / (1.0f + __expf(-x)); }
struct EpiUp {
    static constexpr bool PERM = true, AFTER_DRAIN = false, MIDK = true;
    const unsigned char* g8; int ldg;
    bf16_t* merged; int t1, t2;
    __device__ __forceinline__ void mid(f32x4 (&acc)[2][2][4][2], const Unit& u, int which, int wr, int wc, int fr, int fq) const {
        int row0 = u.pm * BM + wr * 64 + fr, col0 = u.pn * BM + wc * 32 + 8 * fq;
        asm volatile("" : "+v"(row0), "+v"(col0));
#pragma unroll
        for (int ai = 0; ai < 2; ++ai) {
            u32x2 gd[4][2], gn[4][2];
#pragma unroll
            for (int m = 0; m < 4; ++m)
#pragma unroll
                for (int bj = 0; bj < 2; ++bj) { const unsigned char* gp = g8 + (size_t)(row0 + ai * HALF + m * 16) * ldg + col0 + bj * HALF;
                    gd[m][bj] = *(const u32x2*)(gp + which * 2048); gn[m][bj] = *(const u32x2*)(gp + (which + 1) * 2048); }
            asm volatile("" ::: "memory");
#pragma unroll
            for (int m = 0; m < 4; ++m)
#pragma unroll
                for (int bj = 0; bj < 2; ++bj) {
#pragma unroll
                    for (int i = 0; i < 4; ++i) {
                        acc[ai][bj][m][0][i] *= (float)((gd[m][bj].x >> (8 * i)) & 0xffu) * __builtin_amdgcn_rcpf((float)((gn[m][bj].x >> (8 * i)) & 0xffu));
                        acc[ai][bj][m][1][i] *= (float)((gd[m][bj].y >> (8 * i)) & 0xffu) * __builtin_amdgcn_rcpf((float)((gn[m][bj].y >> (8 * i)) & 0xffu)); } }
            asm volatile("" ::: "memory");
        }
    }
    __device__ __forceinline__ void operator()(const f32x4 (&acc)[2][2][4][2], const Unit& u, int wr, int wc, int fr, int fq) const {
        const int row0 = u.pm * BM + wr * 64 + fr, col0 = u.pn * BM + wc * 32 + 8 * fq;
        u32x2 g2[2][4][2];
#pragma unroll
        for (int ai = 0; ai < 2; ++ai)
#pragma unroll
            for (int m = 0; m < 4; ++m)
#pragma unroll
                for (int bj = 0; bj < 2; ++bj) g2[ai][m][bj] = *(const u32x2*)(g8 + (size_t)(row0 + ai * HALF + m * 16) * ldg + 2 * 2048 + col0 + bj * HALF);
#pragma unroll
        for (int ai = 0; ai < 2; ++ai)
#pragma unroll
            for (int m = 0; m < 4; ++m) { const size_t row = (size_t)(row0 + ai * HALF + m * 16);
#pragma unroll
                for (int bj = 0; bj < 2; ++bj) { const int col = col0 + bj * HALF;
                    f32x4 v0 = acc[ai][bj][m][0], v1 = acc[ai][bj][m][1];
#pragma unroll
                    for (int i = 0; i < 4; ++i) { v0[i] *= (float)((g2[ai][m][bj].x >> (8 * i)) & 0xffu) * (1.f / 255.f); v1[i] *= (float)((g2[ai][m][bj].y >> (8 * i)) & 0xffu) * (1.f / 255.f); }
                    u32x4 w; w.x = cvt_pk_bf16(v0[0], v0[1]); w.y = cvt_pk_bf16(v0[2], v0[3]); w.z = cvt_pk_bf16(v1[0], v1[1]); w.w = cvt_pk_bf16(v1[2], v1[3]);
                    *(u32x4*)(merged + row * 2048 + col) = w; } }
    }
};
struct EpiOut {
    static constexpr bool PERM = true, AFTER_DRAIN = false, MIDK = false;
    const float* x; bf16_t* xg; float* rowss;
    __device__ __forceinline__ void operator()(const f32x4 (&acc)[2][2][4][2], const Unit& u, int wr, int wc, int fr, int fq) const {
        const int row0 = u.pm * BM + wr * 64 + fr, col0 = u.pn * BM + wc * 32 + 8 * fq;
#pragma unroll
        for (int ai = 0; ai < 2; ++ai) {
            f32x4 xv[4][2][2];
#pragma unroll
            for (int m = 0; m < 4; ++m)
#pragma unroll
                for (int bj = 0; bj < 2; ++bj) { const float* xp = x + (size_t)(row0 + ai * HALF + m * 16) * 2048 + col0 + bj * HALF; xv[m][bj][0] = *(const f32x4*)xp; xv[m][bj][1] = *(const f32x4*)(xp + 4); }
            asm volatile("" ::: "memory");
#pragma unroll
            for (int m = 0; m < 4; ++m) { const size_t row = (size_t)(row0 + ai * HALF + m * 16); float ss = 0.f;
#pragma unroll
                for (int bj = 0; bj < 2; ++bj) { const int col = col0 + bj * HALF; const size_t off = row * 2048 + col;
                    const f32x4 v0 = acc[ai][bj][m][0] + xv[m][bj][0], v1 = acc[ai][bj][m][1] + xv[m][bj][1];
                    ss += (v0[0] * v0[0] + v0[1] * v0[1]) + (v0[2] * v0[2] + v0[3] * v0[3]) + (v1[0] * v1[0] + v1[1] * v1[1]) + (v1[2] * v1[2] + v1[3] * v1[3]);
                    u32x4 w; w.x = cvt_pk_bf16(v0[0], v0[1]); w.y = cvt_pk_bf16(v0[2], v0[3]); w.z = cvt_pk_bf16(v1[0], v1[1]); w.w = cvt_pk_bf16(v1[2], v1[3]);
                    *(u32x4*)(xg + off) = w; }
                ss += __shfl_xor(ss, 16); ss += __shfl_xor(ss, 32);
                if (fq == 0) rowss[row * 32 + u.pn * 4 + wc] = ss; }
            asm volatile("" ::: "memory");
        }
    }
};
struct EpiI8 {
    static constexpr bool PERM = true, AFTER_DRAIN = false, MIDK = false;
    bf16_t* O; int ldc; const float* sa; const float* sb; int gcol0; unsigned char* g8; int ldg; const float* bg;
    __device__ __forceinline__ static unsigned gq(float x, unsigned w, int byte) { const float e = __builtin_amdgcn_exp2f(x), s255 = __builtin_amdgcn_rcpf(__builtin_fmaf(e, 1.f / 255.f, 1.f / 255.f));
        return __builtin_amdgcn_cvt_pk_u8_f32(__builtin_rintf(fmaxf(s255, 1.f)), byte, w); }
    __device__ __forceinline__ void operator()(const f32x4 (&acc)[2][2][4][2], const Unit& u, int wr, int wc, int fr, int fq) const {
        const int row0 = u.pm * BM + wr * 64 + fr, col0 = u.pn * BM + wc * 32 + 8 * fq;
        f32x4 sb0[2], sb1[2];
#pragma unroll
        for (int bj = 0; bj < 2; ++bj) { sb0[bj] = *(const f32x4*)(sb + col0 + bj * HALF); sb1[bj] = *(const f32x4*)(sb + col0 + bj * HALF + 4); }
        float rsc[2][4];
#pragma unroll
        for (int ai = 0; ai < 2; ++ai)
#pragma unroll
            for (int m = 0; m < 4; ++m) rsc[ai][m] = sa[row0 + ai * HALF + m * 16];
        if (u.pn * BM >= gcol0) {
            f32x4 bg0[2], bg1[2];
#pragma unroll
            for (int bj = 0; bj < 2; ++bj) { bg0[bj] = *(const f32x4*)(bg + col0 - gcol0 + bj * HALF) * -1.44269504089f; bg1[bj] = *(const f32x4*)(bg + col0 - gcol0 + bj * HALF + 4) * -1.44269504089f;
                sb0[bj] = sb0[bj] * -1.44269504089f; sb1[bj] = sb1[bj] * -1.44269504089f; }
            asm volatile("" ::: "memory");
#pragma unroll
            for (int ai = 0; ai < 2; ++ai)
#pragma unroll
                for (int m = 0; m < 4; ++m) { const int row = row0 + ai * HALF + m * 16; const float ra = rsc[ai][m]; unsigned char* rowp = g8 + (size_t)row * ldg + (col0 - gcol0);
#pragma unroll
                    for (int bj = 0; bj < 2; ++bj) { const i32x4 a0 = __builtin_bit_cast(i32x4, acc[ai][bj][m][0]), a1 = __builtin_bit_cast(i32x4, acc[ai][bj][m][1]);
                        u32x2 w; w.x = 0u; w.y = 0u;
#pragma unroll
                        for (int i = 0; i < 4; ++i) { w.x = gq(__builtin_fmaf((float)a0[i] * ra, sb0[bj][i], bg0[bj][i]), w.x, i); w.y = gq(__builtin_fmaf((float)a1[i] * ra, sb1[bj][i], bg1[bj][i]), w.y, i); }
                        *(u32x2*)(rowp + bj * HALF) = w; } }
            return; }
        asm volatile("" ::: "memory");
#pragma unroll
        for (int ai = 0; ai < 2; ++ai)
#pragma unroll
            for (int m = 0; m < 4; ++m) { const int row = row0 + ai * HALF + m * 16; const float ra = rsc[ai][m];
                bf16_t* rowp = ldc ? O + (size_t)row * ldc + col0 : O + (size_t)(col0 >> 6) * ((size_t)8192 * 64) + (size_t)row * 64 + (col0 & 63);
                const size_t bjstep = ldc ? (size_t)HALF : (size_t)2 * 8192 * 64;
#pragma unroll
                for (int bj = 0; bj < 2; ++bj) { const i32x4 a0 = __builtin_bit_cast(i32x4, acc[ai][bj][m][0]), a1 = __builtin_bit_cast(i32x4, acc[ai][bj][m][1]);
                    const f32x4 v0 = {(float)a0[0] * ra * sb0[bj][0], (float)a0[1] * ra * sb0[bj][1], (float)a0[2] * ra * sb0[bj][2], (float)a0[3] * ra * sb0[bj][3]};
                    const f32x4 v1 = {(float)a1[0] * ra * sb1[bj][0], (float)a1[1] * ra * sb1[bj][1], (float)a1[2] * ra * sb1[bj][2], (float)a1[3] * ra * sb1[bj][3]};
                    u32x4 w; w.x = cvt_pk_bf16(v0[0], v0[1]); w.y = cvt_pk_bf16(v0[2], v0[3]); w.z = cvt_pk_bf16(v1[0], v1[1]); w.w = cvt_pk_bf16(v1[2], v1[3]);
                    *(u32x4*)(rowp + bj * bjstep) = w; } }
    }
};
}
constexpr int NWAVES = 8, NTHR = 512;
constexpr int BATCH = 2, SEQ = 4096, DM = 2048, T = BATCH * SEQ;
constexpr int NIN = 12800, MEML = 256, MROWS = BATCH * MEML;
constexpr int HG_H = 6, DIL_H = 12, MEM_H = 4;
constexpr int C_Q = 0, C_V = 768, C_ZF = 1536, C_ZB = 2304, C_HG = 3072, C_DQ = 3840, C_DK = 4608, C_DV = 5376, C_MQ = 6144, C_GATE = 6656;
constexpr int NEXP = 16384;
constexpr size_t PSLAB_STRIDE = (size_t)8192 * 64;
#define PSLAB(tok, col) ((size_t)((col) >> 6) * PSLAB_STRIDE + (size_t)(tok) * 64 + (size_t)((col) & 63))
constexpr float EPS = 1e-6f;
constexpr size_t MiB = 1u << 20;
constexpr size_t WS_CTL = 0;
constexpr size_t WS_LBF = 64 * 1024, WS_LBB = WS_LBF + 4096, WS_ROWSS = 128 * 1024  , WS_SKB = 256 * 1024  , WS_DEC = 512 * 1024  ;
constexpr size_t WS_WIN = 1 * MiB;
constexpr size_t WS_MERGED = WS_WIN;
constexpr size_t WS_WUP = 51 * MiB, WS_WOUT = 59 * MiB, WS_WQ = 67 * MiB, WS_WKV = 75 * MiB;
constexpr size_t WS_KVM = 79 * MiB, WS_KVMT = 80 * MiB;
constexpr size_t WS_MEMN = 81 * MiB;
constexpr size_t WS_LSE = 83 * MiB;
constexpr size_t WS_D = 84 * MiB;
constexpr size_t WS_IDX = 85 * MiB, WS_GATE = 89 * MiB;
constexpr size_t WS_UQ = 93 * MiB, WS_VQ = 125 * MiB;
constexpr size_t WS_SU = 157 * MiB, WS_SV = 157 * MiB + 65536;
constexpr size_t WS_H = 221 * MiB;
constexpr size_t WS_OCAT = WS_H;
constexpr size_t WS_ST = 253 * MiB;
constexpr size_t WS_PROJ = 301 * MiB;
constexpr size_t WS_XG = WS_PROJ, WS_QP = WS_PROJ + 32 * MiB, WS_SC = WS_PROJ + 64 * MiB;
constexpr size_t WS_RSP = 501 * MiB;
constexpr size_t WS_XQ = WS_PROJ + 128 * MiB;
constexpr size_t WS_SX = WS_PROJ + 144 * MiB;
constexpr size_t WS_PA = WS_PROJ + 145 * MiB;
constexpr size_t WS_G8 = 162 * MiB;
constexpr size_t WS_SA = 160 * MiB, WS_SB = 160 * MiB + 65536;
constexpr size_t WS_CMAX = 502 * MiB + 512 * 1024;
constexpr size_t WS_BAR = 502 * MiB;
constexpr size_t BAR_REGION = 20480, BAR_ZERO = 640 * 1024;
constexpr size_t WS_END = 503 * MiB;
constexpr int LDS_BYTES = 156928;
#define GAS __attribute__((address_space(1)))
#define LAS __attribute__((address_space(3)))
typedef unsigned short bf16;
typedef unsigned v4u __attribute__((ext_vector_type(4)));
typedef unsigned v2u __attribute__((ext_vector_type(2)));
typedef float f32x4 __attribute__((ext_vector_type(4)));
typedef float f32x16 __attribute__((ext_vector_type(16)));
typedef short bf16x8 __attribute__((ext_vector_type(8)));
__device__ __forceinline__ float bf2f(unsigned short h) { return __uint_as_float(((unsigned)h) << 16); }
typedef __bf16 hwbf2 __attribute__((ext_vector_type(2)));
typedef float f32x2_ __attribute__((ext_vector_type(2)));
__device__ __forceinline__ unsigned pk2(float lo, float hi) { const f32x2_ v = {lo, hi}; return __builtin_bit_cast(unsigned, __builtin_convertvector(v, hwbf2)); }
__device__ __forceinline__ unsigned f2bf(float f) { return pk2(f, f) & 0xffffu; }
template <int CTRL> __device__ __forceinline__ float dpp5_(float v) { return __builtin_bit_cast(float, __builtin_amdgcn_update_dpp(0, __builtin_bit_cast(int, v), CTRL, 0xf, 0xf, true)); }
__device__ __forceinline__ float rl5_(float v, int l) { return __builtin_bit_cast(float, __builtin_amdgcn_readlane(__builtin_bit_cast(int, v), l)); }
__device__ __forceinline__ float wave_sum(float v) {
    v += dpp5_<0xB1>(v); v += dpp5_<0x4E>(v); v += dpp5_<0x141>(v); v += dpp5_<0x140>(v);
    return (rl5_(v, 0) + rl5_(v, 16)) + (rl5_(v, 32) + rl5_(v, 48));
}
__device__ __forceinline__ float wave_max(float v) {
    v = fmaxf(v, dpp5_<0xB1>(v)); v = fmaxf(v, dpp5_<0x4E>(v)); v = fmaxf(v, dpp5_<0x141>(v)); v = fmaxf(v, dpp5_<0x140>(v));
    return fmaxf(fmaxf(rl5_(v, 0), rl5_(v, 16)), fmaxf(rl5_(v, 32), rl5_(v, 48)));
}
__device__ __forceinline__ float row_rstd(const float* rsp, int t) {
    const f32x4* q = (const f32x4*)(rsp + (size_t)t * 32); float s = 0.f;
#pragma unroll
    for (int i = 0; i < 8; ++i) { const f32x4 v = q[i]; s += (v.x + v.y) + (v.z + v.w); }
    return rsqrtf(s * (1.f / 2048.f) + 1e-6f);
}
__device__ __forceinline__ float sigmoidf_(float x) { return __builtin_amdgcn_rcpf(1.0f + __expf(-x)); }

struct P {
    const GAS float *x, *mem, *g_mix, *w_in, *b_gate, *lbf_l, *lbb_l, *g_hg, *w_kv, *g_mem, *w_up, *w_out, *g_ffn, *w_q, *subk, *pu, *pv, *g_final;
    GAS float* out; GAS float* dst10; GAS unsigned char* ws; int ph_lo, ph_hi;
};
#define WSP(T_, off) ((T_*)(GAS T_*)(p.ws + (off)))

__device__ __forceinline__ void p0_transpose_item(const float* W, int K, int N, bf16* WT, float* scr, int item, int lane, const float* ks = nullptr) {
    const int nblk = N / 32, kb = item / nblk, nb = item % nblk, k0 = 64 * kb, n0 = 32 * nb;
#pragma unroll
    for (int i = 0; i < 8; ++i) { const int kk = 8 * i + (lane >> 3), nq = (lane & 7) * 4; const f32x4 v = __builtin_nontemporal_load((const f32x4*)(W + (size_t)(k0 + kk) * N + n0 + nq));
        const float sc = ks ? ks[k0 + kk] : 1.f; float* d = scr + kk * 33 + nq; d[0] = v.x * sc; d[1] = v.y * sc; d[2] = v.z * sc; d[3] = v.w * sc; }
    asm volatile("s_waitcnt lgkmcnt(0)" ::: "memory");
    const int c = lane & 7;
#pragma unroll
    for (int j = 0; j < 4; ++j) { const int n = (lane >> 3) + 8 * j; const float* s = scr + (8 * c) * 33 + n;
        v4u o; o.x = pk2(s[0 * 33], s[1 * 33]); o.y = pk2(s[2 * 33], s[3 * 33]); o.z = pk2(s[4 * 33], s[5 * 33]); o.w = pk2(s[6 * 33], s[7 * 33]);
        *(v4u*)(WT + (size_t)(n0 + n) * K + k0 + 8 * c) = o; }
    asm volatile("s_waitcnt lgkmcnt(0)" ::: "memory");
}
__device__ __forceinline__ void rms_row_to_bf16(const float* xrow, const float* g, bf16* orow, int lane) {
    const f32x4* xr = (const f32x4*)xrow + lane; const f32x4* gr = (const f32x4*)g + lane;
    f32x4 v[8]; float s = 0.f;
#pragma unroll
    for (int j = 0; j < 8; ++j) { v[j] = xr[64 * j]; s += (v[j].x * v[j].x + v[j].y * v[j].y) + (v[j].z * v[j].z + v[j].w * v[j].w); }
    const float rstd = rsqrtf(wave_sum(s) * (1.f / DM) + EPS);
    v2u* o8 = (v2u*)orow + lane;
#pragma unroll
    for (int j = 0; j < 8; ++j) { const f32x4 gg = gr[64 * j]; v2u w; w.x = pk2(v[j].x * rstd * gg.x, v[j].y * rstd * gg.y); w.y = pk2(v[j].z * rstd * gg.z, v[j].w * rstd * gg.w); o8[64 * j] = w; }
}
__device__ __forceinline__ unsigned q8b(float v, float inv) { return (unsigned)((int)rintf(v * inv)) & 0xffu; }
__device__ __forceinline__ void rms_row_to_i8(const float* xrow, const float* g, unsigned char* orow, float* scale, int lane) {
    const f32x4* xr = (const f32x4*)xrow + lane; const f32x4* gr = (const f32x4*)g + lane;
    f32x4 v[8]; float s = 0.f;
#pragma unroll
    for (int j = 0; j < 8; ++j) { v[j] = xr[64 * j]; s += (v[j].x * v[j].x + v[j].y * v[j].y) + (v[j].z * v[j].z + v[j].w * v[j].w); }
    const float rstd = rsqrtf(wave_sum(s) * (1.f / DM) + EPS); float m = 0.f;
#pragma unroll
    for (int j = 0; j < 8; ++j) { const f32x4 gg = gr[64 * j]; v[j] = v[j] * rstd * gg; m = fmaxf(fmaxf(m, fmaxf(fabsf(v[j].x), fabsf(v[j].y))), fmaxf(fabsf(v[j].z), fabsf(v[j].w))); }
    m = fmaxf(wave_max(m), 1e-30f); const float inv = 127.f / m;
    unsigned* o = (unsigned*)orow + lane;
#pragma unroll
    for (int j = 0; j < 8; ++j) o[64 * j] = q8b(v[j].x, inv) | (q8b(v[j].y, inv) << 8) | (q8b(v[j].z, inv) << 16) | (q8b(v[j].w, inv) << 24);
    if (lane == 0) *scale = m * (1.f / 127.f);
}
__device__ __forceinline__ void p0_qtranspose_item(const float* W, int K, int N, unsigned char* W8T, const unsigned* cmax, float* sb, float* scr, int item, int lane) {
    const int nblk = N / 32, kb = item / nblk, nb = item % nblk, k0 = 64 * kb, n0 = 32 * nb;
#pragma unroll
    for (int i = 0; i < 8; ++i) { const int kk = 8 * i + (lane >> 3), nq = (lane & 7) * 4; const f32x4 v = *(const f32x4*)(W + (size_t)(k0 + kk) * N + n0 + nq);
        float* d = scr + kk * 33 + nq; d[0] = v.x; d[1] = v.y; d[2] = v.z; d[3] = v.w; }
    asm volatile("s_waitcnt lgkmcnt(0)" ::: "memory");
    const int c = lane & 7;
#pragma unroll
    for (int j = 0; j < 4; ++j) { const int n = (lane >> 3) + 8 * j; const float* s = scr + (8 * c) * 33 + n;
        const float m = fmaxf(__uint_as_float(cmax[n0 + n]), 1e-30f), inv = 127.f / m;
        v2u o; o.x = q8b(s[0 * 33], inv) | (q8b(s[1 * 33], inv) << 8) | (q8b(s[2 * 33], inv) << 16) | (q8b(s[3 * 33], inv) << 24);
        o.y = q8b(s[4 * 33], inv) | (q8b(s[5 * 33], inv) << 8) | (q8b(s[6 * 33], inv) << 16) | (q8b(s[7 * 33], inv) << 24);
        *(v2u*)(W8T + (size_t)(n0 + n) * K + k0 + 8 * c) = o;
        if (kb == 0 && c == 0) sb[n0 + n] = m * (1.f / 127.f); }
    asm volatile("s_waitcnt lgkmcnt(0)" ::: "memory");
}
__device__ __forceinline__ void p0_win_strip(const P& p, unsigned char* lds, int strip) {
    const int tid = tidx(), lane = tid & 63, wave = tid >> 6;
    const int n0 = strip * 32 + 4 * (lane & 7), kbase = 256 * wave + 32 * (lane >> 3);
    const float* wp = ((const float*)p.w_in) + (size_t)kbase * NIN + n0;
    f32x4 v[32];
#pragma unroll
    for (int i = 0; i < 32; ++i) v[i] = __builtin_nontemporal_load((const f32x4*)(wp + (size_t)i * NIN));
    f32x4 m = {0.f, 0.f, 0.f, 0.f};
#pragma unroll
    for (int i = 0; i < 32; ++i) { m.x = fmaxf(m.x, fabsf(v[i].x)); m.y = fmaxf(m.y, fabsf(v[i].y)); m.z = fmaxf(m.z, fabsf(v[i].z)); m.w = fmaxf(m.w, fabsf(v[i].w)); }
#pragma unroll
    for (int d = 8; d < 64; d <<= 1) { m.x = fmaxf(m.x, __shfl_xor(m.x, d)); m.y = fmaxf(m.y, __shfl_xor(m.y, d)); m.z = fmaxf(m.z, __shfl_xor(m.z, d)); m.w = fmaxf(m.w, __shfl_xor(m.w, d)); }
    float* red = (float*)lds;
    __syncthreads();
    if (lane < 8) *(f32x4*)(red + wave * 32 + 4 * lane) = m;
    __syncthreads();
    f32x4 mm = *(const f32x4*)(red + 4 * (lane & 7));
#pragma unroll
    for (int w = 1; w < 8; ++w) { const f32x4 t = *(const f32x4*)(red + w * 32 + 4 * (lane & 7)); mm.x = fmaxf(mm.x, t.x); mm.y = fmaxf(mm.y, t.y); mm.z = fmaxf(mm.z, t.z); mm.w = fmaxf(mm.w, t.w); }
    mm.x = fmaxf(mm.x, 1e-30f); mm.y = fmaxf(mm.y, 1e-30f); mm.z = fmaxf(mm.z, 1e-30f); mm.w = fmaxf(mm.w, 1e-30f);
    if (wave == 0 && lane < 8) *(f32x4*)(WSP(float, WS_SB) + n0) = mm * (1.f / 127.f);
    const float inv[4] = {127.f / mm.x, 127.f / mm.y, 127.f / mm.z, 127.f / mm.w};
    unsigned char* w8 = (unsigned char*)(p.ws + WS_WIN);
#pragma unroll
    for (int c = 0; c < 4; ++c) { unsigned d[8];
#pragma unroll
        for (int q = 0; q < 8; ++q) d[q] = q8b(v[4 * q][c], inv[c]) | (q8b(v[4 * q + 1][c], inv[c]) << 8) | (q8b(v[4 * q + 2][c], inv[c]) << 16) | (q8b(v[4 * q + 3][c], inv[c]) << 24);
        v4u lo, hi; lo.x = d[0]; lo.y = d[1]; lo.z = d[2]; lo.w = d[3]; hi.x = d[4]; hi.y = d[5]; hi.z = d[6]; hi.w = d[7];
        unsigned char* o = w8 + (size_t)(kbase >> 7) * ((size_t)NIN * 128) + (size_t)(n0 + c) * 128 + (kbase & 127); *(v4u*)o = lo; *(v4u*)(o + 16) = hi; }
}
__device__ __forceinline__ void phase0(const P& p, unsigned char* lds, int vcu, int G, int bx) {
    const int tid = tidx(), lane = tid & 63, wave = tid >> 6;
    float* scr = (float*)(lds + wave * 16384);
    const int gw = vcu * NWAVES + wave, NGW = G * NWAVES;
    for (int strip = bx; strip < NIN / 32; strip += G) p0_win_strip(p, lds, strip);
    __syncthreads();
    constexpr int I_KV = (DM / 64) * (1024 / 32);
    for (int it = gw; it < I_KV; it += NGW) p0_transpose_item(((const float*)p.w_kv), DM, 1024, WSP(bf16, WS_WKV), scr, it, lane);
    const int nstr2 = NIN / 32 - G;
    const bool wsplit = (G == 256);
    const int xcnt = wsplit ? (bx < nstr2 ? 18 : 50) : T / G, xbase = wsplit ? (bx < nstr2 ? bx * 18 : nstr2 * 18 + (bx - nstr2) * 50) : bx * (T / G);
    for (int r = wave; r < xcnt; r += 16) {
        const int m = xbase + r, m2 = m + 8; const bool two = r + 8 < xcnt;
        const f32x4* xa = (const f32x4*)(((const float*)p.x) + (size_t)m * DM) + lane; const f32x4* xb = (const f32x4*)(((const float*)p.x) + (size_t)(two ? m2 : m) * DM) + lane; const f32x4* gr = (const f32x4*)((const float*)p.g_mix) + lane;
        f32x4 va[8], vb[8], gmx[8]; float sa_ = 0.f, sb_ = 0.f;
#pragma unroll
        for (int j = 0; j < 8; ++j) gmx[j] = gr[64 * j];
#pragma unroll
        for (int j = 0; j < 8; ++j) { va[j] = __builtin_nontemporal_load(xa + 64 * j); vb[j] = __builtin_nontemporal_load(xb + 64 * j); }
#pragma unroll
        for (int j = 0; j < 8; ++j) { sa_ += (va[j].x * va[j].x + va[j].y * va[j].y) + (va[j].z * va[j].z + va[j].w * va[j].w); sb_ += (vb[j].x * vb[j].x + vb[j].y * vb[j].y) + (vb[j].z * vb[j].z + vb[j].w * vb[j].w); }
        const float ra = rsqrtf(wave_sum(sa_) * (1.f / DM) + EPS), rb = rsqrtf(wave_sum(sb_) * (1.f / DM) + EPS); float ma = 0.f, mb = 0.f;
#pragma unroll
        for (int j = 0; j < 8; ++j) { const f32x4 gg = gmx[j]; va[j] = va[j] * ra * gg; vb[j] = vb[j] * rb * gg;
            ma = fmaxf(fmaxf(ma, fmaxf(fabsf(va[j].x), fabsf(va[j].y))), fmaxf(fabsf(va[j].z), fabsf(va[j].w))); mb = fmaxf(fmaxf(mb, fmaxf(fabsf(vb[j].x), fabsf(vb[j].y))), fmaxf(fabsf(vb[j].z), fabsf(vb[j].w))); }
        ma = fmaxf(wave_max(ma), 1e-30f); mb = fmaxf(wave_max(mb), 1e-30f); const float ia = 127.f / ma, ib = 127.f / mb;
        unsigned* oa = (unsigned*)((unsigned char*)(p.ws + WS_H) + (size_t)(lane >> 5) * ((size_t)T * 128) + (size_t)m * 128) + (lane & 31); unsigned* ob = (unsigned*)((unsigned char*)(p.ws + WS_H) + (size_t)(lane >> 5) * ((size_t)T * 128) + (size_t)m2 * 128) + (lane & 31);
#pragma unroll
        for (int j = 0; j < 8; ++j) { oa[(size_t)j * (2 * T * 128 / 4)] = q8b(va[j].x, ia) | (q8b(va[j].y, ia) << 8) | (q8b(va[j].z, ia) << 16) | (q8b(va[j].w, ia) << 24);
            if (two) ob[(size_t)j * (2 * T * 128 / 4)] = q8b(vb[j].x, ib) | (q8b(vb[j].y, ib) << 8) | (q8b(vb[j].z, ib) << 16) | (q8b(vb[j].w, ib) << 24); }
        if (lane == 0) { WSP(float, WS_SA)[m] = ma * (1.f / 127.f); if (two) WSP(float, WS_SA)[m2] = mb * (1.f / 127.f); }
    }
    for (int m = gw; m < MROWS; m += NGW) rms_row_to_bf16(((const float*)p.mem) + (size_t)m * DM, ((const float*)p.g_mem), WSP(bf16, WS_MEMN) + (size_t)m * DM, lane);
    const size_t gt = (size_t)vcu * NTHR + tid, NGT = (size_t)G * NTHR;
    for (size_t i = gt; i < 32768; i += NGT) WSP(bf16, WS_SKB)[i] = (bf16)f2bf(((const float*)p.subk)[i]);
    for (size_t i = gt; i < 768; i += NGT) { WSP(float, WS_LBF)[i] = 1.0f / (1.0f + __expf(((const float*)p.lbf_l)[768 + i] - ((const float*)p.lbf_l)[i])); WSP(float, WS_LBB)[i] = 1.0f / (1.0f + __expf(((const float*)p.lbb_l)[768 + i] - ((const float*)p.lbb_l)[i])); }
}
__device__ __forceinline__ void phase0b(const P& p, unsigned char* lds, int vcu, int G) {}
__device__ __forceinline__ void tail_prep(const P& p, unsigned char* lds, int wi, int nw, int row_hi = 2 * NEXP) {
    const int tid = tidx(), lane = tid & 63, wave = tid >> 6;
    float* scr = (float*)(lds + wave * 16384);
    const int gw = wi * NWAVES + wave, NGW = nw * NWAVES;
    for (int r4 = gw * 4; r4 < row_hi; r4 += NGW * 4) {
        f32x4 v[4][8], gf[8];
#pragma unroll
        for (int j = 0; j < 8; ++j) gf[j] = ((const f32x4*)((const float*)p.g_ffn))[64 * j + lane];
#pragma unroll
        for (int q = 0; q < 4; ++q) { const int r2 = r4 + q, isv = r2 >= NEXP, row = isv ? r2 - NEXP : r2; const f32x4* xr = (const f32x4*)((isv ? ((const float*)p.pv) : ((const float*)p.pu)) + (size_t)row * DM) + lane;
#pragma unroll
            for (int j = 0; j < 8; ++j) v[q][j] = __builtin_nontemporal_load(xr + 64 * j); }
#pragma unroll
        for (int q = 0; q < 4; ++q) { const int r2 = r4 + q, isv = r2 >= NEXP, row = isv ? r2 - NEXP : r2; float m = 0.f;
            if (!isv) {
#pragma unroll
                for (int j = 0; j < 8; ++j) v[q][j] = v[q][j] * gf[j]; }
#pragma unroll
            for (int j = 0; j < 8; ++j) m = fmaxf(fmaxf(m, fmaxf(fabsf(v[q][j].x), fabsf(v[q][j].y))), fmaxf(fabsf(v[q][j].z), fabsf(v[q][j].w)));
            m = fmaxf(wave_max(m), 1e-30f); const float inv = 127.f / m;
            unsigned* o = (unsigned*)(p.ws + (isv ? WS_VQ : WS_UQ) + (size_t)(lane >> 5) * (NEXP * 128) + (size_t)row * 128) + (lane & 31);
#pragma unroll
            for (int j = 0; j < 8; ++j) o[(size_t)j * (2 * NEXP * 128 / 4)] = q8b(v[q][j].x, inv) | (q8b(v[q][j].y, inv) << 8) | (q8b(v[q][j].z, inv) << 16) | (q8b(v[q][j].w, inv) << 24);
            if (lane == 0) WSP(float, isv ? WS_SV : WS_SU)[row] = m * (1.f / 127.f); }
    }
    constexpr int I_SQ = (DM / 64) * (DM / 32);
    const GAS float *w0 = p.w_up, *w1 = p.w_out, *w2 = p.w_q; asm volatile("" : "+s"(w0), "+s"(w1), "+s"(w2));
    auto tload = [&](int it, f32x4 (&v)[8], float (&sc)[8]) {
        const int m = it / I_SQ, item = it - m * I_SQ, kb = item / (DM / 32), nb = item % (DM / 32), k0 = 64 * kb, n0 = 32 * nb;
        const float* Wm = m == 0 ? (const float*)w0 : (m == 1 ? (const float*)w1 : (const float*)w2);
#pragma unroll
        for (int i = 0; i < 8; ++i) { const int kk = 8 * i + (lane >> 3), nq = (lane & 7) * 4; v[i] = __builtin_nontemporal_load((const f32x4*)(Wm + (size_t)(k0 + kk) * DM + n0 + nq));
            sc[i] = (m == 2) ? ((const float*)p.g_ffn)[k0 + kk] : 1.f; } };
    auto tfinish = [&](int it, const f32x4 (&v)[8], const float (&sc)[8]) {
        const int m = it / I_SQ, item = it - m * I_SQ, kb = item / (DM / 32), nb = item % (DM / 32), k0 = 64 * kb, n0 = 32 * nb;
        bf16* WT = (bf16*)(GAS bf16*)(p.ws + (m == 0 ? WS_WUP : (m == 1 ? WS_WOUT : WS_WQ)));
#pragma unroll
        for (int i = 0; i < 8; ++i) { const int kk = 8 * i + (lane >> 3), nq = (lane & 7) * 4; float* d = scr + kk * 33 + nq; d[0] = v[i].x * sc[i]; d[1] = v[i].y * sc[i]; d[2] = v[i].z * sc[i]; d[3] = v[i].w * sc[i]; }
        asm volatile("s_waitcnt lgkmcnt(0)" ::: "memory");
        const int c = lane & 7;
#pragma unroll
        for (int j = 0; j < 4; ++j) { const int n = (lane >> 3) + 8 * j; const float* s = scr + (8 * c) * 33 + n;
            v4u o; o.x = pk2(s[0 * 33], s[1 * 33]); o.y = pk2(s[2 * 33], s[3 * 33]); o.z = pk2(s[4 * 33], s[5 * 33]); o.w = pk2(s[6 * 33], s[7 * 33]);
            *(v4u*)(WT + (size_t)(n0 + n) * DM + k0 + 8 * c) = o; }
        asm volatile("s_waitcnt lgkmcnt(0)" ::: "memory"); };
    { f32x4 vc[8]; float sc[8];
      int it = gw; if (it < 3 * I_SQ) tload(it, vc, sc);
      for (; it < 3 * I_SQ; it += NGW) { f32x4 vn[8]; float sn[8]; const bool more = it + NGW < 3 * I_SQ; if (more) tload(it + NGW, vn, sn);
          tfinish(it, vc, sc);
          if (more) {
#pragma unroll
              for (int i = 0; i < 8; ++i) { vc[i] = vn[i]; sc[i] = sn[i]; } } } }
}
typedef GAS unsigned gu32;
typedef GAS unsigned long long gu64;
#define RLX_AGENT __ATOMIC_RELAXED, __HIP_MEMORY_SCOPE_AGENT
__device__ __forceinline__ unsigned long long rt() { return __builtin_amdgcn_s_memrealtime(); }
#define XB_TMO      128
#define XB_XCNT(j)  (256  + 64 * (j))
#define XB_XSUB(j)  (1280 + 64 * (j))
#define XB_XGEN(j)  (2304 + 64 * (j))
#define XB_TOP      3328
#define XB_TOPGEN   3392
#define XCD_BAR_WORDS 3456
#define XB_SPIN_CAP (1u << 21)

__device__ __forceinline__ unsigned xb_ld(unsigned* p)              { return __hip_atomic_load(p, __ATOMIC_RELAXED, __HIP_MEMORY_SCOPE_AGENT); }
__device__ __forceinline__ unsigned xb_add(unsigned* p, unsigned v) { return __hip_atomic_fetch_add(p, v, __ATOMIC_RELAXED, __HIP_MEMORY_SCOPE_AGENT); }
__device__ __forceinline__ unsigned xb_xcc_id() { return (unsigned)__builtin_amdgcn_s_getreg((3 << 11) | 20) & 0xFu; }
#define XB_SPIN(cond, bar) do { unsigned _sp = 0; while (cond) { __builtin_amdgcn_s_sleep(1); \
    if ((++_sp & 255u) == 0u) { if (xb_ld(&(bar)[XB_TMO])) break; if (_sp > XB_SPIN_CAP) { atomicAdd(&(bar)[XB_TMO], 1u); break; } } } } while (0)

struct XcdBarrier {
    unsigned* bar; unsigned x;
    volatile LAS unsigned* st;
};

__device__ __forceinline__ XcdBarrier xcd_barrier_post(unsigned* bar, volatile LAS unsigned* st) {
    XcdBarrier b; b.bar = bar; b.x = xb_xcc_id(); b.st = st;
    if (threadIdx.x == 0) (void)xb_add(&bar[XB_XCNT(b.x)], 1u);
    return b;
}
__device__ __forceinline__ void xcd_barrier_complete(unsigned* bar, unsigned x, unsigned& nloc, unsigned& nx) {
    const unsigned G = gridDim.x * gridDim.y * gridDim.z;
    unsigned sum, cnt, mine, sp = 0u;
    for (;;) {
        sum = 0u; cnt = 0u; mine = 0u;
#pragma unroll
        for (unsigned j = 0; j < 16; ++j) { const unsigned c = xb_ld(&bar[XB_XCNT(j)]); sum += c; cnt += (c > 0u) ? 1u : 0u; mine = (j == x) ? c : mine; }
        if (sum == G) break;
        __builtin_amdgcn_s_sleep(1);
        if ((++sp & 255u) == 0u) { if (xb_ld(&bar[XB_TMO])) break; if (sp > XB_SPIN_CAP) { atomicAdd(&bar[XB_TMO], 1u); break; } }
    }
    nloc = mine > 0u ? mine : 1u; nx = cnt > 0u ? cnt : 1u;
}

template <bool REL = true, bool ACQ = true> __device__ __forceinline__ void xcd_barrier(const XcdBarrier& b) {
    asm volatile("s_waitcnt vmcnt(0)" ::: "memory");
    __syncthreads();
    if (threadIdx.x == 0) {
        unsigned* bar = b.bar;
        __builtin_amdgcn_s_waitcnt(0);
        unsigned nloc = b.st[0], nx = b.st[1];
        if (nloc == 0u) { xcd_barrier_complete(bar, b.x, nloc, nx); b.st[0] = nloc; b.st[1] = nx; }
        const unsigned old = xb_add(&bar[XB_XSUB(b.x)], 1u);
        const unsigned gen = old / nloc;
        if (old + 1u == (gen + 1u) * nloc) {
            if constexpr (REL) __builtin_amdgcn_fence(__ATOMIC_RELEASE, "agent");
            asm volatile("s_waitcnt vmcnt(0)" ::: "memory");
            (void)xb_add(&bar[XB_TOP], 1u);
        }
        const unsigned target = (gen + 1u) * nx;
        XB_SPIN((int)(xb_ld(&bar[XB_TOP]) - target) < 0, bar);
        if constexpr (ACQ) __builtin_amdgcn_fence(__ATOMIC_ACQUIRE, "agent");
        asm volatile("s_waitcnt vmcnt(0)" ::: "memory");
    }
    __syncthreads();
}
__device__ __forceinline__ f32x16 mfma32(bf16x8 a, bf16x8 b, f32x16 c) { return __builtin_amdgcn_mfma_f32_32x32x16_bf16(a, b, c, 0, 0, 0); }
__device__ __forceinline__ f32x4 mfma16(bf16x8 a, bf16x8 b, f32x4 c) { return __builtin_amdgcn_mfma_f32_16x16x32_bf16(a, b, c, 0, 0, 0); }
template <int CTRL> __device__ __forceinline__ float dppf(float v) { return __builtin_bit_cast(float, __builtin_amdgcn_update_dpp(0, __builtin_bit_cast(int, v), CTRL, 0xf, 0xf, true)); }
__device__ __forceinline__ float sum8(float v) { v += dppf<0xB1>(v); v += dppf<0x4E>(v); v += dppf<0x141>(v); return v; }
__device__ __forceinline__ float max8(float v) { v = fmaxf(v, dppf<0xB1>(v)); v = fmaxf(v, dppf<0x4E>(v)); v = fmaxf(v, dppf<0x141>(v)); return v; }
__device__ __forceinline__ f32x16 zero16() { f32x16 z; for (int i = 0; i < 16; ++i) z[i] = 0.f; return z; }
constexpr float ST_SC = 16.f, ST_ISC = 1.f / 16.f;
__device__ __forceinline__ float st_cl(float x) { return __builtin_amdgcn_fmed3f(x * ST_SC, -448.f, 448.f); }
__device__ __forceinline__ unsigned st_pack4(float a, float b, float c, float d) { int w = 0; w = __builtin_amdgcn_cvt_pk_fp8_f32(st_cl(a), st_cl(b), w, false); w = __builtin_amdgcn_cvt_pk_fp8_f32(st_cl(c), st_cl(d), w, true); return (unsigned)w; }
__device__ __forceinline__ void st_unpack4(unsigned w, float (&f)[4]) { const f32x2_ lo = __builtin_amdgcn_cvt_pk_f32_fp8((int)w, false), hi = __builtin_amdgcn_cvt_pk_f32_fp8((int)w, true); f[0] = lo.x * ST_ISC; f[1] = lo.y * ST_ISC; f[2] = hi.x * ST_ISC; f[3] = hi.y * ST_ISC; }
__device__ __forceinline__ bf16x8 st_frag(v2u w) { float a[4], b[4]; st_unpack4(w.x, a); st_unpack4(w.y, b); v4u o; o.x = pk2(a[0], a[1]); o.y = pk2(a[2], a[3]); o.z = pk2(b[0], b[1]); o.w = pk2(b[2], b[3]); return __builtin_bit_cast(bf16x8, o); }

__device__ __forceinline__ void h1_load(const P& p, int item, unsigned short (&zr)[16], unsigned short (&vr)[16], float& lbv) {
    const int tid = tidx(), c = tid & 127, tq = tid >> 7;
    const int n = item & 63, dir = (item >> 6) & 1, bh = item >> 7, b = bh / 6, h = bh % 6;
    const bf16* proj = WSP(const bf16, WS_PROJ) + (size_t)(b * SEQ + n * 64) * NIN;
    const int zc = (dir ? C_ZB : C_ZF) + h * 128 + c, vc = C_V + h * 128 + c;
    lbv = WSP(const float, dir ? WS_LBB : WS_LBF)[h * 128 + c];
#pragma unroll
    for (int i = 0; i < 16; ++i) { const int s = tq * 16 + i; zr[i] = proj[(size_t)s * NIN + zc]; vr[i] = proj[(size_t)s * NIN + vc]; }
}
__device__ __forceinline__ void h1_item(const P& p, unsigned char* lds, int item, const unsigned short (&zr)[16], const unsigned short (&vr)[16], const float lb) {
    const int tid = tidx(), lane = tid & 63, wave = tid >> 6, c = tid & 127, tq = tid >> 7;
    const int n = item & 63, dir = (item >> 6) & 1, bh = item >> 7, b = bh / 6, h = bh % 6, chain = bh * 2 + dir;
    const bf16* proj = WSP(const bf16, WS_PROJ) + (size_t)(b * SEQ + n * 64) * NIN;
    const int zc = (dir ? C_ZB : C_ZF) + h * 128 + c, vc = C_V + h * 128 + c;
    float* segs = (float*)lds;
    bf16* KhT = (bf16*)(lds + 2048);
    bf16* VT = (bf16*)(lds + 2048 + 18432);
    float fv[16]; float seg = 1.f;
#pragma unroll
    for (int i = 0; i < 16; ++i) { const int s = tq * 16 + i; const float z = bf2f(zr[i]); const float f = lb + (1.f - lb) * sigmoidf_(z);
        fv[i] = f; seg *= f; VT[c * 72 + s] = vr[i]; }
    segs[tq * 128 + c] = seg;
    __syncthreads();
    const float s0 = segs[c], s1 = segs[128 + c], s2 = segs[256 + c], s3 = segs[384 + c];
    if (dir == 0) { float run = (tq < 1 ? s1 : 1.f) * (tq < 2 ? s2 : 1.f) * (tq < 3 ? s3 : 1.f);
#pragma unroll
        for (int i = 15; i >= 0; --i) { KhT[c * 72 + tq * 16 + i] = (bf16)f2bf((1.f - fv[i]) * run); run *= fv[i]; } }
    else { float run = (tq > 0 ? s0 : 1.f) * (tq > 1 ? s1 : 1.f) * (tq > 2 ? s2 : 1.f);
#pragma unroll
        for (int i = 0; i < 16; ++i) { KhT[c * 72 + tq * 16 + i] = (bf16)f2bf((1.f - fv[i]) * run); run *= fv[i]; } }
    if (tq == 0) WSP(float, WS_D)[(size_t)(chain * 64 + n) * 128 + c] = (s0 * s1) * (s2 * s3);
    __syncthreads();
    const int r32 = lane & 31, hi = lane >> 5, dvt = wave >> 1, c0 = (wave & 1) * 64;
    f32x16 acc0 = zero16(), acc1 = zero16();
#pragma unroll
    for (int ks = 0; ks < 4; ++ks) {
        const bf16x8 a = *(const bf16x8*)(VT + (dvt * 32 + r32) * 72 + ks * 16 + hi * 8);
        const bf16x8 b0 = *(const bf16x8*)(KhT + (c0 + r32) * 72 + ks * 16 + hi * 8), b1 = *(const bf16x8*)(KhT + (c0 + 32 + r32) * 72 + ks * 16 + hi * 8);
        acc0 = mfma32(b0, a, acc0); acc1 = mfma32(b1, a, acc1); }
    bf16* st = WSP(bf16, WS_ST) + (size_t)(chain * 64 + n) * 16384 + (size_t)(dvt * 32 + r32) * 128 + c0 + 4 * hi;
#pragma unroll
    for (int q = 0; q < 4; ++q) { v2u w0, w1; w0.x = pk2(acc0[4 * q], acc0[4 * q + 1]); w0.y = pk2(acc0[4 * q + 2], acc0[4 * q + 3]); w1.x = pk2(acc1[4 * q], acc1[4 * q + 1]); w1.y = pk2(acc1[4 * q + 2], acc1[4 * q + 3]);
        *(v2u*)(st + 8 * q) = w0; *(v2u*)(st + 32 + 8 * q) = w1; }
    __syncthreads();
}

__device__ __forceinline__ void h1d_load(const P& p, int item, unsigned short (&zf)[16], unsigned short (&zb)[16], unsigned short (&vr)[16], float& lbf, float& lbb) {
    const int tid = tidx(), c = tid & 127, tq = tid >> 7;
    const int n = item & 63, bh = item >> 6, b = bh / 6, h = bh % 6;
    const bf16* proj = WSP(const bf16, WS_PROJ) + PSLAB((size_t)(b * SEQ + n * 64 + tq * 16), h * 128 + c);
    lbf = WSP(const float, WS_LBF)[h * 128 + c]; lbb = WSP(const float, WS_LBB)[h * 128 + c];
#pragma unroll
    for (int i = 0; i < 16; ++i) { const size_t o = (size_t)i * 64; zf[i] = proj[o + (C_ZF >> 6) * PSLAB_STRIDE]; zb[i] = proj[o + (C_ZB >> 6) * PSLAB_STRIDE]; vr[i] = proj[o + (C_V >> 6) * PSLAB_STRIDE]; }
}
__device__ __forceinline__ void h1d_item(const P& p, unsigned char* lds, int item, const unsigned short (&zf)[16], const unsigned short (&zb)[16], const unsigned short (&vr)[16], const float lbf, const float lbb) {
    const int tid = tidx(), lane = tid & 63, wave = tid >> 6, c = tid & 127, tq = tid >> 7;
    const int n = item & 63, bh = item >> 6;
    float* segs = (float*)lds;
    bf16* KF = (bf16*)(lds + 4096);
    bf16* KB = (bf16*)(lds + 4096 + 18432);
    bf16* VT = (bf16*)(lds + 4096 + 2 * 18432);
    float ff[16], fb[16]; float sf = 1.f, sb = 1.f;
#pragma unroll
    for (int i = 0; i < 16; ++i) { const int s = tq * 16 + i;
        ff[i] = lbf + (1.f - lbf) * sigmoidf_(bf2f(zf[i])); fb[i] = lbb + (1.f - lbb) * sigmoidf_(bf2f(zb[i])); sf *= ff[i]; sb *= fb[i]; VT[c * 72 + s] = vr[i]; }
    segs[tq * 128 + c] = sf; segs[512 + tq * 128 + c] = sb;
    __syncthreads();
    { const float s0 = segs[c], s1 = segs[128 + c], s2 = segs[256 + c], s3 = segs[384 + c];
      float run = (tq < 1 ? s1 : 1.f) * (tq < 2 ? s2 : 1.f) * (tq < 3 ? s3 : 1.f);
#pragma unroll
      for (int i = 15; i >= 0; --i) { KF[c * 72 + tq * 16 + i] = (bf16)f2bf((1.f - ff[i]) * run); run *= ff[i]; }
      if (tq == 0) WSP(float, WS_D)[(size_t)((bh * 2 + 0) * 64 + n) * 128 + c] = (s0 * s1) * (s2 * s3); }
    { const float s0 = segs[512 + c], s1 = segs[512 + 128 + c], s2 = segs[512 + 256 + c], s3 = segs[512 + 384 + c];
      float run = (tq > 0 ? s0 : 1.f) * (tq > 1 ? s1 : 1.f) * (tq > 2 ? s2 : 1.f);
#pragma unroll
      for (int i = 0; i < 16; ++i) { KB[c * 72 + tq * 16 + i] = (bf16)f2bf((1.f - fb[i]) * run); run *= fb[i]; }
      if (tq == 1) WSP(float, WS_D)[(size_t)((bh * 2 + 1) * 64 + n) * 128 + c] = (s0 * s1) * (s2 * s3); }
    __syncthreads();
    const int r32 = lane & 31, hi = lane >> 5, dvt = wave >> 1, c0 = (wave & 1) * 64;
    f32x16 af0 = zero16(), af1 = zero16(), ab0 = zero16(), ab1 = zero16();
#pragma unroll
    for (int ks = 0; ks < 4; ++ks) {
        const bf16x8 a = *(const bf16x8*)(VT + (dvt * 32 + r32) * 72 + ks * 16 + hi * 8);
        const bf16x8 f0 = *(const bf16x8*)(KF + (c0 + r32) * 72 + ks * 16 + hi * 8), f1 = *(const bf16x8*)(KF + (c0 + 32 + r32) * 72 + ks * 16 + hi * 8);
        const bf16x8 b0 = *(const bf16x8*)(KB + (c0 + r32) * 72 + ks * 16 + hi * 8), b1 = *(const bf16x8*)(KB + (c0 + 32 + r32) * 72 + ks * 16 + hi * 8);
        af0 = mfma32(f0, a, af0); af1 = mfma32(f1, a, af1); ab0 = mfma32(b0, a, ab0); ab1 = mfma32(b1, a, ab1); }
    unsigned char* stf = WSP(unsigned char, WS_ST) + (size_t)((bh * 2 + 0) * 64 + n) * 16384 + (size_t)(dvt * 32 + r32) * 128 + c0 + 4 * hi;
    unsigned char* stb = WSP(unsigned char, WS_ST) + (size_t)((bh * 2 + 1) * 64 + n) * 16384 + (size_t)(dvt * 32 + r32) * 128 + c0 + 4 * hi;
#pragma unroll
    for (int q = 0; q < 4; ++q) {
        *(unsigned*)(stf + 8 * q) = st_pack4(af0[4 * q], af0[4 * q + 1], af0[4 * q + 2], af0[4 * q + 3]); *(unsigned*)(stf + 32 + 8 * q) = st_pack4(af1[4 * q], af1[4 * q + 1], af1[4 * q + 2], af1[4 * q + 3]);
        *(unsigned*)(stb + 8 * q) = st_pack4(ab0[4 * q], ab0[4 * q + 1], ab0[4 * q + 2], ab0[4 * q + 3]); *(unsigned*)(stb + 32 + 8 * q) = st_pack4(ab1[4 * q], ab1[4 * q + 1], ab1[4 * q + 2], ab1[4 * q + 3]); }
    __syncthreads();
}

__device__ __forceinline__ void h2_scan(const P& p, int bx, int G, unsigned char* sdst) {
    const int gt = bx * NTHR + tidx(), NGT = G * NTHR;
    for (int w = gt; w < 24 * 4096; w += NGT) {
        const int chain = w >> 12, e4 = w & 4095, c4 = (e4 & 31) * 4, dir = chain & 1;
        float run[4] = {0.f, 0.f, 0.f, 0.f};
        for (int k0 = 0; k0 < 64; k0 += 8) {
            unsigned L[8]; f32x4 d[8];
#pragma unroll
            for (int j = 0; j < 8; ++j) { const int n = dir ? 63 - (k0 + j) : (k0 + j);
                L[j] = *(const unsigned*)(WSP(const unsigned char, WS_ST) + (size_t)(chain * 64 + n) * 16384 + e4 * 4);
                d[j] = *(const f32x4*)(WSP(const float, WS_D) + (size_t)(chain * 64 + n) * 128 + c4); }
#pragma unroll
            for (int j = 0; j < 8; ++j) { const int n = dir ? 63 - (k0 + j) : (k0 + j);
                *(unsigned*)(sdst + (size_t)(chain * 64 + n) * 16384 + e4 * 4) = st_pack4(run[0], run[1], run[2], run[3]);
                float l[4]; st_unpack4(L[j], l);
                run[0] = d[j].x * run[0] + l[0]; run[1] = d[j].y * run[1] + l[1]; run[2] = d[j].z * run[2] + l[2]; run[3] = d[j].w * run[3] + l[3]; }
        }
    }
}

__device__ __forceinline__ void h3_load_z(const P& p, int item, unsigned short (&zf)[16], unsigned short (&zb)[16], float& lbf, float& lbb) {
    const int tid = tidx(), c = tid & 127, tq = tid >> 7;
    const int n = item & 63, bh = item >> 6, b = bh / 6, h = bh % 6;
    const bf16* proj = WSP(const bf16, WS_PROJ) + PSLAB((size_t)(b * SEQ + n * 64 + tq * 16), h * 128 + c);
    lbf = WSP(const float, WS_LBF)[h * 128 + c]; lbb = WSP(const float, WS_LBB)[h * 128 + c];
#pragma unroll
    for (int i = 0; i < 16; ++i) { const size_t o = (size_t)i * 64; zf[i] = proj[o + (C_ZF >> 6) * PSLAB_STRIDE]; zb[i] = proj[o + (C_ZB >> 6) * PSLAB_STRIDE]; }
}
__device__ __forceinline__ void h3_load_vq(const P& p, int item, unsigned short (&vr)[16], unsigned short (&qr)[16]) {
    const int tid = tidx(), c = tid & 127, tq = tid >> 7;
    const int n = item & 63, bh = item >> 6, b = bh / 6, h = bh % 6;
    const bf16* proj = WSP(const bf16, WS_PROJ) + PSLAB((size_t)(b * SEQ + n * 64 + tq * 16), h * 128 + c);
#pragma unroll
    for (int i = 0; i < 16; ++i) { const size_t o = (size_t)i * 64; vr[i] = proj[o + (C_V >> 6) * PSLAB_STRIDE]; qr[i] = proj[o + (C_Q >> 6) * PSLAB_STRIDE]; }
}
__device__ __forceinline__ void h3_item(const P& p, unsigned char* lds, int item, const unsigned short (&zfr)[16], const unsigned short (&zbr)[16], const unsigned short (&vr)[16], const unsigned short (&qr)[16], const float lbF, const float lbB,
                                        const bool more, const int item_next, unsigned short (&nv)[16], unsigned short (&nq)[16]) {
    const int tid = tidx(), lane = tid & 63, wave = tid >> 6, c = tid & 127, tq = tid >> 7;
    const int n = item & 63, bh = item >> 6, b = bh / 6, h = bh % 6;
    const size_t row0 = (size_t)(b * SEQ + n * 64);
    const bf16* proj = WSP(const bf16, WS_PROJ) + row0 * NIN;
    float* SEG = (float*)lds;
    bf16* QF = (bf16*)(lds + 4096);
    bf16* QB = (bf16*)(lds + 4096 + 17408);
    bf16* KF = (bf16*)(lds + 4096 + 2 * 17408);
    bf16* KB = (bf16*)(lds + 4096 + 3 * 17408);
    bf16* VT = (bf16*)(lds + 4096 + 4 * 17408);
    bf16* A2 = (bf16*)(lds + 4096 + 4 * 17408 + 18432);
    float* OB = (float*)(lds + 4096);
    v2u sfr[8], sbr[8];
    { const int r32p = lane & 31, hip = lane >> 5, dtp = wave & 3;
      const unsigned char* stf = WSP(const unsigned char, WS_ST) + (size_t)((bh * 2 + 0) * 64 + n) * 16384 + (size_t)(dtp * 32 + r32p) * 128 + hip * 8;
      const unsigned char* stb = WSP(const unsigned char, WS_ST) + (size_t)((bh * 2 + 1) * 64 + n) * 16384 + (size_t)(dtp * 32 + r32p) * 128 + hip * 8;
#pragma unroll
      for (int ks = 0; ks < 8; ++ks) { sfr[ks] = *(const v2u*)(stf + ks * 16); sbr[ks] = *(const v2u*)(stb + ks * 16); } }
    const bf16* gp_ = WSP(const bf16, WS_PROJ) + PSLAB(row0 + (size_t)(tid >> 3), C_HG + h * 128 + (tid & 7) * 16);
    const v4u g0 = *(const v4u*)gp_, g1 = *(const v4u*)(gp_ + 8);
    f32x4 ghg[4];
#pragma unroll
    for (int k = 0; k < 4; ++k) ghg[k] = *(const f32x4*)(((const float*)p.g_hg) + (tid & 7) * 16 + 4 * k);
    float ffv[16], fbv[16];
    { float sf = 1.f, sb = 1.f;
#pragma unroll
      for (int i = 0; i < 16; ++i) { const int s = tq * 16 + i;
        const float zf = bf2f(zfr[i]), zb = bf2f(zbr[i]);
        const float ff = lbF + (1.f - lbF) * sigmoidf_(zf), fb = lbB + (1.f - lbB) * sigmoidf_(zb);
        ffv[i] = ff; sf *= ff; fbv[i] = fb; sb *= fb;
        VT[c * 72 + s] = vr[i]; }
      SEG[tq * 128 + c] = sf; SEG[512 + tq * 128 + c] = sb; }
    __syncthreads();
    {
      float runf = (tq > 0 ? SEG[c] : 1.f) * (tq > 1 ? SEG[128 + c] : 1.f) * (tq > 2 ? SEG[256 + c] : 1.f);
      float runb = (tq < 1 ? SEG[512 + 128 + c] : 1.f) * (tq < 2 ? SEG[512 + 256 + c] : 1.f) * (tq < 3 ? SEG[512 + 384 + c] : 1.f);
      float bb[16];
#pragma unroll
      for (int i = 15; i >= 0; --i) { runb *= fbv[i]; bb[i] = runb; }
#pragma unroll
      for (int i = 0; i < 16; ++i) { const int s = tq * 16 + i; runf *= ffv[i];
        const float q = bf2f(qr[i]);
        QF[s * 136 + c] = (bf16)f2bf(q * runf); KF[s * 136 + c] = (bf16)f2bf((1.f - ffv[i]) * __builtin_amdgcn_rcpf(runf));
        QB[s * 136 + c] = (bf16)f2bf(q * bb[i]); KB[s * 136 + c] = (bf16)f2bf((1.f - fbv[i]) * __builtin_amdgcn_rcpf(bb[i])); } }
    if (more) h3_load_vq(p, item_next, nv, nq);
    __syncthreads();
    const int r32 = lane & 31, hi = lane >> 5;
    {
      const int dir = wave >> 2, ti = (wave >> 1) & 1, si = wave & 1;
      const bf16* Qd = dir ? QB : QF; const bf16* Kd = dir ? KB : KF;
      f32x16 a = zero16();
#pragma unroll
      for (int ks = 0; ks < 8; ++ks) a = mfma32(*(const bf16x8*)(Qd + (ti * 32 + r32) * 136 + ks * 16 + hi * 8), *(const bf16x8*)(Kd + (si * 32 + r32) * 136 + ks * 16 + hi * 8), a);
#pragma unroll
      for (int r = 0; r < 16; ++r) { const int t = ti * 32 + (r & 3) + 8 * (r >> 2) + 4 * hi, s = si * 32 + r32;
        const bool keep = dir ? (s >= t) : (s <= t);
        A2[t * 136 + dir * 64 + s] = (bf16)f2bf(keep ? a[r] : 0.f); } }
    __syncthreads();
    f32x16 o = zero16();
    const int tt = wave >> 2, dt = wave & 3;
    {
#pragma unroll
      for (int ks = 0; ks < 8; ++ks) {
        o = mfma32(*(const bf16x8*)(QF + (tt * 32 + r32) * 136 + ks * 16 + hi * 8), st_frag(sfr[ks]), o);
        o = mfma32(*(const bf16x8*)(QB + (tt * 32 + r32) * 136 + ks * 16 + hi * 8), st_frag(sbr[ks]), o);
        o = mfma32(*(const bf16x8*)(A2 + (tt * 32 + r32) * 136 + ks * 16 + hi * 8), *(const bf16x8*)(VT + (dt * 32 + r32) * 72 + (ks & 3) * 16 + hi * 8), o); } }
    __syncthreads();
#pragma unroll
    for (int r = 0; r < 16; ++r) OB[(tt * 32 + (r & 3) + 8 * (r >> 2) + 4 * hi) * 132 + dt * 32 + r32] = o[r];
    __syncthreads();
    { const int t = tid >> 3, sub = tid & 7;
      float v[16]; float ss = 0.f;
#pragma unroll
      for (int k = 0; k < 4; ++k) { const f32x4 x = *(const f32x4*)(OB + t * 132 + sub * 16 + 4 * k); v[4 * k] = x.x; v[4 * k + 1] = x.y; v[4 * k + 2] = x.z; v[4 * k + 3] = x.w; ss += (x.x * x.x + x.y * x.y) + (x.z * x.z + x.w * x.w); }
      const float rstd = rsqrtf(sum8(ss) * (1.f / 128.f) + EPS);
      float gz[16]; gz[0] = __uint_as_float(g0.x << 16); gz[1] = __uint_as_float(g0.x & 0xffff0000u); gz[2] = __uint_as_float(g0.y << 16); gz[3] = __uint_as_float(g0.y & 0xffff0000u);
      gz[4] = __uint_as_float(g0.z << 16); gz[5] = __uint_as_float(g0.z & 0xffff0000u); gz[6] = __uint_as_float(g0.w << 16); gz[7] = __uint_as_float(g0.w & 0xffff0000u);
      gz[8] = __uint_as_float(g1.x << 16); gz[9] = __uint_as_float(g1.x & 0xffff0000u); gz[10] = __uint_as_float(g1.y << 16); gz[11] = __uint_as_float(g1.y & 0xffff0000u);
      gz[12] = __uint_as_float(g1.z << 16); gz[13] = __uint_as_float(g1.z & 0xffff0000u); gz[14] = __uint_as_float(g1.w << 16); gz[15] = __uint_as_float(g1.w & 0xffff0000u);
      float o[16];
#pragma unroll
      for (int k = 0; k < 16; ++k) o[k] = v[k] * rstd * ghg[k >> 2][k & 3] * (gz[k] * sigmoidf_(gz[k]));
      v4u w0, w1; w0.x = pk2(o[0], o[1]); w0.y = pk2(o[2], o[3]); w0.z = pk2(o[4], o[5]); w0.w = pk2(o[6], o[7]); w1.x = pk2(o[8], o[9]); w1.y = pk2(o[10], o[11]); w1.z = pk2(o[12], o[13]); w1.w = pk2(o[14], o[15]);
      bf16* orow = WSP(bf16, WS_OCAT) + (row0 + t) * DM + h * 128 + sub * 16;
      *(v4u*)orow = w0; *(v4u*)(orow + 8) = w1; }
    __syncthreads();
}
__device__ __forceinline__ float max4x(float v) { v = fmaxf(v, __shfl_xor(v, 16)); return fmaxf(v, __shfl_xor(v, 32)); }
__device__ __forceinline__ float sum4x(float v) { v += __shfl_xor(v, 16); return v + __shfl_xor(v, 32); }
__device__ __forceinline__ bf16x8 pack_p(const f32x4 a, const f32x4 b) {
    v4u w; w.x = pk2(a.x, a.y); w.y = pk2(a.z, a.w); w.z = pk2(b.x, b.y); w.w = pk2(b.z, b.w); return __builtin_bit_cast(bf16x8, w); }
__device__ __forceinline__ bf16x8 ld_vt2(const bf16* p0, const bf16* p1) { const v2u a = *(const v2u*)p0, b = *(const v2u*)p1; v4u w; w.x = a.x; w.y = a.y; w.z = b.x; w.w = b.y; return __builtin_bit_cast(bf16x8, w); }
struct DilRegs { v4u kv[4], vv[4]; bf16x8 q0, q1; };
__device__ __forceinline__ void dil_decode(int item, int& b, int& head, int& r, int& Ls, int& cres, int& i0) {
    const int blk = item & 31, bh = item >> 5; b = bh / 12; head = bh % 12; const int g = head >> 2;
    r = (g == 0) ? 1 : (g == 1 ? 4 : 16); Ls = SEQ / r; const int nblk = Ls / 128; cres = blk / nblk; i0 = (blk % nblk) * 128;
}
__device__ __forceinline__ void dil_load(const P& p, int item, DilRegs& R) {
    const int tid = tidx(), lane = tid & 63, wave = tid >> 6, fr = lane & 15, h = lane >> 4;
    int b, head, r, Ls, cres, i0; dil_decode(item, b, head, r, Ls, cres, i0);
    const bf16* proj = WSP(const bf16, WS_PROJ);
#pragma unroll
    for (int k = 0; k < 4; ++k) { const int idx = tid + 512 * k, row = idx >> 3, ch = idx & 7; const int j = i0 - 64 + row;
        v4u kv = {0u, 0u, 0u, 0u}, vv = {0u, 0u, 0u, 0u};
        if (j >= 0 && j < Ls) { const size_t tok = (size_t)(b * SEQ + cres + r * j); kv = *(const v4u*)(proj + PSLAB(tok, C_DK + head * 64 + ch * 8)); vv = *(const v4u*)(proj + PSLAB(tok, C_DV + head * 64 + ch * 8)); }
        R.kv[k] = kv; R.vv[k] = vv; }
    const bf16* qp = proj + PSLAB((size_t)(b * SEQ + cres + r * (i0 + 16 * wave + fr)), C_DQ + head * 64 + 8 * h);
    R.q0 = *(const bf16x8*)qp; R.q1 = *(const bf16x8*)(qp + 32);
}
__device__ __forceinline__ void dil_item(const P& p, unsigned char* lds, int item, const DilRegs& R) {
    const int tid = tidx(), lane = tid & 63, wave = tid >> 6, fr = lane & 15, h = lane >> 4;
    int b, head, r, Ls, cres, i0; dil_decode(item, b, head, r, Ls, cres, i0);
    bf16* Ks = (bf16*)lds;
    unsigned char* VI = lds + 36864;
#pragma unroll
    for (int k = 0; k < 4; ++k) { const int idx = tid + 512 * k, row = idx >> 3, ch = idx & 7; const v4u kv = R.kv[k], vv = R.vv[k];
        *(v4u*)(Ks + row * 72 + ch * 8) = kv;
        *(v4u*)(VI + (row >> 3) * 1152 + (ch >> 1) * 288 + (row & 7) * 32 + (ch & 1) * 16) = vv; }
    if (tid < 144) *(v4u*)(VI + 32 * 1152 + tid * 16) = (v4u){0u, 0u, 0u, 0u};
    __syncthreads();
    const int iq = i0 + 16 * wave + fr;
    const bf16x8 q0 = R.q0, q1 = R.q1;
    f32x4 sc[10];
#pragma unroll
    for (int j = 0; j < 9; ++j) { const bf16* kr = Ks + (16 * (wave + j) + fr) * 72 + 8 * h;
        f32x4 s4 = {0.f, 0.f, 0.f, 0.f}; s4 = mfma16(*(const bf16x8*)kr, q0, s4); sc[j] = mfma16(*(const bf16x8*)(kr + 32), q1, s4);
        if (j % 3 == 2) asm volatile("" ::: "memory"); }
    const float slope = exp2f(-8.0f * (float)(head + 1) / 12.0f) * (float)r;
    float m = -3.0e38f;
#pragma unroll
    for (int j = 0; j < 9; ++j)
#pragma unroll
        for (int e = 0; e < 4; ++e) { const int dj = -64 + 16 * j + 4 * h + e - fr, jk = iq + dj, adj = dj < 0 ? -dj : dj;
            const bool ok = (adj <= 64) && (jk >= 0) && (jk < Ls);
            sc[j][e] = ok ? sc[j][e] * 0.125f - slope * (float)adj : -1.0e30f; m = fmaxf(m, sc[j][e]); }
    m = max4x(m); float l = 0.f;
#pragma unroll
    for (int j = 0; j < 9; ++j)
#pragma unroll
        for (int e = 0; e < 4; ++e) { const float pe = sc[j][e] > -1.0e29f ? __expf(sc[j][e] - m) : 0.f; sc[j][e] = pe; l += pe; }
    l = sum4x(l); const float inv = 1.0f / l;
#pragma unroll
    for (int j = 0; j < 9; ++j) sc[j] = sc[j] * inv;
    sc[9] = (f32x4){0.f, 0.f, 0.f, 0.f};
    if (h == 0) WSP(float, WS_LSE)[(size_t)(b * 12 + head) * SEQ + cres + r * iq] = m + __logf(l);
    f32x4 o[4];
#pragma unroll
    for (int dt = 0; dt < 4; ++dt) o[dt] = (f32x4){0.f, 0.f, 0.f, 0.f};
    const unsigned va = (unsigned)(uintptr_t)(LAS unsigned char*)VI + (unsigned)((2 * wave + (h >> 1)) * 1152 + (4 * (h & 1) + (fr >> 2)) * 32 + (fr & 3) * 8);
#pragma unroll
    for (int ks = 0; ks < 5; ++ks) { const bf16x8 pa = pack_p(sc[2 * ks], sc[2 * ks + 1]);
        v2u t0, t1, t2, t3, t4, t5, t6, t7;
        asm volatile("ds_read_b64_tr_b16 %0, %8 offset:%9\n\tds_read_b64_tr_b16 %1, %8 offset:%10\n\tds_read_b64_tr_b16 %2, %8 offset:%11\n\tds_read_b64_tr_b16 %3, %8 offset:%12\n\t"
                     "ds_read_b64_tr_b16 %4, %8 offset:%13\n\tds_read_b64_tr_b16 %5, %8 offset:%14\n\tds_read_b64_tr_b16 %6, %8 offset:%15\n\tds_read_b64_tr_b16 %7, %8 offset:%16\n\ts_waitcnt lgkmcnt(0)"
                     : "=&v"(t0), "=&v"(t1), "=&v"(t2), "=&v"(t3), "=&v"(t4), "=&v"(t5), "=&v"(t6), "=&v"(t7)
                     : "v"(va), "i"(ks * 4608), "i"(ks * 4608 + 2304), "i"(ks * 4608 + 288), "i"(ks * 4608 + 288 + 2304), "i"(ks * 4608 + 576), "i"(ks * 4608 + 576 + 2304), "i"(ks * 4608 + 864), "i"(ks * 4608 + 864 + 2304) : "memory");
        { v4u w; w.x = t0.x; w.y = t0.y; w.z = t1.x; w.w = t1.y; o[0] = mfma16(__builtin_bit_cast(bf16x8, w), pa, o[0]); }
        { v4u w; w.x = t2.x; w.y = t2.y; w.z = t3.x; w.w = t3.y; o[1] = mfma16(__builtin_bit_cast(bf16x8, w), pa, o[1]); }
        { v4u w; w.x = t4.x; w.y = t4.y; w.z = t5.x; w.w = t5.y; o[2] = mfma16(__builtin_bit_cast(bf16x8, w), pa, o[2]); }
        { v4u w; w.x = t6.x; w.y = t6.y; w.z = t7.x; w.w = t7.y; o[3] = mfma16(__builtin_bit_cast(bf16x8, w), pa, o[3]); } }
    { const size_t tok = (size_t)(b * SEQ + cres + r * iq);
      bf16* orow = WSP(bf16, WS_OCAT) + tok * DM + 768 + head * 64 + 4 * h;
#pragma unroll
      for (int dt = 0; dt < 4; ++dt) { v2u w; w.x = pk2(o[dt][0], o[dt][1]); w.y = pk2(o[dt][2], o[dt][3]); *(v2u*)(orow + dt * 16) = w; } }
    __syncthreads();
}

__device__ __forceinline__ void mem_item(const P& p, unsigned char* lds, int item) {
    const int tid = tidx(), lane = tid & 63, wave = tid >> 6, fr = lane & 15, h = lane >> 4;
    const int blk = item & 31, bh = item >> 5, b = bh >> 2, head = bh & 3;
    const size_t row0 = (size_t)(b * SEQ + blk * 128);
    const bf16* qp = WSP(const bf16, WS_PROJ) + PSLAB(row0 + 16 * wave + fr, C_MQ + head * 128 + 8 * h);
    bf16x8 qf[4];
#pragma unroll
    for (int kk = 0; kk < 4; ++kk) qf[kk] = *(const bf16x8*)(qp + (size_t)(kk >> 1) * PSLAB_STRIDE + 32 * (kk & 1));
    bf16* Ks = (bf16*)lds;
    bf16* VT = (bf16*)(lds + 69632);
#pragma unroll
    for (int k = 0; k < 8; ++k) { const int idx = tid + 512 * k;
        { const int row = idx >> 4, ch = idx & 15; *(v4u*)(Ks + row * 136 + ch * 8) = *(const v4u*)(WSP(const bf16, WS_KVM) + (size_t)(b * MEML + row) * 1024 + head * 128 + ch * 8); }
        { const int d = idx >> 5, ch = idx & 31; *(v4u*)(VT + d * 264 + ch * 8) = *(const v4u*)(WSP(const bf16, WS_KVMT) + (size_t)(512 + head * 128 + d) * 512 + b * MEML + ch * 8); } }
    __syncthreads();
    f32x4 sc[16]; float m = -3.0e38f;
#pragma unroll
    for (int j = 0; j < 16; ++j) { const bf16* kr = Ks + (16 * j + fr) * 136 + 8 * h; f32x4 s4 = {0.f, 0.f, 0.f, 0.f};
#pragma unroll
        for (int kk = 0; kk < 4; ++kk) s4 = mfma16(*(const bf16x8*)(kr + 32 * kk), qf[kk], s4);
        sc[j] = s4 * 0.08838834764831845f; m = fmaxf(fmaxf(m, fmaxf(sc[j][0], sc[j][1])), fmaxf(sc[j][2], sc[j][3]));
        if ((j & 1) == 1) asm volatile("" ::: "memory"); }
    m = max4x(m); float l = 0.f;
#pragma unroll
    for (int j = 0; j < 16; ++j)
#pragma unroll
        for (int e = 0; e < 4; ++e) { sc[j][e] = __expf(sc[j][e] - m); l += sc[j][e]; }
    l = sum4x(l); const float inv = 1.0f / l;
    f32x4 o[8];
#pragma unroll
    for (int dt = 0; dt < 8; ++dt) o[dt] = (f32x4){0.f, 0.f, 0.f, 0.f};
#pragma unroll
    for (int ks = 0; ks < 8; ++ks) { const bf16x8 pa = pack_p(sc[2 * ks] * inv, sc[2 * ks + 1] * inv);
        const bf16* v0 = VT + fr * 264 + 32 * ks + 4 * h;
#pragma unroll
        for (int dt = 0; dt < 8; ++dt) o[dt] = mfma16(ld_vt2(v0 + dt * 16 * 264, v0 + dt * 16 * 264 + 16), pa, o[dt]);
        asm volatile("" ::: "memory"); }
    { bf16* orow = WSP(bf16, WS_OCAT) + (row0 + 16 * wave + fr) * DM + 1536 + head * 128 + 4 * h;
#pragma unroll
      for (int dt = 0; dt < 8; ++dt) { v2u w; w.x = pk2(o[dt][0], o[dt][1]); w.y = pk2(o[dt][2], o[dt][3]); *(v2u*)(orow + dt * 16) = w; } }
    __syncthreads();
}

__device__ __forceinline__ void dil_alpha_rows(const P& p, int vcu, int G) {
    const int gt = vcu * NTHR + tidx(), NGT = G * NTHR;
    constexpr int NTASK = T * 96;
    for (int id0 = gt; id0 < NTASK; id0 += 6 * NGT) {
        float l0[6], l1[6], l2[6]; v4u v[6]; int g6[6];
#pragma unroll
        for (int k = 0; k < 6; ++k) { const int id = id0 + k * NGT; g6[k] = -1;
            if (id < NTASK) { const int t = id / 96, ch = id - t * 96, head = ch >> 3, j = head & 3, b = t / SEQ, s = t - b * SEQ; g6[k] = head >> 2;
                const float* L = WSP(const float, WS_LSE) + (size_t)(b * 12 + j) * SEQ + s; l0[k] = L[0]; l1[k] = L[4 * SEQ]; l2[k] = L[8 * SEQ];
                v[k] = *(const v4u*)(WSP(const bf16, WS_OCAT) + (size_t)t * DM + 768 + ch * 8); } }
#pragma unroll
        for (int k = 0; k < 6; ++k) if (g6[k] >= 0) { const int id = id0 + k * NGT, t = id / 96, ch = id - t * 96;
            const float m = fmaxf(l0[k], fmaxf(l1[k], l2[k])), e0 = __expf(l0[k] - m), e1 = __expf(l1[k] - m), e2 = __expf(l2[k] - m);
            const float al = (g6[k] == 0 ? e0 : (g6[k] == 1 ? e1 : e2)) / (e0 + e1 + e2); v4u w = v[k];
            w.x = pk2(__uint_as_float(w.x << 16) * al, __uint_as_float(w.x & 0xffff0000u) * al); w.y = pk2(__uint_as_float(w.y << 16) * al, __uint_as_float(w.y & 0xffff0000u) * al);
            w.z = pk2(__uint_as_float(w.z << 16) * al, __uint_as_float(w.z & 0xffff0000u) * al); w.w = pk2(__uint_as_float(w.w << 16) * al, __uint_as_float(w.w & 0xffff0000u) * al);
            *(v4u*)(WSP(bf16, WS_OCAT) + (size_t)t * DM + 768 + ch * 8) = w; }
    }
}
__device__ __forceinline__ unsigned okey(float f) { const unsigned u = __float_as_uint(f); return u ^ ((unsigned)((int)u >> 31) | 0x80000000u); }
__device__ __forceinline__ float unkey(unsigned k) { const unsigned u = (k & 0x80000000u) ? (k ^ 0x80000000u) : ~k; return __uint_as_float(u); }
__device__ __forceinline__ unsigned umax_(unsigned a, unsigned b) { return a > b ? a : b; }
__device__ __forceinline__ unsigned umin_(unsigned a, unsigned b) { return a < b ? a : b; }
template <int CTRL> __device__ __forceinline__ unsigned dppu(unsigned v) { return (unsigned)__builtin_amdgcn_update_dpp(0, (int)v, CTRL, 0xf, 0xf, true); }
__device__ __forceinline__ void topk_rows(const P& p, int vcu, int G) {
    const int gt = vcu * NTHR + tidx(), NGT = G * NTHR;
    for (int gid = gt; gid < T * 16; gid += NGT) {
        const int row = gid >> 1, half = gid & 1, t = row >> 3, h = row & 7;
        const float* sc = WSP(const float, WS_SC) + (size_t)row * 256 + half * 128;
        unsigned v[16];
#pragma unroll
        for (int i = 0; i < 16; ++i) v[i] = 0u;
        for (int n4 = 0; n4 < 32; ++n4) { const f32x4 q = *(const f32x4*)(sc + n4 * 4);
#pragma unroll
            for (int e = 0; e < 4; ++e) { unsigned x = (okey(q[e]) & 0xffffff80u) | (unsigned)(127 - (n4 * 4 + e));
#pragma unroll
                for (int i = 0; i < 16; ++i) { const unsigned hi = umax_(v[i], x); x = umin_(v[i], x); v[i] = hi; } } }
        float s0[16], s1[16]; unsigned long long p0lo = 0ull, p0hi = 0ull, p1lo = 0ull, p1hi = 0ull;
#pragma unroll
        for (int i = 0; i < 16; ++i) { const unsigned o = dppu<0xB1>(v[i]); const unsigned k0 = half ? o : v[i], k1 = half ? v[i] : o;
            s0[i] = unkey(k0 & 0xffffff80u); s1[i] = unkey(k1 & 0xffffff80u);
            const unsigned long long a0 = (unsigned long long)(127u - (k0 & 127u)) << (8 * (i & 7)), a1 = (unsigned long long)(127u - (k1 & 127u)) << (8 * (i & 7));
            if (i < 8) { p0lo |= a0; p1lo |= a1; } else { p0hi |= a0; p1hi |= a1; } }
        unsigned bk[16];
#pragma unroll
        for (int k = 0; k < 16; ++k) bk[k] = 0u;
#pragma unroll
        for (int i = 0; i < 16; ++i)
#pragma unroll
            for (int j = 0; j < 16; ++j) if ((i + 1) * (j + 1) <= 16) {
                unsigned x = (okey(s0[i] + s1[j]) & 0xffffff00u) | (unsigned)(255 - (i * 16 + j));
#pragma unroll
                for (int k = 0; k < 16; ++k) { const unsigned hi = umax_(bk[k], x); x = umin_(bk[k], x); bk[k] = hi; } }
        const float rstd = row_rstd(WSP(const float, WS_RSP), t);
        const float m = unkey(bk[0] & 0xffffff00u) * rstd; float l = 0.f; float ev[16];
#pragma unroll
        for (int k = 0; k < 16; ++k) { ev[k] = __expf(unkey(bk[k] & 0xffffff00u) * rstd - m); l += ev[k]; }
        const float inv = 1.0f / l;
        int be[16];
#pragma unroll
        for (int k = 0; k < 16; ++k) { const int code = 255 - (int)(bk[k] & 255u), ci = code >> 4, cj = code & 15;
            const int a = (int)(((ci & 8) ? p0hi : p0lo) >> (8 * (ci & 7))) & 0xff, c = (int)(((cj & 8) ? p1hi : p1lo) >> (8 * (cj & 7))) & 0xff;
            be[k] = a * 128 + c; }
        int* io = WSP(int, WS_IDX) + (size_t)t * 128 + h * 16; float* go = WSP(float, WS_GATE) + (size_t)t * 128 + h * 16;
        if (half == 0) {
            *(int4*)io = make_int4(be[0], be[1], be[2], be[3]); *(int4*)(io + 4) = make_int4(be[4], be[5], be[6], be[7]);
            *(f32x4*)go = (f32x4){ev[0] * inv, ev[1] * inv, ev[2] * inv, ev[3] * inv}; *(f32x4*)(go + 4) = (f32x4){ev[4] * inv, ev[5] * inv, ev[6] * inv, ev[7] * inv};
        } else {
            *(int4*)(io + 8) = make_int4(be[8], be[9], be[10], be[11]); *(int4*)(io + 12) = make_int4(be[12], be[13], be[14], be[15]);
            *(f32x4*)(go + 8) = (f32x4){ev[8] * inv, ev[9] * inv, ev[10] * inv, ev[11] * inv}; *(f32x4*)(go + 12) = (f32x4){ev[12] * inv, ev[13] * inv, ev[14] * inv, ev[15] * inv};
        }
    }
}

__device__ __forceinline__ void unpack8(const v4u w, float* f) {
    f[0] = __uint_as_float(w.x << 16); f[1] = __uint_as_float(w.x & 0xffff0000u); f[2] = __uint_as_float(w.y << 16); f[3] = __uint_as_float(w.y & 0xffff0000u);
    f[4] = __uint_as_float(w.z << 16); f[5] = __uint_as_float(w.z & 0xffff0000u); f[6] = __uint_as_float(w.w << 16); f[7] = __uint_as_float(w.w & 0xffff0000u);
}
template <int CTRL> __device__ __forceinline__ float dpp_f(float v) { return __builtin_bit_cast(float, __builtin_amdgcn_update_dpp(0, __builtin_bit_cast(int, v), CTRL, 0xf, 0xf, true)); }
__device__ __forceinline__ float row16_sum(float v) {
    v += dpp_f<0xB1>(v); v += dpp_f<0x4E>(v); v += dpp_f<0x141>(v); v += dpp_f<0x140>(v); return v;
}
__device__ __forceinline__ float swap32_add(float x, float y) {
    auto r = __builtin_amdgcn_permlane32_swap(__float_as_uint(x), __float_as_uint(y), false, false); return __uint_as_float(r[0]) + __uint_as_float(r[1]); }
__device__ __forceinline__ float swap16_add(float x, float y) {
    auto r = __builtin_amdgcn_permlane16_swap(__float_as_uint(x), __float_as_uint(y), false, false); return __uint_as_float(r[0]) + __uint_as_float(r[1]); }
__device__ __forceinline__ float reduce4(float d0, float d1, float d2, float d3) { return row16_sum(swap16_add(swap32_add(d0, d2), swap32_add(d1, d3))); }
__device__ __forceinline__ float rl_f(float v, int l) { return __builtin_bit_cast(float, __builtin_amdgcn_readlane(__builtin_bit_cast(int, v), l)); }
__device__ __forceinline__ float wave_sum_dpp(float v) { const float r = row16_sum(v); return (rl_f(r, 0) + rl_f(r, 16)) + (rl_f(r, 32) + rl_f(r, 48)); }
__device__ __forceinline__ int sdot4(unsigned a, unsigned b, int c) { return __builtin_amdgcn_sdot4((int)a, (int)b, c, false); }
__device__ __forceinline__ unsigned q8(float v, float inv) { return (unsigned)((int)rintf(v * inv)) & 0xffu; }
#ifndef PEER_PB
#define PEER_PB 8
#endif
constexpr int PB = PEER_PB;
__device__ __forceinline__ void peer_rows(const P& p, int vcu, int G, float* dst) {
    const int lane = tidx() & 63, gw = vcu * NWAVES + (tidx() >> 6), NGW = G * NWAVES;
    const v4u* U = WSP(const v4u, WS_UQ); const v4u* V = WSP(const v4u, WS_VQ);
    for (int t = gw; t < T; t += NGW) {
        unsigned xq[8]; float sx;
        { const v4u* xp = WSP(const v4u, WS_XG) + (size_t)t * 256 + lane * 2; float f[32];
          unpack8(xp[0], f); unpack8(xp[1], f + 8); unpack8(xp[128], f + 16); unpack8(xp[129], f + 24);
          float m = 0.f;
#pragma unroll
          for (int i = 0; i < 32; ++i) m = fmaxf(m, fabsf(f[i]));
          m = wave_max(m); m = fmaxf(m, 1e-30f); sx = m * (1.f / 127.f); const float inv = 127.f / m;
#pragma unroll
          for (int i = 0; i < 8; ++i) xq[i] = q8(f[4 * i], inv) | (q8(f[4 * i + 1], inv) << 8) | (q8(f[4 * i + 2], inv) << 16) | (q8(f[4 * i + 3], inv) << 24); }
        const int ia = WSP(const int, WS_IDX)[(size_t)t * 128 + lane], ib = WSP(const int, WS_IDX)[(size_t)t * 128 + 64 + lane];
        const float ascale = row_rstd(WSP(const float, WS_RSP), t) * sx;
        float aa = 0.f, ab = 0.f;
#pragma unroll 1
        for (int e0 = 0; e0 < 128; e0 += PB) {
            v4u w[PB][2];
#pragma unroll
            for (int j = 0; j < PB; ++j) { const int e = e0 + j; const int row = __builtin_amdgcn_readlane(e < 64 ? ia : ib, e & 63);
                const v4u* r = U + (size_t)row * 128 + lane; w[j][0] = r[0]; w[j][1] = r[64]; }
            float d[PB];
#pragma unroll
            for (int j = 0; j < PB; ++j) { int a0 = 0, a1 = 0;
                a0 = sdot4(w[j][0].x, xq[0], a0); a1 = sdot4(w[j][0].y, xq[1], a1); a0 = sdot4(w[j][0].z, xq[2], a0); a1 = sdot4(w[j][0].w, xq[3], a1);
                a0 = sdot4(w[j][1].x, xq[4], a0); a1 = sdot4(w[j][1].y, xq[5], a1); a0 = sdot4(w[j][1].z, xq[6], a0); a1 = sdot4(w[j][1].w, xq[7], a1);
                d[j] = (float)(a0 + a1); }
#pragma unroll
            for (int j4 = 0; j4 < PB; j4 += 4) { const float r0 = reduce4(d[j4], d[j4 + 1], d[j4 + 2], d[j4 + 3]);
#pragma unroll
                for (int j = 0; j < 4; ++j) { const int e = e0 + j4 + j; const float v = rl_f(r0, 16 * j);
                    if (lane == (e & 63)) { if (e < 64) aa = v; else ab = v; } } }
        }
        float ha, hb;
        { const float* SU = WSP(const float, WS_SU); const float* SV = WSP(const float, WS_SV);
          const float ga = WSP(const float, WS_GATE)[(size_t)t * 128 + lane], gb = WSP(const float, WS_GATE)[(size_t)t * 128 + 64 + lane];
          aa *= ascale * SU[ia]; ab *= ascale * SU[ib];
          ha = 0.5f * aa * (1.0f + erff(aa * 0.70710678118f)) * ga * SV[ia]; hb = 0.5f * ab * (1.0f + erff(ab * 0.70710678118f)) * gb * SV[ib]; }
        float acc[32]; float csum = 0.f;
#pragma unroll
        for (int i = 0; i < 32; ++i) acc[i] = 0.f;
#pragma unroll 1
        for (int e0 = 0; e0 < 128; e0 += PB) {
            v4u w[PB][2];
#pragma unroll
            for (int j = 0; j < PB; ++j) { const int e = e0 + j; const int row = __builtin_amdgcn_readlane(e < 64 ? ia : ib, e & 63);
                const v4u* r = V + (size_t)row * 128 + lane; w[j][0] = r[0]; w[j][1] = r[64]; }
#pragma unroll
            for (int j = 0; j < PB; ++j) { const int e = e0 + j; const float h = rl_f(e < 64 ? ha : hb, e & 63); csum += h;
#pragma unroll
                for (int i = 0; i < 2; ++i) { const unsigned x0 = w[j][i].x, x1 = w[j][i].y, x2 = w[j][i].z, x3 = w[j][i].w;
                    acc[16 * i + 0] = fmaf(h, (float)(x0 & 0xffu), acc[16 * i + 0]); acc[16 * i + 1] = fmaf(h, (float)((x0 >> 8) & 0xffu), acc[16 * i + 1]);
                    acc[16 * i + 2] = fmaf(h, (float)((x0 >> 16) & 0xffu), acc[16 * i + 2]); acc[16 * i + 3] = fmaf(h, (float)(x0 >> 24), acc[16 * i + 3]);
                    acc[16 * i + 4] = fmaf(h, (float)(x1 & 0xffu), acc[16 * i + 4]); acc[16 * i + 5] = fmaf(h, (float)((x1 >> 8) & 0xffu), acc[16 * i + 5]);
                    acc[16 * i + 6] = fmaf(h, (float)((x1 >> 16) & 0xffu), acc[16 * i + 6]); acc[16 * i + 7] = fmaf(h, (float)(x1 >> 24), acc[16 * i + 7]);
                    acc[16 * i + 8] = fmaf(h, (float)(x2 & 0xffu), acc[16 * i + 8]); acc[16 * i + 9] = fmaf(h, (float)((x2 >> 8) & 0xffu), acc[16 * i + 9]);
                    acc[16 * i + 10] = fmaf(h, (float)((x2 >> 16) & 0xffu), acc[16 * i + 10]); acc[16 * i + 11] = fmaf(h, (float)(x2 >> 24), acc[16 * i + 11]);
                    acc[16 * i + 12] = fmaf(h, (float)(x3 & 0xffu), acc[16 * i + 12]); acc[16 * i + 13] = fmaf(h, (float)((x3 >> 8) & 0xffu), acc[16 * i + 13]);
                    acc[16 * i + 14] = fmaf(h, (float)((x3 >> 16) & 0xffu), acc[16 * i + 14]); acc[16 * i + 15] = fmaf(h, (float)(x3 >> 24), acc[16 * i + 15]); } }
        }
        const float* orow = ((float*)p.out) + (size_t)t * DM; float* drow = dst + (size_t)t * DM; float ss = 0.f; const float coff = 128.f * csum;
#pragma unroll
        for (int i = 0; i < 2; ++i)
#pragma unroll
            for (int k = 0; k < 4; ++k) { const f32x4 a = *(const f32x4*)(orow + i * 1024 + lane * 16 + 4 * k);
                float* c = acc + 16 * i + 4 * k; c[0] += a.x - coff; c[1] += a.y - coff; c[2] += a.z - coff; c[3] += a.w - coff;
                ss += (c[0] * c[0] + c[1] * c[1]) + (c[2] * c[2] + c[3] * c[3]); }
        const float r2 = rsqrtf(wave_sum_dpp(ss) * (1.f / DM) + EPS);
#pragma unroll
        for (int i = 0; i < 2; ++i)
#pragma unroll
            for (int k = 0; k < 4; ++k) { const f32x4 g = *(const f32x4*)(((const float*)p.g_final) + i * 1024 + lane * 16 + 4 * k); const float* c = acc + 16 * i + 4 * k;
                *(f32x4*)(drow + i * 1024 + lane * 16 + 4 * k) = (f32x4){c[0] * r2 * g.x, c[1] * r2 * g.y, c[2] * r2 * g.z, c[3] * r2 * g.w}; }
    }
}

struct PeerMap { int rho, nx, r, nloc, bal; };
__device__ __forceinline__ PeerMap peer_map(const XcdBarrier& b, volatile LAS unsigned* MISC) {
    if (tidx() == 0) {
        unsigned rho = 0, nx = 1, nloc = 1;
        xcd_barrier_complete(b.bar, b.x, nloc, nx);
        for (unsigned j = 0; j < b.x; ++j) if (xb_ld(&b.bar[XB_XCNT(j)])) ++rho;
        const unsigned r = xb_add(&b.bar[4096 + 64 * b.x], 1u);
        unsigned bal = 1u; for (unsigned j = 0; j < 16; ++j) { const unsigned c = xb_ld(&b.bar[XB_XCNT(j)]); if (c != 0u && c != nloc) bal = 0u; }
        if (nx * nloc != gridDim.x) bal = 0u;
        MISC[4] = rho; MISC[5] = nx; MISC[6] = r % nloc; MISC[7] = nloc; MISC[10] = bal;
    }
    __syncthreads();
    PeerMap m; m.rho = __builtin_amdgcn_readfirstlane((int)MISC[4]); m.nx = __builtin_amdgcn_readfirstlane((int)MISC[5]); m.r = __builtin_amdgcn_readfirstlane((int)MISC[6]);
    m.nloc = __builtin_amdgcn_readfirstlane((int)MISC[7]); m.bal = __builtin_amdgcn_readfirstlane((int)MISC[10]);
    return m;
}
__device__ __forceinline__ void xq_rows(const P& p, int vcu, int G) {
    const int lane = tidx() & 63, gw = vcu * NWAVES + (tidx() >> 6), NGW = G * NWAVES;
    for (int t = gw; t < T; t += NGW) {
        const v4u* xp = WSP(const v4u, WS_XG) + (size_t)t * 256 + lane * 4; float f[32];
        unpack8(xp[0], f); unpack8(xp[1], f + 8); unpack8(xp[2], f + 16); unpack8(xp[3], f + 24);
        float m = 0.f;
#pragma unroll
        for (int i = 0; i < 32; ++i) m = fmaxf(m, fabsf(f[i]));
        m = fmaxf(wave_max(m), 1e-30f); const float inv = 127.f / m;
        v4u o0, o1;
        o0.x = q8(f[0], inv) | (q8(f[1], inv) << 8) | (q8(f[2], inv) << 16) | (q8(f[3], inv) << 24); o0.y = q8(f[4], inv) | (q8(f[5], inv) << 8) | (q8(f[6], inv) << 16) | (q8(f[7], inv) << 24);
        o0.z = q8(f[8], inv) | (q8(f[9], inv) << 8) | (q8(f[10], inv) << 16) | (q8(f[11], inv) << 24); o0.w = q8(f[12], inv) | (q8(f[13], inv) << 8) | (q8(f[14], inv) << 16) | (q8(f[15], inv) << 24);
        o1.x = q8(f[16], inv) | (q8(f[17], inv) << 8) | (q8(f[18], inv) << 16) | (q8(f[19], inv) << 24); o1.y = q8(f[20], inv) | (q8(f[21], inv) << 8) | (q8(f[22], inv) << 16) | (q8(f[23], inv) << 24);
        o1.z = q8(f[24], inv) | (q8(f[25], inv) << 8) | (q8(f[26], inv) << 16) | (q8(f[27], inv) << 24); o1.w = q8(f[28], inv) | (q8(f[29], inv) << 8) | (q8(f[30], inv) << 16) | (q8(f[31], inv) << 24);
        v4u* xo = WSP(v4u, WS_XQ) + (size_t)t * 128 + lane * 2; xo[0] = o0; xo[1] = o1;
        if (lane == 0) WSP(float, WS_SX)[t] = m * (1.f / 127.f);
    }
}
__device__ __forceinline__ void peer_u_sliced(const P& p, const PeerMap& mp) {
    const int lane = tidx() & 63, wave = tidx() >> 6, g = lane >> 4, l = lane & 15;
    const int w0 = mp.r * NWAVES + wave, NW = mp.nloc * NWAVES;
    for (int s = mp.rho; s < 8; s += mp.nx) {
        const unsigned char* ub = (const unsigned char*)(p.ws + WS_UQ) + s * 256 + l * 16;
        float* pa = WSP(float, WS_PA) + (size_t)s * T * 128;
        for (int t = w0; t < T; t += NW) {
            const v4u xq = *(const v4u*)((const unsigned char*)(p.ws + WS_XQ) + (size_t)t * DM + s * 256 + l * 16);
            const int* ip = WSP(const int, WS_IDX) + (size_t)t * 128 + g;
            int idxv[32];
#pragma unroll
            for (int k = 0; k < 32; ++k) idxv[k] = ip[4 * k];
#pragma unroll
            for (int k0 = 0; k0 < 32; k0 += 16) {
                v4u w[16];
#pragma unroll
                for (int k = 0; k < 16; ++k) w[k] = *(const v4u*)(ub + (size_t)idxv[k0 + k] * DM);
#pragma unroll
                for (int k = 0; k < 16; ++k) { int a0 = sdot4(w[k].x, xq.x, 0), a1 = sdot4(w[k].y, xq.y, 0); a0 = sdot4(w[k].z, xq.z, a0); a1 = sdot4(w[k].w, xq.w, a1);
                    const float d = row16_sum((float)(a0 + a1));
                    if (l == 0) pa[(size_t)t * 128 + 4 * (k0 + k) + g] = d; }
            }
        }
    }
}
__device__ __forceinline__ unsigned permb(unsigned hi, unsigned lo, unsigned sel) { return __builtin_amdgcn_perm(hi, lo, sel); }
__device__ __forceinline__ void peer_v_sliced(const P& p, const PeerMap& mp, unsigned char* lds, float* ydst) {
    const int lane = tidx() & 63, wave = tidx() >> 6, g = lane >> 4, l = lane & 15;
    const int w0 = mp.r * NWAVES + wave, NW = mp.nloc * NWAVES;
    unsigned char* hl = lds + wave * 128;
    const float* SU = WSP(const float, WS_SU); const float* SV = WSP(const float, WS_SV); const float* PAb = WSP(const float, WS_PA);
    for (int s = mp.rho; s < 8; s += mp.nx) {
        const unsigned char* vb = (const unsigned char*)(p.ws + WS_VQ) + s * 256 + l * 16;
        for (int t = w0; t < T; t += NW) {
            const float ascale = row_rstd(WSP(const float, WS_RSP), t) * WSP(const float, WS_SX)[t];
            float sh;
            { const int ia = WSP(const int, WS_IDX)[(size_t)t * 128 + lane], ib = WSP(const int, WS_IDX)[(size_t)t * 128 + 64 + lane];
              float aa = 0.f, ab = 0.f;
#pragma unroll
              for (int q = 0; q < 8; ++q) { aa += PAb[((size_t)q * T + t) * 128 + lane]; ab += PAb[((size_t)q * T + t) * 128 + 64 + lane]; }
              aa *= ascale * SU[ia]; ab *= ascale * SU[ib];
              const float ha = 0.5f * aa * (1.0f + erff(aa * 0.70710678118f)) * WSP(const float, WS_GATE)[(size_t)t * 128 + lane] * SV[ia];
              const float hb = 0.5f * ab * (1.0f + erff(ab * 0.70710678118f)) * WSP(const float, WS_GATE)[(size_t)t * 128 + 64 + lane] * SV[ib];
              const float m = fmaxf(wave_max(fmaxf(fabsf(ha), fabsf(hb))), 1e-30f); sh = m * (1.f / 127.f); const float inv = 127.f / m;
              hl[(lane & 3) * 32 + (lane >> 2)] = (unsigned char)q8(ha, inv); hl[(lane & 3) * 32 + 16 + (lane >> 2)] = (unsigned char)q8(hb, inv); }
            const int* ip = WSP(const int, WS_IDX) + (size_t)t * 128 + g;
            int idxv[32];
#pragma unroll
            for (int k = 0; k < 32; ++k) idxv[k] = ip[4 * k];
            const v4u h0 = *(const v4u*)(hl + g * 32), h1 = *(const v4u*)(hl + g * 32 + 16);
            const unsigned hq[8] = {h0.x, h0.y, h0.z, h0.w, h1.x, h1.y, h1.z, h1.w};
            int acc[16];
#pragma unroll
            for (int j = 0; j < 16; ++j) acc[j] = 0;
#pragma unroll
            for (int k0 = 0; k0 < 32; k0 += 16) {
                v4u w[16];
#pragma unroll
                for (int k = 0; k < 16; ++k) w[k] = *(const v4u*)(vb + (size_t)idxv[k0 + k] * DM);
#pragma unroll
                for (int k4 = 0; k4 < 4; ++k4) { const unsigned hd = hq[(k0 >> 2) + k4];
#pragma unroll
                    for (int c4 = 0; c4 < 4; ++c4) {
                        const unsigned a = w[4 * k4][c4], b = w[4 * k4 + 1][c4], c = w[4 * k4 + 2][c4], d = w[4 * k4 + 3][c4];
                        const unsigned pq = permb(b, a, 0x05010400u), qq = permb(b, a, 0x07030602u), rq = permb(d, c, 0x05010400u), sq = permb(d, c, 0x07030602u);
                        acc[4 * c4 + 0] = sdot4(permb(rq, pq, 0x05040100u), hd, acc[4 * c4 + 0]); acc[4 * c4 + 1] = sdot4(permb(rq, pq, 0x07060302u), hd, acc[4 * c4 + 1]);
                        acc[4 * c4 + 2] = sdot4(permb(sq, qq, 0x05040100u), hd, acc[4 * c4 + 2]); acc[4 * c4 + 3] = sdot4(permb(sq, qq, 0x07060302u), hd, acc[4 * c4 + 3]); } }
            }
#pragma unroll
            for (int j = 0; j < 16; ++j) { acc[j] += __shfl_xor(acc[j], 16); acc[j] += __shfl_xor(acc[j], 32); }
            const size_t yo = (size_t)t * DM + s * 256 + l * 16 + 4 * g; const f32x4 x1v = *(const f32x4*)(((float*)p.out) + yo);
            f32x4 o;
            o.x = x1v.x + sh * (float)(g == 0 ? acc[0] : g == 1 ? acc[4] : g == 2 ? acc[8] : acc[12]);
            o.y = x1v.y + sh * (float)(g == 0 ? acc[1] : g == 1 ? acc[5] : g == 2 ? acc[9] : acc[13]);
            o.z = x1v.z + sh * (float)(g == 0 ? acc[2] : g == 1 ? acc[6] : g == 2 ? acc[10] : acc[14]);
            o.w = x1v.w + sh * (float)(g == 0 ? acc[3] : g == 1 ? acc[7] : g == 2 ? acc[11] : acc[15]);
            *(f32x4*)(ydst + yo) = o;
        }
    }
}
__device__ __forceinline__ void final_norm_rows(const P& p, int vcu, int G, float* dst) {
    const int lane = tidx() & 63, gw = vcu * NWAVES + (tidx() >> 6), NGW = G * NWAVES;
    for (int t = gw; t < T; t += NGW) {
        const f32x4* yr = (const f32x4*)(((float*)p.out) + (size_t)t * DM) + lane; const f32x4* gr = (const f32x4*)((const float*)p.g_final) + lane;
        f32x4 v[8]; float s = 0.f;
#pragma unroll
        for (int j = 0; j < 8; ++j) { v[j] = yr[64 * j]; s += (v[j].x * v[j].x + v[j].y * v[j].y) + (v[j].z * v[j].z + v[j].w * v[j].w); }
        const float rstd = rsqrtf(wave_sum(s) * (1.f / DM) + EPS);
        f32x4* o = (f32x4*)(dst + (size_t)t * DM) + lane;
#pragma unroll
        for (int j = 0; j < 8; ++j) o[64 * j] = v[j] * rstd * gr[64 * j];
    }
}

#define TK_CE(a, i, j) { const unsigned h_ = umax_(a[i], a[j]); a[j] = umin_(a[i], a[j]); a[i] = h_; }
__device__ __forceinline__ void sort16_desc(unsigned (&a)[16]) {
    TK_CE(a, 0, 13) TK_CE(a, 1, 12) TK_CE(a, 2, 15) TK_CE(a, 3, 14) TK_CE(a, 4, 8) TK_CE(a, 5, 6) TK_CE(a, 7, 11) TK_CE(a, 9, 10)
    TK_CE(a, 0, 5) TK_CE(a, 1, 7) TK_CE(a, 2, 9) TK_CE(a, 3, 4) TK_CE(a, 6, 13) TK_CE(a, 8, 14) TK_CE(a, 10, 15) TK_CE(a, 11, 12)
    TK_CE(a, 0, 1) TK_CE(a, 2, 3) TK_CE(a, 4, 5) TK_CE(a, 6, 8) TK_CE(a, 7, 9) TK_CE(a, 10, 11) TK_CE(a, 12, 13) TK_CE(a, 14, 15)
    TK_CE(a, 0, 2) TK_CE(a, 1, 3) TK_CE(a, 4, 10) TK_CE(a, 5, 11) TK_CE(a, 6, 7) TK_CE(a, 8, 9) TK_CE(a, 12, 14) TK_CE(a, 13, 15)
    TK_CE(a, 1, 2) TK_CE(a, 3, 12) TK_CE(a, 4, 6) TK_CE(a, 5, 7) TK_CE(a, 8, 10) TK_CE(a, 9, 11) TK_CE(a, 13, 14)
    TK_CE(a, 1, 4) TK_CE(a, 2, 6) TK_CE(a, 5, 8) TK_CE(a, 7, 10) TK_CE(a, 9, 13) TK_CE(a, 11, 14)
    TK_CE(a, 2, 4) TK_CE(a, 3, 6) TK_CE(a, 9, 12) TK_CE(a, 11, 13)
    TK_CE(a, 3, 5) TK_CE(a, 6, 8) TK_CE(a, 7, 9) TK_CE(a, 10, 12)
    TK_CE(a, 3, 4) TK_CE(a, 5, 6) TK_CE(a, 7, 8) TK_CE(a, 9, 10) TK_CE(a, 11, 12)
    TK_CE(a, 6, 7) TK_CE(a, 8, 9)
}
__device__ __forceinline__ void merge_top16(unsigned (&A)[16], const unsigned (&B)[16]) {
#pragma unroll
    for (int i = 0; i < 16; ++i) A[i] = umax_(A[i], B[15 - i]);
#pragma unroll
    for (int j = 8; j >= 1; j >>= 1)
#pragma unroll
        for (int i = 0; i < 16; ++i) if (!(i & j)) TK_CE(A, i, i + j)
}
__host__ __device__ constexpr int cand_index(int i, int j) {
    int n = 0;
    for (int a = 0; a < 16; ++a) for (int b = 0; b < 16; ++b) { if (a == i && b == j) return n; if ((a + 1) * (b + 1) <= 16) ++n; }
    return n;
}
struct EpiRoute {
    static constexpr bool PERM = true, AFTER_DRAIN = true, MIDK = false;
    const bf16* skp; const float* rsp; int* idx; float* gate;
    __device__ __forceinline__ void fused(pg8::f32x4 (&acc)[2][2][4][2], const pg8::Unit& u, int wr, int wc, int fr, int fq, PG8_LAS unsigned char* lds, int wid, int lane) const {
#pragma unroll
        for (int ai = 0; ai < 2; ++ai)
#pragma unroll
            for (int m = 0; m < 4; ++m) { const int row = ai * 128 + wr * 64 + m * 16 + fr;
#pragma unroll
                for (int bj = 0; bj < 2; ++bj) { const int col = bj * 128 + wc * 32 + 8 * fq; const pg8::f32x4 v0 = acc[ai][bj][m][0], v1 = acc[ai][bj][m][1];
                    pg8::u32x4 w; w.x = pg8::cvt_pk_bf16(v0[0], v0[1]); w.y = pg8::cvt_pk_bf16(v0[2], v0[3]); w.z = pg8::cvt_pk_bf16(v1[0], v1[1]); w.w = pg8::cvt_pk_bf16(v1[2], v1[3]);
                    *(PG8_LAS pg8::u32x4*)(lds + row * 528 + col * 2) = w; } }
        asm volatile("s_waitcnt lgkmcnt(0)" ::: "memory"); __builtin_amdgcn_s_barrier(); asm volatile("" ::: "memory");
        const int tk = lane & 31, hi = lane >> 5, trow = 32 * wid + tk;
        unsigned vv[2][16];
#pragma unroll
        for (int ph = 0; ph < 2; ++ph) {
            bf16x8 bq[8];
#pragma unroll
            for (int ks = 0; ks < 8; ++ks) bq[ks] = *(const PG8_LAS bf16x8*)(lds + trow * 528 + (ph * 128 + 16 * ks + 8 * hi) * 2);
#pragma unroll
            for (int nt = 0; nt < 4; ++nt) { f32x16 sc = zero16(); const bf16* ap = skp + (size_t)(ph * 128 + 32 * nt + tk) * 128 + 8 * hi;
#pragma unroll
                for (int ks = 0; ks < 8; ++ks) sc = mfma32(*(const bf16x8*)(ap + 16 * ks), bq[ks], sc);
                unsigned x[16];
#pragma unroll
                for (int r = 0; r < 16; ++r) x[r] = (okey(sc[r]) & 0xffffff80u) | (unsigned)(127 - (32 * nt + (r & 3) + 8 * (r >> 2) + 4 * hi));
                sort16_desc(x);
                if (nt == 0) {
#pragma unroll
                    for (int i = 0; i < 16; ++i) vv[ph][i] = x[i]; }
                else merge_top16(vv[ph], x); }
            unsigned ot[16];
#pragma unroll
            for (int i = 0; i < 16; ++i) ot[i] = (unsigned)__shfl_xor((int)vv[ph][i], 32);
            merge_top16(vv[ph], ot);
        }
        float s0[16], s1[16]; unsigned long long p0lo = 0ull, p0hi = 0ull, p1lo = 0ull, p1hi = 0ull;
#pragma unroll
        for (int i = 0; i < 16; ++i) { const unsigned k0 = vv[0][i], k1 = vv[1][i];
            s0[i] = unkey(k0 & 0xffffff80u); s1[i] = unkey(k1 & 0xffffff80u);
            const unsigned long long a0 = (unsigned long long)(127u - (k0 & 127u)) << (8 * (i & 7)), a1 = (unsigned long long)(127u - (k1 & 127u)) << (8 * (i & 7));
            if (i < 8) { p0lo |= a0; p1lo |= a1; } else { p0hi |= a0; p1hi |= a1; } }
        unsigned bk[16], c1[16], c2[16], c3a = 0u, c3b = 0u;
#pragma unroll
        for (int i = 0; i < 16; ++i)
#pragma unroll
            for (int j = 0; j < 16; ++j) if ((i + 1) * (j + 1) <= 16) {
                const unsigned x = (okey(s0[i] + s1[j]) & 0xffffff00u) | (unsigned)(255 - (i * 16 + j));
                const int n = cand_index(i, j);
                if (n < 16) bk[n & 15] = x; else if (n < 32) c1[n & 15] = x; else if (n < 48) c2[n & 15] = x; else if (n == 48) c3a = x; else c3b = x; }
        sort16_desc(bk); sort16_desc(c1); sort16_desc(c2); merge_top16(bk, c1); merge_top16(bk, c2);
#pragma unroll
        for (int k = 0; k < 16; ++k) { const unsigned hv = umax_(bk[k], c3a); c3a = umin_(bk[k], c3a); bk[k] = hv; }
#pragma unroll
        for (int k = 0; k < 16; ++k) { const unsigned hv = umax_(bk[k], c3b); c3b = umin_(bk[k], c3b); bk[k] = hv; }
        const int t = u.pm * 256 + trow, head = u.pn;
        const float rstd = row_rstd(rsp, t);
        const float mx = unkey(bk[0] & 0xffffff00u) * rstd; float l = 0.f; float ev[16];
#pragma unroll
        for (int k = 0; k < 16; ++k) { ev[k] = __expf(unkey(bk[k] & 0xffffff00u) * rstd - mx); l += ev[k]; }
        const float inv = 1.0f / l;
        int be[16];
#pragma unroll
        for (int k = 0; k < 16; ++k) { const int code = 255 - (int)(bk[k] & 255u), ci = code >> 4, cj = code & 15;
            const int a = (int)(((ci & 8) ? p0hi : p0lo) >> (8 * (ci & 7))) & 0xff, c = (int)(((cj & 8) ? p1hi : p1lo) >> (8 * (cj & 7))) & 0xff;
            be[k] = a * 128 + c; }
        int* io = idx + (size_t)t * 128 + head * 16; float* go = gate + (size_t)t * 128 + head * 16;
        if (hi == 0) {
            *(int4*)io = make_int4(be[0], be[1], be[2], be[3]); *(int4*)(io + 4) = make_int4(be[4], be[5], be[6], be[7]);
            *(f32x4*)go = (f32x4){ev[0] * inv, ev[1] * inv, ev[2] * inv, ev[3] * inv}; *(f32x4*)(go + 4) = (f32x4){ev[4] * inv, ev[5] * inv, ev[6] * inv, ev[7] * inv};
        } else {
            *(int4*)(io + 8) = make_int4(be[8], be[9], be[10], be[11]); *(int4*)(io + 12) = make_int4(be[12], be[13], be[14], be[15]);
            *(f32x4*)(go + 8) = (f32x4){ev[8] * inv, ev[9] * inv, ev[10] * inv, ev[11] * inv}; *(f32x4*)(go + 12) = (f32x4){ev[12] * inv, ev[13] * inv, ev[14] * inv, ev[15] * inv};
        }
    }
};

__device__ __forceinline__ void peer_fused(const P& p, const PeerMap& mp, unsigned char* lds, float* ybuf, float* dst) {
    const int lane = tidx() & 63, wave = tidx() >> 6, g = lane >> 4, l = lane & 15;
    unsigned char* wl = lds + wave * 14848;
    unsigned char* XQl = wl; float* PAl = (float*)(wl + 8192); int* IDl = (int*)(wl + 8192 + 2048); unsigned char* HQl = wl + 8192 + 4096;
    const float* SU = WSP(const float, WS_SU); const float* SV = WSP(const float, WS_SV);
    const int slot = mp.r * NWAVES + wave, nslots = mp.nloc * NWAVES;
    for (int q0 = slot; q0 * mp.nx + mp.rho < T; q0 += 4 * nslots) {
        int tk[4]; float ascale[4], sh[4], ssq[4];
#pragma unroll
        for (int j = 0; j < 4; ++j) { const int t = (q0 + j * nslots) * mp.nx + mp.rho; tk[j] = t < T ? t : -1; ssq[j] = 0.f; sh[j] = 0.f; ascale[j] = 0.f; }
#pragma unroll
        for (int j = 0; j < 4; ++j) if (tk[j] >= 0) { const int t = tk[j];
            const v4u* xp = WSP(const v4u, WS_XG) + (size_t)t * 256 + lane * 4; float f[32];
            unpack8(xp[0], f); unpack8(xp[1], f + 8); unpack8(xp[2], f + 16); unpack8(xp[3], f + 24);
            float m = 0.f;
#pragma unroll
            for (int i = 0; i < 32; ++i) m = fmaxf(m, fabsf(f[i]));
            m = fmaxf(wave_max(m), 1e-30f); const float inv = 127.f / m; ascale[j] = row_rstd(WSP(const float, WS_RSP), t) * m * (1.f / 127.f);
            v4u o0, o1;
            o0.x = q8(f[0], inv) | (q8(f[1], inv) << 8) | (q8(f[2], inv) << 16) | (q8(f[3], inv) << 24); o0.y = q8(f[4], inv) | (q8(f[5], inv) << 8) | (q8(f[6], inv) << 16) | (q8(f[7], inv) << 24);
            o0.z = q8(f[8], inv) | (q8(f[9], inv) << 8) | (q8(f[10], inv) << 16) | (q8(f[11], inv) << 24); o0.w = q8(f[12], inv) | (q8(f[13], inv) << 8) | (q8(f[14], inv) << 16) | (q8(f[15], inv) << 24);
            o1.x = q8(f[16], inv) | (q8(f[17], inv) << 8) | (q8(f[18], inv) << 16) | (q8(f[19], inv) << 24); o1.y = q8(f[20], inv) | (q8(f[21], inv) << 8) | (q8(f[22], inv) << 16) | (q8(f[23], inv) << 24);
            o1.z = q8(f[24], inv) | (q8(f[25], inv) << 8) | (q8(f[26], inv) << 16) | (q8(f[27], inv) << 24); o1.w = q8(f[28], inv) | (q8(f[29], inv) << 8) | (q8(f[30], inv) << 16) | (q8(f[31], inv) << 24);
            *(v4u*)(XQl + j * 2048 + lane * 32) = o0; *(v4u*)(XQl + j * 2048 + lane * 32 + 16) = o1;
            const int ia = WSP(const int, WS_IDX)[(size_t)t * 128 + lane], ib = WSP(const int, WS_IDX)[(size_t)t * 128 + 64 + lane];
            IDl[j * 128 + (lane & 3) * 32 + (lane >> 2)] = ia; IDl[j * 128 + (lane & 3) * 32 + 16 + (lane >> 2)] = ib;
            PAl[j * 128 + lane] = 0.f; PAl[j * 128 + 64 + lane] = 0.f; }
        for (int s = 0; s < 8; ++s) {
            const unsigned char* ub = (const unsigned char*)(p.ws + WS_UQ) + s * 256 + l * 16;
#pragma unroll
            for (int j = 0; j < 4; ++j) if (tk[j] >= 0) {
                const v4u xq = *(const v4u*)(XQl + j * 2048 + s * 256 + l * 16);
#pragma unroll
                for (int k0 = 0; k0 < 32; k0 += 16) {
                    int idxv[16];
#pragma unroll
                    for (int k4 = 0; k4 < 4; ++k4) { const int4 q = *(const int4*)(IDl + j * 128 + g * 32 + k0 + 4 * k4); idxv[4 * k4] = q.x; idxv[4 * k4 + 1] = q.y; idxv[4 * k4 + 2] = q.z; idxv[4 * k4 + 3] = q.w; }
                    v4u w[16];
#pragma unroll
                    for (int k = 0; k < 16; ++k) w[k] = *(const v4u*)(ub + (size_t)idxv[k] * DM);
#pragma unroll
                    for (int k = 0; k < 16; ++k) { int a0 = sdot4(w[k].x, xq.x, 0), a1 = sdot4(w[k].y, xq.y, 0); a0 = sdot4(w[k].z, xq.z, a0); a1 = sdot4(w[k].w, xq.w, a1);
                        const float d = row16_sum((float)(a0 + a1));
                        if (l == 0) PAl[j * 128 + 4 * (k0 + k) + g] += d; }
                }
            }
        }
#pragma unroll
        for (int j = 0; j < 4; ++j) if (tk[j] >= 0) { const int t = tk[j];
            const int ia = IDl[j * 128 + (lane & 3) * 32 + (lane >> 2)], ib = IDl[j * 128 + (lane & 3) * 32 + 16 + (lane >> 2)];
            const float aa = PAl[j * 128 + lane] * ascale[j] * SU[ia], ab = PAl[j * 128 + 64 + lane] * ascale[j] * SU[ib];
            const float ha = 0.5f * aa * (1.0f + erff(aa * 0.70710678118f)) * WSP(const float, WS_GATE)[(size_t)t * 128 + lane] * SV[ia];
            const float hb = 0.5f * ab * (1.0f + erff(ab * 0.70710678118f)) * WSP(const float, WS_GATE)[(size_t)t * 128 + 64 + lane] * SV[ib];
            const float m = fmaxf(wave_max(fmaxf(fabsf(ha), fabsf(hb))), 1e-30f); sh[j] = m * (1.f / 127.f); const float inv = 127.f / m;
            HQl[j * 128 + (lane & 3) * 32 + (lane >> 2)] = (unsigned char)q8(ha, inv); HQl[j * 128 + (lane & 3) * 32 + 16 + (lane >> 2)] = (unsigned char)q8(hb, inv); }
        for (int s = 0; s < 8; ++s) {
            const unsigned char* vb = (const unsigned char*)(p.ws + WS_VQ) + s * 256 + l * 16;
#pragma unroll
            for (int j = 0; j < 4; ++j) if (tk[j] >= 0) {
                const v4u h0 = *(const v4u*)(HQl + j * 128 + g * 32), h1 = *(const v4u*)(HQl + j * 128 + g * 32 + 16);
                const unsigned hq[8] = {h0.x, h0.y, h0.z, h0.w, h1.x, h1.y, h1.z, h1.w};
                int acc[16];
#pragma unroll
                for (int c = 0; c < 16; ++c) acc[c] = 0;
#pragma unroll
                for (int k0 = 0; k0 < 32; k0 += 16) {
                    int idxv[16];
#pragma unroll
                    for (int k4 = 0; k4 < 4; ++k4) { const int4 q = *(const int4*)(IDl + j * 128 + g * 32 + k0 + 4 * k4); idxv[4 * k4] = q.x; idxv[4 * k4 + 1] = q.y; idxv[4 * k4 + 2] = q.z; idxv[4 * k4 + 3] = q.w; }
                    v4u w[16];
#pragma unroll
                    for (int k = 0; k < 16; ++k) w[k] = *(const v4u*)(vb + (size_t)idxv[k] * DM);
#pragma unroll
                    for (int k4 = 0; k4 < 4; ++k4) { const unsigned hd = hq[(k0 >> 2) + k4];
#pragma unroll
                        for (int c4 = 0; c4 < 4; ++c4) {
                            const unsigned a = w[4 * k4][c4], b = w[4 * k4 + 1][c4], c = w[4 * k4 + 2][c4], d = w[4 * k4 + 3][c4];
                            const unsigned pq = permb(b, a, 0x05010400u), qq = permb(b, a, 0x07030602u), rq = permb(d, c, 0x05010400u), sq = permb(d, c, 0x07030602u);
                            acc[4 * c4 + 0] = sdot4(permb(rq, pq, 0x05040100u), hd, acc[4 * c4 + 0]); acc[4 * c4 + 1] = sdot4(permb(rq, pq, 0x07060302u), hd, acc[4 * c4 + 1]);
                            acc[4 * c4 + 2] = sdot4(permb(sq, qq, 0x05040100u), hd, acc[4 * c4 + 2]); acc[4 * c4 + 3] = sdot4(permb(sq, qq, 0x07060302u), hd, acc[4 * c4 + 3]); } }
                }
#pragma unroll
                for (int c = 0; c < 16; ++c) { acc[c] += __shfl_xor(acc[c], 16); acc[c] += __shfl_xor(acc[c], 32); }
                const size_t yo = (size_t)tk[j] * DM + s * 256 + l * 16 + 4 * g; const f32x4 x1v = *(const f32x4*)(((float*)p.out) + yo);
                f32x4 o;
                o.x = x1v.x + sh[j] * (float)(g == 0 ? acc[0] : g == 1 ? acc[4] : g == 2 ? acc[8] : acc[12]);
                o.y = x1v.y + sh[j] * (float)(g == 0 ? acc[1] : g == 1 ? acc[5] : g == 2 ? acc[9] : acc[13]);
                o.z = x1v.z + sh[j] * (float)(g == 0 ? acc[2] : g == 1 ? acc[6] : g == 2 ? acc[10] : acc[14]);
                o.w = x1v.w + sh[j] * (float)(g == 0 ? acc[3] : g == 1 ? acc[7] : g == 2 ? acc[11] : acc[15]);
                *(f32x4*)(ybuf + yo) = o;
                ssq[j] += (o.x * o.x + o.y * o.y) + (o.z * o.z + o.w * o.w);
            }
        }
        asm volatile("s_waitcnt vmcnt(0)" ::: "memory");
#pragma unroll
        for (int j = 0; j < 4; ++j) if (tk[j] >= 0) {
            const float rstd = rsqrtf(wave_sum(ssq[j]) * (1.f / DM) + EPS);
            const f32x4* yr = (const f32x4*)(ybuf + (size_t)tk[j] * DM) + lane; const f32x4* gr = (const f32x4*)((const float*)p.g_final) + lane; f32x4* o = (f32x4*)(dst + (size_t)tk[j] * DM) + lane;
            f32x4 v[8];
#pragma unroll
            for (int i = 0; i < 8; ++i) v[i] = __builtin_nontemporal_load(yr + 64 * i);
#pragma unroll
            for (int i = 0; i < 8; ++i) o[64 * i] = v[i] * rstd * gr[64 * i];
        }
    }
}

__device__ __forceinline__ void peer_fused16(const P& p, const PeerMap& mp, unsigned char* lds, float* ybuf, float* dst) {
    const int lane = tidx() & 63, wave = tidx() >> 6, g = lane >> 3, l = lane & 7;
    unsigned char* wl = lds + wave * 18944;
    unsigned char* XQl = wl; float* PAl = (float*)(wl + 8192); int* IDl = (int*)(wl + 16384); unsigned char* HQl = wl + 16384 + 2048; unsigned char* Yl = wl;
    const float* SU = WSP(const float, WS_SU); const float* SV = WSP(const float, WS_SV);
    const int slot = mp.r * NWAVES + wave, nslots = mp.nloc * NWAVES;
    for (int q0 = slot; q0 * mp.nx + mp.rho < T; q0 += 4 * nslots) {
        int tk[4]; float ascale[4], sh[4], ssq[4];
#pragma unroll
        for (int j = 0; j < 4; ++j) { const int t = (q0 + j * nslots) * mp.nx + mp.rho; tk[j] = t < T ? t : -1; ssq[j] = 0.f; sh[j] = 0.f; ascale[j] = 0.f; }
#pragma unroll
        for (int j = 0; j < 4; ++j) if (tk[j] >= 0) { const int t = tk[j];
            const v4u* xp = WSP(const v4u, WS_XG) + (size_t)t * 256 + lane * 4; float f[32];
            unpack8(xp[0], f); unpack8(xp[1], f + 8); unpack8(xp[2], f + 16); unpack8(xp[3], f + 24);
            float m = 0.f;
#pragma unroll
            for (int i = 0; i < 32; ++i) m = fmaxf(m, fabsf(f[i]));
            m = fmaxf(wave_max(m), 1e-30f); const float inv = 127.f / m; ascale[j] = row_rstd(WSP(const float, WS_RSP), t) * m * (1.f / 127.f);
            v4u o0, o1;
            o0.x = q8(f[0], inv) | (q8(f[1], inv) << 8) | (q8(f[2], inv) << 16) | (q8(f[3], inv) << 24); o0.y = q8(f[4], inv) | (q8(f[5], inv) << 8) | (q8(f[6], inv) << 16) | (q8(f[7], inv) << 24);
            o0.z = q8(f[8], inv) | (q8(f[9], inv) << 8) | (q8(f[10], inv) << 16) | (q8(f[11], inv) << 24); o0.w = q8(f[12], inv) | (q8(f[13], inv) << 8) | (q8(f[14], inv) << 16) | (q8(f[15], inv) << 24);
            o1.x = q8(f[16], inv) | (q8(f[17], inv) << 8) | (q8(f[18], inv) << 16) | (q8(f[19], inv) << 24); o1.y = q8(f[20], inv) | (q8(f[21], inv) << 8) | (q8(f[22], inv) << 16) | (q8(f[23], inv) << 24);
            o1.z = q8(f[24], inv) | (q8(f[25], inv) << 8) | (q8(f[26], inv) << 16) | (q8(f[27], inv) << 24); o1.w = q8(f[28], inv) | (q8(f[29], inv) << 8) | (q8(f[30], inv) << 16) | (q8(f[31], inv) << 24);
            *(v4u*)(XQl + j * 2048 + lane * 32) = o0; *(v4u*)(XQl + j * 2048 + lane * 32 + 16) = o1;
            const int ia = WSP(const int, WS_IDX)[(size_t)t * 128 + lane], ib = WSP(const int, WS_IDX)[(size_t)t * 128 + 64 + lane];
            IDl[j * 128 + (lane & 7) * 16 + (lane >> 3)] = ia; IDl[j * 128 + (lane & 7) * 16 + 8 + (lane >> 3)] = ib;
            PAl[j * 128 + lane] = 0.f; PAl[j * 128 + 64 + lane] = 0.f; }
        int pu[4][16];
#pragma unroll
        for (int j = 0; j < 4; ++j)
#pragma unroll
            for (int k = 0; k < 16; ++k) pu[j][k] = 0;
        for (int s = 0; s < 16; ++s) {
            const unsigned char* ub = (const unsigned char*)(p.ws + WS_UQ) + (size_t)s * (NEXP * 128) + l * 16;
#pragma unroll
            for (int j = 0; j < 4; ++j) if (tk[j] >= 0) {
                const v4u xq = *(const v4u*)(XQl + j * 2048 + s * 128 + l * 16);
                int idxv[16];
#pragma unroll
                for (int k4 = 0; k4 < 4; ++k4) { const int4 q = *(const int4*)(IDl + j * 128 + g * 16 + 4 * k4); idxv[4 * k4] = q.x; idxv[4 * k4 + 1] = q.y; idxv[4 * k4 + 2] = q.z; idxv[4 * k4 + 3] = q.w; }
                v4u w[16];
#pragma unroll
                for (int k = 0; k < 16; ++k) w[k] = *(const v4u*)(ub + (size_t)idxv[k] * 128);
#pragma unroll
                for (int k = 0; k < 16; ++k) { int a0 = sdot4(w[k].x, xq.x, pu[j][k]); a0 = sdot4(w[k].y, xq.y, a0); a0 = sdot4(w[k].z, xq.z, a0); pu[j][k] = sdot4(w[k].w, xq.w, a0); }
            }
        }
#pragma unroll
        for (int j = 0; j < 4; ++j) if (tk[j] >= 0) {
#pragma unroll
            for (int k = 0; k < 16; ++k) { const float d = sum8((float)pu[j][k]); if (l == 0) PAl[j * 128 + 8 * k + g] = d; } }
#pragma unroll
        for (int j = 0; j < 4; ++j) if (tk[j] >= 0) { const int t = tk[j]; int lane = tidx() & 63; asm volatile("" : "+v"(lane));
            const int ia = IDl[j * 128 + (lane & 7) * 16 + (lane >> 3)], ib = IDl[j * 128 + (lane & 7) * 16 + 8 + (lane >> 3)];
            const float aa = PAl[j * 128 + lane] * ascale[j] * SU[ia], ab = PAl[j * 128 + 64 + lane] * ascale[j] * SU[ib];
            const float ha = 0.5f * aa * (1.0f + erff(aa * 0.70710678118f)) * WSP(const float, WS_GATE)[(size_t)t * 128 + lane] * SV[ia];
            const float hb = 0.5f * ab * (1.0f + erff(ab * 0.70710678118f)) * WSP(const float, WS_GATE)[(size_t)t * 128 + 64 + lane] * SV[ib];
            const float m = fmaxf(wave_max(fmaxf(fabsf(ha), fabsf(hb))), 1e-30f); sh[j] = m * (1.f / 127.f); const float inv = 127.f / m;
            HQl[j * 128 + (lane & 7) * 16 + (lane >> 3)] = (unsigned char)q8(ha, inv); HQl[j * 128 + (lane & 7) * 16 + 8 + (lane >> 3)] = (unsigned char)q8(hb, inv); }
        for (int s = 0; s < 16; ++s) {
            const unsigned char* vb = (const unsigned char*)(p.ws + WS_VQ) + (size_t)s * (NEXP * 128) + l * 16;
#pragma unroll
            for (int j = 0; j < 4; ++j) if (tk[j] >= 0) {
                const v4u h0 = *(const v4u*)(HQl + j * 128 + g * 16);
                const unsigned hq[4] = {h0.x, h0.y, h0.z, h0.w};
                int acc[16];
#pragma unroll
                for (int c = 0; c < 16; ++c) acc[c] = 0;
                int idxv[16];
#pragma unroll
                for (int k4 = 0; k4 < 4; ++k4) { const int4 q = *(const int4*)(IDl + j * 128 + g * 16 + 4 * k4); idxv[4 * k4] = q.x; idxv[4 * k4 + 1] = q.y; idxv[4 * k4 + 2] = q.z; idxv[4 * k4 + 3] = q.w; }
                v4u w[16];
#pragma unroll
                for (int k = 0; k < 16; ++k) w[k] = *(const v4u*)(vb + (size_t)idxv[k] * 128);
#pragma unroll
                for (int k4 = 0; k4 < 4; ++k4) { const unsigned hd = hq[k4];
#pragma unroll
                    for (int c4 = 0; c4 < 4; ++c4) {
                        const unsigned a = w[4 * k4][c4], b = w[4 * k4 + 1][c4], c = w[4 * k4 + 2][c4], d = w[4 * k4 + 3][c4];
                        const unsigned pq = permb(b, a, 0x05010400u), qq = permb(b, a, 0x07030602u), rq = permb(d, c, 0x05010400u), sq = permb(d, c, 0x07030602u);
                        acc[4 * c4 + 0] = sdot4(permb(rq, pq, 0x05040100u), hd, acc[4 * c4 + 0]); acc[4 * c4 + 1] = sdot4(permb(rq, pq, 0x07060302u), hd, acc[4 * c4 + 1]);
                        acc[4 * c4 + 2] = sdot4(permb(sq, qq, 0x05040100u), hd, acc[4 * c4 + 2]); acc[4 * c4 + 3] = sdot4(permb(sq, qq, 0x07060302u), hd, acc[4 * c4 + 3]); } }
                int r8[8], r4[4];
#pragma unroll
                for (int c = 0; c < 8; ++c) { auto rr = __builtin_amdgcn_permlane32_swap((unsigned)acc[c], (unsigned)acc[c + 8], false, false); r8[c] = (int)rr[0] + (int)rr[1]; }
#pragma unroll
                for (int c = 0; c < 4; ++c) { auto rr = __builtin_amdgcn_permlane16_swap((unsigned)r8[c], (unsigned)r8[c + 4], false, false); r4[c] = (int)rr[0] + (int)rr[1]; }
                const bool b3 = (lane & 8) != 0;
                const int k0v = b3 ? r4[2] : r4[0], s0v = b3 ? r4[0] : r4[2], k1v = b3 ? r4[3] : r4[1], s1v = b3 ? r4[1] : r4[3];
                const int s0 = k0v + (int)dppu<0x128>((unsigned)s0v), s1 = k1v + (int)dppu<0x128>((unsigned)s1v);
                const size_t yo = (size_t)tk[j] * DM + s * 128 + l * 16 + 2 * g; const unsigned xb = *(const unsigned*)(WSP(const bf16, WS_XG) + yo);
                const float o0 = __uint_as_float(xb << 16) + sh[j] * (float)s0, o1 = __uint_as_float(xb & 0xffff0000u) + sh[j] * (float)s1;
                *(unsigned*)(Yl + j * 4096 + s * 256 + l * 32 + 4 * g) = pk2(o0, o1);
                ssq[j] += o0 * o0 + o1 * o1;
            }
        }
        asm volatile("s_waitcnt lgkmcnt(0)" ::: "memory");
#pragma unroll
        for (int j = 0; j < 4; ++j) if (tk[j] >= 0) {
            const float rstd = rsqrtf(wave_sum(ssq[j]) * (1.f / DM) + EPS);
            const float* gr = (const float*)p.g_final; float* o = dst + (size_t)tk[j] * DM;
#pragma unroll
            for (int i = 0; i < 4; ++i) { const int c8 = (i * 64 + lane) * 8; const v4u yv = *(const v4u*)(Yl + j * 4096 + c8 * 2);
                const f32x4 g0 = *(const f32x4*)(gr + c8), g1 = *(const f32x4*)(gr + c8 + 4);
                f32x4 r0, r1;
                r0.x = __uint_as_float(yv.x << 16) * rstd * g0.x; r0.y = __uint_as_float(yv.x & 0xffff0000u) * rstd * g0.y; r0.z = __uint_as_float(yv.y << 16) * rstd * g0.z; r0.w = __uint_as_float(yv.y & 0xffff0000u) * rstd * g0.w;
                r1.x = __uint_as_float(yv.z << 16) * rstd * g1.x; r1.y = __uint_as_float(yv.z & 0xffff0000u) * rstd * g1.y; r1.z = __uint_as_float(yv.w << 16) * rstd * g1.z; r1.w = __uint_as_float(yv.w & 0xffff0000u) * rstd * g1.w;
                *(f32x4*)(o + c8) = r0; *(f32x4*)(o + c8 + 4) = r1; }
        }
    }
}

__device__ __forceinline__ void peer_fused_s(const P& p, const PeerMap& mp, unsigned char* lds, float* dst, const XcdBarrier& xbar, int bxv) {
    const int lane = tidx() & 63, wave = tidx() >> 6, g = lane >> 3, l = lane & 7;
    unsigned char* wl = lds + (wave < 7 ? wave : 0) * 22400;
    unsigned char* XQl = wl; float* PAl = (float*)(wl + 10240); unsigned short* IDl = (unsigned short*)(wl + 20480); unsigned char* HQl = wl + 20480 + 1280; unsigned char* Yl = wl;
    const float* SU = WSP(const float, WS_SU); const float* SV = WSP(const float, WS_SV);
    const bool tokw = wave < 7;
    {
        int tk[5]; float ascale[5], sh[5], ssq[5];
#pragma unroll
        for (int j = 0; j < 5; ++j) { const int tl = wave * 32 + mp.r + 224 * j; tk[j] = (tokw && tl < 1024) ? tl * 8 + mp.rho : -1; ssq[j] = 0.f; sh[j] = 0.f; ascale[j] = 0.f; }
#pragma unroll
        for (int j = 0; j < 5; ++j) if (tk[j] >= 0) { const int t = tk[j];
            const v4u* xp = WSP(const v4u, WS_XG) + (size_t)t * 256 + lane * 4; float f[32];
            unpack8(xp[0], f); unpack8(xp[1], f + 8); unpack8(xp[2], f + 16); unpack8(xp[3], f + 24);
            float m = 0.f;
#pragma unroll
            for (int i = 0; i < 32; ++i) m = fmaxf(m, fabsf(f[i]));
            m = fmaxf(wave_max(m), 1e-30f); const float inv = 127.f / m; ascale[j] = row_rstd(WSP(const float, WS_RSP), t) * m * (1.f / 127.f);
            v4u o0, o1;
            o0.x = q8(f[0], inv) | (q8(f[1], inv) << 8) | (q8(f[2], inv) << 16) | (q8(f[3], inv) << 24); o0.y = q8(f[4], inv) | (q8(f[5], inv) << 8) | (q8(f[6], inv) << 16) | (q8(f[7], inv) << 24);
            o0.z = q8(f[8], inv) | (q8(f[9], inv) << 8) | (q8(f[10], inv) << 16) | (q8(f[11], inv) << 24); o0.w = q8(f[12], inv) | (q8(f[13], inv) << 8) | (q8(f[14], inv) << 16) | (q8(f[15], inv) << 24);
            o1.x = q8(f[16], inv) | (q8(f[17], inv) << 8) | (q8(f[18], inv) << 16) | (q8(f[19], inv) << 24); o1.y = q8(f[20], inv) | (q8(f[21], inv) << 8) | (q8(f[22], inv) << 16) | (q8(f[23], inv) << 24);
            o1.z = q8(f[24], inv) | (q8(f[25], inv) << 8) | (q8(f[26], inv) << 16) | (q8(f[27], inv) << 24); o1.w = q8(f[28], inv) | (q8(f[29], inv) << 8) | (q8(f[30], inv) << 16) | (q8(f[31], inv) << 24);
            *(v4u*)(XQl + j * 2048 + lane * 32) = o0; *(v4u*)(XQl + j * 2048 + lane * 32 + 16) = o1;
            const int ia = WSP(const int, WS_IDX)[(size_t)t * 128 + lane], ib = WSP(const int, WS_IDX)[(size_t)t * 128 + 64 + lane];
            IDl[j * 128 + (lane & 7) * 16 + (lane >> 3)] = (unsigned short)ia; IDl[j * 128 + (lane & 7) * 16 + 8 + (lane >> 3)] = (unsigned short)ib;
            PAl[j * 128 + lane] = 0.f; PAl[j * 128 + 64 + lane] = 0.f; }
        int pu[5][16];
#pragma unroll
        for (int j = 0; j < 5; ++j)
#pragma unroll
            for (int k = 0; k < 16; ++k) pu[j][k] = 0;
        for (int s = 0; s < 16; ++s) {
            const unsigned char* ub = (const unsigned char*)(p.ws + WS_UQ) + (size_t)s * (NEXP * 128) + l * 16;
#pragma unroll
            for (int j = 0; j < 5; ++j) if (tk[j] >= 0) {
                const v4u xq = *(const v4u*)(XQl + j * 2048 + s * 128 + l * 16);
                int idxv[16];
#pragma unroll
                for (int k8 = 0; k8 < 2; ++k8) { const v4u q = *(const v4u*)(IDl + j * 128 + g * 16 + 8 * k8); idxv[8 * k8] = (int)(q.x & 0xffffu); idxv[8 * k8 + 1] = (int)(q.x >> 16); idxv[8 * k8 + 2] = (int)(q.y & 0xffffu); idxv[8 * k8 + 3] = (int)(q.y >> 16);
                    idxv[8 * k8 + 4] = (int)(q.z & 0xffffu); idxv[8 * k8 + 5] = (int)(q.z >> 16); idxv[8 * k8 + 6] = (int)(q.w & 0xffffu); idxv[8 * k8 + 7] = (int)(q.w >> 16); }
                v4u w[16];
#pragma unroll
                for (int k = 0; k < 16; ++k) w[k] = *(const v4u*)(ub + (size_t)idxv[k] * 128);
#pragma unroll
                for (int k = 0; k < 16; ++k) { int a0 = sdot4(w[k].x, xq.x, pu[j][k]); a0 = sdot4(w[k].y, xq.y, a0); a0 = sdot4(w[k].z, xq.z, a0); pu[j][k] = sdot4(w[k].w, xq.w, a0); }
            }
        }
#pragma unroll
        for (int j = 0; j < 5; ++j) if (tk[j] >= 0) {
#pragma unroll
            for (int k = 0; k < 16; ++k) { const float d = sum8((float)pu[j][k]); if (l == 0) PAl[j * 128 + 8 * k + g] = d; } }
        if (!tokw) {
            auto sload = [&](int r2, f32x4 (&v)[2][8]) {
#pragma unroll
                for (int q = 0; q < 2; ++q) { const f32x4* xr = (const f32x4*)(((const float*)p.pv) + (size_t)(r2 + q) * DM) + lane;
#pragma unroll
                    for (int jj = 0; jj < 8; ++jj) v[q][jj] = __builtin_nontemporal_load(xr + 64 * jj); } };
            f32x4 vc[2][8]; const int r0 = bxv * 64; sload(r0, vc);
            for (int r2 = r0; r2 < r0 + 64; r2 += 2) { f32x4 vn[2][8]; const bool more = r2 + 2 < r0 + 64;
                asm volatile("s_waitcnt vmcnt(18)" ::: "memory");
                if (more) sload(r2 + 2, vn);
#pragma unroll
                for (int q = 0; q < 2; ++q) { const int row = r2 + q; float m = 0.f;
#pragma unroll
                    for (int jj = 0; jj < 8; ++jj) m = fmaxf(fmaxf(m, fmaxf(fabsf(vc[q][jj].x), fabsf(vc[q][jj].y))), fmaxf(fabsf(vc[q][jj].z), fabsf(vc[q][jj].w)));
                    m = fmaxf(wave_max(m), 1e-30f); const float inv = 127.f / m;
                    unsigned* o = (unsigned*)(p.ws + WS_VQ + (size_t)(lane >> 5) * (NEXP * 128) + (size_t)row * 128) + (lane & 31);
#pragma unroll
                    for (int jj = 0; jj < 8; ++jj) o[(size_t)jj * (2 * NEXP * 128 / 4)] = q8b(vc[q][jj].x, inv) | (q8b(vc[q][jj].y, inv) << 8) | (q8b(vc[q][jj].z, inv) << 16) | (q8b(vc[q][jj].w, inv) << 24);
                    if (lane == 0) WSP(float, WS_SV)[row] = m * (1.f / 127.f); }
                if (more) {
#pragma unroll
                    for (int q = 0; q < 2; ++q)
#pragma unroll
                        for (int jj = 0; jj < 8; ++jj) vc[q][jj] = vn[q][jj]; } } }
        xcd_barrier(xbar);
#pragma unroll
        for (int j = 0; j < 5; ++j) if (tk[j] >= 0) { const int t = tk[j]; int lane = tidx() & 63; asm volatile("" : "+v"(lane));
            const int ia = IDl[j * 128 + (lane & 7) * 16 + (lane >> 3)], ib = IDl[j * 128 + (lane & 7) * 16 + 8 + (lane >> 3)];
            const float aa = PAl[j * 128 + lane] * ascale[j] * SU[ia], ab = PAl[j * 128 + 64 + lane] * ascale[j] * SU[ib];
            const float ha = 0.5f * aa * (1.0f + erff(aa * 0.70710678118f)) * WSP(const float, WS_GATE)[(size_t)t * 128 + lane] * SV[ia];
            const float hb = 0.5f * ab * (1.0f + erff(ab * 0.70710678118f)) * WSP(const float, WS_GATE)[(size_t)t * 128 + 64 + lane] * SV[ib];
            const float m = fmaxf(wave_max(fmaxf(fabsf(ha), fabsf(hb))), 1e-30f); sh[j] = m * (1.f / 127.f); const float inv = 127.f / m;
            HQl[j * 128 + (lane & 7) * 16 + (lane >> 3)] = (unsigned char)q8(ha, inv); HQl[j * 128 + (lane & 7) * 16 + 8 + (lane >> 3)] = (unsigned char)q8(hb, inv); }
        for (int s = 0; s < 16; ++s) {
            const unsigned char* vb = (const unsigned char*)(p.ws + WS_VQ) + (size_t)s * (NEXP * 128) + l * 16;
#pragma unroll
            for (int j = 0; j < 5; ++j) if (tk[j] >= 0) {
                const v4u h0 = *(const v4u*)(HQl + j * 128 + g * 16);
                const unsigned hq[4] = {h0.x, h0.y, h0.z, h0.w};
                int acc[16];
#pragma unroll
                for (int c = 0; c < 16; ++c) acc[c] = 0;
                int idxv[16];
#pragma unroll
                for (int k8 = 0; k8 < 2; ++k8) { const v4u q = *(const v4u*)(IDl + j * 128 + g * 16 + 8 * k8); idxv[8 * k8] = (int)(q.x & 0xffffu); idxv[8 * k8 + 1] = (int)(q.x >> 16); idxv[8 * k8 + 2] = (int)(q.y & 0xffffu); idxv[8 * k8 + 3] = (int)(q.y >> 16);
                    idxv[8 * k8 + 4] = (int)(q.z & 0xffffu); idxv[8 * k8 + 5] = (int)(q.z >> 16); idxv[8 * k8 + 6] = (int)(q.w & 0xffffu); idxv[8 * k8 + 7] = (int)(q.w >> 16); }
                v4u w[16];
#pragma unroll
                for (int k = 0; k < 16; ++k) w[k] = *(const v4u*)(vb + (size_t)idxv[k] * 128);
#pragma unroll
                for (int k4 = 0; k4 < 4; ++k4) { const unsigned hd = hq[k4];
#pragma unroll
                    for (int c4 = 0; c4 < 4; ++c4) {
                        const unsigned a = w[4 * k4][c4], b = w[4 * k4 + 1][c4], c = w[4 * k4 + 2][c4], d = w[4 * k4 + 3][c4];
                        const unsigned pq = permb(b, a, 0x05010400u), qq = permb(b, a, 0x07030602u), rq = permb(d, c, 0x05010400u), sq = permb(d, c, 0x07030602u);
                        acc[4 * c4 + 0] = sdot4(permb(rq, pq, 0x05040100u), hd, acc[4 * c4 + 0]); acc[4 * c4 + 1] = sdot4(permb(rq, pq, 0x07060302u), hd, acc[4 * c4 + 1]);
                        acc[4 * c4 + 2] = sdot4(permb(sq, qq, 0x05040100u), hd, acc[4 * c4 + 2]); acc[4 * c4 + 3] = sdot4(permb(sq, qq, 0x07060302u), hd, acc[4 * c4 + 3]); } }
                int r8[8], r4[4];
#pragma unroll
                for (int c = 0; c < 8; ++c) { auto rr = __builtin_amdgcn_permlane32_swap((unsigned)acc[c], (unsigned)acc[c + 8], false, false); r8[c] = (int)rr[0] + (int)rr[1]; }
#pragma unroll
                for (int c = 0; c < 4; ++c) { auto rr = __builtin_amdgcn_permlane16_swap((unsigned)r8[c], (unsigned)r8[c + 4], false, false); r4[c] = (int)rr[0] + (int)rr[1]; }
                const bool b3 = (lane & 8) != 0;
                const int k0v = b3 ? r4[2] : r4[0], s0v = b3 ? r4[0] : r4[2], k1v = b3 ? r4[3] : r4[1], s1v = b3 ? r4[1] : r4[3];
                const int s0 = k0v + (int)dppu<0x128>((unsigned)s0v), s1 = k1v + (int)dppu<0x128>((unsigned)s1v);
                const size_t yo = (size_t)tk[j] * DM + s * 128 + l * 16 + 2 * g; const unsigned xb = *(const unsigned*)(WSP(const bf16, WS_XG) + yo);
                const float o0 = __uint_as_float(xb << 16) + sh[j] * (float)s0, o1 = __uint_as_float(xb & 0xffff0000u) + sh[j] * (float)s1;
                *(unsigned*)(Yl + j * 4096 + s * 256 + l * 32 + 4 * g) = pk2(o0, o1);
                ssq[j] += o0 * o0 + o1 * o1;
            }
        }
        asm volatile("s_waitcnt lgkmcnt(0)" ::: "memory");
#pragma unroll
        for (int j = 0; j < 5; ++j) if (tk[j] >= 0) {
            const float rstd = rsqrtf(wave_sum(ssq[j]) * (1.f / DM) + EPS);
            const float* gr = (const float*)p.g_final; float* o = dst + (size_t)tk[j] * DM;
#pragma unroll
            for (int i = 0; i < 4; ++i) { const int c8 = (i * 64 + lane) * 8; const v4u yv = *(const v4u*)(Yl + j * 4096 + c8 * 2);
                const f32x4 g0 = *(const f32x4*)(gr + c8), g1 = *(const f32x4*)(gr + c8 + 4);
                f32x4 r0, r1;
                r0.x = __uint_as_float(yv.x << 16) * rstd * g0.x; r0.y = __uint_as_float(yv.x & 0xffff0000u) * rstd * g0.y; r0.z = __uint_as_float(yv.y << 16) * rstd * g0.z; r0.w = __uint_as_float(yv.y & 0xffff0000u) * rstd * g0.w;
                r1.x = __uint_as_float(yv.z << 16) * rstd * g1.x; r1.y = __uint_as_float(yv.z & 0xffff0000u) * rstd * g1.y; r1.z = __uint_as_float(yv.w << 16) * rstd * g1.z; r1.w = __uint_as_float(yv.w & 0xffff0000u) * rstd * g1.w;
                __builtin_nontemporal_store(r0, (f32x4*)(o + c8)); __builtin_nontemporal_store(r1, (f32x4*)(o + c8 + 4)); }
        }
    }
}
#ifndef PROBE_IN
#define PROBE_IN 0
#endif
#ifndef MK_SPLIT
#define MK_SPLIT 0
#endif
constexpr int NPHASE = 9;
template <int LO, int HI> __global__ void __launch_bounds__(NTHR, 2) mk_fwd(P p0) {
    extern __shared__ __attribute__((aligned(16))) unsigned char lds[];
    const int G = gridDim.x, bx_hw = blockIdx.x;
    volatile LAS unsigned* MISC = (volatile LAS unsigned*)((LAS unsigned char*)lds + (LDS_BYTES - 64));
    if (threadIdx.x < 16) MISC[threadIdx.x] = 0u;
    __syncthreads();
    XcdBarrier xbar = xcd_barrier_post((unsigned*)(p0.ws + WS_BAR + (HI - LO == NPHASE ? 0 : (p0.ph_hi ? p0.ph_hi : LO)) * BAR_REGION), MISC);
    const PeerMap mp0 = peer_map(xbar, MISC);
    const int bx = (mp0.bal && mp0.nx == 8) ? mp0.r * 8 + mp0.rho : bx_hw;
    const int vcu = (G % 8 == 0) ? (bx % 8) * (G / 8) + bx / 8 : bx;
    const bool pstream = mp0.bal && mp0.nx == 8 && mp0.nloc == 32 && G == 256 && !(PROBE_IN & 64);
#define IN(k) (LO <= (k) && (k) < HI)
#define SEAM(k) do { if constexpr (IN(k) && IN((k) + 1)) { xcd_barrier(xbar); } } while (0)
    PG8_LAS unsigned char* glds = (PG8_LAS unsigned char*)lds;
    typedef pg8::EpiBf16<0> EB;
    if constexpr (IN(0)) { P p = p0; asm volatile("" : "+s"(p.ws)); if (p.ph_lo != 1) phase0(p, lds, vcu, G, bx); } SEAM(0);
    if constexpr (IN(1)) { P p = p0; asm volatile("" : "+s"(p.ws));
        const bool tailwg = (G == 256) && bx >= 80, tail_first = tailwg && (((bx - 80) & 3) != 0);
        if (tail_first && !(PROBE_IN & 64)) { tail_prep(p, lds, bx - 80, G - 80, pstream ? NEXP : 2 * NEXP); __syncthreads(); }
        { pg8::Gemm g{WSP(const bf16, WS_H), WSP(const bf16, WS_WIN), T, NIN, DM / 2, 64, 64, (size_t)T * 128, (size_t)NIN * 128}; pg8::StaticOrder S; S.init(T, NIN, G, bx);
          pg8::EpiI8 E{WSP(bf16, WS_PROJ), 0  , WSP(const float, WS_SA), WSP(const float, WS_SB), C_GATE, WSP(unsigned char, WS_G8), 3 * DM, ((const float*)p.b_gate)}; pg8::gemm_phase<pg8::EpiI8, pg8::StaticOrder, true, true, true>(glds, g, S, E); }
#if PROBE_IN & 16384
        if (bx < 64) { struct OneTile : pg8::StaticOrder { __device__ bool next(int i, pg8::Unit& u) const { if (i >= 1) return false; u.pm = c % 32; u.pn = 3; return true; } };
          pg8::Gemm g{WSP(const bf16, WS_H), WSP(const bf16, WS_WIN), T, NIN, DM / 2, 64, 64, (size_t)T * 128, (size_t)NIN * 128}; OneTile S; S.init(T, NIN, G, bx);
          pg8::EpiI8 E{WSP(bf16, WS_ST), 256, WSP(const float, WS_SA), WSP(const float, WS_SB), 1 << 30, nullptr, 0, nullptr}; pg8::gemm_phase<pg8::EpiI8, OneTile, true, true, true>(glds, g, S, E); }
#endif
#if PROBE_IN & 32
        { struct SameTile : pg8::StaticOrder { __device__ bool next(int i, pg8::Unit& u) const { if (i >= 7) return false; u.pm = c % 8; u.pn = 0; return true; } };
          pg8::Gemm g{WSP(const bf16, WS_H), WSP(const bf16, WS_WIN), T, NIN, DM / 2, DM / 2, DM / 2}; SameTile S; S.init(T, NIN, G, bx);
          pg8::EpiI8 E{WSP(bf16, WS_ST), 256, WSP(const float, WS_SA), WSP(const float, WS_SB), 1 << 30, nullptr, 0, nullptr}; pg8::gemm_phase<pg8::EpiI8, SameTile, true, true, true>(glds, g, S, E); }
#endif
        { pg8::Gemm g{WSP(const bf16, WS_MEMN), WSP(const bf16, WS_WKV), MROWS, 1024, DM, DM, DM}; pg8::StaticOrder S; S.init(MROWS, 1024, G, (bx + G - 64) % G);
          EB E{WSP(bf16, WS_KVM), 1024, nullptr, 0, 0, 1.f}; pg8::gemm_phase<EB, pg8::StaticOrder, true, true>(glds, g, S, E); }
        { pg8::Gemm g{WSP(const bf16, WS_WKV), WSP(const bf16, WS_MEMN), 1024, MROWS, DM, DM, DM}; pg8::StaticOrder S; S.init(1024, MROWS, G, (bx + G - 72) % G);
          EB E{WSP(bf16, WS_KVMT), MROWS, nullptr, 0, 0, 1.f}; pg8::gemm_phase<EB, pg8::StaticOrder, true, true>(glds, g, S, E); }
        if (!(PROBE_IN & 64)) { if (tailwg && !tail_first) tail_prep(p, lds, bx - 80, G - 80, pstream ? NEXP : 2 * NEXP); else if (G != 256) tail_prep(p, lds, bx, G); }
    } SEAM(1);
    if constexpr (IN(2)) { P p = p0; asm volatile("" : "+s"(p.ws));
        if (PROBE_IN & 64) { tail_prep(p, lds, bx, G); __syncthreads(); }
        constexpr int N_DIL = BATCH * DIL_H * 32, N_H1 = BATCH * HG_H * 2 * 64, N_MEM = BATCH * MEM_H * 32;
        { DilRegs R; if (vcu < N_DIL) dil_load(p, vcu, R);
          for (int it = vcu; it < N_DIL; it += G) { DilRegs Rn; const bool more = it + G < N_DIL; if (more) dil_load(p, it + G, Rn); dil_item(p, lds, it, R); if (more) R = Rn; } }
        for (int it = bx; it < N_MEM; it += G) mem_item(p, lds, it);
        { constexpr int N_H1D = BATCH * HG_H * 64;
          unsigned short zf0[16], zb0[16], vc[16]; float lf = 0.f, lb = 0.f; if (bx < N_H1D) h1d_load(p, bx, zf0, zb0, vc, lf, lb);
          for (int it = bx; it < N_H1D; it += G) { unsigned short zf1[16], zb1[16], vn[16]; float lfn = 0.f, lbn = 0.f; const bool more = it + G < N_H1D; if (more) h1d_load(p, it + G, zf1, zb1, vn, lfn, lbn); h1d_item(p, lds, it, zf0, zb0, vc, lf, lb);
              if (more) { lf = lfn; lb = lbn;
#pragma unroll
                  for (int i = 0; i < 16; ++i) { zf0[i] = zf1[i]; zb0[i] = zb1[i]; vc[i] = vn[i]; } } } }
    } SEAM(2);
    if constexpr (IN(3)) { P p = p0; asm volatile("" : "+s"(p.ws)); if (PROBE_IN & 8) h2_scan(p, bx, G, WSP(unsigned char, WS_WIN)); h2_scan(p, bx, G, WSP(unsigned char, WS_ST)); } SEAM(3);
    if constexpr (IN(3) && IN(4)) { if (PROBE_IN & 128) { for (int i = 0; i < 8; ++i) xcd_barrier<!(PROBE_IN & 256), !(PROBE_IN & 512)>(xbar); } }
    if constexpr (IN(4)) { P p = p0; asm volatile("" : "+s"(p.ws)); { constexpr int N_H3 = BATCH * HG_H * 64; unsigned short a0[16], a1[16], a2[16], a3[16]; float lf0 = 0.f, lb0 = 0.f; if (bx < N_H3) { h3_load_z(p, bx, a0, a1, lf0, lb0); h3_load_vq(p, bx, a2, a3); }
          for (int it = bx; it < N_H3; it += G) { unsigned short n0[16], n1[16], n2[16], n3[16]; float lf1 = 0.f, lb1 = 0.f; const bool more = it + G < N_H3; if (more) h3_load_z(p, it + G, n0, n1, lf1, lb1); h3_item(p, lds, it, a0, a1, a2, a3, lf0, lb0, more, it + G, n2, n3);
              if (more) { lf0 = lf1; lb0 = lb1;
#pragma unroll
                  for (int i = 0; i < 16; ++i) { a0[i] = n0[i]; a1[i] = n1[i]; a2[i] = n2[i]; a3[i] = n3[i]; } } } }
        dil_alpha_rows(p, vcu, G); } SEAM(4);
    if constexpr (IN(5)) { P p = p0; asm volatile("" : "+s"(p.ws)); pg8::Gemm g{WSP(const bf16, WS_OCAT), WSP(const bf16, WS_WUP), T, DM, DM, DM, DM}; pg8::StaticOrder S; S.init(T, DM, G, bx);
        pg8::EpiUp E{WSP(const unsigned char, WS_G8), 3 * DM, WSP(bf16, WS_MERGED), 12, 24};
        pg8::gemm_phase<pg8::EpiUp, pg8::StaticOrder, false, true>(glds, g, S, E); } SEAM(5);
    if constexpr (IN(6)) { P p = p0; asm volatile("" : "+s"(p.ws)); pg8::Gemm g{WSP(const bf16, WS_MERGED), WSP(const bf16, WS_WOUT), T, DM, DM, DM, DM}; pg8::StaticOrder S; S.init(T, DM, G, bx);
        pg8::EpiOut E{((const float*)p.x), WSP(bf16, WS_XG), WSP(float, WS_RSP)};
        pg8::gemm_phase<pg8::EpiOut, pg8::StaticOrder, false, true>(glds, g, S, E); } SEAM(6);
    if constexpr (IN(7)) { P p = p0; asm volatile("" : "+s"(p.ws));
        pg8::Gemm g{WSP(const bf16, WS_XG), WSP(const bf16, WS_WQ), T, DM, DM, DM, DM}; pg8::StaticOrder S; S.init(T, DM, G, bx);
        EpiRoute E{WSP(const bf16, WS_SKB), WSP(const float, WS_RSP), WSP(int, WS_IDX), WSP(float, WS_GATE)};
        pg8::gemm_phase<EpiRoute, pg8::StaticOrder, false, true>(glds, g, S, E); } SEAM(7);
    if constexpr (IN(8)) { P p = p0; asm volatile("" : "+s"(p.ws)); const PeerMap mp = mp0; if (PROBE_IN & 1) peer_fused(p, mp, lds, WSP(float, WS_PROJ + 32 * MiB), WSP(float, WS_PROJ + 96 * MiB)); if (pstream) peer_fused_s(p, mp, lds, ((float*)p.dst10), xbar, bx); else peer_fused16(p, mp, lds, ((float*)p.out), ((float*)p.dst10)); }
#undef IN
#undef SEAM
}

#if MK_SPLIT
#define MK_FOR_PH(X) X(0) X(1) X(2) X(3) X(4) X(5) X(6) X(7) X(8)
static bool set_lds() { bool ok = true;
#define X(k) ok = ok && (hipFuncSetAttribute((const void*)mk_fwd<k, k + 1>, hipFuncAttributeMaxDynamicSharedMemorySize, LDS_BYTES) == hipSuccess);
    MK_FOR_PH(X)
#undef X
    return ok; }
static void launch_split(const P& p, int grid, hipStream_t stream) {
#ifndef PROBE_REP
#define PROBE_REP 0
#endif
#define X(k) { P q = p; q.ph_hi = 0; if (k == 0) { q.ph_lo = 0; hipLaunchKernelGGL((mk_fwd<0, 1>), dim3(grid), dim3(NTHR), LDS_BYTES, stream, q); if ((PROBE_REP >> 15) & 1) { q.ph_hi = 15; hipLaunchKernelGGL((mk_fwd<0, 1>), dim3(grid), dim3(NTHR), LDS_BYTES, stream, q); } q.ph_lo = 1; q.ph_hi = 13; } if (((PROBE_REP >> k) & 1)) { P q2 = q; q2.ph_hi = 14; hipLaunchKernelGGL((mk_fwd<k, k + 1>), dim3(grid), dim3(NTHR), LDS_BYTES, stream, q2); } hipLaunchKernelGGL((mk_fwd<k, k + 1>), dim3(grid), dim3(NTHR), LDS_BYTES, stream, q); }
    MK_FOR_PH(X)
#undef X
}
#else
static bool set_lds() { return hipFuncSetAttribute((const void*)mk_fwd<0, NPHASE>, hipFuncAttributeMaxDynamicSharedMemorySize, LDS_BYTES) == hipSuccess; }
#endif

extern "C" void kernel_launch(void* const* d_in, const int* in_sizes, int n_in, void* d_out, int out_size, void* d_ws, size_t ws_size, hipStream_t stream) {
    static int grid = 0;
    if (grid == 0) {
        if (n_in != 18 || out_size != T * DM || ws_size < WS_END) { fprintf(stderr, "kernel_launch: unexpected shapes (n_in %d, out %d, ws %zu)\n", n_in, out_size, ws_size); grid = -1; return; }
        int dev = 0, cus = 0, per_cu = 0;
        (void)hipGetDevice(&dev); (void)hipDeviceGetAttribute(&cus, hipDeviceAttributeMultiprocessorCount, dev);
        if (!set_lds()) { fprintf(stderr, "kernel_launch: hipFuncSetAttribute failed\n"); grid = -1; return; }
        (void)per_cu; (void)hipGetLastError();
        grid = cus;
        if (grid != 256) { fprintf(stderr, "kernel_launch: built for a 256-CU device (one 256x256 GEMM unit per workgroup in the fused-epilogue phases); found %d CUs\n", cus); grid = -1; return; }
    }
    if (grid < 0) return;
    if (hipMemsetAsync((char*)d_ws + WS_BAR, 0, MK_SPLIT ? BAR_ZERO : BAR_REGION, stream) != hipSuccess) { fprintf(stderr, "kernel_launch: memset failed\n"); return; }
    P p{};
    p.x = (const GAS float*)d_in[0]; p.mem = (const GAS float*)d_in[1]; p.g_mix = (const GAS float*)d_in[2]; p.w_in = (const GAS float*)d_in[3]; p.b_gate = (const GAS float*)d_in[4];
    p.lbf_l = (const GAS float*)d_in[5]; p.lbb_l = (const GAS float*)d_in[6]; p.g_hg = (const GAS float*)d_in[7]; p.w_kv = (const GAS float*)d_in[8]; p.g_mem = (const GAS float*)d_in[9];
    p.w_up = (const GAS float*)d_in[10]; p.w_out = (const GAS float*)d_in[11]; p.g_ffn = (const GAS float*)d_in[12]; p.w_q = (const GAS float*)d_in[13]; p.subk = (const GAS float*)d_in[14];
    p.pu = (const GAS float*)d_in[15]; p.pv = (const GAS float*)d_in[16]; p.g_final = (const GAS float*)d_in[17];
    p.out = (GAS float*)d_out; p.dst10 = (GAS float*)d_out; p.ws = (GAS unsigned char*)d_ws;
#if MK_SPLIT
    launch_split(p, grid, stream);
#else
    p.ph_lo = 2; p.ph_hi = NPHASE;
    void* args[] = {&p};
    hipError_t e = hipLaunchCooperativeKernel((const void*)mk_fwd<0, NPHASE>, dim3(grid), dim3(NTHR), args, LDS_BYTES, stream);
    if (e != hipSuccess) fprintf(stderr, "kernel_launch: cooperative launch failed: %s (grid %d)\n", hipGetErrorString(e), grid);
#endif
}
```
